# Optimizing an MI355X kernel written in HIP

```python
import math
import jax, jax.numpy as jnp
from jax import lax
import numpy as np

D_MODEL = 2048
BATCH = 1
SEQ = 8192
DEPTH = 4
DEC_BATCH = 4
DEC_SEQ = 4096
PAST_LEN = 128

GRID_W = 64
Q_BLOCK = 128
ROPE_THETA = 10000.0
EPS = 1e-5
HEAD_DIM = 128
A_HEADS = 6
A_KV_HEADS = 2
A_GROUP = A_HEADS // A_KV_HEADS
B_HEADS = 6
B_Q_RANK = 384
B_KV_RANK = 256
B_NOPE = 128
B_ROPE = 64
B_V = 128
C_HEADS = 4
C_QK = 64
C_V = 2 * C_QK
MIX_WIDTH = A_HEADS * HEAD_DIM + B_HEADS * B_V + C_HEADS * C_V
IN_WIDTHS = (A_HEADS * HEAD_DIM, A_KV_HEADS * HEAD_DIM, A_KV_HEADS * HEAD_DIM,
             B_Q_RANK, B_KV_RANK, B_ROPE,
             C_HEADS * 2 * C_QK, C_HEADS * 2 * C_QK, C_HEADS * C_V)
IN_WIDTH = sum(IN_WIDTHS)
PEER_HEADS = 8
PEER_NKEYS = 128
PEER_EXPERTS = PEER_NKEYS * PEER_NKEYS
PEER_TOPK = 16
PEER_QDIM = 256
PEER_TOK_BLOCK = 128
DN_ALPHA = (2 * DEPTH) ** 0.25
DN_BETA = (8 * DEPTH) ** -0.25

kernel_name = 'hybrid_gqa_mla_diff_peer_encoder'


def rms_norm(x, g):
    xf = x.astype(jnp.float32)
    y = xf * lax.rsqrt(jnp.mean(xf * xf, axis=-1, keepdims=True) + EPS)
    return (y * g.astype(jnp.float32)).astype(x.dtype)


def layer_norm(x, g, b):
    xf = x.astype(jnp.float32)
    mu = jnp.mean(xf, axis=-1, keepdims=True)
    xc = xf - mu
    var = jnp.mean(xc * xc, axis=-1, keepdims=True)
    y = xc * lax.rsqrt(var + EPS) * g.astype(jnp.float32) + b.astype(jnp.float32)
    return y.astype(x.dtype)


def rope(x, pos):
    d = x.shape[-1]
    half = d // 2
    inv = jnp.power(ROPE_THETA, -jnp.arange(half, dtype=jnp.float32) / half)
    ang = pos.astype(jnp.float32)[:, None] * inv[None, :]
    shape = (1, pos.shape[0]) + (1,) * (x.ndim - 3) + (half,)
    cos = jnp.cos(ang).reshape(shape)
    sin = jnp.sin(ang).reshape(shape)
    xf = x.astype(jnp.float32)
    x1, x2 = xf[..., :half], xf[..., half:]
    return jnp.concatenate([x1 * cos - x2 * sin, x2 * cos + x1 * sin], axis=-1).astype(x.dtype)


def rope_axial(x, rows, cols):
    half = x.shape[-1] // 2
    return jnp.concatenate([rope(x[..., :half], rows), rope(x[..., half:], cols)], axis=-1)


def sweep_query_blocks(fn, qs):
    b, s = qs[0].shape[:2]
    nb = s // Q_BLOCK
    blocks = tuple(jnp.moveaxis(q.reshape((b, nb, Q_BLOCK) + q.shape[2:]), 1, 0) for q in qs)
    out = lax.map(fn, blocks)
    return jnp.moveaxis(out, 0, 1).reshape((b, s) + out.shape[3:])


def split_columns(h):
    out, start = [], 0
    for w in IN_WIDTHS:
        out.append(h[..., start:start + w])
        start += w
    return out


def mixer_gqa(q, k, v, qn_g, kn_g, rows, cols):
    b, s, _ = q.shape
    q = rope_axial(rms_norm(q.reshape(b, s, A_HEADS, HEAD_DIM), qn_g), rows, cols)
    k = rope_axial(rms_norm(k.reshape(b, s, A_KV_HEADS, HEAD_DIM), kn_g), rows, cols)
    v = v.reshape(b, s, A_KV_HEADS, HEAD_DIM)
    q = q.reshape(b, s, A_KV_HEADS, A_GROUP, HEAD_DIM)
    scale = HEAD_DIM ** -0.5

    def block(args):
        (qb,) = args
        sc = jnp.einsum('bqhgd,bkhd->bhgqk', qb, k).astype(jnp.float32) * scale
        p = jax.nn.softmax(sc, axis=-1).astype(v.dtype)
        return jnp.einsum('bhgqk,bkhd->bqhgd', p, v)

    o = sweep_query_blocks(block, (q,))
    return o.reshape(b, s, A_HEADS * HEAD_DIM)


def mixer_mla(c_q, c_kv, k_rope, qa_g, kva_g, w_uq, w_ukv, pos):
    b, s, _ = c_q.shape
    qh = (rms_norm(c_q, qa_g) @ w_uq).reshape(b, s, B_HEADS, B_NOPE + B_ROPE)
    q_nope = qh[..., :B_NOPE]
    q_pe = rope(qh[..., B_NOPE:], pos)
    kvh = (rms_norm(c_kv, kva_g) @ w_ukv).reshape(b, s, B_HEADS, B_NOPE + B_V)
    k_nope = kvh[..., :B_NOPE]
    v = kvh[..., B_NOPE:]
    k_pe = rope(k_rope, pos)
    scale = (B_NOPE + B_ROPE) ** -0.5

    def block(args):
        qn, qp = args
        sc = (jnp.einsum('bqhd,bkhd->bhqk', qn, k_nope)
              + jnp.einsum('bqhr,bkr->bhqk', qp, k_pe)).astype(jnp.float32) * scale
        p = jax.nn.softmax(sc, axis=-1).astype(v.dtype)
        return jnp.einsum('bhqk,bkhd->bqhd', p, v)

    o = sweep_query_blocks(block, (q_nope, q_pe))
    return o.reshape(b, s, B_HEADS * B_V)


def mixer_diff(q, k, v, lq1, lk1, lq2, lk2, subln_g, lambda_init, pos):
    b, s, _ = q.shape
    q = rope(q.reshape(b, s, C_HEADS, 2, C_QK), pos)
    k = rope(k.reshape(b, s, C_HEADS, 2, C_QK), pos)
    v = v.reshape(b, s, C_HEADS, C_V)
    f32 = jnp.float32
    lam = (jnp.exp(jnp.sum(lq1.astype(f32) * lk1.astype(f32)))
           - jnp.exp(jnp.sum(lq2.astype(f32) * lk2.astype(f32))) + lambda_init)
    scale = C_QK ** -0.5

    def block(args):
        (qb,) = args
        sc = jnp.einsum('bqhmd,bkhmd->bhmqk', qb, k).astype(f32) * scale
        p = jax.nn.softmax(sc, axis=-1)
        w = (p[:, :, 0] - lam * p[:, :, 1]).astype(v.dtype)
        return jnp.einsum('bhqk,bkhd->bqhd', w, v)

    o = sweep_query_blocks(block, (q,))
    o = rms_norm(o, subln_g) * (1.0 - lambda_init)
    return o.reshape(b, s, C_HEADS * C_V)


def peer_ffn(x, w_query, sub_keys, expert_u, expert_v):
    b, s, d = x.shape
    xt = x.reshape(-1, PEER_TOK_BLOCK, d)
    half = PEER_QDIM // 2

    def block(xb):
        t = xb.shape[0]
        q = (xb @ w_query).reshape(t, PEER_HEADS, 2, half)
        s_sub = jnp.einsum('thmc,mnc->thmn', q, sub_keys).astype(jnp.float32)
        v1, i1 = lax.top_k(s_sub[:, :, 0], PEER_TOPK)
        v2, i2 = lax.top_k(s_sub[:, :, 1], PEER_TOPK)
        cand = (v1[..., :, None] + v2[..., None, :]).reshape(t, PEER_HEADS, PEER_TOPK * PEER_TOPK)
        cand_id = (i1[..., :, None] * PEER_NKEYS + i2[..., None, :]).reshape(t, PEER_HEADS, PEER_TOPK * PEER_TOPK)
        top_s, top_pos = lax.top_k(cand, PEER_TOPK)
        idx = jnp.take_along_axis(cand_id, top_pos, axis=-1)
        g = jax.nn.softmax(top_s, axis=-1)
        u = expert_u[idx]
        act = jax.nn.gelu(jnp.einsum('td,thkd->thk', xb, u).astype(jnp.float32), approximate=False)
        w = (g * act).astype(xb.dtype)
        return jnp.einsum('thk,thkd->td', w, expert_v[idx])

    y = lax.map(block, xt)
    return y.reshape(b, s, d)


def encoder_layer(x, pos, rows, cols, lambda_init, w_in, a_qnorm_g, a_knorm_g, b_qnorm_g, b_kvnorm_g,
                  b_w_uq, b_w_ukv, c_lambda_q1, c_lambda_k1, c_lambda_q2, c_lambda_k2, c_subln_g,
                  w_o, ln1_g, ln1_b, peer_w_query, peer_sub_keys, peer_u, peer_v, ln2_g, ln2_b):
    a_q, a_k, a_v, b_cq, b_ckv, b_kr, c_q, c_k, c_v = split_columns(x @ w_in)
    out_a = mixer_gqa(a_q, a_k, a_v, a_qnorm_g, a_knorm_g, rows, cols)
    out_b = mixer_mla(b_cq, b_ckv, b_kr, b_qnorm_g, b_kvnorm_g, b_w_uq, b_w_ukv, pos)
    out_c = mixer_diff(c_q, c_k, c_v, c_lambda_q1, c_lambda_k1, c_lambda_q2, c_lambda_k2,
                       c_subln_g, lambda_init, pos)
    mix = jnp.concatenate([out_a, out_b, out_c], axis=-1) @ w_o
    x = layer_norm(DN_ALPHA * x + mix, ln1_g, ln1_b)
    x = layer_norm(DN_ALPHA * x + peer_ffn(x, peer_w_query, peer_sub_keys, peer_u, peer_v), ln2_g, ln2_b)
    return x


def trunk(x, w_in, a_qnorm_g, a_knorm_g, b_qnorm_g, b_kvnorm_g, b_w_uq, b_w_ukv,
          c_lambda_q1, c_lambda_k1, c_lambda_q2, c_lambda_k2, c_subln_g, w_o, ln1_g, ln1_b,
          peer_w_query, peer_sub_keys, peer_u, peer_v, ln2_g, ln2_b):
    s = x.shape[1]
    n_rows = s // GRID_W
    pos = jnp.arange(s, dtype=jnp.int32)
    rows = jnp.repeat(jnp.arange(n_rows, dtype=jnp.int32), GRID_W)
    cols = jnp.broadcast_to(jnp.arange(GRID_W, dtype=jnp.int32)[None, :], (n_rows, GRID_W)).reshape(-1)
    for l in range(DEPTH):
        lambda_init = 0.8 - 0.6 * math.exp(-0.3 * l)
        x = encoder_layer(x, pos, rows, cols, lambda_init, w_in[l], a_qnorm_g[l], a_knorm_g[l],
                          b_qnorm_g[l], b_kvnorm_g[l], b_w_uq[l], b_w_ukv[l],
                          c_lambda_q1[l], c_lambda_k1[l], c_lambda_q2[l], c_lambda_k2[l], c_subln_g[l],
                          w_o[l], ln1_g[l], ln1_b[l], peer_w_query[l], peer_sub_keys[l],
                          peer_u[l], peer_v[l], ln2_g[l], ln2_b[l])
    return x


def setup_inputs(seed: int = 0) -> dict:
    key = jax.random.key(seed)
    ks = jax.random.split(key, 24)
    f32 = jnp.float32
    L = DEPTH

    def nrm(k, shape, scale):
        return jax.random.normal(k, shape, f32) * scale

    def gain(k, shape):
        return 1.0 + 0.02 * jax.random.normal(k, shape, f32)

    return {
        'x_prompt': nrm(ks[0], (BATCH, SEQ, D_MODEL), 1.0),
        'x_sample': nrm(ks[1], (DEC_BATCH, DEC_SEQ, D_MODEL), 1.0),
        'w_in': nrm(ks[2], (L, D_MODEL, IN_WIDTH), D_MODEL ** -0.5),
        'a_qnorm_g': gain(ks[3], (L, HEAD_DIM)),
        'a_knorm_g': gain(ks[4], (L, HEAD_DIM)),
        'b_qnorm_g': gain(ks[5], (L, B_Q_RANK)),
        'b_kvnorm_g': gain(ks[6], (L, B_KV_RANK)),
        'b_w_uq': nrm(ks[7], (L, B_Q_RANK, B_HEADS * (B_NOPE + B_ROPE)), B_Q_RANK ** -0.5),
        'b_w_ukv': nrm(ks[8], (L, B_KV_RANK, B_HEADS * (B_NOPE + B_V)), B_KV_RANK ** -0.5),
        'c_lambda_q1': nrm(ks[9], (L, C_QK), 0.1),
        'c_lambda_k1': nrm(ks[10], (L, C_QK), 0.1),
        'c_lambda_q2': nrm(ks[11], (L, C_QK), 0.1),
        'c_lambda_k2': nrm(ks[12], (L, C_QK), 0.1),
        'c_subln_g': gain(ks[13], (L, C_V)),
        'w_o': nrm(ks[14], (L, MIX_WIDTH, D_MODEL), DN_BETA * MIX_WIDTH ** -0.5),
        'ln1_g': gain(ks[15], (L, D_MODEL)),
        'ln1_b': nrm(ks[16], (L, D_MODEL), 0.02),
        'peer_w_query': nrm(ks[17], (L, D_MODEL, PEER_HEADS * PEER_QDIM), D_MODEL ** -0.5),
        'peer_sub_keys': nrm(ks[18], (L, 2, PEER_NKEYS, PEER_QDIM // 2), (PEER_QDIM // 2) ** -0.5),
        'peer_u': nrm(ks[19], (L, PEER_EXPERTS, D_MODEL), D_MODEL ** -0.5),
        'peer_v': nrm(ks[20], (L, PEER_EXPERTS, D_MODEL), DN_BETA * PEER_HEADS ** -0.5),
        'ln2_g': gain(ks[21], (L, D_MODEL)),
        'ln2_b': nrm(ks[22], (L, D_MODEL), 0.02),
    }


def reference(x_prompt, x_sample, w_in, a_qnorm_g, a_knorm_g, b_qnorm_g, b_kvnorm_g, b_w_uq, b_w_ukv,
              c_lambda_q1, c_lambda_k1, c_lambda_q2, c_lambda_k2, c_subln_g, w_o, ln1_g, ln1_b,
              peer_w_query, peer_sub_keys, peer_u, peer_v, ln2_g, ln2_b):
    y_prompt = trunk(x_prompt, w_in, a_qnorm_g, a_knorm_g, b_qnorm_g, b_kvnorm_g, b_w_uq, b_w_ukv,
                     c_lambda_q1, c_lambda_k1, c_lambda_q2, c_lambda_k2, c_subln_g, w_o, ln1_g, ln1_b,
                     peer_w_query, peer_sub_keys, peer_u, peer_v, ln2_g, ln2_b)
    y_sample = trunk(x_sample, w_in, a_qnorm_g, a_knorm_g, b_qnorm_g, b_kvnorm_g, b_w_uq, b_w_ukv,
                     c_lambda_q1, c_lambda_k1, c_lambda_q2, c_lambda_k2, c_subln_g, w_o, ln1_g, ln1_b,
                     peer_w_query, peer_sub_keys, peer_u, peer_v, ln2_g, ln2_b)
    return (y_prompt, y_sample)
```

```cpp
#include <hip/hip_runtime.h>
#include <cstdio>
#include <cstdint>

#ifndef MK_LAUNCH_PER_PHASE
#define MK_LAUNCH_PER_PHASE 0
#endif
#ifndef MK_DBG
#define MK_DBG 0
#endif

constexpr int DM = 2048, TT = 24576, T_PROMPT = 8192, S_SAMPLE = 4096, DEPTH = 4;
constexpr int INW = 3520, INP = 3584;
constexpr int H_AQ = 0, H_AK = 768, H_AV = 1024, H_BCQ = 1280, H_BCKV = 1664, H_BKR = 1920, H_CQ = 1984, H_CK = 2496, H_CV = 3008;
constexpr int BQW = 1152, BQP = 1280, BKVW = 1536, BVW = 768;
constexpr int NEXP = 16384, PEER_H = 8, PEER_K = 16;
constexpr float EPS = 1e-5f;
constexpr float DN_ALPHA = 1.681792830507429f;
constexpr double ROPE_R = 0.7498942093324559;

namespace pg8 {
#define PG8_LAS __attribute__((address_space(3)))
typedef unsigned short bf16_t;
typedef short bf16x8 __attribute__((ext_vector_type(8)));
typedef float f32x4 __attribute__((ext_vector_type(4)));
typedef unsigned u32x4 __attribute__((ext_vector_type(4)));
constexpr int BM = 256, BK = 64, HALF = 128, HTB = HALF * BK * 2  , STAGE_BYTES = 8 * HTB, NXCD = 8, WGM = 8;

__host__ __device__ __forceinline__ int lds_byte(int r, int c) { const int st = (r >> 4) * 2 + (c >> 5), rr = r & 15, cc = c & 31, ob = rr * 64 + cc * 2; return st * 1024 + (ob ^ (((ob >> 9) & 1) << 5)); }
__host__ __device__ __forceinline__ void stage_rc(int b, int& R, int& C) { const int st = b / 1024, sb = b % 1024, swz = sb ^ (((sb >> 9) & 1) << 5); R = (st >> 1) * 16 + swz / 64; C = (st & 1) * 32 + (swz % 64) / 2; }
__host__ __device__ __forceinline__ int perm32(int rho) { const int n = rho >> 4, i = rho & 15; return 8 * (i >> 2) + 4 * n + (i & 3); }

struct Unit { int pm, pn; };
struct Gemm { const bf16_t* A; const bf16_t* Bt; int M, N, K, lda, ldb; };

struct StaticOrder {
    int nM, nN, nwg, G, c;
    __host__ __device__ void init(int M, int N, int G_, int c_) { nM = M / BM; nN = N / BM; nwg = nM * nN; G = G_; c = c_; }
    __host__ __device__ bool next(int i, Unit& u) const {
        const long L = (long)i * G + c; if (L >= nwg) return false;
        int wgid = (int)L; { const int q = nwg / NXCD, r = nwg % NXCD, xcd = wgid % NXCD, off = wgid / NXCD; wgid = (xcd < r ? xcd * (q + 1) : r * (q + 1) + (xcd - r) * q) + off; }
        const int nig = WGM * nN, gid = wgid / nig, fm = gid * WGM, gsz = (nM - fm) < WGM ? (nM - fm) : WGM;
        u.pm = fm + ((wgid % nig) % gsz); u.pn = (wgid % nig) / gsz; return true;
    }
    __device__ __forceinline__ void a_ready(const Unit&) const {}
    __device__ __forceinline__ void done(const Unit&) const {}
};

__device__ __forceinline__ unsigned cvt_pk_bf16(float lo, float hi) { unsigned r; asm volatile("v_cvt_pk_bf16_f32 %0, %1, %2" : "=v"(r) : "v"(lo), "v"(hi)); return r; }
template <class F> struct EpiRow8 {
    static constexpr bool PERM = true, AFTER_DRAIN = false; F f;
    __device__ __forceinline__ void operator()(const f32x4 (&acc)[2][2][4][2], const Unit& u, int wr, int wc, int fr, int fq) const {
        const int row0 = u.pm * BM + wr * 64 + fr, col0 = u.pn * BM + wc * 32 + 8 * fq;
#pragma unroll
        for (int ai = 0; ai < 2; ++ai)
#pragma unroll
            for (int m = 0; m < 4; ++m)
#pragma unroll
                for (int bj = 0; bj < 2; ++bj) { f(row0 + ai * HALF + m * 16, col0 + bj * HALF, acc[ai][bj][m][0], acc[ai][bj][m][1]); asm volatile("" ::: "memory"); }
    }
};
template <class Epi, class Sched, bool ALIGN_EPI = false, bool SP2 = false>
__device__ __forceinline__ void gemm_phase(PG8_LAS unsigned char* lds, const Gemm g, const Sched& S, const Epi& E) {
    int tid_ = threadIdx.x; asm volatile("" : "+v"(tid_));
    const int tid = tid_, wid = __builtin_amdgcn_readfirstlane(tid >> 6), lane = tid & 63, wr = wid >> 2, wc = wid & 3, fr = lane & 15, fq = lane >> 4;
    const int K = g.K, nt = K / BK;
    unsigned voffA[2], voffB[2];
#pragma unroll
    for (int i = 0; i < 2; ++i) { int R, C; stage_rc(tid * 16 + i * 8192, R, C); const int Rb = Epi::PERM ? ((R & ~31) + perm32(R & 31)) : R;
        voffA[i] = (unsigned)(R * g.lda + C) * 2u; voffB[i] = (unsigned)(Rb * g.ldb + C) * 2u; }
    const size_t kstep = (size_t)(BK * 2);
    const size_t hstepA = (size_t)HALF * g.lda * 2, hstepB = (size_t)HALF * g.ldb * 2;
    const size_t tstepA = 2 * hstepA, tstepB = 2 * hstepB;
    const unsigned ldsw = (unsigned)wid * 1024u;
    const int aoff = lds_byte(wr * 64 + fr, fq * 8), boff = lds_byte(wc * 32 + fr, fq * 8);
#define PG8_SA(b, h) (((b) * 2 + (h)) * HTB)
#define PG8_SB(b, h) ((4 + (b) * 2 + (h)) * HTB)
#define PG8_STAGE(bufoff, gbase, voff) do { _Pragma("unroll") for (int _i = 0; _i < 2; ++_i) \
        __builtin_amdgcn_global_load_lds((const unsigned*)((const char*)(gbase) + (voff)[_i]), (PG8_LAS unsigned*)(lds + (bufoff) + ldsw + _i * 8192), 16, 0, 0); } while (0)
#define PG8_LDA(dst, b, h) do { _Pragma("unroll") for (int m = 0; m < 4; ++m) _Pragma("unroll") for (int k = 0; k < 2; ++k) dst[m][k] = *(const PG8_LAS bf16x8*)(lds + PG8_SA(b, h) + aoff + m * 2048 + k * 1024); } while (0)
#define PG8_LDB(dst, b, h) do { _Pragma("unroll") for (int n = 0; n < 2; ++n) _Pragma("unroll") for (int k = 0; k < 2; ++k) dst[n][k] = *(const PG8_LAS bf16x8*)(lds + PG8_SB(b, h) + boff + n * 2048 + k * 1024); } while (0)
#define PG8_MMA(ai, bj, At, Bt) do { __builtin_amdgcn_s_setprio(1); _Pragma("unroll") for (int m = 0; m < 4; ++m) _Pragma("unroll") for (int n = 0; n < 2; ++n) _Pragma("unroll") for (int k = 0; k < 2; ++k) \
        acc[ai][bj][m][n] = __builtin_amdgcn_mfma_f32_16x16x32_bf16(Bt[n][k], At[m][k], acc[ai][bj][m][n], 0, 0, 0); __builtin_amdgcn_s_setprio(0); } while (0)
#define PG8_WAIT_V(n) asm volatile("s_waitcnt vmcnt(" #n ")" ::: "memory")
#define PG8_WAIT_L(n) asm volatile("s_waitcnt lgkmcnt(" #n ")" ::: "memory")
#define PG8_BAR __builtin_amdgcn_s_barrier()
#define PG8_SCHED __builtin_amdgcn_sched_barrier(0)
    Unit cur, nxt; int ui = 0;
    if (!S.next(0, cur)) return;
    f32x4 acc[2][2][4][2];
#pragma unroll
    for (int a = 0; a < 2; ++a)
#pragma unroll
        for (int b = 0; b < 2; ++b)
#pragma unroll
            for (int m = 0; m < 4; ++m)
#pragma unroll
                for (int n = 0; n < 2; ++n) acc[a][b][m][n] = (f32x4){0.f, 0.f, 0.f, 0.f};
    bf16x8 At[4][2], B0[2][2], B1[2][2];
    const char* cA = (const char*)g.A + (size_t)cur.pm * tstepA; const char* cB = (const char*)g.Bt + (size_t)cur.pn * tstepB;
    S.a_ready(cur);
    if constexpr (SP2) {
        PG8_STAGE(PG8_SB(0, 0), cB, voffB); PG8_STAGE(PG8_SB(0, 1), cB + hstepB, voffB); PG8_STAGE(PG8_SA(0, 0), cA, voffA); PG8_STAGE(PG8_SA(0, 1), cA + hstepA, voffA);
        if (wr == 1) PG8_BAR;
        PG8_WAIT_V(2); PG8_BAR;
        PG8_STAGE(PG8_SB(1, 0), cB + kstep, voffB); PG8_STAGE(PG8_SA(1, 0), cA + kstep, voffA); PG8_STAGE(PG8_SB(1, 1), cB + hstepB + kstep, voffB);
        PG8_WAIT_V(6); PG8_BAR;
    } else {
        PG8_STAGE(PG8_SB(0, 0), cB, voffB); PG8_STAGE(PG8_SA(0, 0), cA, voffA); PG8_STAGE(PG8_SB(0, 1), cB + hstepB, voffB); PG8_STAGE(PG8_SA(0, 1), cA + hstepA, voffA);
        if (wr == 1) PG8_BAR;
        PG8_WAIT_V(4); PG8_BAR;
        PG8_STAGE(PG8_SB(1, 0), cB + kstep, voffB); PG8_STAGE(PG8_SA(1, 0), cA + kstep, voffA); PG8_STAGE(PG8_SB(1, 1), cB + hstepB + kstep, voffB);
        PG8_WAIT_V(6); PG8_BAR;
    }
    for (;;) {
        const bool has_next = S.next(ui + 1, nxt);
        const char* nA = has_next ? (const char*)g.A + (size_t)nxt.pm * tstepA : cA; const char* nB = has_next ? (const char*)g.Bt + (size_t)nxt.pn * tstepB : cB;
        for (int t = 0; t < nt; t += 2) {
            const bool last = (t == nt - 2);
            const char* a1 = cA + (size_t)(t + 1) * kstep;
            const char* a2 = last ? nA : cA + (size_t)(t + 2) * kstep; const char* b2 = last ? nB : cB + (size_t)(t + 2) * kstep;
            const char* a3 = a2 + kstep; const char* b3 = b2 + kstep;
            if (last && has_next) S.a_ready(nxt);
            if constexpr (SP2) {
            PG8_LDB(B0, 0, 0); PG8_LDB(B1, 0, 1); PG8_SCHED; PG8_LDA(At, 0, 0); PG8_STAGE(PG8_SA(1, 1), a1 + hstepA, voffA);
            PG8_WAIT_V(8); PG8_WAIT_L(0); PG8_BAR; PG8_MMA(0, 0, At, B0); PG8_MMA(0, 1, At, B1); PG8_BAR; PG8_SCHED;
            PG8_LDA(At, 0, 1); PG8_STAGE(PG8_SB(0, 0), b2, voffB); PG8_STAGE(PG8_SB(0, 1), b2 + hstepB, voffB); PG8_STAGE(PG8_SA(0, 0), a2, voffA);
            PG8_WAIT_V(8); PG8_WAIT_L(0); PG8_BAR; PG8_MMA(1, 0, At, B0); PG8_MMA(1, 1, At, B1); PG8_BAR; PG8_SCHED;
            PG8_LDB(B0, 1, 0); PG8_LDB(B1, 1, 1); PG8_SCHED; PG8_LDA(At, 1, 0); PG8_STAGE(PG8_SA(0, 1), a2 + hstepA, voffA);
            PG8_WAIT_V(8); PG8_WAIT_L(0); PG8_BAR; PG8_MMA(0, 0, At, B0); PG8_MMA(0, 1, At, B1); PG8_BAR; PG8_SCHED;
            PG8_LDA(At, 1, 1); PG8_STAGE(PG8_SB(1, 0), b3, voffB); PG8_STAGE(PG8_SB(1, 1), b3 + hstepB, voffB); PG8_STAGE(PG8_SA(1, 0), a3, voffA);
            PG8_WAIT_V(8); PG8_WAIT_L(0); PG8_BAR; PG8_MMA(1, 0, At, B0); PG8_MMA(1, 1, At, B1); PG8_BAR; PG8_SCHED;
            } else {
            PG8_LDB(B0, 0, 0); PG8_SCHED; PG8_LDA(At, 0, 0); PG8_STAGE(PG8_SA(1, 1), a1 + hstepA, voffA);
            PG8_WAIT_L(8); PG8_BAR; PG8_WAIT_L(0); PG8_MMA(0, 0, At, B0); PG8_BAR; PG8_SCHED;
            PG8_LDB(B1, 0, 1); PG8_STAGE(PG8_SB(0, 0), b2, voffB);
            PG8_BAR; PG8_WAIT_L(0); PG8_MMA(0, 1, At, B1); PG8_BAR;
            PG8_LDA(At, 0, 1); PG8_STAGE(PG8_SA(0, 0), a2, voffA);
            PG8_BAR; PG8_WAIT_L(0); PG8_MMA(1, 0, At, B0); PG8_BAR; PG8_SCHED;
            PG8_STAGE(PG8_SB(0, 1), b2 + hstepB, voffB);
            PG8_WAIT_V(6); PG8_BAR; PG8_MMA(1, 1, At, B1); PG8_BAR;
            PG8_LDB(B0, 1, 0); PG8_SCHED; PG8_LDA(At, 1, 0); PG8_STAGE(PG8_SA(0, 1), a2 + hstepA, voffA);
            PG8_WAIT_L(8); PG8_BAR; PG8_WAIT_L(0); PG8_MMA(0, 0, At, B0); PG8_BAR; PG8_SCHED;
            PG8_LDB(B1, 1, 1); PG8_STAGE(PG8_SB(1, 0), b3, voffB);
            PG8_BAR; PG8_WAIT_L(0); PG8_MMA(0, 1, At, B1); PG8_BAR;
            PG8_LDA(At, 1, 1); PG8_STAGE(PG8_SA(1, 0), a3, voffA);
            PG8_BAR; PG8_WAIT_L(0); PG8_MMA(1, 0, At, B0); PG8_BAR; PG8_SCHED;
            PG8_STAGE(PG8_SB(1, 1), b3 + hstepB, voffB);
            PG8_WAIT_V(6); PG8_BAR; PG8_MMA(1, 1, At, B1); PG8_BAR;
            }
        }
        if constexpr (ALIGN_EPI) { if (wr == 0) PG8_BAR; }
        if constexpr (!Epi::AFTER_DRAIN) { E(acc, cur, wr, wc, fr, fq); S.done(cur); }
        if (!has_next) break;
#pragma unroll
        for (int a = 0; a < 2; ++a)
#pragma unroll
            for (int b = 0; b < 2; ++b)
#pragma unroll
                for (int m = 0; m < 4; ++m)
#pragma unroll
                    for (int n = 0; n < 2; ++n) acc[a][b][m][n] = (f32x4){0.f, 0.f, 0.f, 0.f};
        cur = nxt; cA = nA; cB = nB; ++ui;
        if constexpr (ALIGN_EPI) { if (wr == 1) PG8_BAR; }
    }
    PG8_WAIT_V(0);
    if constexpr (!ALIGN_EPI) { if (wr == 0) PG8_BAR; }
    PG8_BAR;
    if constexpr (Epi::AFTER_DRAIN) { E.fused(acc, cur, wr, wc, fr, fq, lds, wid, lane); S.done(cur); }
#undef PG8_SA
#undef PG8_SB
#undef PG8_STAGE
#undef PG8_LDA
#undef PG8_LDB
#undef PG8_MMA
#undef PG8_WAIT_V
#undef PG8_WAIT_L
#undef PG8_BAR
#undef PG8_SCHED
}
}

namespace att {
using pg8::bf16_t;
using bf16x8 = __attribute__((ext_vector_type(8))) short;
using s16x4  = __attribute__((ext_vector_type(4))) short;
using f32x16 = __attribute__((ext_vector_type(16))) float;
using u32x4  = __attribute__((ext_vector_type(4))) unsigned;
using f32x4_t = __attribute__((ext_vector_type(4))) float;
constexpr int NW = 8, QBLK = 32, KVBLK = 64, DV = 128;
constexpr int SHM_V = KVBLK * DV * 2;
#define ATT_SBAR() __builtin_amdgcn_sched_barrier(0)
__device__ __forceinline__ int crow(int r, int hi) { return (r & 3) + 8 * (r >> 2) + 4 * hi; }
__device__ __forceinline__ unsigned cvtpk(float lo, float hi) { unsigned r; asm volatile("v_cvt_pk_bf16_f32 %0, %1, %2" : "=v"(r) : "v"(lo), "v"(hi)); return r; }
constexpr float THR = 8.f;

template <int DQK> struct Cfg {
  static constexpr int KROW = DQK * 2 + 16;
  static constexpr int SHM_K = KVBLK * KROW;
  static constexpr int NCH = DQK / 8;
  static constexpr int KPT = DQK / 64;
  static constexpr int ND0 = DQK / 16;
  static constexpr int LDS_BYTES = 2 * SHM_V + 2 * SHM_K + NW * 64 * 4;
};

__device__ __forceinline__ void partialSM(f32x16& p0, f32x16& p1, float& m_reg, float& mn, float& alpha, const float C, const float thr_raw) {
  float pmax = p0[0];
#pragma unroll
  for (int r = 1; r < 16; ++r) pmax = fmaxf(pmax, p0[r]);
#pragma unroll
  for (int r = 0; r < 16; ++r) pmax = fmaxf(pmax, p1[r]);
  { auto rr = __builtin_amdgcn_permlane32_swap(__float_as_uint(pmax), __float_as_uint(pmax), false, false);
    pmax = fmaxf(__uint_as_float(rr[0]), __uint_as_float(rr[1])); }
  if (__builtin_expect(__all(pmax - m_reg <= thr_raw), 1)) { mn = m_reg; alpha = 1.f; }
  else { mn = fmaxf(m_reg, pmax); alpha = __builtin_amdgcn_exp2f((m_reg - mn) * C); m_reg = mn; }
  float mnC = -mn * C;
#pragma unroll
  for (int r = 0; r < 16; ++r) p0[r] = fmaf(p0[r], C, mnC);
#pragma unroll
  for (int r = 0; r < 16; ++r) p1[r] = fmaf(p1[r], C, mnC);
#pragma unroll
  for (int r = 0; r < 16; ++r) p0[r] = __builtin_amdgcn_exp2f(p0[r]);
}
__device__ __forceinline__ void finishSM(f32x16& p0, f32x16& p1, float alpha, float& l_reg, bf16x8& pa0, bf16x8& pa1, bf16x8& pa2, bf16x8& pa3) {
#pragma unroll
  for (int r = 0; r < 16; ++r) p1[r] = __builtin_amdgcn_exp2f(p1[r]);
  float ps = 0;
#pragma unroll
  for (int r = 0; r < 16; ++r) ps += p0[r];
#pragma unroll
  for (int r = 0; r < 16; ++r) ps += p1[r];
  { auto rr = __builtin_amdgcn_permlane32_swap(__float_as_uint(ps), __float_as_uint(ps), false, false);
    ps = __uint_as_float(rr[0]) + __uint_as_float(rr[1]); }
  l_reg = l_reg * alpha + ps;
#define ATT_PK4(P, BASE, OUT) do { unsigned a0 = cvtpk(P[BASE + 0], P[BASE + 1]), a1 = cvtpk(P[BASE + 2], P[BASE + 3]);   \
    unsigned b0 = cvtpk(P[BASE + 4], P[BASE + 5]), b1 = cvtpk(P[BASE + 6], P[BASE + 7]);                              \
    auto r0 = __builtin_amdgcn_permlane32_swap(a0, b0, false, false); auto r1 = __builtin_amdgcn_permlane32_swap(a1, b1, false, false); \
    u32x4 w = {r0[0], r1[0], r0[1], r1[1]}; OUT = *reinterpret_cast<bf16x8*>(&w); } while (0)
  ATT_PK4(p0, 0, pa0); ATT_PK4(p0, 8, pa1); ATT_PK4(p1, 0, pa2); ATT_PK4(p1, 8, pa3);
#undef ATT_PK4
}
template <int DQK> __device__ __forceinline__ void qkt(f32x16& p0, f32x16& p1, const char* Ks, const bf16x8* qr, int r32, int hi) {
  constexpr int KROW = Cfg<DQK>::KROW;
  p0 = f32x16{}; p1 = f32x16{};
#pragma unroll
  for (int d0 = 0; d0 < DQK / 16; ++d0) { const int cb = (d0 * 16 + hi * 8) * 2;
    bf16x8 b0 = *reinterpret_cast<const bf16x8*>(Ks + r32 * KROW + cb);
    bf16x8 b1 = *reinterpret_cast<const bf16x8*>(Ks + (32 + r32) * KROW + cb);
    p0 = __builtin_amdgcn_mfma_f32_32x32x16_bf16(b0, qr[d0], p0, 0, 0, 0);
    p1 = __builtin_amdgcn_mfma_f32_32x32x16_bf16(b1, qr[d0], p1, 0, 0, 0); }
}
__device__ __forceinline__ int v_st(int k, int c) { const int kk = (k & ~0xC) | ((k & 4) << 1) | ((k & 8) >> 1); return ((kk >> 3) * 4 + (c >> 5)) * 512 + ((kk & 7) * 32 + (c & 31)) * 2; }
__device__ __forceinline__ int v_rd_base(int lane) { return ((lane & 3) << 3) | (((lane >> 2) & 3) << 6) | (((lane >> 4) & 1) << 5) | (((lane >> 5) & 1) << 8); }
constexpr int v_rd_off(int d0, int ks, int half) { return d0 * 512 + ks * 4096 + half * 2048; }
template <int OFF> __device__ __forceinline__ s16x4 tr_read(int vb) {
  s16x4 r; asm volatile("ds_read_b64_tr_b16 %0, %1 offset:%2" : "=&v"(r) : "v"(vb), "i"(OFF) : "memory"); return r;
}
template <int D0> __device__ __forceinline__ void pv_one(f32x16& od, int vb, bf16x8 pa0, bf16x8 pa1, bf16x8 pa2, bf16x8 pa3) {
  const s16x4 l0 = tr_read<v_rd_off(D0, 0, 0)>(vb), h0 = tr_read<v_rd_off(D0, 0, 1)>(vb), l1 = tr_read<v_rd_off(D0, 1, 0)>(vb), h1 = tr_read<v_rd_off(D0, 1, 1)>(vb);
  const s16x4 l2 = tr_read<v_rd_off(D0, 2, 0)>(vb), h2 = tr_read<v_rd_off(D0, 2, 1)>(vb), l3 = tr_read<v_rd_off(D0, 3, 0)>(vb), h3 = tr_read<v_rd_off(D0, 3, 1)>(vb);
  asm volatile("s_waitcnt lgkmcnt(0)" ::: "memory"); ATT_SBAR();
#define ATT_PK(L, H) (bf16x8){L[0], L[1], L[2], L[3], H[0], H[1], H[2], H[3]}
  od = __builtin_amdgcn_mfma_f32_32x32x16_bf16(pa0, ATT_PK(l0, h0), od, 0, 0, 0);
  od = __builtin_amdgcn_mfma_f32_32x32x16_bf16(pa1, ATT_PK(l1, h1), od, 0, 0, 0);
  od = __builtin_amdgcn_mfma_f32_32x32x16_bf16(pa2, ATT_PK(l2, h2), od, 0, 0, 0);
  od = __builtin_amdgcn_mfma_f32_32x32x16_bf16(pa3, ATT_PK(l3, h3), od, 0, 0, 0);
#undef ATT_PK
}
__device__ __forceinline__ void pv_d0(f32x16* o, int vb, bf16x8 pa0, bf16x8 pa1, bf16x8 pa2, bf16x8 pa3) {
  pv_one<0>(o[0], vb, pa0, pa1, pa2, pa3); pv_one<1>(o[1], vb, pa0, pa1, pa2, pa3); pv_one<2>(o[2], vb, pa0, pa1, pa2, pa3); pv_one<3>(o[3], vb, pa0, pa1, pa2, pa3);
}

struct OutArgs { bf16_t* Ob; int LDO; float* stash; float lam, post; const float* g; };

template <int DQK, int LDQ, int LDK, int LDV, int MODE, bool SIMPLE = false>
__device__ __forceinline__ void attn_body(const bf16_t* __restrict__ Qb, const bf16_t* __restrict__ Kh, const bf16_t* __restrict__ Vh,
                                          int seq, float scale, const OutArgs& oa, char* lds) {
  using CF = Cfg<DQK>;
  constexpr int KPT = CF::KPT, NCH = CF::NCH, ND0 = CF::ND0, SHM_K = CF::SHM_K, KROW = CF::KROW;
  const float C = scale * 1.4426950408889634f, thr_raw = THR / scale;
  int tid_ = threadIdx.x; asm volatile("" : "+v"(tid_));
  const int tid = tid_, wid = tid >> 6, lane = tid & 63, r32 = lane & 31, hi = lane >> 5;
  char* V_lds = lds; char* K_lds = lds + 2 * SHM_V;
  float* ws = (float*)(lds + 2 * SHM_V + 2 * SHM_K) + wid * 64; float* li_l = ws; float* al_l = ws + 32;
  float m_reg = -1e30f, l_reg = 0; f32x16 o[4] = {}; bf16x8 qr[ND0];
  const bf16_t* Qw = Qb + (long)(wid * QBLK + r32) * LDQ + hi * 8;
#pragma unroll
  for (int d0 = 0; d0 < ND0; ++d0) qr[d0] = *reinterpret_cast<const bf16x8*>(Qw + d0 * 16);
  const int sr = tid >> 4, sc = (tid & 15) * 8, vst0 = v_st(sr, sc), vst1 = v_st(32 + sr, sc);
  int kgo[KPT], klo[KPT];
#pragma unroll
  for (int i = 0; i < KPT; ++i) { const int c = tid + 512 * i, row = c / NCH, ch = c % NCH; kgo[i] = row * LDK + ch * 8; klo[i] = row * KROW + ch * 16; }
  const int vb0 = (int)(uintptr_t)V_lds + v_rd_base(lane);
  struct Slot { bf16x8 vs0, vs1; bf16x8 ks[KPT]; };
  Slot s0_, s1_;
#define ATT_SLOAD(S, k0) do { (S).vs0 = *reinterpret_cast<const bf16x8*>(&Vh[(long)((k0) + sr) * LDV + sc]); (S).vs1 = *reinterpret_cast<const bf16x8*>(&Vh[(long)((k0) + 32 + sr) * LDV + sc]); \
    _Pragma("unroll") for (int _i = 0; _i < KPT; ++_i) (S).ks[_i] = *reinterpret_cast<const bf16x8*>(&Kh[(long)(k0) * LDK + kgo[_i]]); } while (0)
#define ATT_SWRITE(b, S) do { *(bf16x8*)(V_lds + (b) * SHM_V + vst0) = (S).vs0; *(bf16x8*)(V_lds + (b) * SHM_V + vst1) = (S).vs1; \
    _Pragma("unroll") for (int _i = 0; _i < KPT; ++_i) *(bf16x8*)(K_lds + (b) * SHM_K + klo[_i]) = (S).ks[_i]; } while (0)
#define ATT_SWAIT() asm volatile("s_waitcnt vmcnt(%0)" :: "n"(2 + KPT) : "memory")
#define ATT_RESC(a) do { if (__any((a) < 1.f)) { if (hi == 0) al_l[r32] = (a); asm volatile("s_waitcnt lgkmcnt(0)" ::: "memory"); \
    _Pragma("unroll") for (int d = 0; d < 4; ++d) _Pragma("unroll") for (int r = 0; r < 16; ++r) o[d][r] *= al_l[crow(r, hi)]; } } while (0)
  bf16x8 pa0, pa1, pa2, pa3; const int NT = seq / KVBLK;
  if constexpr (SIMPLE) {
    f32x16 p0, p1; float mn, al;
    ATT_SLOAD(s0_, 0); asm volatile("s_waitcnt vmcnt(0)" ::: "memory"); ATT_SWRITE(0, s0_); ATT_SLOAD(s0_, KVBLK); __syncthreads();
    for (int j = 0; j < NT; ++j) { const int b = j & 1;
      ATT_SBAR(); qkt<DQK>(p0, p1, K_lds + b * SHM_K, qr, r32, hi);
      partialSM(p0, p1, m_reg, mn, al, C, thr_raw); ATT_RESC(al);
      finishSM(p0, p1, al, l_reg, pa0, pa1, pa2, pa3); ATT_SBAR();
      pv_d0(o, vb0 + b * SHM_V, pa0, pa1, pa2, pa3); ATT_SBAR();
      if (j + 1 < NT) { asm volatile("s_waitcnt vmcnt(0)" ::: "memory"); ATT_SWRITE(1 - b, s0_); if (j + 2 < NT) ATT_SLOAD(s0_, (j + 2) * KVBLK); }
      __syncthreads();
    }
  } else {
  f32x16 pA0, pA1, pB0, pB1; float mnA, mnB, alA, alB;
  ATT_SLOAD(s0_, 0); asm volatile("s_waitcnt vmcnt(0)" ::: "memory"); ATT_SWRITE(0, s0_); __syncthreads();
  qkt<DQK>(pA0, pA1, K_lds, qr, r32, hi); partialSM(pA0, pA1, m_reg, mnA, alA, C, thr_raw);
  ATT_SLOAD(s1_, KVBLK); if (2 < NT) ATT_SLOAD(s0_, 2 * KVBLK);
  ATT_SWAIT(); ATT_SWRITE(1, s1_); __syncthreads();
  for (int j = 1; j + 1 < NT; j += 2) {
    ATT_SBAR(); qkt<DQK>(pB0, pB1, K_lds + SHM_K, qr, r32, hi);
    finishSM(pA0, pA1, alA, l_reg, pa0, pa1, pa2, pa3); ATT_SBAR();
    ATT_SLOAD(s1_, (j + 2) * KVBLK); ATT_SBAR();
    pv_d0(o, vb0, pa0, pa1, pa2, pa3); partialSM(pB0, pB1, m_reg, mnB, alB, C, thr_raw);
    __syncthreads(); ATT_SWAIT(); ATT_SWRITE(0, s0_);
    ATT_RESC(alB); __syncthreads();
    ATT_SBAR(); qkt<DQK>(pA0, pA1, K_lds, qr, r32, hi);
    finishSM(pB0, pB1, alB, l_reg, pa0, pa1, pa2, pa3); ATT_SBAR();
    if (j + 3 < NT) ATT_SLOAD(s0_, (j + 3) * KVBLK); ATT_SBAR();
    pv_d0(o, vb0 + SHM_V, pa0, pa1, pa2, pa3); partialSM(pA0, pA1, m_reg, mnA, alA, C, thr_raw);
    __syncthreads(); ATT_SWAIT(); ATT_SWRITE(1, s1_);
    ATT_RESC(alA); __syncthreads();
  }
  ATT_SBAR(); qkt<DQK>(pB0, pB1, K_lds + SHM_K, qr, r32, hi);
  finishSM(pA0, pA1, alA, l_reg, pa0, pa1, pa2, pa3); ATT_SBAR();
  pv_d0(o, vb0, pa0, pa1, pa2, pa3); partialSM(pB0, pB1, m_reg, mnB, alB, C, thr_raw);
  __syncthreads(); ATT_RESC(alB);
  finishSM(pB0, pB1, alB, l_reg, pa0, pa1, pa2, pa3); ATT_SBAR();
  pv_d0(o, vb0 + SHM_V, pa0, pa1, pa2, pa3);
  }
  if (hi == 0) li_l[r32] = l_reg; asm volatile("s_waitcnt lgkmcnt(0)" ::: "memory");
  float rli[16];
#pragma unroll
  for (int r = 0; r < 16; ++r) rli[r] = __builtin_amdgcn_rcpf(li_l[crow(r, hi)]);
  __syncthreads();
  float* Ot = (float*)(lds + wid * 16384);
#pragma unroll
  for (int r = 0; r < 16; ++r) { const int orow = crow(r, hi);
#pragma unroll
    for (int d0 = 0; d0 < 4; ++d0) Ot[orow * 128 + d0 * 32 + r32] = o[d0][r] * rli[r]; }
  asm volatile("s_waitcnt lgkmcnt(0)" ::: "memory");
  const int er = lane >> 4, ec = (lane & 15) * 8;
  if constexpr (MODE == 0) {
    bf16_t* Ow = oa.Ob + (long)(wid * QBLK + er) * oa.LDO + ec;
#pragma unroll
    for (int k = 0; k < 8; ++k) { const float* sp = Ot + (4 * k + er) * 128 + ec; const f32x4_t a = *(const f32x4_t*)sp, b = *(const f32x4_t*)(sp + 4);
      *(u32x4*)(Ow + (long)(4 * k) * oa.LDO) = (u32x4){cvtpk(a[0], a[1]), cvtpk(a[2], a[3]), cvtpk(b[0], b[1]), cvtpk(b[2], b[3])}; }
  } else if constexpr (MODE == 1) {
    float* Sw = oa.stash + (wid * QBLK + er) * 128 + ec;
#pragma unroll
    for (int k = 0; k < 8; ++k) { const float* sp = Ot + (4 * k + er) * 128 + ec; const f32x4_t a = *(const f32x4_t*)sp, b = *(const f32x4_t*)(sp + 4);
      *(f32x4_t*)(Sw + 4 * k * 128) = a; *(f32x4_t*)(Sw + 4 * k * 128 + 4) = b; }
  } else {
    const float* Sw = oa.stash + (wid * QBLK + er) * 128 + ec; bf16_t* Ow = oa.Ob + (long)(wid * QBLK + er) * oa.LDO + ec;
    const f32x4_t g0 = *(const f32x4_t*)(oa.g + ec) * oa.post, g1 = *(const f32x4_t*)(oa.g + ec + 4) * oa.post;
#pragma unroll
    for (int k = 0; k < 8; ++k) { asm volatile("" ::: "memory"); const float* sp = Ot + (4 * k + er) * 128 + ec; f32x4_t a = *(const f32x4_t*)sp, b = *(const f32x4_t*)(sp + 4);
      a = *(const f32x4_t*)(Sw + 4 * k * 128) - oa.lam * a; b = *(const f32x4_t*)(Sw + 4 * k * 128 + 4) - oa.lam * b;
      float ss = (a[0] * a[0] + a[1] * a[1]) + (a[2] * a[2] + a[3] * a[3]) + (b[0] * b[0] + b[1] * b[1]) + (b[2] * b[2] + b[3] * b[3]);
      ss += __shfl_xor(ss, 1); ss += __shfl_xor(ss, 2); ss += __shfl_xor(ss, 4); ss += __shfl_xor(ss, 8);
      const float rn = 1.0f / sqrtf(ss * (1.0f / 128.0f) + EPS);
      a = a * rn * g0; b = b * rn * g1;
      *(u32x4*)(Ow + (long)(4 * k) * oa.LDO) = (u32x4){cvtpk(a[0], a[1]), cvtpk(a[2], a[3]), cvtpk(b[0], b[1]), cvtpk(b[2], b[3])}; }
  }
  __syncthreads();
#undef ATT_SLOAD
#undef ATT_SWRITE
#undef ATT_SWAIT
#undef ATT_RESC
}

template <int DQK, int LDQ, int LDK, int LDV, int MODE>
__device__ __forceinline__ void attn_body2(const bf16_t* __restrict__ Qb, const bf16_t* __restrict__ Kh, const bf16_t* __restrict__ Vh,
                                           int seq, float scale, const OutArgs& oa, char* lds, __attribute__((address_space(3))) unsigned char* ldsl) {
  using CF = Cfg<DQK>;
  constexpr int ND0 = CF::ND0, SHM_K = CF::SHM_K, KROW = CF::KROW, SLOT = SHM_K + SHM_V, KCH = SHM_K / 1024, NKI = (KCH + 7) / 8;
  static_assert(SHM_K % 1024 == 0 && 3 * SLOT + NW * 256 <= 131072, "attention LDS ring");
  const float C = scale * 1.4426950408889634f, thr_raw = THR / scale;
  int tid_ = threadIdx.x; asm volatile("" : "+v"(tid_));
  const int tid = tid_, wid = __builtin_amdgcn_readfirstlane(tid >> 6), lane = tid & 63, r32 = lane & 31, hi = lane >> 5;
  float* ws = (float*)(lds + 3 * SLOT) + wid * 64; float* li_l = ws; float* al_l = ws + 32;
  float m_reg = -1e30f, l_reg = 0; f32x16 o[4] = {}; bf16x8 qr[ND0];
  int ksrc[NKI], vsrc[2];
#pragma unroll
  for (int i = 0; i < NKI; ++i) { const int ob = (wid + 8 * i) * 1024 + lane * 16, row = ob / KROW, within = ob - row * KROW; ksrc[i] = (row < KVBLK ? row : 0) * LDK + (within < 2 * DQK ? within / 2 : 0); }
#pragma unroll
  for (int i = 0; i < 2; ++i) { const int gi = (2 * wid + i) * 64 + lane, c8 = (gi & 3) | (((gi >> 5) & 3) << 2), kk = ((gi >> 2) & 7) | ((gi >> 7) << 3), k = (kk & ~0xC) | ((kk & 4) << 1) | ((kk & 8) >> 1); vsrc[i] = k * LDV + c8 * 8; }
#define ATT_GLDS(g, l) __builtin_amdgcn_global_load_lds((const unsigned*)(g), (__attribute__((address_space(3))) unsigned*)(l), 16, 0, 0)
#define ATT_DMA(k0, s) do { __attribute__((address_space(3))) unsigned char* _kb = ldsl + (s) * SLOT; \
    _Pragma("unroll") for (int _i = 0; _i < NKI; ++_i) { if (wid + 8 * _i < KCH) ATT_GLDS(Kh + (long)(k0) * LDK + ksrc[_i], _kb + (wid + 8 * _i) * 1024); } \
    _Pragma("unroll") for (int _i = 0; _i < 2; ++_i) ATT_GLDS(Vh + (long)(k0) * LDV + vsrc[_i], _kb + SHM_K + (2 * wid + _i) * 1024); } while (0)
#define ATT_BAR() do { asm volatile("s_waitcnt vmcnt(0) lgkmcnt(0)" ::: "memory"); __builtin_amdgcn_s_barrier(); asm volatile("" ::: "memory"); } while (0)
#define ATT_RESC2(a) do { if (__any((a) < 1.f)) { if (hi == 0) al_l[r32] = (a); asm volatile("s_waitcnt lgkmcnt(0)" ::: "memory"); \
    _Pragma("unroll") for (int d = 0; d < 4; ++d) _Pragma("unroll") for (int r = 0; r < 16; ++r) o[d][r] *= al_l[crow(r, hi)]; } } while (0)
  const int NT = seq / KVBLK;
  ATT_DMA(0, 0); ATT_DMA(KVBLK, 1);
  const bf16_t* Qw = Qb + (long)(wid * QBLK + r32) * LDQ + hi * 8;
#pragma unroll
  for (int d0 = 0; d0 < ND0; ++d0) qr[d0] = *reinterpret_cast<const bf16x8*>(Qw + d0 * 16);
  ATT_BAR();
  const int vb0 = (int)(uintptr_t)lds + SHM_K + v_rd_base(lane);
  f32x16 pA0, pA1, pB0, pB1; float mnA, mnB, alA, alB; bf16x8 pa0, pa1, pa2, pa3;
  qkt<DQK>(pA0, pA1, lds, qr, r32, hi); partialSM(pA0, pA1, m_reg, mnA, alA, C, thr_raw);
  if (2 < NT) ATT_DMA(2 * KVBLK, 2);
  int sj = 1, sp = 0;
  for (int j = 1; j + 1 < NT; j += 2) {
    ATT_SBAR(); qkt<DQK>(pB0, pB1, lds + sj * SLOT, qr, r32, hi);
    finishSM(pA0, pA1, alA, l_reg, pa0, pa1, pa2, pa3); ATT_SBAR();
    pv_d0(o, vb0 + sp * SLOT, pa0, pa1, pa2, pa3); partialSM(pB0, pB1, m_reg, mnB, alB, C, thr_raw);
    ATT_BAR();
    if (j + 2 < NT) ATT_DMA((j + 2) * KVBLK, sp);
    ATT_RESC2(alB);
    { const int t = sp; sp = sj; sj = (sj == 2) ? 0 : sj + 1; (void)t; }
    ATT_SBAR(); qkt<DQK>(pA0, pA1, lds + sj * SLOT, qr, r32, hi);
    finishSM(pB0, pB1, alB, l_reg, pa0, pa1, pa2, pa3); ATT_SBAR();
    pv_d0(o, vb0 + sp * SLOT, pa0, pa1, pa2, pa3); partialSM(pA0, pA1, m_reg, mnA, alA, C, thr_raw);
    ATT_BAR();
    if (j + 3 < NT) ATT_DMA((j + 3) * KVBLK, sp);
    ATT_RESC2(alA);
    { sp = sj; sj = (sj == 2) ? 0 : sj + 1; }
  }
  ATT_SBAR(); qkt<DQK>(pB0, pB1, lds + sj * SLOT, qr, r32, hi);
  finishSM(pA0, pA1, alA, l_reg, pa0, pa1, pa2, pa3); ATT_SBAR();
  pv_d0(o, vb0 + sp * SLOT, pa0, pa1, pa2, pa3); partialSM(pB0, pB1, m_reg, mnB, alB, C, thr_raw);
  ATT_RESC2(alB);
  finishSM(pB0, pB1, alB, l_reg, pa0, pa1, pa2, pa3); ATT_SBAR();
  pv_d0(o, vb0 + sj * SLOT, pa0, pa1, pa2, pa3);
  if (hi == 0) li_l[r32] = l_reg; asm volatile("s_waitcnt lgkmcnt(0)" ::: "memory");
  float rli[16];
#pragma unroll
  for (int r = 0; r < 16; ++r) rli[r] = __builtin_amdgcn_rcpf(li_l[crow(r, hi)]);
  ATT_BAR();
  float* Ot = (float*)(lds + wid * 16384);
#pragma unroll
  for (int r = 0; r < 16; ++r) { const int orow = crow(r, hi);
#pragma unroll
    for (int d0 = 0; d0 < 4; ++d0) Ot[orow * 128 + d0 * 32 + r32] = o[d0][r] * rli[r]; }
  asm volatile("s_waitcnt lgkmcnt(0)" ::: "memory");
  const int er = lane >> 4, ec = (lane & 15) * 8;
  if constexpr (MODE == 0) {
    bf16_t* Ow = oa.Ob + (long)(wid * QBLK + er) * oa.LDO + ec;
#pragma unroll
    for (int k = 0; k < 8; ++k) { const float* sp2 = Ot + (4 * k + er) * 128 + ec; const f32x4_t a = *(const f32x4_t*)sp2, b = *(const f32x4_t*)(sp2 + 4);
      *(u32x4*)(Ow + (long)(4 * k) * oa.LDO) = (u32x4){cvtpk(a[0], a[1]), cvtpk(a[2], a[3]), cvtpk(b[0], b[1]), cvtpk(b[2], b[3])}; }
  } else if constexpr (MODE == 1) {
    float* Sw = oa.stash + (wid * QBLK + er) * 128 + ec;
#pragma unroll
    for (int k = 0; k < 8; ++k) { const float* sp2 = Ot + (4 * k + er) * 128 + ec; const f32x4_t a = *(const f32x4_t*)sp2, b = *(const f32x4_t*)(sp2 + 4);
      *(f32x4_t*)(Sw + 4 * k * 128) = a; *(f32x4_t*)(Sw + 4 * k * 128 + 4) = b; }
  } else {
    const float* Sw = oa.stash + (wid * QBLK + er) * 128 + ec; bf16_t* Ow = oa.Ob + (long)(wid * QBLK + er) * oa.LDO + ec;
    const f32x4_t g0 = *(const f32x4_t*)(oa.g + ec) * oa.post, g1 = *(const f32x4_t*)(oa.g + ec + 4) * oa.post;
#pragma unroll
    for (int k = 0; k < 8; ++k) { asm volatile("" ::: "memory"); const float* sp2 = Ot + (4 * k + er) * 128 + ec; f32x4_t a = *(const f32x4_t*)sp2, b = *(const f32x4_t*)(sp2 + 4);
      a = *(const f32x4_t*)(Sw + 4 * k * 128) - oa.lam * a; b = *(const f32x4_t*)(Sw + 4 * k * 128 + 4) - oa.lam * b;
      float ss = (a[0] * a[0] + a[1] * a[1]) + (a[2] * a[2] + a[3] * a[3]) + (b[0] * b[0] + b[1] * b[1]) + (b[2] * b[2] + b[3] * b[3]);
      ss += __shfl_xor(ss, 1); ss += __shfl_xor(ss, 2); ss += __shfl_xor(ss, 4); ss += __shfl_xor(ss, 8);
      const float rn = 1.0f / sqrtf(ss * (1.0f / 128.0f) + EPS);
      a = a * rn * g0; b = b * rn * g1;
      *(u32x4*)(Ow + (long)(4 * k) * oa.LDO) = (u32x4){cvtpk(a[0], a[1]), cvtpk(a[2], a[3]), cvtpk(b[0], b[1]), cvtpk(b[2], b[3])}; }
  }
  ATT_BAR();
#undef ATT_GLDS
#undef ATT_DMA
#undef ATT_BAR
#undef ATT_RESC2
}
}

#define GAS __attribute__((address_space(1)))
#define LAS __attribute__((address_space(3)))
typedef unsigned short bf16;
typedef unsigned v4u __attribute__((ext_vector_type(4)));
typedef unsigned v2u __attribute__((ext_vector_type(2)));
typedef float f32x4 __attribute__((ext_vector_type(4)));
typedef float f32x2 __attribute__((ext_vector_type(2)));
typedef __bf16 bf16x2_t __attribute__((ext_vector_type(2)));
typedef GAS unsigned gu32;
#define RLX_AGENT __ATOMIC_RELAXED, __HIP_MEMORY_SCOPE_AGENT
#define LDS_WAIT() asm volatile("s_waitcnt lgkmcnt(0)" ::: "memory")
#define VM_WAIT() asm volatile("s_waitcnt vmcnt(0)" ::: "memory")
__device__ __forceinline__ unsigned pk2(float lo, float hi) { unsigned r; asm volatile("v_cvt_pk_bf16_f32 %0, %1, %2" : "=v"(r) : "v"(lo), "v"(hi)); return r; }
__device__ __forceinline__ float bflo(unsigned w) { return __uint_as_float(w << 16); }
__device__ __forceinline__ float bfhi(unsigned w) { return __uint_as_float(w & 0xffff0000u); }
__device__ __forceinline__ float dot2bf(unsigned a, unsigned b, float acc) { return __builtin_amdgcn_fdot2_f32_bf16(__builtin_bit_cast(bf16x2_t, a), __builtin_bit_cast(bf16x2_t, b), acc, false); }
__device__ __forceinline__ float wave_sum(float v) {
#pragma unroll
    for (int o = 1; o < 64; o <<= 1) v += __shfl_xor(v, o);
    return v;
}

#define XB_TMO      128
#define XB_XCNT(j)  (256  + 64 * (j))
#define XB_XSUB(j)  (1280 + 64 * (j))
#define XB_XGEN(j)  (2304 + 64 * (j))
#define XB_TOP      3328
#define XB_TOPGEN   3392
#define XCD_BAR_WORDS 3456
#define XB_SPIN_CAP (1u << 18)

__device__ __forceinline__ unsigned xb_ld(unsigned* p)              { return __hip_atomic_load(p, __ATOMIC_RELAXED, __HIP_MEMORY_SCOPE_AGENT); }
__device__ __forceinline__ unsigned xb_add(unsigned* p, unsigned v) { return __hip_atomic_fetch_add(p, v, __ATOMIC_RELAXED, __HIP_MEMORY_SCOPE_AGENT); }
__device__ __forceinline__ unsigned xb_xcc_id() { return (unsigned)__builtin_amdgcn_s_getreg((3 << 11) | 20) & 0xFu; }
#define XB_SPIN(cond, bar) do { unsigned _sp = 0; while (cond) { __builtin_amdgcn_s_sleep(1); \
    if ((++_sp & 255u) == 0u) { if (xb_ld(&(bar)[XB_TMO])) break; if (_sp > XB_SPIN_CAP) { atomicAdd(&(bar)[XB_TMO], 1u); break; } } } } while (0)

struct XcdBarrier {
    unsigned* bar; unsigned x;
    volatile LAS unsigned* st;
};

__device__ __forceinline__ XcdBarrier xcd_barrier_post(unsigned* bar, volatile LAS unsigned* st) {
    XcdBarrier b; b.bar = bar; b.x = xb_xcc_id(); b.st = st;
    if (threadIdx.x == 0) (void)xb_add(&bar[XB_XCNT(b.x)], 1u);
    return b;
}
__device__ __forceinline__ void xcd_barrier_complete(unsigned* bar, unsigned x, unsigned& nloc, unsigned& nx) {
    const unsigned G = gridDim.x * gridDim.y * gridDim.z;
    unsigned sum, cnt, mine, sp = 0u;
    for (;;) {
        sum = 0u; cnt = 0u; mine = 0u;
#pragma unroll
        for (unsigned j = 0; j < 16; ++j) { const unsigned c = xb_ld(&bar[XB_XCNT(j)]); sum += c; cnt += (c > 0u) ? 1u : 0u; mine = (j == x) ? c : mine; }
        if (sum == G) break;
        __builtin_amdgcn_s_sleep(1);
        if ((++sp & 255u) == 0u) { if (xb_ld(&bar[XB_TMO])) break; if (sp > XB_SPIN_CAP) { atomicAdd(&bar[XB_TMO], 1u); break; } }
    }
    nloc = mine > 0u ? mine : 1u; nx = cnt > 0u ? cnt : 1u;
}

__device__ __forceinline__ void xcd_barrier(const XcdBarrier& b) {
    asm volatile("s_waitcnt vmcnt(0)" ::: "memory");
    __syncthreads();
    if (threadIdx.x == 0) {
        unsigned* bar = b.bar;
        __builtin_amdgcn_s_waitcnt(0);
        unsigned nloc = b.st[0], nx = b.st[1];
        if (nloc == 0u) { xcd_barrier_complete(bar, b.x, nloc, nx); b.st[0] = nloc; b.st[1] = nx; }
        const unsigned old = xb_add(&bar[XB_XSUB(b.x)], 1u);
        const unsigned gen = old / nloc;
        if (old + 1u == (gen + 1u) * nloc) {
            __builtin_amdgcn_fence(__ATOMIC_RELEASE, "agent");
            asm volatile("s_waitcnt vmcnt(0)" ::: "memory");
            const unsigned og = xb_add(&bar[XB_TOP], 1u);
            const unsigned tg = og / nx;
            if (og + 1u == (tg + 1u) * nx) xb_add(&bar[XB_TOPGEN], 1u);
            else XB_SPIN(xb_ld(&bar[XB_TOPGEN]) == tg, bar);
            __builtin_amdgcn_fence(__ATOMIC_ACQUIRE, "agent");
            xb_add(&bar[XB_XGEN(b.x)], 1u);
            asm volatile("s_waitcnt vmcnt(0)" ::: "memory");
        } else {
            XB_SPIN(xb_ld(&bar[XB_XGEN(b.x)]) == gen, bar);
            __builtin_amdgcn_fence(__ATOMIC_ACQUIRE, "agent");
            asm volatile("s_waitcnt vmcnt(0)" ::: "memory");
        }
    }
    __syncthreads();
}


constexpr size_t MiB = 1u << 20;
constexpr size_t WS_CTL = 0, CTL_BYTES = 1 * MiB;
constexpr size_t WS_ROPE = 1 * MiB;
constexpr size_t WS_WIN = 4 * MiB;
constexpr size_t WS_WUQ = 60 * MiB;
constexpr size_t WS_WUKV = 64 * MiB;
constexpr size_t WS_WO = 68 * MiB;
constexpr size_t WS_WQ = 100 * MiB;
constexpr size_t WS_SUBK = 132 * MiB;
constexpr size_t WS_U = 134 * MiB;
constexpr size_t WS_V = 262 * MiB;
constexpr size_t WS_USC = 390 * MiB, WS_VSC = 391 * MiB;
constexpr size_t WS_X = 646 * MiB;
constexpr size_t WS_X1 = 742 * MiB;
constexpr size_t WS_H = 838 * MiB;
constexpr size_t WS_BQ = 1006 * MiB;
constexpr size_t WS_BK = 1060 * MiB;
constexpr size_t WS_BV = 1114 * MiB;
constexpr size_t WS_AO = 1150 * MiB;
constexpr size_t WS_Y = 1246 * MiB;
constexpr size_t WS_SKD = 1438 * MiB;
constexpr size_t WS_WQS = 1470 * MiB;
constexpr size_t WQS_LAYER = (size_t)2048 * 2048 + 2048;
constexpr size_t WS_STASH = 1534 * MiB;
constexpr size_t WS_EID = 518 * MiB, WS_GATEV = 530 * MiB, WS_USCT = 542 * MiB, WS_WT = 554 * MiB;
constexpr size_t WS_X8 = 566 * MiB;
constexpr size_t WS_XS = 614 * MiB;
constexpr size_t WS_PD = 1566 * MiB;
constexpr size_t WS_END = 1758 * MiB;
#if MK_DBG
constexpr size_t WS_SC = WS_END, WS_NEED = WS_END + 192 * MiB;
#else
constexpr size_t WS_SC = WS_Y, WS_NEED = WS_END;
#endif
constexpr int CW_BAR = 4096;
constexpr int CW_QUEUE = 8192;
constexpr int CW_SQ = 12288;
constexpr int CW_DBG = 16384;

constexpr int RING_BYTES = 131072;
constexpr int MISC_OFF = RING_BYTES;
constexpr int LDS_BYTES = 147456;

struct Args { const float* in[23]; float* out; unsigned char* ws; int ph_lo, ph_hi; };

struct Frame {
    LAS unsigned char* lds; char* lds_g;
    gu32* ctl; unsigned char* ws;
    int tid, lane, wave, gw, ngw;
};

template <int MODE> __device__ __forceinline__ int rowmap(int n) {
    if (MODE == 0) return n;
    const int head = n / 192, w = n - head * 192; if (w < 128) return n;
    const int e = w - 128, s = e >> 5, f = e & 31; return head * 192 + 128 + 2 * f + s;
}
template <int MODE> __device__ __forceinline__ void transpose_item(const float* W, int K, int N, bf16* WT, LAS float* scr, int item, int lane) {
    const int nblk = N / 32, kb = item / nblk, nb = item % nblk, k0 = 64 * kb, n0 = 32 * nb;
#pragma unroll 8
    for (int i = 0; i < 32; ++i) { const int kk = 2 * i + (lane >> 5); scr[kk * 33 + (lane & 31)] = W[(size_t)(k0 + kk) * N + n0 + (lane & 31)]; }
    LDS_WAIT(); asm volatile("" ::: "memory");
    const int c = lane & 7;
#pragma unroll
    for (int j = 0; j < 4; ++j) { const int n = (lane >> 3) + 8 * j; const LAS float* s = scr + (8 * c) * 33 + n;
        v4u o; o.x = pk2(s[0 * 33], s[1 * 33]); o.y = pk2(s[2 * 33], s[3 * 33]); o.z = pk2(s[4 * 33], s[5 * 33]); o.w = pk2(s[6 * 33], s[7 * 33]);
        *(v4u*)(WT + (size_t)rowmap<MODE>(n0 + n) * K + k0 + 8 * c) = o; }
    LDS_WAIT(); asm volatile("" ::: "memory");
}
__device__ __forceinline__ void sincos_d(double a, float& c, float& s) {
    const double q = __builtin_rint(a * 0.6366197723675814); const double y = a - q * 1.5707963267948966 - q * 6.123233995736766e-17;
    const double y2 = y * y;
    double sp = -7.647163731819816e-13; sp = sp * y2 + 1.6059043836821613e-10; sp = sp * y2 - 2.505210838544172e-08; sp = sp * y2 + 2.7557319223985893e-06;
    sp = sp * y2 - 1.984126984126984e-04; sp = sp * y2 + 8.333333333333333e-03; sp = sp * y2 - 1.6666666666666666e-01; sp = y + y * y2 * sp;
    double cp = 4.779477332387385e-14; cp = cp * y2 - 1.1470745597729725e-11; cp = cp * y2 + 2.08767569878681e-09; cp = cp * y2 - 2.755731922398589e-07;
    cp = cp * y2 + 2.48015873015873e-05; cp = cp * y2 - 1.388888888888889e-03; cp = cp * y2 + 4.1666666666666664e-02; cp = cp * y2 - 0.5; cp = 1.0 + y2 * cp;
    const int qi = (int)((long long)q & 3);
    const double sv = (qi & 1) ? cp : sp, cv = (qi & 1) ? sp : cp;
    s = (float)((qi & 2) ? -sv : sv); c = (float)(((qi + 1) & 2) ? -cv : cv);
}
__device__ __forceinline__ void p0_prologue(Frame& F, const Args& A) {
    LAS float* scr = (LAS float*)(F.lds + F.wave * 16384);
    constexpr int I_IN = 32 * 110, I_UQ = 6 * 36, I_UKV = 4 * 48, I_O = 32 * 64, I_L = I_IN + I_UQ + I_UKV + I_O;
    for (int it = F.gw; it < DEPTH * I_L; it += F.ngw) {
        const int l = it / I_L; int r = it - l * I_L;
        if (r < I_IN) { transpose_item<0>(A.in[2] + (size_t)l * DM * INW, DM, INW, (bf16*)(F.ws + WS_WIN) + (size_t)l * INP * DM, scr, r, F.lane); continue; } r -= I_IN;
        if (r < I_UQ) { transpose_item<1>(A.in[7] + (size_t)l * 384 * BQW, 384, BQW, (bf16*)(F.ws + WS_WUQ) + (size_t)l * BQP * 384, scr, r, F.lane); continue; } r -= I_UQ;
        if (r < I_UKV) { transpose_item<0>(A.in[8] + (size_t)l * 256 * BKVW, 256, BKVW, (bf16*)(F.ws + WS_WUKV) + (size_t)l * BKVW * 256, scr, r, F.lane); continue; } r -= I_UKV;
        transpose_item<0>(A.in[14] + (size_t)l * DM * DM, DM, DM, (bf16*)(F.ws + WS_WO) + (size_t)l * DM * DM, scr, r, F.lane);
    }
    const size_t gt = (size_t)blockIdx.x * 512 + F.tid, ngt = (size_t)gridDim.x * 512;
    for (size_t i = gt; i < (size_t)DEPTH * 64 * DM / 8; i += ngt) { const size_t l = i / (64 * DM / 8), o = i % (64 * DM / 8);
        *(v4u*)((bf16*)(F.ws + WS_WIN) + (l * INP + INW) * DM + o * 8) = (v4u){0u, 0u, 0u, 0u}; }
    for (size_t i = gt; i < (size_t)DEPTH * 128 * 384 / 8; i += ngt) { const size_t l = i / (128 * 384 / 8), o = i % (128 * 384 / 8);
        *(v4u*)((bf16*)(F.ws + WS_WUQ) + (l * BQP + BQW) * 384 + o * 8) = (v4u){0u, 0u, 0u, 0u}; }
    for (size_t i = gt; i < (size_t)DEPTH * DM * DM / 8; i += ngt) { const float* sp = A.in[17] + i * 8; const f32x4 a = *(const f32x4*)sp, b = *(const f32x4*)(sp + 4);
        *(v4u*)((bf16*)(F.ws + WS_WQ) + i * 8) = (v4u){pk2(a.x, a.y), pk2(a.z, a.w), pk2(b.x, b.y), pk2(b.z, b.w)}; }
    for (size_t i = gt; i < (size_t)DEPTH * DM * DM / 8; i += ngt) { const size_t l = i / (DM * DM / 8), o = i % (DM * DM / 8), r = o / (DM / 8), k = (o % (DM / 8)) * 8;
        v4u w = (v4u){0u, 0u, 0u, 0u};
        if ((r >> 7) == (k >> 7)) { const int m = (int)((r >> 7) & 1); const float* sp = A.in[18] + ((l * 2 + m) * 128 + (r & 127)) * 128 + (k & 127); const f32x4 a = *(const f32x4*)sp, b = *(const f32x4*)(sp + 4);
            w = (v4u){pk2(a.x, a.y), pk2(a.z, a.w), pk2(b.x, b.y), pk2(b.z, b.w)}; }
        *(v4u*)((bf16*)(F.ws + WS_SKD) + (l * DM + r) * DM + k) = w; }
    for (int r = F.gw; r < 2 * DEPTH * NEXP; r += F.ngw) { const int tb = r >= DEPTH * NEXP, rr = tb ? r - DEPTH * NEXP : r;
        const float* src = A.in[19 + tb] + (size_t)rr * DM + F.lane * 32; f32x4 v[8]; float am = 0.f;
#pragma unroll
        for (int j = 0; j < 8; ++j) { v[j] = *(const f32x4*)(src + 4 * j); am = fmaxf(am, fmaxf(fmaxf(fabsf(v[j][0]), fabsf(v[j][1])), fmaxf(fabsf(v[j][2]), fabsf(v[j][3])))); }
#pragma unroll
        for (int o = 1; o < 64; o <<= 1) am = fmaxf(am, __shfl_xor(am, o));
        unsigned w[8]; float sci;
        if (tb) {
            int ex = (int)((__float_as_uint(am) >> 23) & 0xffu) - 126; if (ex < -100 || ex > 100) ex = 0;
            const float sc = __uint_as_float((unsigned)(127 + 7 - ex) << 23); sci = __uint_as_float((unsigned)(127 + ex - 7) << 23);
#pragma unroll
            for (int j = 0; j < 8; ++j) { unsigned q = 0u; q = __builtin_amdgcn_cvt_pk_fp8_f32(v[j][0] * sc, v[j][1] * sc, q, false); q = __builtin_amdgcn_cvt_pk_fp8_f32(v[j][2] * sc, v[j][3] * sc, q, true); w[j] = q; }
        } else {
            const float sc = am > 1e-30f ? 127.0f / am : 0.f; sci = am * (1.0f / 127.0f);
#pragma unroll
            for (int j = 0; j < 8; ++j) { const int q0 = (int)__builtin_rintf(v[j][0] * sc), q1 = (int)__builtin_rintf(v[j][1] * sc), q2 = (int)__builtin_rintf(v[j][2] * sc), q3 = (int)__builtin_rintf(v[j][3] * sc);
                w[j] = (unsigned)(q0 & 0xff) | ((unsigned)(q1 & 0xff) << 8) | ((unsigned)(q2 & 0xff) << 16) | ((unsigned)(q3 & 0xff) << 24); }
        }
        const size_t lyr = (size_t)rr / NEXP, ex_ = (size_t)rr % NEXP;
        unsigned char* dst = F.ws + (tb ? WS_V : WS_U) + lyr * NEXP * DM + (size_t)(F.lane >> 2) * (NEXP * 128) + ex_ * 128 + (F.lane & 3) * 32;
        *(v4u*)dst = (v4u){w[0], w[1], w[2], w[3]}; *(v4u*)(dst + 16) = (v4u){w[4], w[5], w[6], w[7]};
        if (F.lane == 0) ((float*)(F.ws + (tb ? WS_VSC : WS_USC)))[rr] = sci; }
    for (size_t i = gt; i < (size_t)TT * DM / 8; i += ngt) { const size_t np = (size_t)T_PROMPT * DM / 8;
        const float* s = (i < np) ? A.in[0] + i * 8 : A.in[1] + (i - np) * 8; const f32x4 a = *(const f32x4*)s, b = *(const f32x4*)(s + 4);
        *(v4u*)((bf16*)(F.ws + WS_X) + i * 8) = (v4u){pk2(a.x, a.y), pk2(a.z, a.w), pk2(b.x, b.y), pk2(b.z, b.w)}; }
    for (size_t i = gt; i < (size_t)8192 * 32; i += ngt) { const int p = (int)(i >> 5), f = (int)(i & 31); double inv = 1.0; for (int k = 0; k < f; ++k) inv *= ROPE_R;
        float c, s; sincos_d((double)p * inv, c, s); ((f32x2*)(F.ws + WS_ROPE))[i] = (f32x2){c, s}; }
}

__device__ __forceinline__ void tok_seq(int t, int& s0, int& slen, int& pos) {
    if (t < T_PROMPT) { s0 = 0; slen = T_PROMPT; pos = t; } else { const int r = t - T_PROMPT; s0 = T_PROMPT + (r / S_SAMPLE) * S_SAMPLE; slen = S_SAMPLE; pos = r % S_SAMPLE; }
}
#define UNPACK8(W_, X_, O_) do { X_[O_ + 0] = bflo((W_)[0]); X_[O_ + 1] = bfhi((W_)[0]); X_[O_ + 2] = bflo((W_)[1]); X_[O_ + 3] = bfhi((W_)[1]); X_[O_ + 4] = bflo((W_)[2]); X_[O_ + 5] = bfhi((W_)[2]); X_[O_ + 6] = bflo((W_)[3]); X_[O_ + 7] = bfhi((W_)[3]); } while (0)
#define PACK8(X_, O_) ((v4u){pk2(X_[O_ + 0], X_[O_ + 1]), pk2(X_[O_ + 2], X_[O_ + 3]), pk2(X_[O_ + 4], X_[O_ + 5]), pk2(X_[O_ + 6], X_[O_ + 7])})

__device__ __forceinline__ void phase_prep(Frame& F, const Args& A, int l) {
    const float* qn_g = A.in[3] + l * 128; const float* kn_g = A.in[4] + l * 128; const float* qa_g = A.in[5] + l * 384; const float* kva_g = A.in[6] + l * 256;
    const f32x2* rope = (const f32x2*)(F.ws + WS_ROPE);
    bf16* H = (bf16*)(F.ws + WS_H); bf16* BK = (bf16*)(F.ws + WS_BK);
    int tid_ = threadIdx.x; asm volatile("" : "+v"(tid_)); const int lane = tid_ & 63;
    for (int t = F.gw; t < TT; t += F.ngw) {
        int s0, slen, pos; tok_seq(t, s0, slen, pos);
        bf16* hrow = H + (size_t)t * INP;
        {
            const v4u w0 = *(const v4u*)(hrow + lane * 16), w1 = *(const v4u*)(hrow + lane * 16 + 8);
            float x[16]; UNPACK8(w0, x, 0); UNPACK8(w1, x, 8);
            float ss = 0.f;
#pragma unroll
            for (int i = 0; i < 16; ++i) ss += x[i] * x[i];
            ss += __shfl_xor(ss, 1); ss += __shfl_xor(ss, 2); ss += __shfl_xor(ss, 4);
            const float rinv = 1.0f / sqrtf(ss * (1.0f / 128.0f) + EPS);
            const int head = lane >> 3, j = lane & 7; const float* g = (head < 6 ? qn_g : kn_g) + j * 16;
            const int p = (j < 4) ? (pos >> 6) : (pos & 63); const f32x2* tb = rope + p * 32 + (j & 1) * 16; const bool first = (j & 2) == 0;
#pragma unroll
            for (int i = 0; i < 16; ++i) x[i] = x[i] * rinv * g[i];
#pragma unroll
            for (int i = 0; i < 16; ++i) { const float pr = __shfl_xor(x[i], 2); const f32x2 cs = tb[i]; x[i] = first ? x[i] * cs.x - pr * cs.y : x[i] * cs.x + pr * cs.y; }
            *(v4u*)(hrow + lane * 16) = PACK8(x, 0); *(v4u*)(hrow + lane * 16 + 8) = PACK8(x, 8);
        }
        {
            bf16* cp = hrow + H_CQ + lane * 16;
            const v4u w0 = *(const v4u*)cp, w1 = *(const v4u*)(cp + 8);
            float x[16]; UNPACK8(w0, x, 0); UNPACK8(w1, x, 8);
            const int j = lane & 3; const f32x2* tb = rope + pos * 32 + (j & 1) * 16; const bool first = (j & 2) == 0;
#pragma unroll
            for (int i = 0; i < 16; ++i) { const float pr = __shfl_xor(x[i], 2); const f32x2 cs = tb[i]; x[i] = first ? x[i] * cs.x - pr * cs.y : x[i] * cs.x + pr * cs.y; }
            *(v4u*)cp = PACK8(x, 0); *(v4u*)(cp + 8) = PACK8(x, 8);
        }
        {
            float x[8]; v4u w = (v4u){0u, 0u, 0u, 0u};
            if (lane < 48) w = *(const v4u*)(hrow + H_BCQ + lane * 8);
            UNPACK8(w, x, 0); float ss = 0.f;
#pragma unroll
            for (int i = 0; i < 8; ++i) ss += x[i] * x[i];
            ss = wave_sum(ss); float rinv = 1.0f / sqrtf(ss * (1.0f / 384.0f) + EPS);
            if (lane < 48) {
#pragma unroll
                for (int i = 0; i < 8; ++i) x[i] = x[i] * rinv * qa_g[lane * 8 + i];
                *(v4u*)(hrow + H_BCQ + lane * 8) = PACK8(x, 0); }
            w = (v4u){0u, 0u, 0u, 0u};
            if (lane < 32) w = *(const v4u*)(hrow + H_BCKV + lane * 8);
            UNPACK8(w, x, 0); ss = 0.f;
#pragma unroll
            for (int i = 0; i < 8; ++i) ss += x[i] * x[i];
            ss = wave_sum(ss); rinv = 1.0f / sqrtf(ss * (1.0f / 256.0f) + EPS);
            if (lane < 32) {
#pragma unroll
                for (int i = 0; i < 8; ++i) x[i] = x[i] * rinv * kva_g[lane * 8 + i];
                *(v4u*)(hrow + H_BCKV + lane * 8) = PACK8(x, 0); }
            const int l8 = lane & 7;
            w = *(const v4u*)(hrow + H_BKR + l8 * 8); UNPACK8(w, x, 0);
            const f32x2* tb = rope + pos * 32 + (l8 & 3) * 8; const bool first = l8 < 4; float o2[8];
#pragma unroll
            for (int i = 0; i < 8; ++i) { const float pr = __shfl_xor(x[i], 4); const f32x2 cs = tb[i]; x[i] = first ? x[i] * cs.x - pr * cs.y : x[i] * cs.x + pr * cs.y; }
#pragma unroll
            for (int i = 0; i < 8; ++i) o2[i] = __shfl_xor(x[i], 4);
            if (lane < 4) {
                const v4u a = (v4u){pk2(x[0], o2[0]), pk2(x[1], o2[1]), pk2(x[2], o2[2]), pk2(x[3], o2[3])}, b = (v4u){pk2(x[4], o2[4]), pk2(x[5], o2[5]), pk2(x[6], o2[6]), pk2(x[7], o2[7])};
                bf16* kp = BK + (size_t)t * BQW + 128 + lane * 16;
#pragma unroll
                for (int h = 0; h < 6; ++h) { *(v4u*)(kp + h * 192) = a; *(v4u*)(kp + h * 192 + 8) = b; }
            }
        }
    }
}

struct StoreBf16 {
    bf16* O; int ldc, ncols;
    __device__ __forceinline__ void operator()(int row, int col, f32x4 v0, f32x4 v1) const {
        if (col < ncols) *(v4u*)(O + (size_t)row * ldc + col) = (v4u){pk2(v0[0], v0[1]), pk2(v0[2], v0[3]), pk2(v1[0], v1[1]), pk2(v1[2], v1[3])}; }
};
struct StoreF32 {
    float* O; int ldc;
    __device__ __forceinline__ void operator()(int row, int col, f32x4 v0, f32x4 v1) const { float* p = O + (size_t)row * ldc + col; *(f32x4*)p = v0; *(f32x4*)(p + 4) = v1; }
};
struct StoreMlaQ {
    bf16* O; const f32x2* rope;
    __device__ __forceinline__ void operator()(int row, int col, f32x4 v0, f32x4 v1) const {
        if (col >= BQW) return;
        const int w = col % 192;
        if (w >= 128) { int s0, slen, pos; tok_seq(row, s0, slen, pos); const f32x2* tb = rope + pos * 32 + ((w - 128) >> 1);
            const f32x2 c0 = tb[0], c1 = tb[1], c2 = tb[2], c3 = tb[3];
            const f32x4 a = v0, b = v1;
            v0[0] = a[0] * c0.x - a[1] * c0.y; v0[1] = a[1] * c0.x + a[0] * c0.y; v0[2] = a[2] * c1.x - a[3] * c1.y; v0[3] = a[3] * c1.x + a[2] * c1.y;
            v1[0] = b[0] * c2.x - b[1] * c2.y; v1[1] = b[1] * c2.x + b[0] * c2.y; v1[2] = b[2] * c3.x - b[3] * c3.y; v1[3] = b[3] * c3.x + b[2] * c3.y; }
        *(v4u*)(O + (size_t)row * BQW + col) = (v4u){pk2(v0[0], v0[1]), pk2(v0[2], v0[3]), pk2(v1[0], v1[1]), pk2(v1[2], v1[3])}; }
};
struct StoreMlaKV {
    bf16* BK; bf16* BV;
    __device__ __forceinline__ void operator()(int row, int col, f32x4 v0, f32x4 v1) const {
        const int head = col >> 8, w = col & 255; bf16* p = (w < 128) ? BK + (size_t)row * BQW + head * 192 + w : BV + (size_t)row * BVW + head * 128 + (w - 128);
        *(v4u*)p = (v4u){pk2(v0[0], v0[1]), pk2(v0[2], v0[3]), pk2(v1[0], v1[1]), pk2(v1[2], v1[3])}; }
};
struct StoreResid {
    float* Y; const bf16* X;
    __device__ __forceinline__ void operator()(int row, int col, f32x4 v0, f32x4 v1) const {
        const v4u xw = *(const v4u*)(X + (size_t)row * DM + col); float x[8]; UNPACK8(xw, x, 0);
        float* p = Y + (size_t)row * DM + col;
        *(f32x4*)p = (f32x4){DN_ALPHA * x[0] + v0[0], DN_ALPHA * x[1] + v0[1], DN_ALPHA * x[2] + v0[2], DN_ALPHA * x[3] + v0[3]};
        *(f32x4*)(p + 4) = (f32x4){DN_ALPHA * x[4] + v1[0], DN_ALPHA * x[5] + v1[1], DN_ALPHA * x[6] + v1[2], DN_ALPHA * x[7] + v1[3]}; }
};
struct FoldOrder {
    int G, c;
    __device__ __forceinline__ bool next(int i, pg8::Unit& u) const { const int idx = i * G + c; if (idx >= DEPTH * 64) return false; const int l = idx >> 6, r = idx & 63; u.pm = l * 8 + (r >> 3); u.pn = l * 8 + (r & 7); return true; }
    __device__ __forceinline__ void a_ready(const pg8::Unit&) const {}
    __device__ __forceinline__ void done(const pg8::Unit&) const {}
};
template <class F> __device__ __forceinline__ void run_gemm(Frame& Fr, const bf16* Aop, int lda, const bf16* Bt, int M, int N, int K, const F& f) {
    int Kv = K; asm volatile("" : "+s"(Kv));
    pg8::Gemm g{Aop, Bt, M, N, Kv, lda, K}; pg8::StaticOrder S; S.init(M, N, (int)gridDim.x, (int)blockIdx.x);
    pg8::EpiRow8<F> E{f};
    pg8::gemm_phase<pg8::EpiRow8<F>, pg8::StaticOrder, true, true>(Fr.lds, g, S, E);
}

#ifndef ATTN_V2
#define ATTN_V2 1
#endif
#if ATTN_V2
#define ATTN_FN attn_body2
#define ATTN_X
#define ATTN_L , F.lds
#else
#define ATTN_FN attn_body
#define ATTN_X , true
#define ATTN_L
#endif
__device__ __forceinline__ int queue_next(Frame& F, gu32* q) {
    volatile LAS unsigned* W = (volatile LAS unsigned*)(F.lds + MISC_OFF) + 4;
    __syncthreads();
    if (threadIdx.x == 0) W[0] = __hip_atomic_fetch_add(q, 1u, RLX_AGENT);
    __syncthreads();
    return (int)W[0];
}
__device__ __forceinline__ void att_unit(int u, int NH, int& head, int& t0, int& s0, int& slen) {
    if (u < NH * 32) { head = u / 32; s0 = 0; slen = T_PROMPT; t0 = (u % 32) * 256; }
    else { const int v = u - NH * 32, sq = v / (NH * 16), r = v % (NH * 16); head = r / 16; s0 = T_PROMPT + sq * S_SAMPLE; slen = S_SAMPLE; t0 = s0 + (r % 16) * 256; }
}
__device__ __forceinline__ void phase_attn(Frame& F, const Args& A, int l, int rep = 0) {
    const bf16* H = (const bf16*)(F.ws + WS_H); bf16* AO = (bf16*)(F.ws + WS_AO);
    float d1 = 0.f, d2 = 0.f;
    for (int i = 0; i < 64; ++i) { d1 += A.in[9][l * 64 + i] * A.in[10][l * 64 + i]; d2 += A.in[11][l * 64 + i] * A.in[12][l * 64 + i]; }
    const float lam_init = 0.8f - 0.6f * expf(-0.3f * (float)l);
    const float lam = expf(d1) - expf(d2) + lam_init;
#ifndef AT_EN
#define AT_EN 7
#endif
    if (AT_EN & 1) {
        float* stash = (float*)(F.ws + WS_STASH) + (size_t)blockIdx.x * 256 * 128;
        for (;;) { const int u = queue_next(F, F.ctl + CW_QUEUE + 64 * (3 * l + 0) + 16 * rep); if (u >= 4 * 32 + 4 * 4 * 16) break;
            int head, t0, s0, slen; att_unit(u, 4, head, t0, s0, slen);
            att::OutArgs oa{AO + (size_t)t0 * DM + 1536 + head * 128, DM, stash, lam, 1.0f - lam_init, A.in[13] + l * 128};
            att::ATTN_FN<64, INP, INP, INP, 1 ATTN_X>(H + (size_t)t0 * INP + H_CQ + head * 128, H + (size_t)s0 * INP + H_CK + head * 128, H + (size_t)s0 * INP + H_CV + head * 128, slen, 0.125f, oa, F.lds_g ATTN_L);
            att::ATTN_FN<64, INP, INP, INP, 2 ATTN_X>(H + (size_t)t0 * INP + H_CQ + head * 128 + 64, H + (size_t)s0 * INP + H_CK + head * 128 + 64, H + (size_t)s0 * INP + H_CV + head * 128, slen, 0.125f, oa, F.lds_g ATTN_L);
        }
    }
    if (AT_EN & 2) {
        const bf16* BQ = (const bf16*)(F.ws + WS_BQ); const bf16* BK = (const bf16*)(F.ws + WS_BK); const bf16* BV = (const bf16*)(F.ws + WS_BV);
        for (;;) { const int u = queue_next(F, F.ctl + CW_QUEUE + 64 * (3 * l + 1) + 16 * rep); if (u >= 6 * 32 + 4 * 6 * 16) break;
            int head, t0, s0, slen; att_unit(u, 6, head, t0, s0, slen);
            att::OutArgs oa{AO + (size_t)t0 * DM + 768 + head * 128, DM, nullptr, 0.f, 0.f, nullptr};
            att::ATTN_FN<192, BQW, BQW, BVW, 0 ATTN_X>(BQ + (size_t)t0 * BQW + head * 192, BK + (size_t)s0 * BQW + head * 192, BV + (size_t)s0 * BVW + head * 128, slen, 0.07216878364870322f, oa, F.lds_g ATTN_L);
        }
    }
    if (AT_EN & 4) {
        for (;;) { const int u = queue_next(F, F.ctl + CW_QUEUE + 64 * (3 * l + 2) + 16 * rep); if (u >= 6 * 32 + 4 * 6 * 16) break;
            int head, t0, s0, slen; att_unit(u, 6, head, t0, s0, slen); const int kvh = head / 3;
            att::OutArgs oa{AO + (size_t)t0 * DM + head * 128, DM, nullptr, 0.f, 0.f, nullptr};
            att::ATTN_FN<128, INP, INP, INP, 0 ATTN_X>(H + (size_t)t0 * INP + H_AQ + head * 128, H + (size_t)s0 * INP + H_AK + kvh * 128, H + (size_t)s0 * INP + H_AV + kvh * 128, slen, 0.08838834764831845f, oa, F.lds_g ATTN_L);
        }
    }
}

__device__ __forceinline__ void phase_ln1(Frame& F, const Args& A, int l) {
    int tid_ = threadIdx.x; asm volatile("" : "+v"(tid_)); const int lane = tid_ & 63;
    const float* Y = (const float*)(F.ws + WS_Y); bf16* X1 = (bf16*)(F.ws + WS_X1); const float* g = A.in[15] + l * DM; const float* b = A.in[16] + l * DM;
    for (int t = F.gw; t < TT; t += F.ngw) {
        float v[32];
#pragma unroll
        for (int j = 0; j < 4; ++j) { const float* p = Y + (size_t)t * DM + j * 512 + lane * 8; const f32x4 a = *(const f32x4*)p, c = *(const f32x4*)(p + 4);
            v[8 * j] = a[0]; v[8 * j + 1] = a[1]; v[8 * j + 2] = a[2]; v[8 * j + 3] = a[3]; v[8 * j + 4] = c[0]; v[8 * j + 5] = c[1]; v[8 * j + 6] = c[2]; v[8 * j + 7] = c[3]; }
        float s = 0.f;
#pragma unroll
        for (int i = 0; i < 32; ++i) s += v[i];
        const float mean = wave_sum(s) * (1.0f / DM); float q = 0.f;
#pragma unroll
        for (int i = 0; i < 32; ++i) { v[i] -= mean; q += v[i] * v[i]; }
        const float rstd = 1.0f / sqrtf(wave_sum(q) * (1.0f / DM) + EPS);
        float am = 0.f;
#pragma unroll
        for (int j = 0; j < 4; ++j) { const int c0 = j * 512 + lane * 8;
#pragma unroll
            for (int i = 0; i < 8; ++i) { v[8 * j + i] = v[8 * j + i] * rstd * g[c0 + i] + b[c0 + i]; am = fmaxf(am, fabsf(v[8 * j + i])); }
            *(v4u*)(X1 + (size_t)t * DM + c0) = PACK8(v, 8 * j); }
#pragma unroll
        for (int o = 1; o < 64; o <<= 1) am = fmaxf(am, __shfl_xor(am, o));
        const float sc = am > 1e-30f ? 127.0f / am : 0.f;
#pragma unroll
        for (int j = 0; j < 4; ++j) { unsigned q[2];
#pragma unroll
            for (int hh = 0; hh < 2; ++hh) { const int q0 = (int)__builtin_rintf(v[8 * j + 4 * hh] * sc), q1 = (int)__builtin_rintf(v[8 * j + 4 * hh + 1] * sc), q2 = (int)__builtin_rintf(v[8 * j + 4 * hh + 2] * sc), q3 = (int)__builtin_rintf(v[8 * j + 4 * hh + 3] * sc);
                q[hh] = (unsigned)(q0 & 0xff) | ((unsigned)(q1 & 0xff) << 8) | ((unsigned)(q2 & 0xff) << 16) | ((unsigned)(q3 & 0xff) << 24); }
            *(v2u*)(F.ws + WS_X8 + (size_t)t * DM + j * 512 + lane * 8) = (v2u){q[0], q[1]}; }
        if (lane == 0) ((float*)(F.ws + WS_XS))[t] = am * (1.0f / 127.0f);
    }
}

#define PEER_CVT(wd, f0, f1) do { f0 = __builtin_amdgcn_cvt_pk_f32_fp8((int)(wd), false); f1 = __builtin_amdgcn_cvt_pk_f32_fp8((int)(wd), true); } while (0)
#define DPP_STEP8(c, ctrl) do { _Pragma("unroll") for (int _h = 0; _h < 8; ++_h) c[_h] += __builtin_amdgcn_update_dpp(0, c[_h], ctrl, 0xf, 0xf, true); } while (0)
__device__ __forceinline__ void sum32x8(int (&c)[8]) {
    DPP_STEP8(c, 0xB1); DPP_STEP8(c, 0x4E); DPP_STEP8(c, 0x141); DPP_STEP8(c, 0x140);
#pragma unroll
    for (int h = 0; h < 8; ++h) { const auto r = __builtin_amdgcn_permlane16_swap((unsigned)c[h], (unsigned)c[h], false, false); c[h] = (int)(r[0] + r[1]); } }
__device__ __forceinline__ void sum64x8(int (&c)[8]) {
    sum32x8(c);
#pragma unroll
    for (int h = 0; h < 8; ++h) { const auto r = __builtin_amdgcn_permlane32_swap((unsigned)c[h], (unsigned)c[h], false, false); c[h] = (int)(r[0] + r[1]); } }
__device__ __forceinline__ float funkey(unsigned k) { return __uint_as_float((k & 0x80000000u) ? (k ^ 0x80000000u) : ~k); }
__device__ __forceinline__ unsigned fkey(float f) { const unsigned u = __float_as_uint(f); return u ^ ((unsigned)((int)u >> 31) | 0x80000000u); }
#define DPPI(v, ctrl) __builtin_amdgcn_update_dpp(0, (v), (ctrl), 0xf, 0xf, true)
__device__ __forceinline__ void phase_peer_topk(Frame& F, const Args& A, int l) {
    const float* SC = (const float*)(F.ws + WS_SC);
    const float* Usc = (const float*)(F.ws + WS_USC) + l * NEXP; const float* Vsc = (const float*)(F.ws + WS_VSC) + l * NEXP;
    int tid_ = threadIdx.x; asm volatile("" : "+v"(tid_)); const int lane = tid_ & 63;
    LAS float* selv = (LAS float*)(F.lds + F.wave * 16384);
    LAS int* seli = (LAS int*)(F.lds + F.wave * 16384 + 1024);
    LAS int* eid = (LAS int*)(F.lds + F.wave * 16384 + 2048);
    LAS float* gate = (LAS float*)(F.lds + F.wave * 16384 + 2560);
    LAS float* dummy = (LAS float*)(F.lds + F.wave * 16384 + 4096) + lane;
    for (int t = F.gw; t < TT; t += F.ngw) {
        unsigned kk[32];
        {
            const f32x4* sp = (const f32x4*)(SC + (size_t)t * 2048 + lane * 32);
#pragma unroll
            for (int j = 0; j < 8; ++j) { const f32x4 v = sp[j];
#pragma unroll
                for (int c = 0; c < 4; ++c) { kk[4 * j + c] = fkey(v[c]); asm volatile("" : "+v"(kk[4 * j + c])); } }
        }
        unsigned pv = 0u; int na = 128;
#pragma unroll 1
        for (int bit = 31; bit >= 0; --bit) { const unsigned cv = pv | (1u << bit); int c = 0;
#pragma unroll
            for (int i = 0; i < 32; ++i) c += (int)(kk[i] >= cv);
            c += DPPI(c, 0xB1); c += DPPI(c, 0x4E);
            const bool ok = c >= 16; pv = ok ? cv : pv; na = ok ? c : na;
            if (!__any(na != 16)) break; }
        {
            int cl = 0;
#pragma unroll
            for (int i = 0; i < 32; ++i) cl += (int)(kk[i] >= pv);
            const int q = lane & 3; const int c1 = DPPI(cl, 0x90), c2 = DPPI(cl, 0x40), c3 = DPPI(cl, 0x00);
            int pos = (q >= 1 ? c1 : 0) + (q >= 2 ? c2 : 0) + (q >= 3 ? c3 : 0);
            const int lb = (lane >> 2) * 16, ib = q * 32;
#pragma unroll
            for (int i = 0; i < 32; ++i) { const bool f = kk[i] >= pv; const bool w = f && pos < 16;
                LAS float* pvv = w ? selv + lb + pos : dummy; LAS int* pii = w ? seli + lb + pos : (LAS int*)dummy;
                *pvv = funkey(kk[i]); asm volatile("" ::: "memory"); *pii = ib + i; asm volatile("" ::: "memory"); pos += (int)f; }
        }
        LDS_WAIT(); asm volatile("" ::: "memory");
        const int hd = lane >> 3, q8 = lane & 7; int i2[16]; int i1a, i1b;
        {   const float va = selv[hd * 32 + 2 * q8], vb = selv[hd * 32 + 2 * q8 + 1]; i1a = seli[hd * 32 + 2 * q8] * 128; i1b = seli[hd * 32 + 2 * q8 + 1] * 128;
#pragma unroll
            for (int j = 0; j < 4; ++j) { const f32x4 v2 = *(const LAS f32x4*)(selv + hd * 32 + 16 + 4 * j); const v4u ii = *(const LAS v4u*)(seli + hd * 32 + 16 + 4 * j);
#pragma unroll
                for (int c = 0; c < 4; ++c) { kk[4 * j + c] = fkey(va + v2[c]); kk[16 + 4 * j + c] = fkey(vb + v2[c]); i2[4 * j + c] = (int)ii[c];
                    asm volatile("" : "+v"(kk[4 * j + c]), "+v"(kk[16 + 4 * j + c])); } }
        }
        pv = 0u; na = 256;
#pragma unroll 1
        for (int bit = 31; bit >= 0; --bit) { const unsigned cv = pv | (1u << bit); int c = 0;
#pragma unroll
            for (int i = 0; i < 32; ++i) c += (int)(kk[i] >= cv);
            c += DPPI(c, 0xB1); c += DPPI(c, 0x4E); c += DPPI(c, 0x141);
            const bool ok = c >= 16; pv = ok ? cv : pv; na = ok ? c : na;
            if (!__any(na != 16)) break; }
        {   int cl = 0;
#pragma unroll
            for (int i = 0; i < 32; ++i) cl += (int)(kk[i] >= pv);
            const int q = lane & 3; const int c1 = DPPI(cl, 0x90), c2 = DPPI(cl, 0x40), c3 = DPPI(cl, 0x00);
            int qt = cl; qt += DPPI(qt, 0xB1); qt += DPPI(qt, 0x4E); const int lowq = DPPI(qt, 0x141);
            int pos = (q >= 1 ? c1 : 0) + (q >= 2 ? c2 : 0) + (q >= 3 ? c3 : 0) + ((lane & 4) ? lowq : 0);
            const int lb = hd * 16;
#pragma unroll
            for (int i = 0; i < 32; ++i) { const bool f = kk[i] >= pv; const bool w = f && pos < 16;
                LAS float* pg = w ? gate + lb + pos : dummy; LAS int* pe = w ? eid + lb + pos : (LAS int*)dummy;
                *pg = funkey(kk[i]); asm volatile("" ::: "memory"); *pe = (i < 16 ? i1a : i1b) + i2[i & 15]; asm volatile("" ::: "memory"); pos += (int)f; }
        }
        LDS_WAIT(); asm volatile("" ::: "memory");
#pragma unroll
        for (int qq = 0; qq < 2; ++qq) { const int e = lane + 64 * qq; const float sc = gate[e]; float mx = sc;
            mx = fmaxf(mx, __shfl_xor(mx, 1)); mx = fmaxf(mx, __shfl_xor(mx, 2)); mx = fmaxf(mx, __shfl_xor(mx, 4)); mx = fmaxf(mx, __shfl_xor(mx, 8));
            const float ex = __expf(sc - mx); float sm = ex;
            sm += __shfl_xor(sm, 1); sm += __shfl_xor(sm, 2); sm += __shfl_xor(sm, 4); sm += __shfl_xor(sm, 8);
            const int ee = eid[e]; const float su = Usc[ee], sv = Vsc[ee];
            const size_t go = (size_t)t * 128 + e;
            ((int*)(F.ws + WS_EID))[go] = ee; ((float*)(F.ws + WS_GATEV))[go] = ex / sm * sv; ((float*)(F.ws + WS_USCT))[go] = su; }
        LDS_WAIT(); asm volatile("" ::: "memory");
    }
}

#define SL_DEC16(Rv, fv) do { _Pragma("unroll") for (int _k = 0; _k < 4; ++_k) { f32x2 _a, _b; PEER_CVT((Rv)[_k], _a, _b); fv[4 * _k] = _a[0]; fv[4 * _k + 1] = _a[1]; fv[4 * _k + 2] = _b[0]; fv[4 * _k + 3] = _b[1]; } } while (0)
#define SL_LOADE(EB, tt) do { const v4u* _ep = (const v4u*)(EID + (size_t)(tt) * 128 + g * 16); EB[0] = _ep[0]; EB[1] = _ep[1]; EB[2] = _ep[2]; EB[3] = _ep[3]; } while (0)
#define SL_LOADR(R, EB, tbl) do { _Pragma("unroll") for (int _i = 0; _i < 16; ++_i) R[_i] = *(const v4u*)((tbl) + (EB[_i >> 2][_i & 3] * 128u + coff)); } while (0)
__device__ __forceinline__ void phase_peer_u(Frame& F, const Args& A, int l, int rep = 0) {
    int tid_ = threadIdx.x; asm volatile("" : "+v"(tid_)); const int lane = tid_ & 63, g = lane >> 3, j = lane & 7;
    const unsigned char* Ut = F.ws + WS_U + (size_t)l * NEXP * DM; const unsigned char* X8 = F.ws + WS_X8; const unsigned* EID = (const unsigned*)(F.ws + WS_EID);
    float* PD = (float*)(F.ws + WS_PD);
    const int xcd = (int)(xb_xcc_id() & 7u);
    for (int kk = 0; kk < 16; ++kk) { const int s = (2 * xcd + kk) & 15; const unsigned coff = (unsigned)(s * (NEXP * 128) + j * 16);
        for (;;) { const int it = queue_next(F, F.ctl + CW_SQ + 16 * ((2 * l + 0) * 16 + s) + 8 * rep); if (it >= TT / 256) break;
            const int tb = it * 256 + F.wave * 32;
            v4u R0[16], R1[16], EB[4], XA[1], XB[1];
#define SU_LOADX(XV, tt) do { XV[0] = *(const v4u*)(X8 + (size_t)(tt) * DM + s * 128 + j * 16); } while (0)
#define SU_COMP(R, XV, tt) do { float p[16]; \
                _Pragma("unroll") for (int _i = 0; _i < 16; ++_i) { int ia = 0; _Pragma("unroll") for (int _k = 0; _k < 4; ++_k) ia = __builtin_amdgcn_sdot4((int)R[_i][_k], (int)XV[0][_k], ia, false); \
                    float acc = (float)ia; asm volatile("" : "+v"(acc)); p[_i] = acc; } \
                float q8[8], q4[4], q2[2]; \
                { const bool b = (lane & 4) != 0; _Pragma("unroll") for (int _i = 0; _i < 8; ++_i) { const float keep = b ? p[_i + 8] : p[_i], send = b ? p[_i] : p[_i + 8]; q8[_i] = keep + __shfl_xor(send, 4); } } \
                { const bool b = (lane & 2) != 0; _Pragma("unroll") for (int _i = 0; _i < 4; ++_i) { const float keep = b ? q8[_i + 4] : q8[_i], send = b ? q8[_i] : q8[_i + 4]; q4[_i] = keep + __shfl_xor(send, 2); } } \
                { const bool b = (lane & 1) != 0; _Pragma("unroll") for (int _i = 0; _i < 2; ++_i) { const float keep = b ? q4[_i + 2] : q4[_i], send = b ? q4[_i] : q4[_i + 2]; q2[_i] = keep + __shfl_xor(send, 1); } } \
                *(f32x2*)(PD + ((size_t)s * TT + (tt)) * 128 + 2 * lane) = (f32x2){q2[0], q2[1]}; } while (0)
            SL_LOADE(EB, tb); SU_LOADX(XA, tb); SL_LOADR(R0, EB, Ut); SL_LOADE(EB, tb + 1); SU_LOADX(XB, tb + 1);
#pragma unroll 1
            for (int k = 0; k < 32; k += 2) {
                SL_LOADR(R1, EB, Ut); if (k + 2 < 32) SL_LOADE(EB, tb + k + 2);
                __builtin_amdgcn_sched_barrier(0);
                SU_COMP(R0, XA, tb + k); if (k + 2 < 32) SU_LOADX(XA, tb + k + 2);
                __builtin_amdgcn_sched_barrier(0);
                if (k + 2 < 32) SL_LOADR(R0, EB, Ut); if (k + 3 < 32) SL_LOADE(EB, tb + k + 3);
                __builtin_amdgcn_sched_barrier(0);
                SU_COMP(R1, XB, tb + k + 1); if (k + 3 < 32) SU_LOADX(XB, tb + k + 3);
                __builtin_amdgcn_sched_barrier(0);
            }
        }
    }
}
__device__ __forceinline__ void phase_peer_w(Frame& F, const Args& A, int l) {
    int tid_ = threadIdx.x; asm volatile("" : "+v"(tid_)); const int lane = tid_ & 63;
    const float* PD = (const float*)(F.ws + WS_PD); const float* G = (const float*)(F.ws + WS_GATEV); const float* US = (const float*)(F.ws + WS_USCT); float* W = (float*)(F.ws + WS_WT);
    for (int t = F.gw; t < TT; t += F.ngw) { f32x2 a = (f32x2){0.f, 0.f};
#pragma unroll
        for (int s = 0; s < 16; ++s) a += *(const f32x2*)(PD + ((size_t)s * TT + t) * 128 + 2 * lane);
        const f32x2 us = *(const f32x2*)(US + (size_t)t * 128 + 2 * lane), gv = *(const f32x2*)(G + (size_t)t * 128 + 2 * lane);
        const float xs = ((const float*)(F.ws + WS_XS))[t]; const float h0 = a[0] * us[0] * xs, h1 = a[1] * us[1] * xs;
        *(f32x2*)(W + (size_t)t * 128 + 2 * lane) = (f32x2){gv[0] * 0.5f * h0 * (1.0f + erff(h0 * 0.7071067811865476f)), gv[1] * 0.5f * h1 * (1.0f + erff(h1 * 0.7071067811865476f))}; }
}
__device__ __forceinline__ void phase_peer_v(Frame& F, const Args& A, int l, int rep = 0) {
    int tid_ = threadIdx.x; asm volatile("" : "+v"(tid_)); const int lane = tid_ & 63, g = lane >> 3, j = lane & 7;
    const unsigned char* Vt = F.ws + WS_V + (size_t)l * NEXP * DM; const unsigned* EID = (const unsigned*)(F.ws + WS_EID); const float* W = (const float*)(F.ws + WS_WT);
    float* YP = (float*)(F.ws + WS_Y);
    const int xcd = (int)(xb_xcc_id() & 7u);
    for (int kk = 0; kk < 16; ++kk) { const int s = (2 * xcd + kk) & 15; const unsigned coff = (unsigned)(s * (NEXP * 128) + j * 16);
        for (;;) { const int it = queue_next(F, F.ctl + CW_SQ + 16 * ((2 * l + 1) * 16 + s) + 8 * rep); if (it >= TT / 256) break;
            const int tb = it * 256 + F.wave * 32;
            v4u R0[16], R1[16], EB[4]; f32x4 WA[4], WB[4];
#define SV_LOADW(WV, tt) do { const f32x4* _wp = (const f32x4*)(W + (size_t)(tt) * 128 + g * 16); WV[0] = _wp[0]; WV[1] = _wp[1]; WV[2] = _wp[2]; WV[3] = _wp[3]; } while (0)
#define SV_COMP(R, WV, tt) do { f32x2 y2[8]; _Pragma("unroll") for (int _k = 0; _k < 8; ++_k) y2[_k] = (f32x2){0.f, 0.f}; \
                _Pragma("unroll") for (int _i = 0; _i < 16; ++_i) { const float wi = WV[_i >> 2][_i & 3]; const f32x2 w2 = (f32x2){wi, wi}; _Pragma("unroll") for (int _k = 0; _k < 4; ++_k) { f32x2 _a, _b; PEER_CVT(R[_i][_k], _a, _b); y2[2 * _k] = w2 * _a + y2[2 * _k]; y2[2 * _k + 1] = w2 * _b + y2[2 * _k + 1]; } \
                    asm volatile("" : "+v"(y2[0]), "+v"(y2[1]), "+v"(y2[2]), "+v"(y2[3]), "+v"(y2[4]), "+v"(y2[5]), "+v"(y2[6]), "+v"(y2[7])); } \
                float y[16]; _Pragma("unroll") for (int _k = 0; _k < 8; ++_k) { y[2 * _k] = y2[_k][0]; y[2 * _k + 1] = y2[_k][1]; } \
                float z8[8], z4[4], z2[2]; \
                { const bool b = (lane & 32) != 0; _Pragma("unroll") for (int _i = 0; _i < 8; ++_i) { const float keep = b ? y[_i + 8] : y[_i], send = b ? y[_i] : y[_i + 8]; z8[_i] = keep + __shfl_xor(send, 32); } } \
                { const bool b = (lane & 16) != 0; _Pragma("unroll") for (int _i = 0; _i < 4; ++_i) { const float keep = b ? z8[_i + 4] : z8[_i], send = b ? z8[_i] : z8[_i + 4]; z4[_i] = keep + __shfl_xor(send, 16); } } \
                { const bool b = (lane & 8) != 0; _Pragma("unroll") for (int _i = 0; _i < 2; ++_i) { const float keep = b ? z4[_i + 2] : z4[_i], send = b ? z4[_i] : z4[_i + 2]; z2[_i] = keep + __shfl_xor(send, 8); } } \
                *(f32x2*)(YP + (size_t)(tt) * DM + s * 128 + j * 16 + 2 * g) = (f32x2){z2[0], z2[1]}; } while (0)
            SL_LOADE(EB, tb); SV_LOADW(WA, tb); SL_LOADR(R0, EB, Vt); SL_LOADE(EB, tb + 1); SV_LOADW(WB, tb + 1);
#pragma unroll 1
            for (int k = 0; k < 32; k += 2) {
                SL_LOADR(R1, EB, Vt); if (k + 2 < 32) SL_LOADE(EB, tb + k + 2);
                __builtin_amdgcn_sched_barrier(0);
                SV_COMP(R0, WA, tb + k); if (k + 2 < 32) SV_LOADW(WA, tb + k + 2);
                __builtin_amdgcn_sched_barrier(0);
                if (k + 2 < 32) SL_LOADR(R0, EB, Vt); if (k + 3 < 32) SL_LOADE(EB, tb + k + 3);
                __builtin_amdgcn_sched_barrier(0);
                SV_COMP(R1, WB, tb + k + 1); if (k + 3 < 32) SV_LOADW(WB, tb + k + 3);
                __builtin_amdgcn_sched_barrier(0);
            }
        }
    }
}
__device__ __forceinline__ void phase_ln2(Frame& F, const Args& A, int l) {
    int tid_ = threadIdx.x; asm volatile("" : "+v"(tid_)); const int lane = tid_ & 63;
    const float* YP = (const float*)(F.ws + WS_Y); const bf16* X1 = (const bf16*)(F.ws + WS_X1); bf16* Xn = (bf16*)(F.ws + WS_X); const float* g2 = A.in[21] + l * DM; const float* b2 = A.in[22] + l * DM;
    for (int t = F.gw; t < TT; t += F.ngw) {
        float v[32];
#pragma unroll
        for (int jj = 0; jj < 4; ++jj) { const int c0 = jj * 512 + lane * 8; const float* p = YP + (size_t)t * DM + c0; const f32x4 a = *(const f32x4*)p, c = *(const f32x4*)(p + 4);
            const v4u xw = *(const v4u*)(X1 + (size_t)t * DM + c0); float x[8]; UNPACK8(xw, x, 0);
            v[8 * jj] = DN_ALPHA * x[0] + a[0]; v[8 * jj + 1] = DN_ALPHA * x[1] + a[1]; v[8 * jj + 2] = DN_ALPHA * x[2] + a[2]; v[8 * jj + 3] = DN_ALPHA * x[3] + a[3];
            v[8 * jj + 4] = DN_ALPHA * x[4] + c[0]; v[8 * jj + 5] = DN_ALPHA * x[5] + c[1]; v[8 * jj + 6] = DN_ALPHA * x[6] + c[2]; v[8 * jj + 7] = DN_ALPHA * x[7] + c[3]; }
        float sm = 0.f;
#pragma unroll
        for (int i = 0; i < 32; ++i) sm += v[i];
        const float mean = wave_sum(sm) * (1.0f / DM); float qq = 0.f;
#pragma unroll
        for (int i = 0; i < 32; ++i) { v[i] -= mean; qq += v[i] * v[i]; }
        const float rstd = 1.0f / sqrtf(wave_sum(qq) * (1.0f / DM) + EPS);
#pragma unroll
        for (int jj = 0; jj < 4; ++jj) { const int c0 = jj * 512 + lane * 8; float o[8];
#pragma unroll
            for (int i = 0; i < 8; ++i) o[i] = v[8 * jj + i] * rstd * g2[c0 + i] + b2[c0 + i];
            if (l == DEPTH - 1) { float* op = A.out + (size_t)t * DM + c0; *(f32x4*)op = (f32x4){o[0], o[1], o[2], o[3]}; *(f32x4*)(op + 4) = (f32x4){o[4], o[5], o[6], o[7]}; }
            else *(v4u*)(Xn + (size_t)t * DM + c0) = PACK8(o, 0); }
    }
}

constexpr int NPL = 9, NPHASE = 1 + DEPTH * NPL;
__global__ void __launch_bounds__(512, 2) fwd_kernel(Args args) {
    extern __shared__ __attribute__((aligned(16))) unsigned char lds[];
    Frame F;
    F.lds = (LAS unsigned char*)lds; F.lds_g = (char*)lds;
    F.tid = threadIdx.x; F.lane = F.tid & 63; F.wave = __builtin_amdgcn_readfirstlane(F.tid >> 6);
    F.gw = blockIdx.x * 8 + F.wave; F.ngw = gridDim.x * 8;
    F.ws = args.ws; F.ctl = (gu32*)(args.ws + WS_CTL);
    volatile LAS unsigned* MISC = (volatile LAS unsigned*)(F.lds + MISC_OFF);
    if (F.tid < 32) MISC[F.tid] = 0u;
    __syncthreads();
    const int lo = args.ph_lo, hi = args.ph_hi;
    XcdBarrier bar; bar.bar = (unsigned*)(F.ctl + CW_BAR); bar.x = 0; bar.st = MISC;
    bar = xcd_barrier_post((unsigned*)(F.ctl + CW_BAR), MISC);
#ifndef PH_EN
#define PH_EN 0x3ff
#endif
#ifndef MK_REP_ATTN
#define MK_REP_ATTN 0
#endif
#ifndef MK_REP_PEER
#define MK_REP_PEER 0
#endif
#ifndef MK_REP_GEMM
#define MK_REP_GEMM 0
#endif
#define IN(k) (lo <= (k) && (k) < hi)
#define EN(b) ((PH_EN >> (b)) & 1)
#define SEAM(k) do { if (IN(k) && IN((k) + 1)) xcd_barrier(bar); } while (0)
    const bf16* X = (const bf16*)(F.ws + WS_X); const bf16* X1 = (const bf16*)(F.ws + WS_X1); bf16* H = (bf16*)(F.ws + WS_H);

    if (EN(9) && IN(0)) { p0_prologue(F, args); xcd_barrier(bar);
        { int Kv = DM; asm volatile("" : "+s"(Kv)); pg8::Gemm g{(const bf16*)(F.ws + WS_SKD), (const bf16*)(F.ws + WS_WQ), DEPTH * DM, DEPTH * DM, Kv, DM, DM};
          FoldOrder S{(int)gridDim.x, (int)blockIdx.x}; pg8::EpiRow8<StoreBf16> E{StoreBf16{(bf16*)(F.ws + WS_WQS), DM, DEPTH * DM}};
          pg8::gemm_phase<pg8::EpiRow8<StoreBf16>, FoldOrder, true, true>(F.lds, g, S, E); }
        SEAM(0); }

    for (int l = 0; l < DEPTH; ++l) {
        const int pb = 1 + NPL * l;
        if (EN(0) && IN(pb + 0)) { int nrep = 1 + MK_REP_GEMM; asm volatile("" : "+s"(nrep));
#pragma unroll 1
            for (int rep = 0; rep < nrep; ++rep) { if (rep) xcd_barrier(bar); run_gemm(F, X, DM, (const bf16*)(F.ws + WS_WIN) + (size_t)l * INP * DM, TT, INP, DM, StoreBf16{H, INP, INP}); }
            SEAM(pb + 0); }
        if (EN(1) && IN(pb + 1)) { phase_prep(F, args, l); SEAM(pb + 1); }
        if (EN(2) && IN(pb + 2)) {
#ifndef NO_G1
            run_gemm(F, H + H_BCQ, INP, (const bf16*)(F.ws + WS_WUQ) + (size_t)l * BQP * 384, TT, BQP, 384, StoreMlaQ{(bf16*)(F.ws + WS_BQ), (const f32x2*)(F.ws + WS_ROPE)});
#endif
#ifndef NO_G2
            run_gemm(F, H + H_BCKV, INP, (const bf16*)(F.ws + WS_WUKV) + (size_t)l * BKVW * 256, TT, BKVW, 256, StoreMlaKV{(bf16*)(F.ws + WS_BK), (bf16*)(F.ws + WS_BV)});
#endif
            SEAM(pb + 2); }
        if (EN(3) && IN(pb + 3)) { int nrep = 1 + MK_REP_ATTN; asm volatile("" : "+s"(nrep));
#pragma unroll 1
            for (int rep = 0; rep < nrep; ++rep) { if (rep) xcd_barrier(bar); phase_attn(F, args, l, rep); }
            SEAM(pb + 3); }
        if (EN(4) && IN(pb + 4)) { run_gemm(F, (const bf16*)(F.ws + WS_AO), DM, (const bf16*)(F.ws + WS_WO) + (size_t)l * DM * DM, TT, DM, DM, StoreResid{(float*)(F.ws + WS_Y), X}); SEAM(pb + 4); }
        if (EN(5) && IN(pb + 5)) { phase_ln1(F, args, l); SEAM(pb + 5); }
        if (EN(6) && IN(pb + 6)) { run_gemm(F, X1, DM, (const bf16*)(F.ws + WS_WQS) + (size_t)l * WQS_LAYER, TT, DM, DM, StoreF32{(float*)(F.ws + WS_SC), DM}); SEAM(pb + 6); }
        if (EN(8) && IN(pb + 8)) {
#ifndef MK_REP_TOPK
#define MK_REP_TOPK 0
#endif
#ifndef MK_REP_PU
#define MK_REP_PU 0
#endif
#ifndef MK_REP_PV
#define MK_REP_PV 0
#endif
            { int nrep = 1 + MK_REP_TOPK; asm volatile("" : "+s"(nrep));
#pragma unroll 1
              for (int rep = 0; rep < nrep; ++rep) { phase_peer_topk(F, args, l); xcd_barrier(bar); } }
            { int nrep = 1 + MK_REP_PU; asm volatile("" : "+s"(nrep));
#pragma unroll 1
              for (int rep = 0; rep < nrep; ++rep) { phase_peer_u(F, args, l, rep); xcd_barrier(bar); } }
            phase_peer_w(F, args, l); xcd_barrier(bar);
            { int nrep = 1 + MK_REP_PV; asm volatile("" : "+s"(nrep));
#pragma unroll 1
              for (int rep = 0; rep < nrep; ++rep) { phase_peer_v(F, args, l, rep); xcd_barrier(bar); } }
            phase_ln2(F, args, l);
            SEAM(pb + 8); }
    }
#undef IN
#undef SEAM
}

extern "C" void kernel_launch(void* const* d_in, const int* in_sizes, int n_in, void* d_out, int out_size, void* d_ws, size_t ws_size, hipStream_t stream) {
    static int grid = 0;
    if (grid == 0) {
        if (n_in != 23 || in_sizes[0] != T_PROMPT * DM || in_sizes[1] != (TT - T_PROMPT) * DM || out_size != TT * DM || ws_size < WS_NEED) {
            fprintf(stderr, "kernel_launch: shape mismatch (n_in %d, in0 %d, in1 %d, out %d, ws %zu need %zu); nothing launched\n", n_in, n_in > 0 ? in_sizes[0] : -1, n_in > 1 ? in_sizes[1] : -1, out_size, ws_size, (size_t)WS_NEED); grid = -1; return; }
        int dev = 0, cus = 0, per_cu = 0;
        if (hipGetDevice(&dev) != hipSuccess || hipDeviceGetAttribute(&cus, hipDeviceAttributeMultiprocessorCount, dev) != hipSuccess) { fprintf(stderr, "kernel_launch: device query failed\n"); grid = -1; return; }
        if (hipFuncSetAttribute((const void*)fwd_kernel, hipFuncAttributeMaxDynamicSharedMemorySize, LDS_BYTES) != hipSuccess) { fprintf(stderr, "kernel_launch: hipFuncSetAttribute failed\n"); grid = -1; return; }
        if (hipOccupancyMaxActiveBlocksPerMultiprocessor(&per_cu, (const void*)fwd_kernel, 512, LDS_BYTES) != hipSuccess || per_cu < 1) { fprintf(stderr, "kernel_launch: occupancy query says %d blocks per CU\n", per_cu); }
        (void)hipGetLastError();
        grid = cus;
    }
    if (grid < 0) return;
    if (hipMemsetAsync((char*)d_ws + WS_CTL, 0, CTL_BYTES, stream) != hipSuccess) { fprintf(stderr, "kernel_launch: memset failed\n"); return; }
    Args a{};
    for (int i = 0; i < 23; ++i) a.in[i] = (const float*)d_in[i];
    a.out = (float*)d_out; a.ws = (unsigned char*)d_ws;
#if MK_LAUNCH_PER_PHASE
    for (int k = 0; k < NPHASE; ++k) { a.ph_lo = k; a.ph_hi = k + 1; hipLaunchKernelGGL(fwd_kernel, dim3(grid), dim3(512), LDS_BYTES, stream, a); }
#else
    a.ph_lo = 0; a.ph_hi = NPHASE; hipLaunchKernelGGL(fwd_kernel, dim3(grid), dim3(512), LDS_BYTES, stream, a);
#endif
#if MK_DBG
    if (MK_DBG & 1) hipLaunchKernelGGL(dbg_h, dim3(48), dim3(256), 0, stream, a);
    if (MK_DBG & 2) hipLaunchKernelGGL(dbg_mla, dim3(48), dim3(256), 0, stream, a);
    if (MK_DBG & 28) hipLaunchKernelGGL(dbg_attn, dim3(64), dim3(256), 0, stream, a);
    if (MK_DBG & 224) hipLaunchKernelGGL(dbg_gemms, dim3(48), dim3(256), 0, stream, a);
    if (MK_DBG & 256) hipLaunchKernelGGL(dbg_peer, dim3(48), dim3(256), 0, stream, a);
    hipLaunchKernelGGL(dbg_scale, dim3(1024), dim3(256), 0, stream, a);
#endif
    const hipError_t le = hipPeekAtLastError();
    if (le != hipSuccess) fprintf(stderr, "kernel_launch: launch failed: %s\n", hipGetErrorName(le));
}
```

```cpp
#include <hip/hip_runtime.h>
#include <cstdio>
#include <cstdint>

#ifndef MK_LAUNCH_PER_PHASE
#define MK_LAUNCH_PER_PHASE 0
#endif
#ifndef MK_DBG
#define MK_DBG 0
#endif

constexpr int DM = 2048, TT = 24576, T_PROMPT = 8192, S_SAMPLE = 4096, DEPTH = 4;
constexpr int INW = 3520, INP = 3584;
constexpr int H_AQ = 0, H_AK = 768, H_AV = 1024, H_BCQ = 1280, H_BCKV = 1664, H_BKR = 1920, H_CQ = 1984, H_CK = 2496, H_CV = 3008;
constexpr int BQW = 1152, BQP = 1280, BKVW = 1536, BVW = 768;
constexpr int NEXP = 16384, PEER_H = 8, PEER_K = 16;
constexpr float EPS = 1e-5f;
constexpr float DN_ALPHA = 1.681792830507429f;
constexpr double ROPE_R = 0.7498942093324559;

namespace pg8 {
#define PG8_LAS __attribute__((address_space(3)))
typedef unsigned short bf16_t;
typedef short bf16x8 __attribute__((ext_vector_type(8)));
typedef float f32x4 __attribute__((ext_vector_type(4)));
typedef unsigned u32x4 __attribute__((ext_vector_type(4)));
constexpr int BM = 256, BK = 64, HALF = 128, HTB = HALF * BK * 2  , STAGE_BYTES = 8 * HTB, NXCD = 8, WGM = 8;

__host__ __device__ __forceinline__ int lds_byte(int r, int c) { const int st = (r >> 4) * 2 + (c >> 5), rr = r & 15, cc = c & 31, ob = rr * 64 + cc * 2; return st * 1024 + (ob ^ (((ob >> 9) & 1) << 5)); }
__host__ __device__ __forceinline__ void stage_rc(int b, int& R, int& C) { const int st = b / 1024, sb = b % 1024, swz = sb ^ (((sb >> 9) & 1) << 5); R = (st >> 1) * 16 + swz / 64; C = (st & 1) * 32 + (swz % 64) / 2; }
__host__ __device__ __forceinline__ int perm32(int rho) { const int n = rho >> 4, i = rho & 15; return 8 * (i >> 2) + 4 * n + (i & 3); }

struct Unit { int pm, pn; };
struct Gemm { const bf16_t* A; const bf16_t* Bt; int M, N, K, lda, ldb; };

struct StaticOrder {
    int nM, nN, nwg, G, c;
    __host__ __device__ void init(int M, int N, int G_, int c_) { nM = M / BM; nN = N / BM; nwg = nM * nN; G = G_; c = c_; }
    __host__ __device__ bool next(int i, Unit& u) const {
        const long L = (long)i * G + c; if (L >= nwg) return false;
        int wgid = (int)L; { const int q = nwg / NXCD, r = nwg % NXCD, xcd = wgid % NXCD, off = wgid / NXCD; wgid = (xcd < r ? xcd * (q + 1) : r * (q + 1) + (xcd - r) * q) + off; }
        const int nig = WGM * nN, gid = wgid / nig, fm = gid * WGM, gsz = (nM - fm) < WGM ? (nM - fm) : WGM;
        u.pm = fm + ((wgid % nig) % gsz); u.pn = (wgid % nig) / gsz; return true;
    }
    __device__ __forceinline__ void a_ready(const Unit&) const {}
    __device__ __forceinline__ void done(const Unit&) const {}
};

__device__ __forceinline__ unsigned cvt_pk_bf16(float lo, float hi) { unsigned r; asm volatile("v_cvt_pk_bf16_f32 %0, %1, %2" : "=v"(r) : "v"(lo), "v"(hi)); return r; }
template <class F> struct EpiRow8 {
    static constexpr bool PERM = true, AFTER_DRAIN = false; F f;
    __device__ __forceinline__ void operator()(const f32x4 (&acc)[2][2][4][2], const Unit& u, int wr, int wc, int fr, int fq) const {
        const int row0 = u.pm * BM + wr * 64 + fr, col0 = u.pn * BM + wc * 32 + 8 * fq;
#pragma unroll
        for (int ai = 0; ai < 2; ++ai)
#pragma unroll
            for (int m = 0; m < 4; ++m)
#pragma unroll
                for (int bj = 0; bj < 2; ++bj) { f(row0 + ai * HALF + m * 16, col0 + bj * HALF, acc[ai][bj][m][0], acc[ai][bj][m][1]); asm volatile("" ::: "memory"); }
    }
};
template <class Epi, class Sched, bool ALIGN_EPI = false, bool SP2 = false>
__device__ __forceinline__ void gemm_phase(PG8_LAS unsigned char* lds, const Gemm g, const Sched& S, const Epi& E) {
    int tid_ = threadIdx.x; asm volatile("" : "+v"(tid_));
    const int tid = tid_, wid = __builtin_amdgcn_readfirstlane(tid >> 6), lane = tid & 63, wr = wid >> 2, wc = wid & 3, fr = lane & 15, fq = lane >> 4;
    const int K = g.K, nt = K / BK;
    unsigned voffA[2], voffB[2];
#pragma unroll
    for (int i = 0; i < 2; ++i) { int R, C; stage_rc(tid * 16 + i * 8192, R, C); const int Rb = Epi::PERM ? ((R & ~31) + perm32(R & 31)) : R;
        voffA[i] = (unsigned)(R * g.lda + C) * 2u; voffB[i] = (unsigned)(Rb * g.ldb + C) * 2u; }
    const size_t kstep = (size_t)(BK * 2);
    const size_t hstepA = (size_t)HALF * g.lda * 2, hstepB = (size_t)HALF * g.ldb * 2;
    const size_t tstepA = 2 * hstepA, tstepB = 2 * hstepB;
    const unsigned ldsw = (unsigned)wid * 1024u;
    const int aoff = lds_byte(wr * 64 + fr, fq * 8), boff = lds_byte(wc * 32 + fr, fq * 8);
#define PG8_SA(b, h) (((b) * 2 + (h)) * HTB)
#define PG8_SB(b, h) ((4 + (b) * 2 + (h)) * HTB)
#define PG8_STAGE(bufoff, gbase, voff) do { _Pragma("unroll") for (int _i = 0; _i < 2; ++_i) \
        __builtin_amdgcn_global_load_lds((const unsigned*)((const char*)(gbase) + (voff)[_i]), (PG8_LAS unsigned*)(lds + (bufoff) + ldsw + _i * 8192), 16, 0, 0); } while (0)
#define PG8_LDA(dst, b, h) do { _Pragma("unroll") for (int m = 0; m < 4; ++m) _Pragma("unroll") for (int k = 0; k < 2; ++k) dst[m][k] = *(const PG8_LAS bf16x8*)(lds + PG8_SA(b, h) + aoff + m * 2048 + k * 1024); } while (0)
#define PG8_LDB(dst, b, h) do { _Pragma("unroll") for (int n = 0; n < 2; ++n) _Pragma("unroll") for (int k = 0; k < 2; ++k) dst[n][k] = *(const PG8_LAS bf16x8*)(lds + PG8_SB(b, h) + boff + n * 2048 + k * 1024); } while (0)
#define PG8_MMA(ai, bj, At, Bt) do { __builtin_amdgcn_s_setprio(1); _Pragma("unroll") for (int m = 0; m < 4; ++m) _Pragma("unroll") for (int n = 0; n < 2; ++n) _Pragma("unroll") for (int k = 0; k < 2; ++k) \
        acc[ai][bj][m][n] = __builtin_amdgcn_mfma_f32_16x16x32_bf16(Bt[n][k], At[m][k], acc[ai][bj][m][n], 0, 0, 0); __builtin_amdgcn_s_setprio(0); } while (0)
#define PG8_WAIT_V(n) asm volatile("s_waitcnt vmcnt(" #n ")" ::: "memory")
#define PG8_WAIT_L(n) asm volatile("s_waitcnt lgkmcnt(" #n ")" ::: "memory")
#define PG8_BAR __builtin_amdgcn_s_barrier()
#define PG8_SCHED __builtin_amdgcn_sched_barrier(0)
    Unit cur, nxt; int ui = 0;
    if (!S.next(0, cur)) return;
    f32x4 acc[2][2][4][2];
#pragma unroll
    for (int a = 0; a < 2; ++a)
#pragma unroll
        for (int b = 0; b < 2; ++b)
#pragma unroll
            for (int m = 0; m < 4; ++m)
#pragma unroll
                for (int n = 0; n < 2; ++n) acc[a][b][m][n] = (f32x4){0.f, 0.f, 0.f, 0.f};
    bf16x8 At[4][2], B0[2][2], B1[2][2];
    const char* cA = (const char*)g.A + (size_t)cur.pm * tstepA; const char* cB = (const char*)g.Bt + (size_t)cur.pn * tstepB;
    S.a_ready(cur);
    if constexpr (SP2) {
        PG8_STAGE(PG8_SB(0, 0), cB, voffB); PG8_STAGE(PG8_SB(0, 1), cB + hstepB, voffB); PG8_STAGE(PG8_SA(0, 0), cA, voffA); PG8_STAGE(PG8_SA(0, 1), cA + hstepA, voffA);
        if (wr == 1) PG8_BAR;
        PG8_WAIT_V(2); PG8_BAR;
        PG8_STAGE(PG8_SB(1, 0), cB + kstep, voffB); PG8_STAGE(PG8_SA(1, 0), cA + kstep, voffA); PG8_STAGE(PG8_SB(1, 1), cB + hstepB + kstep, voffB);
        PG8_WAIT_V(6); PG8_BAR;
    } else {
        PG8_STAGE(PG8_SB(0, 0), cB, voffB); PG8_STAGE(PG8_SA(0, 0), cA, voffA); PG8_STAGE(PG8_SB(0, 1), cB + hstepB, voffB); PG8_STAGE(PG8_SA(0, 1), cA + hstepA, voffA);
        if (wr == 1) PG8_BAR;
        PG8_WAIT_V(4); PG8_BAR;
        PG8_STAGE(PG8_SB(1, 0), cB + kstep, voffB); PG8_STAGE(PG8_SA(1, 0), cA + kstep, voffA); PG8_STAGE(PG8_SB(1, 1), cB + hstepB + kstep, voffB);
        PG8_WAIT_V(6); PG8_BAR;
    }
    for (;;) {
        const bool has_next = S.next(ui + 1, nxt);
        const char* nA = has_next ? (const char*)g.A + (size_t)nxt.pm * tstepA : cA; const char* nB = has_next ? (const char*)g.Bt + (size_t)nxt.pn * tstepB : cB;
        for (int t = 0; t < nt; t += 2) {
            const bool last = (t == nt - 2);
            const char* a1 = cA + (size_t)(t + 1) * kstep;
            const char* a2 = last ? nA : cA + (size_t)(t + 2) * kstep; const char* b2 = last ? nB : cB + (size_t)(t + 2) * kstep;
            const char* a3 = a2 + kstep; const char* b3 = b2 + kstep;
            if (last && has_next) S.a_ready(nxt);
            if constexpr (SP2) {
            PG8_LDB(B0, 0, 0); PG8_LDB(B1, 0, 1); PG8_SCHED; PG8_LDA(At, 0, 0); PG8_STAGE(PG8_SA(1, 1), a1 + hstepA, voffA);
            PG8_WAIT_V(8); PG8_WAIT_L(0); PG8_BAR; PG8_MMA(0, 0, At, B0); PG8_MMA(0, 1, At, B1); PG8_BAR; PG8_SCHED;
            PG8_LDA(At, 0, 1); PG8_STAGE(PG8_SB(0, 0), b2, voffB); PG8_STAGE(PG8_SB(0, 1), b2 + hstepB, voffB); PG8_STAGE(PG8_SA(0, 0), a2, voffA);
            PG8_WAIT_V(8); PG8_WAIT_L(0); PG8_BAR; PG8_MMA(1, 0, At, B0); PG8_MMA(1, 1, At, B1); PG8_BAR; PG8_SCHED;
            PG8_LDB(B0, 1, 0); PG8_LDB(B1, 1, 1); PG8_SCHED; PG8_LDA(At, 1, 0); PG8_STAGE(PG8_SA(0, 1), a2 + hstepA, voffA);
            PG8_WAIT_V(8); PG8_WAIT_L(0); PG8_BAR; PG8_MMA(0, 0, At, B0); PG8_MMA(0, 1, At, B1); PG8_BAR; PG8_SCHED;
            PG8_LDA(At, 1, 1); PG8_STAGE(PG8_SB(1, 0), b3, voffB); PG8_STAGE(PG8_SB(1, 1), b3 + hstepB, voffB); PG8_STAGE(PG8_SA(1, 0), a3, voffA);
            PG8_WAIT_V(8); PG8_WAIT_L(0); PG8_BAR; PG8_MMA(1, 0, At, B0); PG8_MMA(1, 1, At, B1); PG8_BAR; PG8_SCHED;
            } else {
            PG8_LDB(B0, 0, 0); PG8_SCHED; PG8_LDA(At, 0, 0); PG8_STAGE(PG8_SA(1, 1), a1 + hstepA, voffA);
            PG8_WAIT_L(8); PG8_BAR; PG8_WAIT_L(0); PG8_MMA(0, 0, At, B0); PG8_BAR; PG8_SCHED;
            PG8_LDB(B1, 0, 1); PG8_STAGE(PG8_SB(0, 0), b2, voffB);
            PG8_BAR; PG8_WAIT_L(0); PG8_MMA(0, 1, At, B1); PG8_BAR;
            PG8_LDA(At, 0, 1); PG8_STAGE(PG8_SA(0, 0), a2, voffA);
            PG8_BAR; PG8_WAIT_L(0); PG8_MMA(1, 0, At, B0); PG8_BAR; PG8_SCHED;
            PG8_STAGE(PG8_SB(0, 1), b2 + hstepB, voffB);
            PG8_WAIT_V(6); PG8_BAR; PG8_MMA(1, 1, At, B1); PG8_BAR;
            PG8_LDB(B0, 1, 0); PG8_SCHED; PG8_LDA(At, 1, 0); PG8_STAGE(PG8_SA(0, 1), a2 + hstepA, voffA);
            PG8_WAIT_L(8); PG8_BAR; PG8_WAIT_L(0); PG8_MMA(0, 0, At, B0); PG8_BAR; PG8_SCHED;
            PG8_LDB(B1, 1, 1); PG8_STAGE(PG8_SB(1, 0), b3, voffB);
            PG8_BAR; PG8_WAIT_L(0); PG8_MMA(0, 1, At, B1); PG8_BAR;
            PG8_LDA(At, 1, 1); PG8_STAGE(PG8_SA(1, 0), a3, voffA);
            PG8_BAR; PG8_WAIT_L(0); PG8_MMA(1, 0, At, B0); PG8_BAR; PG8_SCHED;
            PG8_STAGE(PG8_SB(1, 1), b3 + hstepB, voffB);
            PG8_WAIT_V(6); PG8_BAR; PG8_MMA(1, 1, At, B1); PG8_BAR;
            }
        }
        if constexpr (ALIGN_EPI) { if (wr == 0) PG8_BAR; }
        if constexpr (!Epi::AFTER_DRAIN) { E(acc, cur, wr, wc, fr, fq); S.done(cur); }
        if (!has_next) break;
#pragma unroll
        for (int a = 0; a < 2; ++a)
#pragma unroll
            for (int b = 0; b < 2; ++b)
#pragma unroll
                for (int m = 0; m < 4; ++m)
#pragma unroll
                    for (int n = 0; n < 2; ++n) acc[a][b][m][n] = (f32x4){0.f, 0.f, 0.f, 0.f};
        cur = nxt; cA = nA; cB = nB; ++ui;
        if constexpr (ALIGN_EPI) { if (wr == 1) PG8_BAR; }
    }
    PG8_WAIT_V(0);
    if constexpr (!ALIGN_EPI) { if (wr == 0) PG8_BAR; }
    PG8_BAR;
    if constexpr (Epi::AFTER_DRAIN) { E.fused(acc, cur, wr, wc, fr, fq, lds, wid, lane); S.done(cur); }
#undef PG8_SA
#undef PG8_SB
#undef PG8_STAGE
#undef PG8_LDA
#undef PG8_LDB
#undef PG8_MMA
#undef PG8_WAIT_V
#undef PG8_WAIT_L
#undef PG8_BAR
#undef PG8_SCHED
}
}

namespace att {
using pg8::bf16_t;
using bf16x8 = __attribute__((ext_vector_type(8))) short;
using s16x4  = __attribute__((ext_vector_type(4))) short;
using f32x16 = __attribute__((ext_vector_type(16))) float;
using u32x4  = __attribute__((ext_vector_type(4))) unsigned;
using f32x4_t = __attribute__((ext_vector_type(4))) float;
constexpr int NW = 8, QBLK = 32, KVBLK = 64, DV = 128;
constexpr int SHM_V = KVBLK * DV * 2;
#define ATT_SBAR() __builtin_amdgcn_sched_barrier(0)
__device__ __forceinline__ int crow(int r, int hi) { return (r & 3) + 8 * (r >> 2) + 4 * hi; }
__device__ __forceinline__ unsigned cvtpk(float lo, float hi) { unsigned r; asm volatile("v_cvt_pk_bf16_f32 %0, %1, %2" : "=v"(r) : "v"(lo), "v"(hi)); return r; }
constexpr float THR = 8.f;

template <int DQK> struct Cfg {
  static constexpr int KROW = DQK * 2 + 16;
  static constexpr int SHM_K = KVBLK * KROW;
  static constexpr int NCH = DQK / 8;
  static constexpr int KPT = DQK / 64;
  static constexpr int ND0 = DQK / 16;
  static constexpr int LDS_BYTES = 2 * SHM_V + 2 * SHM_K + NW * 64 * 4;
};

__device__ __forceinline__ void partialSM(f32x16& p0, f32x16& p1, float& m_reg, float& mn, float& alpha, const float C, const float thr_raw) {
  float pmax = p0[0];
#pragma unroll
  for (int r = 1; r < 16; ++r) pmax = fmaxf(pmax, p0[r]);
#pragma unroll
  for (int r = 0; r < 16; ++r) pmax = fmaxf(pmax, p1[r]);
  { auto rr = __builtin_amdgcn_permlane32_swap(__float_as_uint(pmax), __float_as_uint(pmax), false, false);
    pmax = fmaxf(__uint_as_float(rr[0]), __uint_as_float(rr[1])); }
  if (__builtin_expect(__all(pmax - m_reg <= thr_raw), 1)) { mn = m_reg; alpha = 1.f; }
  else { mn = fmaxf(m_reg, pmax); alpha = __builtin_amdgcn_exp2f((m_reg - mn) * C); m_reg = mn; }
  float mnC = -mn * C;
#pragma unroll
  for (int r = 0; r < 16; ++r) p0[r] = fmaf(p0[r], C, mnC);
#pragma unroll
  for (int r = 0; r < 16; ++r) p1[r] = fmaf(p1[r], C, mnC);
#pragma unroll
  for (int r = 0; r < 16; ++r) p0[r] = __builtin_amdgcn_exp2f(p0[r]);
}
__device__ __forceinline__ void finishSM(f32x16& p0, f32x16& p1, float alpha, float& l_reg, bf16x8& pa0, bf16x8& pa1, bf16x8& pa2, bf16x8& pa3) {
#pragma unroll
  for (int r = 0; r < 16; ++r) p1[r] = __builtin_amdgcn_exp2f(p1[r]);
  float ps = 0;
#pragma unroll
  for (int r = 0; r < 16; ++r) ps += p0[r];
#pragma unroll
  for (int r = 0; r < 16; ++r) ps += p1[r];
  { auto rr = __builtin_amdgcn_permlane32_swap(__float_as_uint(ps), __float_as_uint(ps), false, false);
    ps = __uint_as_float(rr[0]) + __uint_as_float(rr[1]); }
  l_reg = l_reg * alpha + ps;
#define ATT_PK4(P, BASE, OUT) do { unsigned a0 = cvtpk(P[BASE + 0], P[BASE + 1]), a1 = cvtpk(P[BASE + 2], P[BASE + 3]);   \
    unsigned b0 = cvtpk(P[BASE + 4], P[BASE + 5]), b1 = cvtpk(P[BASE + 6], P[BASE + 7]);                              \
    auto r0 = __builtin_amdgcn_permlane32_swap(a0, b0, false, false); auto r1 = __builtin_amdgcn_permlane32_swap(a1, b1, false, false); \
    u32x4 w = {r0[0], r1[0], r0[1], r1[1]}; OUT = *reinterpret_cast<bf16x8*>(&w); } while (0)
  ATT_PK4(p0, 0, pa0); ATT_PK4(p0, 8, pa1); ATT_PK4(p1, 0, pa2); ATT_PK4(p1, 8, pa3);
#undef ATT_PK4
}
template <int DQK> __device__ __forceinline__ void qkt(f32x16& p0, f32x16& p1, const char* Ks, const bf16x8* qr, int r32, int hi) {
  constexpr int KROW = Cfg<DQK>::KROW;
  p0 = f32x16{}; p1 = f32x16{};
#pragma unroll
  for (int d0 = 0; d0 < DQK / 16; ++d0) { const int cb = (d0 * 16 + hi * 8) * 2;
    bf16x8 b0 = *reinterpret_cast<const bf16x8*>(Ks + r32 * KROW + cb);
    bf16x8 b1 = *reinterpret_cast<const bf16x8*>(Ks + (32 + r32) * KROW + cb);
    p0 = __builtin_amdgcn_mfma_f32_32x32x16_bf16(b0, qr[d0], p0, 0, 0, 0);
    p1 = __builtin_amdgcn_mfma_f32_32x32x16_bf16(b1, qr[d0], p1, 0, 0, 0); }
}
__device__ __forceinline__ int v_st(int k, int c) { const int kk = (k & ~0xC) | ((k & 4) << 1) | ((k & 8) >> 1); return ((kk >> 3) * 4 + (c >> 5)) * 512 + ((kk & 7) * 32 + (c & 31)) * 2; }
__device__ __forceinline__ int v_rd_base(int lane) { return ((lane & 3) << 3) | (((lane >> 2) & 3) << 6) | (((lane >> 4) & 1) << 5) | (((lane >> 5) & 1) << 8); }
constexpr int v_rd_off(int d0, int ks, int half) { return d0 * 512 + ks * 4096 + half * 2048; }
template <int OFF> __device__ __forceinline__ s16x4 tr_read(int vb) {
  s16x4 r; asm volatile("ds_read_b64_tr_b16 %0, %1 offset:%2" : "=&v"(r) : "v"(vb), "i"(OFF) : "memory"); return r;
}
template <int D0> __device__ __forceinline__ void pv_one(f32x16& od, int vb, bf16x8 pa0, bf16x8 pa1, bf16x8 pa2, bf16x8 pa3) {
  const s16x4 l0 = tr_read<v_rd_off(D0, 0, 0)>(vb), h0 = tr_read<v_rd_off(D0, 0, 1)>(vb), l1 = tr_read<v_rd_off(D0, 1, 0)>(vb), h1 = tr_read<v_rd_off(D0, 1, 1)>(vb);
  const s16x4 l2 = tr_read<v_rd_off(D0, 2, 0)>(vb), h2 = tr_read<v_rd_off(D0, 2, 1)>(vb), l3 = tr_read<v_rd_off(D0, 3, 0)>(vb), h3 = tr_read<v_rd_off(D0, 3, 1)>(vb);
  asm volatile("s_waitcnt lgkmcnt(0)" ::: "memory"); ATT_SBAR();
#define ATT_PK(L, H) (bf16x8){L[0], L[1], L[2], L[3], H[0], H[1], H[2], H[3]}
  od = __builtin_amdgcn_mfma_f32_32x32x16_bf16(pa0, ATT_PK(l0, h0), od, 0, 0, 0);
  od = __builtin_amdgcn_mfma_f32_32x32x16_bf16(pa1, ATT_PK(l1, h1), od, 0, 0, 0);
  od = __builtin_amdgcn_mfma_f32_32x32x16_bf16(pa2, ATT_PK(l2, h2), od, 0, 0, 0);
  od = __builtin_amdgcn_mfma_f32_32x32x16_bf16(pa3, ATT_PK(l3, h3), od, 0, 0, 0);
#undef ATT_PK
}
__device__ __forceinline__ void pv_d0(f32x16* o, int vb, bf16x8 pa0, bf16x8 pa1, bf16x8 pa2, bf16x8 pa3) {
  pv_one<0>(o[0], vb, pa0, pa1, pa2, pa3); pv_one<1>(o[1], vb, pa0, pa1, pa2, pa3); pv_one<2>(o[2], vb, pa0, pa1, pa2, pa3); pv_one<3>(o[3], vb, pa0, pa1, pa2, pa3);
}

struct OutArgs { bf16_t* Ob; int LDO; float* stash; float lam, post; const float* g; };

template <int DQK, int LDQ, int LDK, int LDV, int MODE, bool SIMPLE = false>
__device__ __forceinline__ void attn_body(const bf16_t* __restrict__ Qb, const bf16_t* __restrict__ Kh, const bf16_t* __restrict__ Vh,
                                          int seq, float scale, const OutArgs& oa, char* lds) {
  using CF = Cfg<DQK>;
  constexpr int KPT = CF::KPT, NCH = CF::NCH, ND0 = CF::ND0, SHM_K = CF::SHM_K, KROW = CF::KROW;
  const float C = scale * 1.4426950408889634f, thr_raw = THR / scale;
  int tid_ = threadIdx.x; asm volatile("" : "+v"(tid_));
  const int tid = tid_, wid = tid >> 6, lane = tid & 63, r32 = lane & 31, hi = lane >> 5;
  char* V_lds = lds; char* K_lds = lds + 2 * SHM_V;
  float* ws = (float*)(lds + 2 * SHM_V + 2 * SHM_K) + wid * 64; float* li_l = ws; float* al_l = ws + 32;
  float m_reg = -1e30f, l_reg = 0; f32x16 o[4] = {}; bf16x8 qr[ND0];
  const bf16_t* Qw = Qb + (long)(wid * QBLK + r32) * LDQ + hi * 8;
#pragma unroll
  for (int d0 = 0; d0 < ND0; ++d0) qr[d0] = *reinterpret_cast<const bf16x8*>(Qw + d0 * 16);
  const int sr = tid >> 4, sc = (tid & 15) * 8, vst0 = v_st(sr, sc), vst1 = v_st(32 + sr, sc);
  int kgo[KPT], klo[KPT];
#pragma unroll
  for (int i = 0; i < KPT; ++i) { const int c = tid + 512 * i, row = c / NCH, ch = c % NCH; kgo[i] = row * LDK + ch * 8; klo[i] = row * KROW + ch * 16; }
  const int vb0 = (int)(uintptr_t)V_lds + v_rd_base(lane);
  struct Slot { bf16x8 vs0, vs1; bf16x8 ks[KPT]; };
  Slot s0_, s1_;
#define ATT_SLOAD(S, k0) do { (S).vs0 = *reinterpret_cast<const bf16x8*>(&Vh[(long)((k0) + sr) * LDV + sc]); (S).vs1 = *reinterpret_cast<const bf16x8*>(&Vh[(long)((k0) + 32 + sr) * LDV + sc]); \
    _Pragma("unroll") for (int _i = 0; _i < KPT; ++_i) (S).ks[_i] = *reinterpret_cast<const bf16x8*>(&Kh[(long)(k0) * LDK + kgo[_i]]); } while (0)
#define ATT_SWRITE(b, S) do { *(bf16x8*)(V_lds + (b) * SHM_V + vst0) = (S).vs0; *(bf16x8*)(V_lds + (b) * SHM_V + vst1) = (S).vs1; \
    _Pragma("unroll") for (int _i = 0; _i < KPT; ++_i) *(bf16x8*)(K_lds + (b) * SHM_K + klo[_i]) = (S).ks[_i]; } while (0)
#define ATT_SWAIT() asm volatile("s_waitcnt vmcnt(%0)" :: "n"(2 + KPT) : "memory")
#define ATT_RESC(a) do { if (__any((a) < 1.f)) { if (hi == 0) al_l[r32] = (a); asm volatile("s_waitcnt lgkmcnt(0)" ::: "memory"); \
    _Pragma("unroll") for (int d = 0; d < 4; ++d) _Pragma("unroll") for (int r = 0; r < 16; ++r) o[d][r] *= al_l[crow(r, hi)]; } } while (0)
  bf16x8 pa0, pa1, pa2, pa3; const int NT = seq / KVBLK;
  if constexpr (SIMPLE) {
    f32x16 p0, p1; float mn, al;
    ATT_SLOAD(s0_, 0); asm volatile("s_waitcnt vmcnt(0)" ::: "memory"); ATT_SWRITE(0, s0_); ATT_SLOAD(s0_, KVBLK); __syncthreads();
    for (int j = 0; j < NT; ++j) { const int b = j & 1;
      ATT_SBAR(); qkt<DQK>(p0, p1, K_lds + b * SHM_K, qr, r32, hi);
      partialSM(p0, p1, m_reg, mn, al, C, thr_raw); ATT_RESC(al);
      finishSM(p0, p1, al, l_reg, pa0, pa1, pa2, pa3); ATT_SBAR();
      pv_d0(o, vb0 + b * SHM_V, pa0, pa1, pa2, pa3); ATT_SBAR();
      if (j + 1 < NT) { asm volatile("s_waitcnt vmcnt(0)" ::: "memory"); ATT_SWRITE(1 - b, s0_); if (j + 2 < NT) ATT_SLOAD(s0_, (j + 2) * KVBLK); }
      __syncthreads();
    }
  } else {
  f32x16 pA0, pA1, pB0, pB1; float mnA, mnB, alA, alB;
  ATT_SLOAD(s0_, 0); asm volatile("s_waitcnt vmcnt(0)" ::: "memory"); ATT_SWRITE(0, s0_); __syncthreads();
  qkt<DQK>(pA0, pA1, K_lds, qr, r32, hi); partialSM(pA0, pA1, m_reg, mnA, alA, C, thr_raw);
  ATT_SLOAD(s1_, KVBLK); if (2 < NT) ATT_SLOAD(s0_, 2 * KVBLK);
  ATT_SWAIT(); ATT_SWRITE(1, s1_); __syncthreads();
  for (int j = 1; j + 1 < NT; j += 2) {
    ATT_SBAR(); qkt<DQK>(pB0, pB1, K_lds + SHM_K, qr, r32, hi);
    finishSM(pA0, pA1, alA, l_reg, pa0, pa1, pa2, pa3); ATT_SBAR();
    ATT_SLOAD(s1_, (j + 2) * KVBLK); ATT_SBAR();
    pv_d0(o, vb0, pa0, pa1, pa2, pa3); partialSM(pB0, pB1, m_reg, mnB, alB, C, thr_raw);
    __syncthreads(); ATT_SWAIT(); ATT_SWRITE(0, s0_);
    ATT_RESC(alB); __syncthreads();
    ATT_SBAR(); qkt<DQK>(pA0, pA1, K_lds, qr, r32, hi);
    finishSM(pB0, pB1, alB, l_reg, pa0, pa1, pa2, pa3); ATT_SBAR();
    if (j + 3 < NT) ATT_SLOAD(s0_, (j + 3) * KVBLK); ATT_SBAR();
    pv_d0(o, vb0 + SHM_V, pa0, pa1, pa2, pa3); partialSM(pA0, pA1, m_reg, mnA, alA, C, thr_raw);
    __syncthreads(); ATT_SWAIT(); ATT_SWRITE(1, s1_);
    ATT_RESC(alA); __syncthreads();
  }
  ATT_SBAR(); qkt<DQK>(pB0, pB1, K_lds + SHM_K, qr, r32, hi);
  finishSM(pA0, pA1, alA, l_reg, pa0, pa1, pa2, pa3); ATT_SBAR();
  pv_d0(o, vb0, pa0, pa1, pa2, pa3); partialSM(pB0, pB1, m_reg, mnB, alB, C, thr_raw);
  __syncthreads(); ATT_RESC(alB);
  finishSM(pB0, pB1, alB, l_reg, pa0, pa1, pa2, pa3); ATT_SBAR();
  pv_d0(o, vb0 + SHM_V, pa0, pa1, pa2, pa3);
  }
  if (hi == 0) li_l[r32] = l_reg; asm volatile("s_waitcnt lgkmcnt(0)" ::: "memory");
  float rli[16];
#pragma unroll
  for (int r = 0; r < 16; ++r) rli[r] = __builtin_amdgcn_rcpf(li_l[crow(r, hi)]);
  __syncthreads();
  float* Ot = (float*)(lds + wid * 16384);
#pragma unroll
  for (int r = 0; r < 16; ++r) { const int orow = crow(r, hi);
#pragma unroll
    for (int d0 = 0; d0 < 4; ++d0) Ot[orow * 128 + d0 * 32 + r32] = o[d0][r] * rli[r]; }
  asm volatile("s_waitcnt lgkmcnt(0)" ::: "memory");
  const int er = lane >> 4, ec = (lane & 15) * 8;
  if constexpr (MODE == 0) {
    bf16_t* Ow = oa.Ob + (long)(wid * QBLK + er) * oa.LDO + ec;
#pragma unroll
    for (int k = 0; k < 8; ++k) { const float* sp = Ot + (4 * k + er) * 128 + ec; const f32x4_t a = *(const f32x4_t*)sp, b = *(const f32x4_t*)(sp + 4);
      *(u32x4*)(Ow + (long)(4 * k) * oa.LDO) = (u32x4){cvtpk(a[0], a[1]), cvtpk(a[2], a[3]), cvtpk(b[0], b[1]), cvtpk(b[2], b[3])}; }
  } else if constexpr (MODE == 1) {
    float* Sw = oa.stash + (wid * QBLK + er) * 128 + ec;
#pragma unroll
    for (int k = 0; k < 8; ++k) { const float* sp = Ot + (4 * k + er) * 128 + ec; const f32x4_t a = *(const f32x4_t*)sp, b = *(const f32x4_t*)(sp + 4);
      *(f32x4_t*)(Sw + 4 * k * 128) = a; *(f32x4_t*)(Sw + 4 * k * 128 + 4) = b; }
  } else {
    const float* Sw = oa.stash + (wid * QBLK + er) * 128 + ec; bf16_t* Ow = oa.Ob + (long)(wid * QBLK + er) * oa.LDO + ec;
    const f32x4_t g0 = *(const f32x4_t*)(oa.g + ec) * oa.post, g1 = *(const f32x4_t*)(oa.g + ec + 4) * oa.post;
#pragma unroll
    for (int k = 0; k < 8; ++k) { asm volatile("" ::: "memory"); const float* sp = Ot + (4 * k + er) * 128 + ec; f32x4_t a = *(const f32x4_t*)sp, b = *(const f32x4_t*)(sp + 4);
      a = *(const f32x4_t*)(Sw + 4 * k * 128) - oa.lam * a; b = *(const f32x4_t*)(Sw + 4 * k * 128 + 4) - oa.lam * b;
      float ss = (a[0] * a[0] + a[1] * a[1]) + (a[2] * a[2] + a[3] * a[3]) + (b[0] * b[0] + b[1] * b[1]) + (b[2] * b[2] + b[3] * b[3]);
      ss += __shfl_xor(ss, 1); ss += __shfl_xor(ss, 2); ss += __shfl_xor(ss, 4); ss += __shfl_xor(ss, 8);
      const float rn = 1.0f / sqrtf(ss * (1.0f / 128.0f) + EPS);
      a = a * rn * g0; b = b * rn * g1;
      *(u32x4*)(Ow + (long)(4 * k) * oa.LDO) = (u32x4){cvtpk(a[0], a[1]), cvtpk(a[2], a[3]), cvtpk(b[0], b[1]), cvtpk(b[2], b[3])}; }
  }
  __syncthreads();
#undef ATT_SLOAD
#undef ATT_SWRITE
#undef ATT_SWAIT
#undef ATT_RESC
}

template <int DQK, int LDQ, int LDK, int LDV, int MODE>
__device__ __forceinline__ void attn_body2(const bf16_t* __restrict__ Qb, const bf16_t* __restrict__ Kh, const bf16_t* __restrict__ Vh,
                                           int seq, float scale, const OutArgs& oa, char* lds, __attribute__((address_space(3))) unsigned char* ldsl) {
  using CF = Cfg<DQK>;
  constexpr int ND0 = CF::ND0, SHM_K = CF::SHM_K, KROW = CF::KROW, SLOT = SHM_K + SHM_V, KCH = SHM_K / 1024, NKI = (KCH + 7) / 8;
  static_assert(SHM_K % 1024 == 0 && 3 * SLOT + NW * 256 <= 131072, "attention LDS ring");
  const float C = scale * 1.4426950408889634f, thr_raw = THR / scale;
  int tid_ = threadIdx.x; asm volatile("" : "+v"(tid_));
  const int tid = tid_, wid = __builtin_amdgcn_readfirstlane(tid >> 6), lane = tid & 63, r32 = lane & 31, hi = lane >> 5;
  float* ws = (float*)(lds + 3 * SLOT) + wid * 64; float* li_l = ws; float* al_l = ws + 32;
  float m_reg = -1e30f, l_reg = 0; f32x16 o[4] = {}; bf16x8 qr[ND0];
  int ksrc[NKI], vsrc[2];
#pragma unroll
  for (int i = 0; i < NKI; ++i) { const int ob = (wid + 8 * i) * 1024 + lane * 16, row = ob / KROW, within = ob - row * KROW; ksrc[i] = (row < KVBLK ? row : 0) * LDK + (within < 2 * DQK ? within / 2 : 0); }
#pragma unroll
  for (int i = 0; i < 2; ++i) { const int gi = (2 * wid + i) * 64 + lane, c8 = (gi & 3) | (((gi >> 5) & 3) << 2), kk = ((gi >> 2) & 7) | ((gi >> 7) << 3), k = (kk & ~0xC) | ((kk & 4) << 1) | ((kk & 8) >> 1); vsrc[i] = k * LDV + c8 * 8; }
#define ATT_GLDS(g, l) __builtin_amdgcn_global_load_lds((const unsigned*)(g), (__attribute__((address_space(3))) unsigned*)(l), 16, 0, 0)
#define ATT_DMA(k0, s) do { __attribute__((address_space(3))) unsigned char* _kb = ldsl + (s) * SLOT; \
    _Pragma("unroll") for (int _i = 0; _i < NKI; ++_i) { if (wid + 8 * _i < KCH) ATT_GLDS(Kh + (long)(k0) * LDK + ksrc[_i], _kb + (wid + 8 * _i) * 1024); } \
    _Pragma("unroll") for (int _i = 0; _i < 2; ++_i) ATT_GLDS(Vh + (long)(k0) * LDV + vsrc[_i], _kb + SHM_K + (2 * wid + _i) * 1024); } while (0)
#define ATT_BAR() do { asm volatile("s_waitcnt vmcnt(0) lgkmcnt(0)" ::: "memory"); __builtin_amdgcn_s_barrier(); asm volatile("" ::: "memory"); } while (0)
#define ATT_RESC2(a) do { if (__any((a) < 1.f)) { if (hi == 0) al_l[r32] = (a); asm volatile("s_waitcnt lgkmcnt(0)" ::: "memory"); \
    _Pragma("unroll") for (int d = 0; d < 4; ++d) _Pragma("unroll") for (int r = 0; r < 16; ++r) o[d][r] *= al_l[crow(r, hi)]; } } while (0)
  const int NT = seq / KVBLK;
  ATT_DMA(0, 0); ATT_DMA(KVBLK, 1);
  const bf16_t* Qw = Qb + (long)(wid * QBLK + r32) * LDQ + hi * 8;
#pragma unroll
  for (int d0 = 0; d0 < ND0; ++d0) qr[d0] = *reinterpret_cast<const bf16x8*>(Qw + d0 * 16);
  ATT_BAR();
  const int vb0 = (int)(uintptr_t)lds + SHM_K + v_rd_base(lane);
  f32x16 pA0, pA1, pB0, pB1; float mnA, mnB, alA, alB; bf16x8 pa0, pa1, pa2, pa3;
  qkt<DQK>(pA0, pA1, lds, qr, r32, hi); partialSM(pA0, pA1, m_reg, mnA, alA, C, thr_raw);
  if (2 < NT) ATT_DMA(2 * KVBLK, 2);
  int sj = 1, sp = 0;
  for (int j = 1; j + 1 < NT; j += 2) {
    ATT_SBAR(); qkt<DQK>(pB0, pB1, lds + sj * SLOT, qr, r32, hi);
    finishSM(pA0, pA1, alA, l_reg, pa0, pa1, pa2, pa3); ATT_SBAR();
    pv_d0(o, vb0 + sp * SLOT, pa0, pa1, pa2, pa3); partialSM(pB0, pB1, m_reg, mnB, alB, C, thr_raw);
    ATT_BAR();
    if (j + 2 < NT) ATT_DMA((j + 2) * KVBLK, sp);
    ATT_RESC2(alB);
    { const int t = sp; sp = sj; sj = (sj == 2) ? 0 : sj + 1; (void)t; }
    ATT_SBAR(); qkt<DQK>(pA0, pA1, lds + sj * SLOT, qr, r32, hi);
    finishSM(pB0, pB1, alB, l_reg, pa0, pa1, pa2, pa3); ATT_SBAR();
    pv_d0(o, vb0 + sp * SLOT, pa0, pa1, pa2, pa3); partialSM(pA0, pA1, m_reg, mnA, alA, C, thr_raw);
    ATT_BAR();
    if (j + 3 < NT) ATT_DMA((j + 3) * KVBLK, sp);
    ATT_RESC2(alA);
    { sp = sj; sj = (sj == 2) ? 0 : sj + 1; }
  }
  ATT_SBAR(); qkt<DQK>(pB0, pB1, lds + sj * SLOT, qr, r32, hi);
  finishSM(pA0, pA1, alA, l_reg, pa0, pa1, pa2, pa3); ATT_SBAR();
  pv_d0(o, vb0 + sp * SLOT, pa0, pa1, pa2, pa3); partialSM(pB0, pB1, m_reg, mnB, alB, C, thr_raw);
  ATT_RESC2(alB);
  finishSM(pB0, pB1, alB, l_reg, pa0, pa1, pa2, pa3); ATT_SBAR();
  pv_d0(o, vb0 + sj * SLOT, pa0, pa1, pa2, pa3);
  if (hi == 0) li_l[r32] = l_reg; asm volatile("s_waitcnt lgkmcnt(0)" ::: "memory");
  float rli[16];
#pragma unroll
  for (int r = 0; r < 16; ++r) rli[r] = __builtin_amdgcn_rcpf(li_l[crow(r, hi)]);
  ATT_BAR();
  float* Ot = (float*)(lds + wid * 16384);
#pragma unroll
  for (int r = 0; r < 16; ++r) { const int orow = crow(r, hi);
#pragma unroll
    for (int d0 = 0; d0 < 4; ++d0) Ot[orow * 128 + d0 * 32 + r32] = o[d0][r] * rli[r]; }
  asm volatile("s_waitcnt lgkmcnt(0)" ::: "memory");
  const int er = lane >> 4, ec = (lane & 15) * 8;
  if constexpr (MODE == 0) {
    bf16_t* Ow = oa.Ob + (long)(wid * QBLK + er) * oa.LDO + ec;
#pragma unroll
    for (int k = 0; k < 8; ++k) { const float* sp2 = Ot + (4 * k + er) * 128 + ec; const f32x4_t a = *(const f32x4_t*)sp2, b = *(const f32x4_t*)(sp2 + 4);
      *(u32x4*)(Ow + (long)(4 * k) * oa.LDO) = (u32x4){cvtpk(a[0], a[1]), cvtpk(a[2], a[3]), cvtpk(b[0], b[1]), cvtpk(b[2], b[3])}; }
  } else if constexpr (MODE == 1) {
    float* Sw = oa.stash + (wid * QBLK + er) * 128 + ec;
#pragma unroll
    for (int k = 0; k < 8; ++k) { const float* sp2 = Ot + (4 * k + er) * 128 + ec; const f32x4_t a = *(const f32x4_t*)sp2, b = *(const f32x4_t*)(sp2 + 4);
      *(f32x4_t*)(Sw + 4 * k * 128) = a; *(f32x4_t*)(Sw + 4 * k * 128 + 4) = b; }
  } else {
    const float* Sw = oa.stash + (wid * QBLK + er) * 128 + ec; bf16_t* Ow = oa.Ob + (long)(wid * QBLK + er) * oa.LDO + ec;
    const f32x4_t g0 = *(const f32x4_t*)(oa.g + ec) * oa.post, g1 = *(const f32x4_t*)(oa.g + ec + 4) * oa.post;
#pragma unroll
    for (int k = 0; k < 8; ++k) { asm volatile("" ::: "memory"); const float* sp2 = Ot + (4 * k + er) * 128 + ec; f32x4_t a = *(const f32x4_t*)sp2, b = *(const f32x4_t*)(sp2 + 4);
      a = *(const f32x4_t*)(Sw + 4 * k * 128) - oa.lam * a; b = *(const f32x4_t*)(Sw + 4 * k * 128 + 4) - oa.lam * b;
      float ss = (a[0] * a[0] + a[1] * a[1]) + (a[2] * a[2] + a[3] * a[3]) + (b[0] * b[0] + b[1] * b[1]) + (b[2] * b[2] + b[3] * b[3]);
      ss += __shfl_xor(ss, 1); ss += __shfl_xor(ss, 2); ss += __shfl_xor(ss, 4); ss += __shfl_xor(ss, 8);
      const float rn = 1.0f / sqrtf(ss * (1.0f / 128.0f) + EPS);
      a = a * rn * g0; b = b * rn * g1;
      *(u32x4*)(Ow + (long)(4 * k) * oa.LDO) = (u32x4){cvtpk(a[0], a[1]), cvtpk(a[2], a[3]), cvtpk(b[0], b[1]), cvtpk(b[2], b[3])}; }
  }
  ATT_BAR();
#undef ATT_GLDS
#undef ATT_DMA
#undef ATT_BAR
#undef ATT_RESC2
}

template <int OFF> __device__ __forceinline__ bf16x8 ds_rd128(int addr) { bf16x8 r; asm volatile("ds_read_b128 %0, %1 offset:%2" : "=&v"(r) : "v"(addr), "i"(OFF) : "memory"); return r; }
template <int N> __device__ __forceinline__ void wait_lgkm() { asm volatile("s_waitcnt lgkmcnt(%0)" :: "n"(N) : "memory"); }
#define ATT_RKG(dst, g) do { dst[0] = ds_rd128<(2 * (g)) * 32>(kb); dst[1] = ds_rd128<(2 * (g)) * 32 + 32 * KROW>(kb); dst[2] = ds_rd128<(2 * (g) + 1) * 32>(kb); dst[3] = ds_rd128<(2 * (g) + 1) * 32 + 32 * KROW>(kb); } while (0)
#define ATT_MKG(src, g) do { p0 = __builtin_amdgcn_mfma_f32_32x32x16_bf16(src[0], qr[2 * (g)], p0, 0, 0, 0); p1 = __builtin_amdgcn_mfma_f32_32x32x16_bf16(src[1], qr[2 * (g)], p1, 0, 0, 0); \
    p0 = __builtin_amdgcn_mfma_f32_32x32x16_bf16(src[2], qr[2 * (g) + 1], p0, 0, 0, 0); p1 = __builtin_amdgcn_mfma_f32_32x32x16_bf16(src[3], qr[2 * (g) + 1], p1, 0, 0, 0); } while (0)
#define ATT_PKV(L, H) (bf16x8){L[0], L[1], L[2], L[3], H[0], H[1], H[2], H[3]}
#define ATT_VRD(D0, P) const s16x4 P##l0 = tr_read<v_rd_off(D0, 0, 0)>(vb), P##h0 = tr_read<v_rd_off(D0, 0, 1)>(vb), P##l1 = tr_read<v_rd_off(D0, 1, 0)>(vb), P##h1 = tr_read<v_rd_off(D0, 1, 1)>(vb), \
    P##l2 = tr_read<v_rd_off(D0, 2, 0)>(vb), P##h2 = tr_read<v_rd_off(D0, 2, 1)>(vb), P##l3 = tr_read<v_rd_off(D0, 3, 0)>(vb), P##h3 = tr_read<v_rd_off(D0, 3, 1)>(vb)
#define ATT_VMM(od, P) do { od = __builtin_amdgcn_mfma_f32_32x32x16_bf16(pa0, ATT_PKV(P##l0, P##h0), od, 0, 0, 0); od = __builtin_amdgcn_mfma_f32_32x32x16_bf16(pa1, ATT_PKV(P##l1, P##h1), od, 0, 0, 0); \
    od = __builtin_amdgcn_mfma_f32_32x32x16_bf16(pa2, ATT_PKV(P##l2, P##h2), od, 0, 0, 0); od = __builtin_amdgcn_mfma_f32_32x32x16_bf16(pa3, ATT_PKV(P##l3, P##h3), od, 0, 0, 0); } while (0)
#define ATT_W(n) do { wait_lgkm<n>(); ATT_SBAR(); } while (0)
template <int DQK, bool PV> __device__ __forceinline__ void att_mblock(f32x16& p0, f32x16& p1, f32x16* o, const bf16x8* qr, int kb, int vb, bf16x8 pa0, bf16x8 pa1, bf16x8 pa2, bf16x8 pa3) {
  constexpr int KROW = Cfg<DQK>::KROW, NG = DQK / 32;
  constexpr int WK = PV ? 8 : 0;
  bf16x8 kA[4], kB[4];
  p0 = f32x16{}; p1 = f32x16{};
  ATT_RKG(kA, 0); ATT_RKG(kB, 1);
  if constexpr (NG == 2) {
    if constexpr (PV) {
      ATT_W(4); ATT_MKG(kA, 0); ATT_SBAR(); ATT_VRD(0, a);
      ATT_W(8); ATT_MKG(kB, 1); ATT_SBAR(); ATT_VRD(1, b);
      ATT_W(8); ATT_VMM(o[0], a); ATT_SBAR(); ATT_VRD(2, c);
      ATT_W(8); ATT_VMM(o[1], b); ATT_SBAR(); ATT_VRD(3, d);
      ATT_W(8); ATT_VMM(o[2], c); ATT_SBAR();
      ATT_W(0); ATT_VMM(o[3], d);
    } else { ATT_W(4); ATT_MKG(kA, 0); ATT_SBAR(); ATT_W(0); ATT_MKG(kB, 1); }
  } else if constexpr (NG == 4) {
    ATT_W(4); ATT_MKG(kA, 0); ATT_SBAR(); ATT_RKG(kA, 2);
    ATT_W(4); ATT_MKG(kB, 1); ATT_SBAR(); ATT_RKG(kB, 3);
    if constexpr (PV) {
      ATT_W(4); ATT_MKG(kA, 2); ATT_SBAR(); ATT_VRD(0, a);
      ATT_W(8); ATT_MKG(kB, 3); ATT_SBAR(); ATT_VRD(1, b);
      ATT_W(8); ATT_VMM(o[0], a); ATT_SBAR(); ATT_VRD(2, c);
      ATT_W(8); ATT_VMM(o[1], b); ATT_SBAR(); ATT_VRD(3, d);
      ATT_W(8); ATT_VMM(o[2], c); ATT_SBAR();
      ATT_W(0); ATT_VMM(o[3], d);
    } else { ATT_W(4); ATT_MKG(kA, 2); ATT_SBAR(); ATT_W(0); ATT_MKG(kB, 3); }
  } else {
    ATT_W(4); ATT_MKG(kA, 0); ATT_SBAR(); ATT_RKG(kA, 2);
    ATT_W(4); ATT_MKG(kB, 1); ATT_SBAR(); ATT_RKG(kB, 3);
    ATT_W(4); ATT_MKG(kA, 2); ATT_SBAR(); ATT_RKG(kA, 4);
    ATT_W(4); ATT_MKG(kB, 3); ATT_SBAR(); ATT_RKG(kB, 5);
    if constexpr (PV) {
      ATT_W(4); ATT_MKG(kA, 4); ATT_SBAR(); ATT_VRD(0, a);
      ATT_W(8); ATT_MKG(kB, 5); ATT_SBAR(); ATT_VRD(1, b);
      ATT_W(8); ATT_VMM(o[0], a); ATT_SBAR(); ATT_VRD(2, c);
      ATT_W(8); ATT_VMM(o[1], b); ATT_SBAR(); ATT_VRD(3, d);
      ATT_W(8); ATT_VMM(o[2], c); ATT_SBAR();
      ATT_W(0); ATT_VMM(o[3], d);
    } else { ATT_W(4); ATT_MKG(kA, 4); ATT_SBAR(); ATT_W(0); ATT_MKG(kB, 5); }
  }
  (void)WK;
}
__device__ __forceinline__ void att_pvblock(f32x16* o, int vb, bf16x8 pa0, bf16x8 pa1, bf16x8 pa2, bf16x8 pa3) {
  ATT_VRD(0, a); ATT_VRD(1, b);
  ATT_W(8); ATT_VMM(o[0], a); ATT_SBAR(); ATT_VRD(2, c);
  ATT_W(8); ATT_VMM(o[1], b); ATT_SBAR(); ATT_VRD(3, d);
  ATT_W(8); ATT_VMM(o[2], c); ATT_SBAR();
  ATT_W(0); ATT_VMM(o[3], d);
}

template <int DQK, int LDQ, int LDK, int LDV, int MODE>
__device__ __forceinline__ void attn_body3(const bf16_t* __restrict__ Qb, const bf16_t* __restrict__ Kh, const bf16_t* __restrict__ Vh,
                                           int seq, float scale, const OutArgs& oa, char* lds, __attribute__((address_space(3))) unsigned char* ldsl) {
  using CF = Cfg<DQK>;
  constexpr int ND0 = CF::ND0, SHM_K = CF::SHM_K, KROW = CF::KROW, SLOT = SHM_K + SHM_V, KCH = SHM_K / 1024, NKI = (KCH + 7) / 8, NDMA = NKI + 2;
  static_assert(SHM_K % 1024 == 0 && 3 * SLOT + NW * 256 + 1024 <= 131072, "attention LDS ring");
  const float C = scale * 1.4426950408889634f, thr_raw = THR / scale;
  int tid_ = threadIdx.x; asm volatile("" : "+v"(tid_));
  const int tid = tid_, wid = __builtin_amdgcn_readfirstlane(tid >> 6), lane = tid & 63, r32 = lane & 31, hi = lane >> 5, grp = wid >> 2;
  float* ws = (float*)(lds + 3 * SLOT) + wid * 64; float* li_l = ws; float* al_l = ws + 32;
  float m_reg = -1e30f, l_reg = 0; f32x16 o[4] = {}; bf16x8 qr[ND0];
  int ksrc[NKI], vsrc[2];
#pragma unroll
  for (int i = 0; i < NKI; ++i) { const int ob = (wid + 8 * i) * 1024 + lane * 16, row = ob / KROW, within = ob - row * KROW; ksrc[i] = (row < KVBLK ? row : 0) * LDK + (within < 2 * DQK ? within / 2 : 0); }
#pragma unroll
  for (int i = 0; i < 2; ++i) { const int gi = (2 * wid + i) * 64 + lane, c8 = (gi & 3) | (((gi >> 5) & 3) << 2), kk = ((gi >> 2) & 7) | ((gi >> 7) << 3), k = (kk & ~0xC) | ((kk & 4) << 1) | ((kk & 8) >> 1); vsrc[i] = k * LDV + c8 * 8; }
#define ATT_GLDS(g, l) __builtin_amdgcn_global_load_lds((const unsigned*)(g), (__attribute__((address_space(3))) unsigned*)(l), 16, 0, 0)
#define ATT_DMA(k0, s) do { __attribute__((address_space(3))) unsigned char* _kb = ldsl + (s) * SLOT; \
    _Pragma("unroll") for (int _i = 0; _i < NKI; ++_i) { const int _ci = wid + 8 * _i; ATT_GLDS(Kh + (long)(k0) * LDK + ksrc[_i], _ci < KCH ? _kb + _ci * 1024 : ldsl + 3 * SLOT + NW * 256); } \
    _Pragma("unroll") for (int _i = 0; _i < 2; ++_i) ATT_GLDS(Vh + (long)(k0) * LDV + vsrc[_i], _kb + SHM_K + (2 * wid + _i) * 1024); } while (0)
#define ATT_BAR0() do { asm volatile("s_waitcnt vmcnt(0) lgkmcnt(0)" ::: "memory"); __builtin_amdgcn_s_barrier(); asm volatile("" ::: "memory"); } while (0)
#define ATT_BARN() do { asm volatile("s_waitcnt vmcnt(%0) lgkmcnt(0)" :: "n"(NDMA) : "memory"); __builtin_amdgcn_s_barrier(); asm volatile("" ::: "memory"); } while (0)
  const int NT = seq / KVBLK;
  ATT_DMA(0, 0); ATT_DMA(KVBLK, 1);
  const bf16_t* Qw = Qb + (long)(wid * QBLK + r32) * LDQ + hi * 8;
#pragma unroll
  for (int d0 = 0; d0 < ND0; ++d0) qr[d0] = *reinterpret_cast<const bf16x8*>(Qw + d0 * 16);
  ATT_BAR0();
  const int vb0 = (int)(uintptr_t)lds + SHM_K + v_rd_base(lane);
  f32x16 p0, p1; float mn, al; bf16x8 pa0 = {}, pa1 = {}, pa2 = {}, pa3 = {};
  if (grp) ATT_BAR0();
  const int kb0 = (int)(uintptr_t)lds + r32 * KROW + hi * 16;
#define ATT_VBLOCK() do { partialSM(p0, p1, m_reg, mn, al, C, thr_raw); \
    if (__any(al < 1.f)) { if (hi == 0) al_l[r32] = al; asm volatile("s_waitcnt lgkmcnt(0)" ::: "memory"); \
      _Pragma("unroll") for (int d = 0; d < 4; ++d) _Pragma("unroll") for (int r = 0; r < 16; ++r) o[d][r] *= al_l[crow(r, hi)]; } \
    finishSM(p0, p1, al, l_reg, pa0, pa1, pa2, pa3); ATT_SBAR(); } while (0)
  ATT_SBAR(); att_mblock<DQK, false>(p0, p1, o, qr, kb0, vb0, pa0, pa1, pa2, pa3); ATT_SBAR();
  if (grp == 0) ATT_BARN(); else ATT_BAR0();
  if (grp == 1 && 2 < NT) ATT_DMA(2 * KVBLK, 2);
  ATT_VBLOCK();
  if (grp == 0) ATT_BAR0(); else ATT_BARN();
  int sj = 1, sp = 0;
  for (int j = 1; j < NT; ++j) {
    if (grp == 0 && j + 1 < NT) ATT_DMA((j + 1) * KVBLK, (sj == 2) ? 0 : sj + 1);
    ATT_SBAR(); att_mblock<DQK, true>(p0, p1, o, qr, kb0 + sj * SLOT, vb0 + sp * SLOT, pa0, pa1, pa2, pa3); ATT_SBAR();
    if (grp == 0) ATT_BARN(); else ATT_BAR0();
    if (grp == 1 && j + 2 < NT) ATT_DMA((j + 2) * KVBLK, sp);
    ATT_VBLOCK();
    if (grp == 0) ATT_BAR0(); else ATT_BARN();
    sp = sj; sj = (sj == 2) ? 0 : sj + 1;
  }
  att_pvblock(o, vb0 + sp * SLOT, pa0, pa1, pa2, pa3);
  if (grp == 0) ATT_BAR0();
  if (hi == 0) li_l[r32] = l_reg; asm volatile("s_waitcnt lgkmcnt(0)" ::: "memory");
  float rli[16];
#pragma unroll
  for (int r = 0; r < 16; ++r) rli[r] = __builtin_amdgcn_rcpf(li_l[crow(r, hi)]);
  ATT_BAR0();
  float* Ot = (float*)(lds + wid * 16384);
#pragma unroll
  for (int r = 0; r < 16; ++r) { const int orow = crow(r, hi);
#pragma unroll
    for (int d0 = 0; d0 < 4; ++d0) Ot[orow * 128 + d0 * 32 + r32] = o[d0][r] * rli[r]; }
  asm volatile("s_waitcnt lgkmcnt(0)" ::: "memory");
  const int er = lane >> 4, ec = (lane & 15) * 8;
  if constexpr (MODE == 0) {
    bf16_t* Ow = oa.Ob + (long)(wid * QBLK + er) * oa.LDO + ec;
#pragma unroll
    for (int k = 0; k < 8; ++k) { const float* sp2 = Ot + (4 * k + er) * 128 + ec; const f32x4_t a = *(const f32x4_t*)sp2, b = *(const f32x4_t*)(sp2 + 4);
      *(u32x4*)(Ow + (long)(4 * k) * oa.LDO) = (u32x4){cvtpk(a[0], a[1]), cvtpk(a[2], a[3]), cvtpk(b[0], b[1]), cvtpk(b[2], b[3])}; }
  } else if constexpr (MODE == 1) {
    float* Sw = oa.stash + (wid * QBLK + er) * 128 + ec;
#pragma unroll
    for (int k = 0; k < 8; ++k) { const float* sp2 = Ot + (4 * k + er) * 128 + ec; const f32x4_t a = *(const f32x4_t*)sp2, b = *(const f32x4_t*)(sp2 + 4);
      *(f32x4_t*)(Sw + 4 * k * 128) = a; *(f32x4_t*)(Sw + 4 * k * 128 + 4) = b; }
  } else {
    const float* Sw = oa.stash + (wid * QBLK + er) * 128 + ec; bf16_t* Ow = oa.Ob + (long)(wid * QBLK + er) * oa.LDO + ec;
    const f32x4_t g0 = *(const f32x4_t*)(oa.g + ec) * oa.post, g1 = *(const f32x4_t*)(oa.g + ec + 4) * oa.post;
#pragma unroll
    for (int k = 0; k < 8; ++k) { asm volatile("" ::: "memory"); const float* sp2 = Ot + (4 * k + er) * 128 + ec; f32x4_t a = *(const f32x4_t*)sp2, b = *(const f32x4_t*)(sp2 + 4);
      a = *(const f32x4_t*)(Sw + 4 * k * 128) - oa.lam * a; b = *(const f32x4_t*)(Sw + 4 * k * 128 + 4) - oa.lam * b;
      float ss = (a[0] * a[0] + a[1] * a[1]) + (a[2] * a[2] + a[3] * a[3]) + (b[0] * b[0] + b[1] * b[1]) + (b[2] * b[2] + b[3] * b[3]);
      ss += __shfl_xor(ss, 1); ss += __shfl_xor(ss, 2); ss += __shfl_xor(ss, 4); ss += __shfl_xor(ss, 8);
      const float rn = 1.0f / sqrtf(ss * (1.0f / 128.0f) + EPS);
      a = a * rn * g0; b = b * rn * g1;
      *(u32x4*)(Ow + (long)(4 * k) * oa.LDO) = (u32x4){cvtpk(a[0], a[1]), cvtpk(a[2], a[3]), cvtpk(b[0], b[1]), cvtpk(b[2], b[3])}; }
  }
  ATT_BAR0();
#undef ATT_GLDS
#undef ATT_DMA
#undef ATT_BAR0
#undef ATT_BARN
#undef ATT_VBLOCK
}
}

#define GAS __attribute__((address_space(1)))
#define LAS __attribute__((address_space(3)))
typedef unsigned short bf16;
typedef unsigned v4u __attribute__((ext_vector_type(4)));
typedef unsigned v2u __attribute__((ext_vector_type(2)));
typedef float f32x4 __attribute__((ext_vector_type(4)));
typedef float f32x2 __attribute__((ext_vector_type(2)));
typedef __bf16 bf16x2_t __attribute__((ext_vector_type(2)));
typedef GAS unsigned gu32;
#define RLX_AGENT __ATOMIC_RELAXED, __HIP_MEMORY_SCOPE_AGENT
#define LDS_WAIT() asm volatile("s_waitcnt lgkmcnt(0)" ::: "memory")
#define VM_WAIT() asm volatile("s_waitcnt vmcnt(0)" ::: "memory")
__device__ __forceinline__ unsigned pk2(float lo, float hi) { unsigned r; asm volatile("v_cvt_pk_bf16_f32 %0, %1, %2" : "=v"(r) : "v"(lo), "v"(hi)); return r; }
__device__ __forceinline__ float bflo(unsigned w) { return __uint_as_float(w << 16); }
__device__ __forceinline__ float bfhi(unsigned w) { return __uint_as_float(w & 0xffff0000u); }
__device__ __forceinline__ float dot2bf(unsigned a, unsigned b, float acc) { return __builtin_amdgcn_fdot2_f32_bf16(__builtin_bit_cast(bf16x2_t, a), __builtin_bit_cast(bf16x2_t, b), acc, false); }
__device__ __forceinline__ float wave_sum(float v) {
#pragma unroll
    for (int o = 1; o < 64; o <<= 1) v += __shfl_xor(v, o);
    return v;
}

#define XB_TMO      128
#define XB_XCNT(j)  (256  + 64 * (j))
#define XB_XSUB(j)  (1280 + 64 * (j))
#define XB_XGEN(j)  (2304 + 64 * (j))
#define XB_TOP      3328
#define XB_TOPGEN   3392
#define XCD_BAR_WORDS 3456
#define XB_SPIN_CAP (1u << 18)

__device__ __forceinline__ unsigned xb_ld(unsigned* p)              { return __hip_atomic_load(p, __ATOMIC_RELAXED, __HIP_MEMORY_SCOPE_AGENT); }
__device__ __forceinline__ unsigned xb_add(unsigned* p, unsigned v) { return __hip_atomic_fetch_add(p, v, __ATOMIC_RELAXED, __HIP_MEMORY_SCOPE_AGENT); }
__device__ __forceinline__ unsigned xb_xcc_id() { return (unsigned)__builtin_amdgcn_s_getreg((3 << 11) | 20) & 0xFu; }
#define XB_SPIN(cond, bar) do { unsigned _sp = 0; while (cond) { __builtin_amdgcn_s_sleep(1); \
    if ((++_sp & 255u) == 0u) { if (xb_ld(&(bar)[XB_TMO])) break; if (_sp > XB_SPIN_CAP) { atomicAdd(&(bar)[XB_TMO], 1u); break; } } } } while (0)

struct XcdBarrier {
    unsigned* bar; unsigned x;
    volatile LAS unsigned* st;
};

__device__ __forceinline__ XcdBarrier xcd_barrier_post(unsigned* bar, volatile LAS unsigned* st) {
    XcdBarrier b; b.bar = bar; b.x = xb_xcc_id(); b.st = st;
    if (threadIdx.x == 0) (void)xb_add(&bar[XB_XCNT(b.x)], 1u);
    return b;
}
__device__ __forceinline__ void xcd_barrier_complete(unsigned* bar, unsigned x, unsigned& nloc, unsigned& nx) {
    const unsigned G = gridDim.x * gridDim.y * gridDim.z;
    unsigned sum, cnt, mine, sp = 0u;
    for (;;) {
        sum = 0u; cnt = 0u; mine = 0u;
#pragma unroll
        for (unsigned j = 0; j < 16; ++j) { const unsigned c = xb_ld(&bar[XB_XCNT(j)]); sum += c; cnt += (c > 0u) ? 1u : 0u; mine = (j == x) ? c : mine; }
        if (sum == G) break;
        __builtin_amdgcn_s_sleep(1);
        if ((++sp & 255u) == 0u) { if (xb_ld(&bar[XB_TMO])) break; if (sp > XB_SPIN_CAP) { atomicAdd(&bar[XB_TMO], 1u); break; } }
    }
    nloc = mine > 0u ? mine : 1u; nx = cnt > 0u ? cnt : 1u;
}

__device__ __forceinline__ void xcd_barrier(const XcdBarrier& b) {
    asm volatile("s_waitcnt vmcnt(0)" ::: "memory");
    __syncthreads();
    if (threadIdx.x == 0) {
        unsigned* bar = b.bar;
        __builtin_amdgcn_s_waitcnt(0);
        unsigned nloc = b.st[0], nx = b.st[1];
        if (nloc == 0u) { xcd_barrier_complete(bar, b.x, nloc, nx); b.st[0] = nloc; b.st[1] = nx; }
        const unsigned old = xb_add(&bar[XB_XSUB(b.x)], 1u);
        const unsigned gen = old / nloc;
        if (old + 1u == (gen + 1u) * nloc) {
            __builtin_amdgcn_fence(__ATOMIC_RELEASE, "agent");
            asm volatile("s_waitcnt vmcnt(0)" ::: "memory");
            const unsigned og = xb_add(&bar[XB_TOP], 1u);
            const unsigned tg = og / nx;
            if (og + 1u == (tg + 1u) * nx) xb_add(&bar[XB_TOPGEN], 1u);
            else XB_SPIN(xb_ld(&bar[XB_TOPGEN]) == tg, bar);
            __builtin_amdgcn_fence(__ATOMIC_ACQUIRE, "agent");
            xb_add(&bar[XB_XGEN(b.x)], 1u);
            asm volatile("s_waitcnt vmcnt(0)" ::: "memory");
        } else {
            XB_SPIN(xb_ld(&bar[XB_XGEN(b.x)]) == gen, bar);
            __builtin_amdgcn_fence(__ATOMIC_ACQUIRE, "agent");
            asm volatile("s_waitcnt vmcnt(0)" ::: "memory");
        }
    }
    __syncthreads();
}


constexpr size_t MiB = 1u << 20;
constexpr size_t WS_CTL = 0, CTL_BYTES = 1 * MiB;
constexpr size_t WS_ROPE = 1 * MiB;
constexpr size_t WS_WIN = 4 * MiB;
constexpr size_t WS_WUQ = 60 * MiB;
constexpr size_t WS_WUKV = 64 * MiB;
constexpr size_t WS_WO = 68 * MiB;
constexpr size_t WS_WQ = 100 * MiB;
constexpr size_t WS_SUBK = 132 * MiB;
constexpr size_t WS_U = 134 * MiB;
constexpr size_t WS_V = 262 * MiB;
constexpr size_t WS_USC = 390 * MiB, WS_VSC = 391 * MiB;
constexpr size_t WS_X = 646 * MiB;
constexpr size_t WS_X1 = 742 * MiB;
constexpr size_t WS_H = 838 * MiB;
constexpr size_t WS_BQ = 1006 * MiB;
constexpr size_t WS_BK = 1060 * MiB;
constexpr size_t WS_BV = 1114 * MiB;
constexpr size_t WS_AO = 1150 * MiB;
constexpr size_t WS_Y = 1246 * MiB;
constexpr size_t WS_SKD = 1438 * MiB;
constexpr size_t WS_WQS = 1470 * MiB;
constexpr size_t WQS_LAYER = (size_t)2048 * 2048 + 2048;
constexpr size_t WS_STASH = 1534 * MiB;
constexpr size_t WS_EID = 518 * MiB, WS_GATEV = 530 * MiB, WS_USCT = 542 * MiB, WS_WT = 554 * MiB;
constexpr size_t WS_X8 = 566 * MiB;
constexpr size_t WS_XS = 614 * MiB;
constexpr size_t WS_PD = 1566 * MiB;
constexpr size_t WS_END = 1758 * MiB;
#if MK_DBG
constexpr size_t WS_SC = WS_END, WS_NEED = WS_END + 192 * MiB;
#else
constexpr size_t WS_SC = WS_Y, WS_NEED = WS_END;
#endif
constexpr int CW_BAR = 4096;
constexpr int CW_QUEUE = 8192;
constexpr int CW_SQ = 12288;
constexpr int CW_DBG = 16384;

constexpr int RING_BYTES = 131072;
constexpr int MISC_OFF = RING_BYTES;
constexpr int LDS_BYTES = 147456;

struct Args { const float* in[23]; float* out; unsigned char* ws; int ph_lo, ph_hi; };

struct Frame {
    LAS unsigned char* lds; char* lds_g;
    gu32* ctl; unsigned char* ws;
    int tid, lane, wave, gw, ngw;
};

template <int MODE> __device__ __forceinline__ int rowmap(int n) {
    if (MODE == 0) return n;
    const int head = n / 192, w = n - head * 192; if (w < 128) return n;
    const int e = w - 128, s = e >> 5, f = e & 31; return head * 192 + 128 + 2 * f + s;
}
template <int MODE> __device__ __forceinline__ void transpose_item(const float* W, int K, int N, bf16* WT, LAS float* scr, int item, int lane) {
    const int nblk = N / 32, kb = item / nblk, nb = item % nblk, k0 = 64 * kb, n0 = 32 * nb;
#pragma unroll 8
    for (int i = 0; i < 32; ++i) { const int kk = 2 * i + (lane >> 5); scr[kk * 33 + (lane & 31)] = W[(size_t)(k0 + kk) * N + n0 + (lane & 31)]; }
    LDS_WAIT(); asm volatile("" ::: "memory");
    const int c = lane & 7;
#pragma unroll
    for (int j = 0; j < 4; ++j) { const int n = (lane >> 3) + 8 * j; const LAS float* s = scr + (8 * c) * 33 + n;
        v4u o; o.x = pk2(s[0 * 33], s[1 * 33]); o.y = pk2(s[2 * 33], s[3 * 33]); o.z = pk2(s[4 * 33], s[5 * 33]); o.w = pk2(s[6 * 33], s[7 * 33]);
        *(v4u*)(WT + (size_t)rowmap<MODE>(n0 + n) * K + k0 + 8 * c) = o; }
    LDS_WAIT(); asm volatile("" ::: "memory");
}
__device__ __forceinline__ void sincos_d(double a, float& c, float& s) {
    const double q = __builtin_rint(a * 0.6366197723675814); const double y = a - q * 1.5707963267948966 - q * 6.123233995736766e-17;
    const double y2 = y * y;
    double sp = -7.647163731819816e-13; sp = sp * y2 + 1.6059043836821613e-10; sp = sp * y2 - 2.505210838544172e-08; sp = sp * y2 + 2.7557319223985893e-06;
    sp = sp * y2 - 1.984126984126984e-04; sp = sp * y2 + 8.333333333333333e-03; sp = sp * y2 - 1.6666666666666666e-01; sp = y + y * y2 * sp;
    double cp = 4.779477332387385e-14; cp = cp * y2 - 1.1470745597729725e-11; cp = cp * y2 + 2.08767569878681e-09; cp = cp * y2 - 2.755731922398589e-07;
    cp = cp * y2 + 2.48015873015873e-05; cp = cp * y2 - 1.388888888888889e-03; cp = cp * y2 + 4.1666666666666664e-02; cp = cp * y2 - 0.5; cp = 1.0 + y2 * cp;
    const int qi = (int)((long long)q & 3);
    const double sv = (qi & 1) ? cp : sp, cv = (qi & 1) ? sp : cp;
    s = (float)((qi & 2) ? -sv : sv); c = (float)(((qi + 1) & 2) ? -cv : cv);
}
__device__ __forceinline__ void p0_prologue(Frame& F, const Args& A) {
    LAS float* scr = (LAS float*)(F.lds + F.wave * 16384);
    constexpr int I_IN = 32 * 110, I_UQ = 6 * 36, I_UKV = 4 * 48, I_O = 32 * 64, I_L = I_IN + I_UQ + I_UKV + I_O;
    for (int it = F.gw; it < DEPTH * I_L; it += F.ngw) {
        const int l = it / I_L; int r = it - l * I_L;
        if (r < I_IN) { transpose_item<0>(A.in[2] + (size_t)l * DM * INW, DM, INW, (bf16*)(F.ws + WS_WIN) + (size_t)l * INP * DM, scr, r, F.lane); continue; } r -= I_IN;
        if (r < I_UQ) { transpose_item<1>(A.in[7] + (size_t)l * 384 * BQW, 384, BQW, (bf16*)(F.ws + WS_WUQ) + (size_t)l * BQP * 384, scr, r, F.lane); continue; } r -= I_UQ;
        if (r < I_UKV) { transpose_item<0>(A.in[8] + (size_t)l * 256 * BKVW, 256, BKVW, (bf16*)(F.ws + WS_WUKV) + (size_t)l * BKVW * 256, scr, r, F.lane); continue; } r -= I_UKV;
        transpose_item<0>(A.in[14] + (size_t)l * DM * DM, DM, DM, (bf16*)(F.ws + WS_WO) + (size_t)l * DM * DM, scr, r, F.lane);
    }
    const size_t gt = (size_t)blockIdx.x * 512 + F.tid, ngt = (size_t)gridDim.x * 512;
    for (size_t i = gt; i < (size_t)DEPTH * 64 * DM / 8; i += ngt) { const size_t l = i / (64 * DM / 8), o = i % (64 * DM / 8);
        *(v4u*)((bf16*)(F.ws + WS_WIN) + (l * INP + INW) * DM + o * 8) = (v4u){0u, 0u, 0u, 0u}; }
    for (size_t i = gt; i < (size_t)DEPTH * 128 * 384 / 8; i += ngt) { const size_t l = i / (128 * 384 / 8), o = i % (128 * 384 / 8);
        *(v4u*)((bf16*)(F.ws + WS_WUQ) + (l * BQP + BQW) * 384 + o * 8) = (v4u){0u, 0u, 0u, 0u}; }
    for (size_t i = gt; i < (size_t)DEPTH * DM * DM / 8; i += ngt) { const float* sp = A.in[17] + i * 8; const f32x4 a = *(const f32x4*)sp, b = *(const f32x4*)(sp + 4);
        *(v4u*)((bf16*)(F.ws + WS_WQ) + i * 8) = (v4u){pk2(a.x, a.y), pk2(a.z, a.w), pk2(b.x, b.y), pk2(b.z, b.w)}; }
    for (size_t i = gt; i < (size_t)DEPTH * DM * DM / 8; i += ngt) { const size_t l = i / (DM * DM / 8), o = i % (DM * DM / 8), r = o / (DM / 8), k = (o % (DM / 8)) * 8;
        v4u w = (v4u){0u, 0u, 0u, 0u};
        if ((r >> 7) == (k >> 7)) { const int m = (int)((r >> 7) & 1); const float* sp = A.in[18] + ((l * 2 + m) * 128 + (r & 127)) * 128 + (k & 127); const f32x4 a = *(const f32x4*)sp, b = *(const f32x4*)(sp + 4);
            w = (v4u){pk2(a.x, a.y), pk2(a.z, a.w), pk2(b.x, b.y), pk2(b.z, b.w)}; }
        *(v4u*)((bf16*)(F.ws + WS_SKD) + (l * DM + r) * DM + k) = w; }
    for (int r = F.gw; r < 2 * DEPTH * NEXP; r += F.ngw) { const int tb = r >= DEPTH * NEXP, rr = tb ? r - DEPTH * NEXP : r;
        const float* src = A.in[19 + tb] + (size_t)rr * DM + F.lane * 32; f32x4 v[8]; float am = 0.f;
#pragma unroll
        for (int j = 0; j < 8; ++j) { v[j] = *(const f32x4*)(src + 4 * j); am = fmaxf(am, fmaxf(fmaxf(fabsf(v[j][0]), fabsf(v[j][1])), fmaxf(fabsf(v[j][2]), fabsf(v[j][3])))); }
#pragma unroll
        for (int o = 1; o < 64; o <<= 1) am = fmaxf(am, __shfl_xor(am, o));
        unsigned w[8]; float sci;
        if (tb) {
            int ex = (int)((__float_as_uint(am) >> 23) & 0xffu) - 126; if (ex < -100 || ex > 100) ex = 0;
            const float sc = __uint_as_float((unsigned)(127 + 7 - ex) << 23); sci = __uint_as_float((unsigned)(127 + ex - 7) << 23);
#pragma unroll
            for (int j = 0; j < 8; ++j) { unsigned q = 0u; q = __builtin_amdgcn_cvt_pk_fp8_f32(v[j][0] * sc, v[j][1] * sc, q, false); q = __builtin_amdgcn_cvt_pk_fp8_f32(v[j][2] * sc, v[j][3] * sc, q, true); w[j] = q; }
        } else {
            const float sc = am > 1e-30f ? 127.0f / am : 0.f; sci = am * (1.0f / 127.0f);
#pragma unroll
            for (int j = 0; j < 8; ++j) { const int q0 = (int)__builtin_rintf(v[j][0] * sc), q1 = (int)__builtin_rintf(v[j][1] * sc), q2 = (int)__builtin_rintf(v[j][2] * sc), q3 = (int)__builtin_rintf(v[j][3] * sc);
                w[j] = (unsigned)(q0 & 0xff) | ((unsigned)(q1 & 0xff) << 8) | ((unsigned)(q2 & 0xff) << 16) | ((unsigned)(q3 & 0xff) << 24); }
        }
        const size_t lyr = (size_t)rr / NEXP, ex_ = (size_t)rr % NEXP;
        unsigned char* dst = F.ws + (tb ? WS_V : WS_U) + lyr * NEXP * DM + (size_t)(F.lane >> 2) * (NEXP * 128) + ex_ * 128 + (F.lane & 3) * 32;
        *(v4u*)dst = (v4u){w[0], w[1], w[2], w[3]}; *(v4u*)(dst + 16) = (v4u){w[4], w[5], w[6], w[7]};
        if (F.lane == 0) ((float*)(F.ws + (tb ? WS_VSC : WS_USC)))[rr] = sci; }
    for (size_t i = gt; i < (size_t)TT * DM / 8; i += ngt) { const size_t np = (size_t)T_PROMPT * DM / 8;
        const float* s = (i < np) ? A.in[0] + i * 8 : A.in[1] + (i - np) * 8; const f32x4 a = *(const f32x4*)s, b = *(const f32x4*)(s + 4);
        *(v4u*)((bf16*)(F.ws + WS_X) + i * 8) = (v4u){pk2(a.x, a.y), pk2(a.z, a.w), pk2(b.x, b.y), pk2(b.z, b.w)}; }
    for (size_t i = gt; i < (size_t)8192 * 32; i += ngt) { const int p = (int)(i >> 5), f = (int)(i & 31); double inv = 1.0; for (int k = 0; k < f; ++k) inv *= ROPE_R;
        float c, s; sincos_d((double)p * inv, c, s); ((f32x2*)(F.ws + WS_ROPE))[i] = (f32x2){c, s}; }
}

__device__ __forceinline__ void tok_seq(int t, int& s0, int& slen, int& pos) {
    if (t < T_PROMPT) { s0 = 0; slen = T_PROMPT; pos = t; } else { const int r = t - T_PROMPT; s0 = T_PROMPT + (r / S_SAMPLE) * S_SAMPLE; slen = S_SAMPLE; pos = r % S_SAMPLE; }
}
#define UNPACK8(W_, X_, O_) do { X_[O_ + 0] = bflo((W_)[0]); X_[O_ + 1] = bfhi((W_)[0]); X_[O_ + 2] = bflo((W_)[1]); X_[O_ + 3] = bfhi((W_)[1]); X_[O_ + 4] = bflo((W_)[2]); X_[O_ + 5] = bfhi((W_)[2]); X_[O_ + 6] = bflo((W_)[3]); X_[O_ + 7] = bfhi((W_)[3]); } while (0)
#define PACK8(X_, O_) ((v4u){pk2(X_[O_ + 0], X_[O_ + 1]), pk2(X_[O_ + 2], X_[O_ + 3]), pk2(X_[O_ + 4], X_[O_ + 5]), pk2(X_[O_ + 6], X_[O_ + 7])})

__device__ __forceinline__ void phase_prep(Frame& F, const Args& A, int l) {
    const float* qn_g = A.in[3] + l * 128; const float* kn_g = A.in[4] + l * 128; const float* qa_g = A.in[5] + l * 384; const float* kva_g = A.in[6] + l * 256;
    const f32x2* rope = (const f32x2*)(F.ws + WS_ROPE);
    bf16* H = (bf16*)(F.ws + WS_H); bf16* BK = (bf16*)(F.ws + WS_BK);
    int tid_ = threadIdx.x; asm volatile("" : "+v"(tid_)); const int lane = tid_ & 63;
    for (int t = F.gw; t < TT; t += F.ngw) {
        int s0, slen, pos; tok_seq(t, s0, slen, pos);
        bf16* hrow = H + (size_t)t * INP;
        {
            const v4u w0 = *(const v4u*)(hrow + lane * 16), w1 = *(const v4u*)(hrow + lane * 16 + 8);
            float x[16]; UNPACK8(w0, x, 0); UNPACK8(w1, x, 8);
            float ss = 0.f;
#pragma unroll
            for (int i = 0; i < 16; ++i) ss += x[i] * x[i];
            ss += __shfl_xor(ss, 1); ss += __shfl_xor(ss, 2); ss += __shfl_xor(ss, 4);
            const float rinv = 1.0f / sqrtf(ss * (1.0f / 128.0f) + EPS);
            const int head = lane >> 3, j = lane & 7; const float* g = (head < 6 ? qn_g : kn_g) + j * 16;
            const int p = (j < 4) ? (pos >> 6) : (pos & 63); const f32x2* tb = rope + p * 32 + (j & 1) * 16; const bool first = (j & 2) == 0;
#pragma unroll
            for (int i = 0; i < 16; ++i) x[i] = x[i] * rinv * g[i];
#pragma unroll
            for (int i = 0; i < 16; ++i) { const float pr = __shfl_xor(x[i], 2); const f32x2 cs = tb[i]; x[i] = first ? x[i] * cs.x - pr * cs.y : x[i] * cs.x + pr * cs.y; }
            *(v4u*)(hrow + lane * 16) = PACK8(x, 0); *(v4u*)(hrow + lane * 16 + 8) = PACK8(x, 8);
        }
        {
            bf16* cp = hrow + H_CQ + lane * 16;
            const v4u w0 = *(const v4u*)cp, w1 = *(const v4u*)(cp + 8);
            float x[16]; UNPACK8(w0, x, 0); UNPACK8(w1, x, 8);
            const int j = lane & 3; const f32x2* tb = rope + pos * 32 + (j & 1) * 16; const bool first = (j & 2) == 0;
#pragma unroll
            for (int i = 0; i < 16; ++i) { const float pr = __shfl_xor(x[i], 2); const f32x2 cs = tb[i]; x[i] = first ? x[i] * cs.x - pr * cs.y : x[i] * cs.x + pr * cs.y; }
            *(v4u*)cp = PACK8(x, 0); *(v4u*)(cp + 8) = PACK8(x, 8);
        }
        {
            float x[8]; v4u w = (v4u){0u, 0u, 0u, 0u};
            if (lane < 48) w = *(const v4u*)(hrow + H_BCQ + lane * 8);
            UNPACK8(w, x, 0); float ss = 0.f;
#pragma unroll
            for (int i = 0; i < 8; ++i) ss += x[i] * x[i];
            ss = wave_sum(ss); float rinv = 1.0f / sqrtf(ss * (1.0f / 384.0f) + EPS);
            if (lane < 48) {
#pragma unroll
                for (int i = 0; i < 8; ++i) x[i] = x[i] * rinv * qa_g[lane * 8 + i];
                *(v4u*)(hrow + H_BCQ + lane * 8) = PACK8(x, 0); }
            w = (v4u){0u, 0u, 0u, 0u};
            if (lane < 32) w = *(const v4u*)(hrow + H_BCKV + lane * 8);
            UNPACK8(w, x, 0); ss = 0.f;
#pragma unroll
            for (int i = 0; i < 8; ++i) ss += x[i] * x[i];
            ss = wave_sum(ss); rinv = 1.0f / sqrtf(ss * (1.0f / 256.0f) + EPS);
            if (lane < 32) {
#pragma unroll
                for (int i = 0; i < 8; ++i) x[i] = x[i] * rinv * kva_g[lane * 8 + i];
                *(v4u*)(hrow + H_BCKV + lane * 8) = PACK8(x, 0); }
            const int l8 = lane & 7;
            w = *(const v4u*)(hrow + H_BKR + l8 * 8); UNPACK8(w, x, 0);
            const f32x2* tb = rope + pos * 32 + (l8 & 3) * 8; const bool first = l8 < 4; float o2[8];
#pragma unroll
            for (int i = 0; i < 8; ++i) { const float pr = __shfl_xor(x[i], 4); const f32x2 cs = tb[i]; x[i] = first ? x[i] * cs.x - pr * cs.y : x[i] * cs.x + pr * cs.y; }
#pragma unroll
            for (int i = 0; i < 8; ++i) o2[i] = __shfl_xor(x[i], 4);
            if (lane < 4) {
                const v4u a = (v4u){pk2(x[0], o2[0]), pk2(x[1], o2[1]), pk2(x[2], o2[2]), pk2(x[3], o2[3])}, b = (v4u){pk2(x[4], o2[4]), pk2(x[5], o2[5]), pk2(x[6], o2[6]), pk2(x[7], o2[7])};
                bf16* kp = BK + (size_t)t * BQW + 128 + lane * 16;
#pragma unroll
                for (int h = 0; h < 6; ++h) { *(v4u*)(kp + h * 192) = a; *(v4u*)(kp + h * 192 + 8) = b; }
            }
        }
    }
}

struct StoreBf16 {
    bf16* O; int ldc, ncols;
    __device__ __forceinline__ void operator()(int row, int col, f32x4 v0, f32x4 v1) const {
        if (col < ncols) *(v4u*)(O + (size_t)row * ldc + col) = (v4u){pk2(v0[0], v0[1]), pk2(v0[2], v0[3]), pk2(v1[0], v1[1]), pk2(v1[2], v1[3])}; }
};
struct StoreF32 {
    float* O; int ldc;
    __device__ __forceinline__ void operator()(int row, int col, f32x4 v0, f32x4 v1) const { float* p = O + (size_t)row * ldc + col; *(f32x4*)p = v0; *(f32x4*)(p + 4) = v1; }
};
struct StoreMlaQ {
    bf16* O; const f32x2* rope;
    __device__ __forceinline__ void operator()(int row, int col, f32x4 v0, f32x4 v1) const {
        if (col >= BQW) return;
        const int w = col % 192;
        if (w >= 128) { int s0, slen, pos; tok_seq(row, s0, slen, pos); const f32x2* tb = rope + pos * 32 + ((w - 128) >> 1);
            const f32x2 c0 = tb[0], c1 = tb[1], c2 = tb[2], c3 = tb[3];
            const f32x4 a = v0, b = v1;
            v0[0] = a[0] * c0.x - a[1] * c0.y; v0[1] = a[1] * c0.x + a[0] * c0.y; v0[2] = a[2] * c1.x - a[3] * c1.y; v0[3] = a[3] * c1.x + a[2] * c1.y;
            v1[0] = b[0] * c2.x - b[1] * c2.y; v1[1] = b[1] * c2.x + b[0] * c2.y; v1[2] = b[2] * c3.x - b[3] * c3.y; v1[3] = b[3] * c3.x + b[2] * c3.y; }
        *(v4u*)(O + (size_t)row * BQW + col) = (v4u){pk2(v0[0], v0[1]), pk2(v0[2], v0[3]), pk2(v1[0], v1[1]), pk2(v1[2], v1[3])}; }
};
struct StoreMlaKV {
    bf16* BK; bf16* BV;
    __device__ __forceinline__ void operator()(int row, int col, f32x4 v0, f32x4 v1) const {
        const int head = col >> 8, w = col & 255; bf16* p = (w < 128) ? BK + (size_t)row * BQW + head * 192 + w : BV + (size_t)row * BVW + head * 128 + (w - 128);
        *(v4u*)p = (v4u){pk2(v0[0], v0[1]), pk2(v0[2], v0[3]), pk2(v1[0], v1[1]), pk2(v1[2], v1[3])}; }
};
struct StoreResid {
    float* Y; const bf16* X;
    __device__ __forceinline__ void operator()(int row, int col, f32x4 v0, f32x4 v1) const {
        const v4u xw = *(const v4u*)(X + (size_t)row * DM + col); float x[8]; UNPACK8(xw, x, 0);
        float* p = Y + (size_t)row * DM + col;
        *(f32x4*)p = (f32x4){DN_ALPHA * x[0] + v0[0], DN_ALPHA * x[1] + v0[1], DN_ALPHA * x[2] + v0[2], DN_ALPHA * x[3] + v0[3]};
        *(f32x4*)(p + 4) = (f32x4){DN_ALPHA * x[4] + v1[0], DN_ALPHA * x[5] + v1[1], DN_ALPHA * x[6] + v1[2], DN_ALPHA * x[7] + v1[3]}; }
};
struct FoldOrder {
    int G, c;
    __device__ __forceinline__ bool next(int i, pg8::Unit& u) const { const int idx = i * G + c; if (idx >= DEPTH * 64) return false; const int l = idx >> 6, r = idx & 63; u.pm = l * 8 + (r >> 3); u.pn = l * 8 + (r & 7); return true; }
    __device__ __forceinline__ void a_ready(const pg8::Unit&) const {}
    __device__ __forceinline__ void done(const pg8::Unit&) const {}
};
template <class F> __device__ __forceinline__ void run_gemm(Frame& Fr, const bf16* Aop, int lda, const bf16* Bt, int M, int N, int K, const F& f) {
    int Kv = K; asm volatile("" : "+s"(Kv));
    pg8::Gemm g{Aop, Bt, M, N, Kv, lda, K}; pg8::StaticOrder S; S.init(M, N, (int)gridDim.x, (int)blockIdx.x);
    pg8::EpiRow8<F> E{f};
    pg8::gemm_phase<pg8::EpiRow8<F>, pg8::StaticOrder, true, true>(Fr.lds, g, S, E);
}

#ifndef ATTN_V2
#define ATTN_V2 1
#endif
#if ATTN_V2
#ifndef ATTN_V3
#define ATTN_V3 1
#endif
#if ATTN_V3
#define ATTN_FN attn_body3
#else
#define ATTN_FN attn_body2
#endif
#define ATTN_X
#define ATTN_L , F.lds
#else
#define ATTN_FN attn_body
#define ATTN_X , true
#define ATTN_L
#endif
__device__ __forceinline__ int queue_next(Frame& F, gu32* q) {
    volatile LAS unsigned* W = (volatile LAS unsigned*)(F.lds + MISC_OFF) + 4;
    __syncthreads();
    if (threadIdx.x == 0) W[0] = __hip_atomic_fetch_add(q, 1u, RLX_AGENT);
    __syncthreads();
    return (int)W[0];
}
__device__ __forceinline__ void att_unit(int u, int NH, int& head, int& t0, int& s0, int& slen) {
    if (u < NH * 32) { head = u / 32; s0 = 0; slen = T_PROMPT; t0 = (u % 32) * 256; }
    else { const int v = u - NH * 32, sq = v / (NH * 16), r = v % (NH * 16); head = r / 16; s0 = T_PROMPT + sq * S_SAMPLE; slen = S_SAMPLE; t0 = s0 + (r % 16) * 256; }
}
__device__ __forceinline__ void phase_attn(Frame& F, const Args& A, int l, int rep = 0) {
    const bf16* H = (const bf16*)(F.ws + WS_H); bf16* AO = (bf16*)(F.ws + WS_AO);
    float d1 = 0.f, d2 = 0.f;
    for (int i = 0; i < 64; ++i) { d1 += A.in[9][l * 64 + i] * A.in[10][l * 64 + i]; d2 += A.in[11][l * 64 + i] * A.in[12][l * 64 + i]; }
    const float lam_init = 0.8f - 0.6f * expf(-0.3f * (float)l);
    const float lam = expf(d1) - expf(d2) + lam_init;
#ifndef AT_EN
#define AT_EN 7
#endif
#ifndef MK_REP_TYPES
#define MK_REP_TYPES 7
#endif
    const int at_en = (rep == 0) ? AT_EN : MK_REP_TYPES;
    if (at_en & 1) {
        float* stash = (float*)(F.ws + WS_STASH) + (size_t)blockIdx.x * 256 * 128;
        for (;;) { const int u = queue_next(F, F.ctl + CW_QUEUE + 64 * (3 * l + 0) + 16 * rep); if (u >= 4 * 32 + 4 * 4 * 16) break;
            int head, t0, s0, slen; att_unit(u, 4, head, t0, s0, slen);
            att::OutArgs oa{AO + (size_t)t0 * DM + 1536 + head * 128, DM, stash, lam, 1.0f - lam_init, A.in[13] + l * 128};
            att::ATTN_FN<64, INP, INP, INP, 1 ATTN_X>(H + (size_t)t0 * INP + H_CQ + head * 128, H + (size_t)s0 * INP + H_CK + head * 128, H + (size_t)s0 * INP + H_CV + head * 128, slen, 0.125f, oa, F.lds_g ATTN_L);
            att::ATTN_FN<64, INP, INP, INP, 2 ATTN_X>(H + (size_t)t0 * INP + H_CQ + head * 128 + 64, H + (size_t)s0 * INP + H_CK + head * 128 + 64, H + (size_t)s0 * INP + H_CV + head * 128, slen, 0.125f, oa, F.lds_g ATTN_L);
        }
    }
    if (at_en & 2) {
        const bf16* BQ = (const bf16*)(F.ws + WS_BQ); const bf16* BK = (const bf16*)(F.ws + WS_BK); const bf16* BV = (const bf16*)(F.ws + WS_BV);
        for (;;) { const int u = queue_next(F, F.ctl + CW_QUEUE + 64 * (3 * l + 1) + 16 * rep); if (u >= 6 * 32 + 4 * 6 * 16) break;
            int head, t0, s0, slen; att_unit(u, 6, head, t0, s0, slen);
            att::OutArgs oa{AO + (size_t)t0 * DM + 768 + head * 128, DM, nullptr, 0.f, 0.f, nullptr};
            att::ATTN_FN<192, BQW, BQW, BVW, 0 ATTN_X>(BQ + (size_t)t0 * BQW + head * 192, BK + (size_t)s0 * BQW + head * 192, BV + (size_t)s0 * BVW + head * 128, slen, 0.07216878364870322f, oa, F.lds_g ATTN_L);
        }
    }
    if (at_en & 4) {
        for (;;) { const int u = queue_next(F, F.ctl + CW_QUEUE + 64 * (3 * l + 2) + 16 * rep); if (u >= 6 * 32 + 4 * 6 * 16) break;
            int head, t0, s0, slen; att_unit(u, 6, head, t0, s0, slen); const int kvh = head / 3;
            att::OutArgs oa{AO + (size_t)t0 * DM + head * 128, DM, nullptr, 0.f, 0.f, nullptr};
            att::ATTN_FN<128, INP, INP, INP, 0 ATTN_X>(H + (size_t)t0 * INP + H_AQ + head * 128, H + (size_t)s0 * INP + H_AK + kvh * 128, H + (size_t)s0 * INP + H_AV + kvh * 128, slen, 0.08838834764831845f, oa, F.lds_g ATTN_L);
        }
    }
}

__device__ __forceinline__ void phase_ln1(Frame& F, const Args& A, int l) {
    int tid_ = threadIdx.x; asm volatile("" : "+v"(tid_)); const int lane = tid_ & 63;
    const float* Y = (const float*)(F.ws + WS_Y); bf16* X1 = (bf16*)(F.ws + WS_X1); const float* g = A.in[15] + l * DM; const float* b = A.in[16] + l * DM;
    for (int t = F.gw; t < TT; t += F.ngw) {
        float v[32];
#pragma unroll
        for (int j = 0; j < 4; ++j) { const float* p = Y + (size_t)t * DM + j * 512 + lane * 8; const f32x4 a = *(const f32x4*)p, c = *(const f32x4*)(p + 4);
            v[8 * j] = a[0]; v[8 * j + 1] = a[1]; v[8 * j + 2] = a[2]; v[8 * j + 3] = a[3]; v[8 * j + 4] = c[0]; v[8 * j + 5] = c[1]; v[8 * j + 6] = c[2]; v[8 * j + 7] = c[3]; }
        float s = 0.f;
#pragma unroll
        for (int i = 0; i < 32; ++i) s += v[i];
        const float mean = wave_sum(s) * (1.0f / DM); float q = 0.f;
#pragma unroll
        for (int i = 0; i < 32; ++i) { v[i] -= mean; q += v[i] * v[i]; }
        const float rstd = 1.0f / sqrtf(wave_sum(q) * (1.0f / DM) + EPS);
        float am = 0.f;
#pragma unroll
        for (int j = 0; j < 4; ++j) { const int c0 = j * 512 + lane * 8;
#pragma unroll
            for (int i = 0; i < 8; ++i) { v[8 * j + i] = v[8 * j + i] * rstd * g[c0 + i] + b[c0 + i]; am = fmaxf(am, fabsf(v[8 * j + i])); }
            *(v4u*)(X1 + (size_t)t * DM + c0) = PACK8(v, 8 * j); }
#pragma unroll
        for (int o = 1; o < 64; o <<= 1) am = fmaxf(am, __shfl_xor(am, o));
        const float sc = am > 1e-30f ? 127.0f / am : 0.f;
#pragma unroll
        for (int j = 0; j < 4; ++j) { unsigned q[2];
#pragma unroll
            for (int hh = 0; hh < 2; ++hh) { const int q0 = (int)__builtin_rintf(v[8 * j + 4 * hh] * sc), q1 = (int)__builtin_rintf(v[8 * j + 4 * hh + 1] * sc), q2 = (int)__builtin_rintf(v[8 * j + 4 * hh + 2] * sc), q3 = (int)__builtin_rintf(v[8 * j + 4 * hh + 3] * sc);
                q[hh] = (unsigned)(q0 & 0xff) | ((unsigned)(q1 & 0xff) << 8) | ((unsigned)(q2 & 0xff) << 16) | ((unsigned)(q3 & 0xff) << 24); }
            *(v2u*)(F.ws + WS_X8 + (size_t)t * DM + j * 512 + lane * 8) = (v2u){q[0], q[1]}; }
        if (lane == 0) ((float*)(F.ws + WS_XS))[t] = am * (1.0f / 127.0f);
    }
}

#define PEER_CVT(wd, f0, f1) do { f0 = __builtin_amdgcn_cvt_pk_f32_fp8((int)(wd), false); f1 = __builtin_amdgcn_cvt_pk_f32_fp8((int)(wd), true); } while (0)
#define DPP_STEP8(c, ctrl) do { _Pragma("unroll") for (int _h = 0; _h < 8; ++_h) c[_h] += __builtin_amdgcn_update_dpp(0, c[_h], ctrl, 0xf, 0xf, true); } while (0)
__device__ __forceinline__ void sum32x8(int (&c)[8]) {
    DPP_STEP8(c, 0xB1); DPP_STEP8(c, 0x4E); DPP_STEP8(c, 0x141); DPP_STEP8(c, 0x140);
#pragma unroll
    for (int h = 0; h < 8; ++h) { const auto r = __builtin_amdgcn_permlane16_swap((unsigned)c[h], (unsigned)c[h], false, false); c[h] = (int)(r[0] + r[1]); } }
__device__ __forceinline__ void sum64x8(int (&c)[8]) {
    sum32x8(c);
#pragma unroll
    for (int h = 0; h < 8; ++h) { const auto r = __builtin_amdgcn_permlane32_swap((unsigned)c[h], (unsigned)c[h], false, false); c[h] = (int)(r[0] + r[1]); } }
__device__ __forceinline__ float funkey(unsigned k) { return __uint_as_float((k & 0x80000000u) ? (k ^ 0x80000000u) : ~k); }
__device__ __forceinline__ unsigned fkey(float f) { const unsigned u = __float_as_uint(f); return u ^ ((unsigned)((int)u >> 31) | 0x80000000u); }
#define DPPI(v, ctrl) __builtin_amdgcn_update_dpp(0, (v), (ctrl), 0xf, 0xf, true)
__device__ __forceinline__ void phase_peer_topk(Frame& F, const Args& A, int l) {
    const float* SC = (const float*)(F.ws + WS_SC);
    const float* Usc = (const float*)(F.ws + WS_USC) + l * NEXP; const float* Vsc = (const float*)(F.ws + WS_VSC) + l * NEXP;
    int tid_ = threadIdx.x; asm volatile("" : "+v"(tid_)); const int lane = tid_ & 63;
    LAS float* selv = (LAS float*)(F.lds + F.wave * 16384);
    LAS int* seli = (LAS int*)(F.lds + F.wave * 16384 + 1024);
    LAS int* eid = (LAS int*)(F.lds + F.wave * 16384 + 2048);
    LAS float* gate = (LAS float*)(F.lds + F.wave * 16384 + 2560);
    LAS float* dummy = (LAS float*)(F.lds + F.wave * 16384 + 4096) + lane;
    for (int t = F.gw; t < TT; t += F.ngw) {
        unsigned kk[32];
        {
            const f32x4* sp = (const f32x4*)(SC + (size_t)t * 2048 + lane * 32);
#pragma unroll
            for (int j = 0; j < 8; ++j) { const f32x4 v = sp[j];
#pragma unroll
                for (int c = 0; c < 4; ++c) { kk[4 * j + c] = fkey(v[c]); asm volatile("" : "+v"(kk[4 * j + c])); } }
        }
        unsigned pv = 0u; int na = 128;
#pragma unroll 1
        for (int bit = 31; bit >= 0; --bit) { const unsigned cv = pv | (1u << bit); int c = 0;
#pragma unroll
            for (int i = 0; i < 32; ++i) c += (int)(kk[i] >= cv);
            c += DPPI(c, 0xB1); c += DPPI(c, 0x4E);
            const bool ok = c >= 16; pv = ok ? cv : pv; na = ok ? c : na;
            if (!__any(na != 16)) break; }
        {
            int cl = 0;
#pragma unroll
            for (int i = 0; i < 32; ++i) cl += (int)(kk[i] >= pv);
            const int q = lane & 3; const int c1 = DPPI(cl, 0x90), c2 = DPPI(cl, 0x40), c3 = DPPI(cl, 0x00);
            int pos = (q >= 1 ? c1 : 0) + (q >= 2 ? c2 : 0) + (q >= 3 ? c3 : 0);
            const int lb = (lane >> 2) * 16, ib = q * 32;
#pragma unroll
            for (int i = 0; i < 32; ++i) { const bool f = kk[i] >= pv; const bool w = f && pos < 16;
                LAS float* pvv = w ? selv + lb + pos : dummy; LAS int* pii = w ? seli + lb + pos : (LAS int*)dummy;
                *pvv = funkey(kk[i]); asm volatile("" ::: "memory"); *pii = ib + i; asm volatile("" ::: "memory"); pos += (int)f; }
        }
        LDS_WAIT(); asm volatile("" ::: "memory");
        const int hd = lane >> 3, q8 = lane & 7; int i2[16]; int i1a, i1b;
        {   const float va = selv[hd * 32 + 2 * q8], vb = selv[hd * 32 + 2 * q8 + 1]; i1a = seli[hd * 32 + 2 * q8] * 128; i1b = seli[hd * 32 + 2 * q8 + 1] * 128;
#pragma unroll
            for (int j = 0; j < 4; ++j) { const f32x4 v2 = *(const LAS f32x4*)(selv + hd * 32 + 16 + 4 * j); const v4u ii = *(const LAS v4u*)(seli + hd * 32 + 16 + 4 * j);
#pragma unroll
                for (int c = 0; c < 4; ++c) { kk[4 * j + c] = fkey(va + v2[c]); kk[16 + 4 * j + c] = fkey(vb + v2[c]); i2[4 * j + c] = (int)ii[c];
                    asm volatile("" : "+v"(kk[4 * j + c]), "+v"(kk[16 + 4 * j + c])); } }
        }
        pv = 0u; na = 256;
#pragma unroll 1
        for (int bit = 31; bit >= 0; --bit) { const unsigned cv = pv | (1u << bit); int c = 0;
#pragma unroll
            for (int i = 0; i < 32; ++i) c += (int)(kk[i] >= cv);
            c += DPPI(c, 0xB1); c += DPPI(c, 0x4E); c += DPPI(c, 0x141);
            const bool ok = c >= 16; pv = ok ? cv : pv; na = ok ? c : na;
            if (!__any(na != 16)) break; }
        {   int cl = 0;
#pragma unroll
            for (int i = 0; i < 32; ++i) cl += (int)(kk[i] >= pv);
            const int q = lane & 3; const int c1 = DPPI(cl, 0x90), c2 = DPPI(cl, 0x40), c3 = DPPI(cl, 0x00);
            int qt = cl; qt += DPPI(qt, 0xB1); qt += DPPI(qt, 0x4E); const int lowq = DPPI(qt, 0x141);
            int pos = (q >= 1 ? c1 : 0) + (q >= 2 ? c2 : 0) + (q >= 3 ? c3 : 0) + ((lane & 4) ? lowq : 0);
            const int lb = hd * 16;
#pragma unroll
            for (int i = 0; i < 32; ++i) { const bool f = kk[i] >= pv; const bool w = f && pos < 16;
                LAS float* pg = w ? gate + lb + pos : dummy; LAS int* pe = w ? eid + lb + pos : (LAS int*)dummy;
                *pg = funkey(kk[i]); asm volatile("" ::: "memory"); *pe = (i < 16 ? i1a : i1b) + i2[i & 15]; asm volatile("" ::: "memory"); pos += (int)f; }
        }
        LDS_WAIT(); asm volatile("" ::: "memory");
#pragma unroll
        for (int qq = 0; qq < 2; ++qq) { const int e = lane + 64 * qq; const float sc = gate[e]; float mx = sc;
            mx = fmaxf(mx, __shfl_xor(mx, 1)); mx = fmaxf(mx, __shfl_xor(mx, 2)); mx = fmaxf(mx, __shfl_xor(mx, 4)); mx = fmaxf(mx, __shfl_xor(mx, 8));
            const float ex = __expf(sc - mx); float sm = ex;
            sm += __shfl_xor(sm, 1); sm += __shfl_xor(sm, 2); sm += __shfl_xor(sm, 4); sm += __shfl_xor(sm, 8);
            const int ee = eid[e]; const float su = Usc[ee], sv = Vsc[ee];
            const size_t go = (size_t)t * 128 + e;
            ((int*)(F.ws + WS_EID))[go] = ee; ((float*)(F.ws + WS_GATEV))[go] = ex / sm * sv; ((float*)(F.ws + WS_USCT))[go] = su; }
        LDS_WAIT(); asm volatile("" ::: "memory");
    }
}

#define SL_DEC16(Rv, fv) do { _Pragma("unroll") for (int _k = 0; _k < 4; ++_k) { f32x2 _a, _b; PEER_CVT((Rv)[_k], _a, _b); fv[4 * _k] = _a[0]; fv[4 * _k + 1] = _a[1]; fv[4 * _k + 2] = _b[0]; fv[4 * _k + 3] = _b[1]; } } while (0)
#define SL_LOADE(EB, tt) do { const v4u* _ep = (const v4u*)(EID + (size_t)(tt) * 128 + g * 16); EB[0] = _ep[0]; EB[1] = _ep[1]; EB[2] = _ep[2]; EB[3] = _ep[3]; } while (0)
#define SL_LOADR(R, EB, tbl) do { _Pragma("unroll") for (int _i = 0; _i < 16; ++_i) R[_i] = *(const v4u*)((tbl) + (EB[_i >> 2][_i & 3] * 128u + coff)); } while (0)
__device__ __forceinline__ void phase_peer_u(Frame& F, const Args& A, int l, int rep = 0) {
    int tid_ = threadIdx.x; asm volatile("" : "+v"(tid_)); const int lane = tid_ & 63, g = lane >> 3, j = lane & 7;
    const unsigned char* Ut = F.ws + WS_U + (size_t)l * NEXP * DM; const unsigned char* X8 = F.ws + WS_X8; const unsigned* EID = (const unsigned*)(F.ws + WS_EID);
    float* PD = (float*)(F.ws + WS_PD);
    const int xcd = (int)(xb_xcc_id() & 7u);
    for (int kk = 0; kk < 16; ++kk) { const int s = (2 * xcd + kk) & 15; const unsigned coff = (unsigned)(s * (NEXP * 128) + j * 16);
        for (;;) { const int it = queue_next(F, F.ctl + CW_SQ + 16 * ((2 * l + 0) * 16 + s) + 8 * rep); if (it >= TT / 256) break;
            const int tb = it * 256 + F.wave * 32;
            v4u R0[16], R1[16], EB[4], XA[1], XB[1];
#define SU_LOADX(XV, tt) do { XV[0] = *(const v4u*)(X8 + (size_t)(tt) * DM + s * 128 + j * 16); } while (0)
#define SU_COMP(R, XV, tt) do { float p[16]; \
                _Pragma("unroll") for (int _i = 0; _i < 16; ++_i) { int ia = 0; _Pragma("unroll") for (int _k = 0; _k < 4; ++_k) ia = __builtin_amdgcn_sdot4((int)R[_i][_k], (int)XV[0][_k], ia, false); \
                    float acc = (float)ia; asm volatile("" : "+v"(acc)); p[_i] = acc; } \
                float q8[8], q4[4], q2[2]; \
                { const bool b = (lane & 4) != 0; _Pragma("unroll") for (int _i = 0; _i < 8; ++_i) { const float keep = b ? p[_i + 8] : p[_i], send = b ? p[_i] : p[_i + 8]; q8[_i] = keep + __shfl_xor(send, 4); } } \
                { const bool b = (lane & 2) != 0; _Pragma("unroll") for (int _i = 0; _i < 4; ++_i) { const float keep = b ? q8[_i + 4] : q8[_i], send = b ? q8[_i] : q8[_i + 4]; q4[_i] = keep + __shfl_xor(send, 2); } } \
                { const bool b = (lane & 1) != 0; _Pragma("unroll") for (int _i = 0; _i < 2; ++_i) { const float keep = b ? q4[_i + 2] : q4[_i], send = b ? q4[_i] : q4[_i + 2]; q2[_i] = keep + __shfl_xor(send, 1); } } \
                *(f32x2*)(PD + ((size_t)s * TT + (tt)) * 128 + 2 * lane) = (f32x2){q2[0], q2[1]}; } while (0)
            SL_LOADE(EB, tb); SU_LOADX(XA, tb); SL_LOADR(R0, EB, Ut); SL_LOADE(EB, tb + 1); SU_LOADX(XB, tb + 1);
#pragma unroll 1
            for (int k = 0; k < 32; k += 2) {
                SL_LOADR(R1, EB, Ut); if (k + 2 < 32) SL_LOADE(EB, tb + k + 2);
                __builtin_amdgcn_sched_barrier(0);
                SU_COMP(R0, XA, tb + k); if (k + 2 < 32) SU_LOADX(XA, tb + k + 2);
                __builtin_amdgcn_sched_barrier(0);
                if (k + 2 < 32) SL_LOADR(R0, EB, Ut); if (k + 3 < 32) SL_LOADE(EB, tb + k + 3);
                __builtin_amdgcn_sched_barrier(0);
                SU_COMP(R1, XB, tb + k + 1); if (k + 3 < 32) SU_LOADX(XB, tb + k + 3);
                __builtin_amdgcn_sched_barrier(0);
            }
        }
    }
}
__device__ __forceinline__ void phase_peer_w(Frame& F, const Args& A, int l) {
    int tid_ = threadIdx.x; asm volatile("" : "+v"(tid_)); const int lane = tid_ & 63;
    const float* PD = (const float*)(F.ws + WS_PD); const float* G = (const float*)(F.ws + WS_GATEV); const float* US = (const float*)(F.ws + WS_USCT); float* W = (float*)(F.ws + WS_WT);
    for (int t = F.gw; t < TT; t += F.ngw) { f32x2 a = (f32x2){0.f, 0.f};
#pragma unroll
        for (int s = 0; s < 16; ++s) a += *(const f32x2*)(PD + ((size_t)s * TT + t) * 128 + 2 * lane);
        const f32x2 us = *(const f32x2*)(US + (size_t)t * 128 + 2 * lane), gv = *(const f32x2*)(G + (size_t)t * 128 + 2 * lane);
        const float xs = ((const float*)(F.ws + WS_XS))[t]; const float h0 = a[0] * us[0] * xs, h1 = a[1] * us[1] * xs;
        *(f32x2*)(W + (size_t)t * 128 + 2 * lane) = (f32x2){gv[0] * 0.5f * h0 * (1.0f + erff(h0 * 0.7071067811865476f)), gv[1] * 0.5f * h1 * (1.0f + erff(h1 * 0.7071067811865476f))}; }
}
__device__ __forceinline__ void phase_peer_v(Frame& F, const Args& A, int l, int rep = 0) {
    int tid_ = threadIdx.x; asm volatile("" : "+v"(tid_)); const int lane = tid_ & 63, g = lane >> 3, j = lane & 7;
    const unsigned char* Vt = F.ws + WS_V + (size_t)l * NEXP * DM; const unsigned* EID = (const unsigned*)(F.ws + WS_EID); const float* W = (const float*)(F.ws + WS_WT);
    float* YP = (float*)(F.ws + WS_Y);
    const int xcd = (int)(xb_xcc_id() & 7u);
    for (int kk = 0; kk < 16; ++kk) { const int s = (2 * xcd + kk) & 15; const unsigned coff = (unsigned)(s * (NEXP * 128) + j * 16);
        for (;;) { const int it = queue_next(F, F.ctl + CW_SQ + 16 * ((2 * l + 1) * 16 + s) + 8 * rep); if (it >= TT / 256) break;
            const int tb = it * 256 + F.wave * 32;
            v4u R0[16], R1[16], EB[4]; f32x4 WA[4], WB[4];
#define SV_LOADW(WV, tt) do { const f32x4* _wp = (const f32x4*)(W + (size_t)(tt) * 128 + g * 16); WV[0] = _wp[0]; WV[1] = _wp[1]; WV[2] = _wp[2]; WV[3] = _wp[3]; } while (0)
#define SV_COMP(R, WV, tt) do { f32x2 y2[8]; _Pragma("unroll") for (int _k = 0; _k < 8; ++_k) y2[_k] = (f32x2){0.f, 0.f}; \
                _Pragma("unroll") for (int _i = 0; _i < 16; ++_i) { const float wi = WV[_i >> 2][_i & 3]; const f32x2 w2 = (f32x2){wi, wi}; _Pragma("unroll") for (int _k = 0; _k < 4; ++_k) { f32x2 _a, _b; PEER_CVT(R[_i][_k], _a, _b); y2[2 * _k] = w2 * _a + y2[2 * _k]; y2[2 * _k + 1] = w2 * _b + y2[2 * _k + 1]; } \
                    asm volatile("" : "+v"(y2[0]), "+v"(y2[1]), "+v"(y2[2]), "+v"(y2[3]), "+v"(y2[4]), "+v"(y2[5]), "+v"(y2[6]), "+v"(y2[7])); } \
                float y[16]; _Pragma("unroll") for (int _k = 0; _k < 8; ++_k) { y[2 * _k] = y2[_k][0]; y[2 * _k + 1] = y2[_k][1]; } \
                float z8[8], z4[4], z2[2]; \
                { const bool b = (lane & 32) != 0; _Pragma("unroll") for (int _i = 0; _i < 8; ++_i) { const float keep = b ? y[_i + 8] : y[_i], send = b ? y[_i] : y[_i + 8]; z8[_i] = keep + __shfl_xor(send, 32); } } \
                { const bool b = (lane & 16) != 0; _Pragma("unroll") for (int _i = 0; _i < 4; ++_i) { const float keep = b ? z8[_i + 4] : z8[_i], send = b ? z8[_i] : z8[_i + 4]; z4[_i] = keep + __shfl_xor(send, 16); } } \
                { const bool b = (lane & 8) != 0; _Pragma("unroll") for (int _i = 0; _i < 2; ++_i) { const float keep = b ? z4[_i + 2] : z4[_i], send = b ? z4[_i] : z4[_i + 2]; z2[_i] = keep + __shfl_xor(send, 8); } } \
                *(f32x2*)(YP + (size_t)(tt) * DM + s * 128 + j * 16 + 2 * g) = (f32x2){z2[0], z2[1]}; } while (0)
            SL_LOADE(EB, tb); SV_LOADW(WA, tb); SL_LOADR(R0, EB, Vt); SL_LOADE(EB, tb + 1); SV_LOADW(WB, tb + 1);
#pragma unroll 1
            for (int k = 0; k < 32; k += 2) {
                SL_LOADR(R1, EB, Vt); if (k + 2 < 32) SL_LOADE(EB, tb + k + 2);
                __builtin_amdgcn_sched_barrier(0);
                SV_COMP(R0, WA, tb + k); if (k + 2 < 32) SV_LOADW(WA, tb + k + 2);
                __builtin_amdgcn_sched_barrier(0);
                if (k + 2 < 32) SL_LOADR(R0, EB, Vt); if (k + 3 < 32) SL_LOADE(EB, tb + k + 3);
                __builtin_amdgcn_sched_barrier(0);
                SV_COMP(R1, WB, tb + k + 1); if (k + 3 < 32) SV_LOADW(WB, tb + k + 3);
                __builtin_amdgcn_sched_barrier(0);
            }
        }
    }
}
__device__ __forceinline__ void phase_ln2(Frame& F, const Args& A, int l) {
    int tid_ = threadIdx.x; asm volatile("" : "+v"(tid_)); const int lane = tid_ & 63;
    const float* YP = (const float*)(F.ws + WS_Y); const bf16* X1 = (const bf16*)(F.ws + WS_X1); bf16* Xn = (bf16*)(F.ws + WS_X); const float* g2 = A.in[21] + l * DM; const float* b2 = A.in[22] + l * DM;
    for (int t = F.gw; t < TT; t += F.ngw) {
        float v[32];
#pragma unroll
        for (int jj = 0; jj < 4; ++jj) { const int c0 = jj * 512 + lane * 8; const float* p = YP + (size_t)t * DM + c0; const f32x4 a = *(const f32x4*)p, c = *(const f32x4*)(p + 4);
            const v4u xw = *(const v4u*)(X1 + (size_t)t * DM + c0); float x[8]; UNPACK8(xw, x, 0);
            v[8 * jj] = DN_ALPHA * x[0] + a[0]; v[8 * jj + 1] = DN_ALPHA * x[1] + a[1]; v[8 * jj + 2] = DN_ALPHA * x[2] + a[2]; v[8 * jj + 3] = DN_ALPHA * x[3] + a[3];
            v[8 * jj + 4] = DN_ALPHA * x[4] + c[0]; v[8 * jj + 5] = DN_ALPHA * x[5] + c[1]; v[8 * jj + 6] = DN_ALPHA * x[6] + c[2]; v[8 * jj + 7] = DN_ALPHA * x[7] + c[3]; }
        float sm = 0.f;
#pragma unroll
        for (int i = 0; i < 32; ++i) sm += v[i];
        const float mean = wave_sum(sm) * (1.0f / DM); float qq = 0.f;
#pragma unroll
        for (int i = 0; i < 32; ++i) { v[i] -= mean; qq += v[i] * v[i]; }
        const float rstd = 1.0f / sqrtf(wave_sum(qq) * (1.0f / DM) + EPS);
#pragma unroll
        for (int jj = 0; jj < 4; ++jj) { const int c0 = jj * 512 + lane * 8; float o[8];
#pragma unroll
            for (int i = 0; i < 8; ++i) o[i] = v[8 * jj + i] * rstd * g2[c0 + i] + b2[c0 + i];
            if (l == DEPTH - 1) { float* op = A.out + (size_t)t * DM + c0; *(f32x4*)op = (f32x4){o[0], o[1], o[2], o[3]}; *(f32x4*)(op + 4) = (f32x4){o[4], o[5], o[6], o[7]}; }
            else *(v4u*)(Xn + (size_t)t * DM + c0) = PACK8(o, 0); }
    }
}

constexpr int NPL = 9, NPHASE = 1 + DEPTH * NPL;
__global__ void __launch_bounds__(512, 2) fwd_kernel(Args args) {
    extern __shared__ __attribute__((aligned(16))) unsigned char lds[];
    Frame F;
    F.lds = (LAS unsigned char*)lds; F.lds_g = (char*)lds;
    F.tid = threadIdx.x; F.lane = F.tid & 63; F.wave = __builtin_amdgcn_readfirstlane(F.tid >> 6);
    F.gw = blockIdx.x * 8 + F.wave; F.ngw = gridDim.x * 8;
    F.ws = args.ws; F.ctl = (gu32*)(args.ws + WS_CTL);
    volatile LAS unsigned* MISC = (volatile LAS unsigned*)(F.lds + MISC_OFF);
    if (F.tid < 32) MISC[F.tid] = 0u;
    __syncthreads();
    const int lo = args.ph_lo, hi = args.ph_hi;
    XcdBarrier bar; bar.bar = (unsigned*)(F.ctl + CW_BAR); bar.x = 0; bar.st = MISC;
    bar = xcd_barrier_post((unsigned*)(F.ctl + CW_BAR), MISC);
#ifndef PH_EN
#define PH_EN 0x3ff
#endif
#ifndef MK_REP_ATTN
#define MK_REP_ATTN 0
#endif
#ifndef MK_REP_PEER
#define MK_REP_PEER 0
#endif
#ifndef MK_REP_GEMM
#define MK_REP_GEMM 0
#endif
#define IN(k) (lo <= (k) && (k) < hi)
#define EN(b) ((PH_EN >> (b)) & 1)
#define SEAM(k) do { if (IN(k) && IN((k) + 1)) xcd_barrier(bar); } while (0)
    const bf16* X = (const bf16*)(F.ws + WS_X); const bf16* X1 = (const bf16*)(F.ws + WS_X1); bf16* H = (bf16*)(F.ws + WS_H);

    if (EN(9) && IN(0)) { p0_prologue(F, args); xcd_barrier(bar);
        { int Kv = DM; asm volatile("" : "+s"(Kv)); pg8::Gemm g{(const bf16*)(F.ws + WS_SKD), (const bf16*)(F.ws + WS_WQ), DEPTH * DM, DEPTH * DM, Kv, DM, DM};
          FoldOrder S{(int)gridDim.x, (int)blockIdx.x}; pg8::EpiRow8<StoreBf16> E{StoreBf16{(bf16*)(F.ws + WS_WQS), DM, DEPTH * DM}};
          pg8::gemm_phase<pg8::EpiRow8<StoreBf16>, FoldOrder, true, true>(F.lds, g, S, E); }
        SEAM(0); }

    for (int l = 0; l < DEPTH; ++l) {
        const int pb = 1 + NPL * l;
        if (EN(0) && IN(pb + 0)) { int nrep = 1 + MK_REP_GEMM; asm volatile("" : "+s"(nrep));
#pragma unroll 1
            for (int rep = 0; rep < nrep; ++rep) { if (rep) xcd_barrier(bar); run_gemm(F, X, DM, (const bf16*)(F.ws + WS_WIN) + (size_t)l * INP * DM, TT, INP, DM, StoreBf16{H, INP, INP}); }
            SEAM(pb + 0); }
        if (EN(1) && IN(pb + 1)) { phase_prep(F, args, l); SEAM(pb + 1); }
        if (EN(2) && IN(pb + 2)) {
#ifndef NO_G1
            run_gemm(F, H + H_BCQ, INP, (const bf16*)(F.ws + WS_WUQ) + (size_t)l * BQP * 384, TT, BQP, 384, StoreMlaQ{(bf16*)(F.ws + WS_BQ), (const f32x2*)(F.ws + WS_ROPE)});
#endif
#ifndef NO_G2
            run_gemm(F, H + H_BCKV, INP, (const bf16*)(F.ws + WS_WUKV) + (size_t)l * BKVW * 256, TT, BKVW, 256, StoreMlaKV{(bf16*)(F.ws + WS_BK), (bf16*)(F.ws + WS_BV)});
#endif
            SEAM(pb + 2); }
        if (EN(3) && IN(pb + 3)) { int nrep = 1 + MK_REP_ATTN; asm volatile("" : "+s"(nrep));
#pragma unroll 1
            for (int rep = 0; rep < nrep; ++rep) { if (rep) xcd_barrier(bar); phase_attn(F, args, l, rep); }
            SEAM(pb + 3); }
        if (EN(4) && IN(pb + 4)) { run_gemm(F, (const bf16*)(F.ws + WS_AO), DM, (const bf16*)(F.ws + WS_WO) + (size_t)l * DM * DM, TT, DM, DM, StoreResid{(float*)(F.ws + WS_Y), X}); SEAM(pb + 4); }
        if (EN(5) && IN(pb + 5)) { phase_ln1(F, args, l); SEAM(pb + 5); }
        if (EN(6) && IN(pb + 6)) { run_gemm(F, X1, DM, (const bf16*)(F.ws + WS_WQS) + (size_t)l * WQS_LAYER, TT, DM, DM, StoreF32{(float*)(F.ws + WS_SC), DM}); SEAM(pb + 6); }
        if (EN(8) && IN(pb + 8)) {
#ifndef MK_REP_TOPK
#define MK_REP_TOPK 0
#endif
#ifndef MK_REP_PU
#define MK_REP_PU 0
#endif
#ifndef MK_REP_PV
#define MK_REP_PV 0
#endif
            { int nrep = 1 + MK_REP_TOPK; asm volatile("" : "+s"(nrep));
#pragma unroll 1
              for (int rep = 0; rep < nrep; ++rep) { phase_peer_topk(F, args, l); xcd_barrier(bar); } }
            { int nrep = 1 + MK_REP_PU; asm volatile("" : "+s"(nrep));
#pragma unroll 1
              for (int rep = 0; rep < nrep; ++rep) { phase_peer_u(F, args, l, rep); xcd_barrier(bar); } }
            phase_peer_w(F, args, l); xcd_barrier(bar);
            { int nrep = 1 + MK_REP_PV; asm volatile("" : "+s"(nrep));
#pragma unroll 1
              for (int rep = 0; rep < nrep; ++rep) { phase_peer_v(F, args, l, rep); xcd_barrier(bar); } }
            phase_ln2(F, args, l);
            SEAM(pb + 8); }
    }
#undef IN
#undef SEAM
}

extern "C" void kernel_launch(void* const* d_in, const int* in_sizes, int n_in, void* d_out, int out_size, void* d_ws, size_t ws_size, hipStream_t stream) {
    static int grid = 0;
    if (grid == 0) {
        if (n_in != 23 || in_sizes[0] != T_PROMPT * DM || in_sizes[1] != (TT - T_PROMPT) * DM || out_size != TT * DM || ws_size < WS_NEED) {
            fprintf(stderr, "kernel_launch: shape mismatch (n_in %d, in0 %d, in1 %d, out %d, ws %zu need %zu); nothing launched\n", n_in, n_in > 0 ? in_sizes[0] : -1, n_in > 1 ? in_sizes[1] : -1, out_size, ws_size, (size_t)WS_NEED); grid = -1; return; }
        int dev = 0, cus = 0, per_cu = 0;
        if (hipGetDevice(&dev) != hipSuccess || hipDeviceGetAttribute(&cus, hipDeviceAttributeMultiprocessorCount, dev) != hipSuccess) { fprintf(stderr, "kernel_launch: device query failed\n"); grid = -1; return; }
        if (hipFuncSetAttribute((const void*)fwd_kernel, hipFuncAttributeMaxDynamicSharedMemorySize, LDS_BYTES) != hipSuccess) { fprintf(stderr, "kernel_launch: hipFuncSetAttribute failed\n"); grid = -1; return; }
        if (hipOccupancyMaxActiveBlocksPerMultiprocessor(&per_cu, (const void*)fwd_kernel, 512, LDS_BYTES) != hipSuccess || per_cu < 1) { fprintf(stderr, "kernel_launch: occupancy query says %d blocks per CU\n", per_cu); }
        (void)hipGetLastError();
        grid = cus;
    }
    if (grid < 0) return;
    if (hipMemsetAsync((char*)d_ws + WS_CTL, 0, CTL_BYTES, stream) != hipSuccess) { fprintf(stderr, "kernel_launch: memset failed\n"); return; }
    Args a{};
    for (int i = 0; i < 23; ++i) a.in[i] = (const float*)d_in[i];
    a.out = (float*)d_out; a.ws = (unsigned char*)d_ws;
#if MK_LAUNCH_PER_PHASE
    for (int k = 0; k < NPHASE; ++k) { a.ph_lo = k; a.ph_hi = k + 1; hipLaunchKernelGGL(fwd_kernel, dim3(grid), dim3(512), LDS_BYTES, stream, a); }
#else
    a.ph_lo = 0; a.ph_hi = NPHASE; hipLaunchKernelGGL(fwd_kernel, dim3(grid), dim3(512), LDS_BYTES, stream, a);
#endif
#if MK_DBG
    if (MK_DBG & 1) hipLaunchKernelGGL(dbg_h, dim3(48), dim3(256), 0, stream, a);
    if (MK_DBG & 2) hipLaunchKernelGGL(dbg_mla, dim3(48), dim3(256), 0, stream, a);
    if (MK_DBG & 28) hipLaunchKernelGGL(dbg_attn, dim3(64), dim3(256), 0, stream, a);
    if (MK_DBG & 224) hipLaunchKernelGGL(dbg_gemms, dim3(48), dim3(256), 0, stream, a);
    if (MK_DBG & 256) hipLaunchKernelGGL(dbg_peer, dim3(48), dim3(256), 0, stream, a);
    hipLaunchKernelGGL(dbg_scale, dim3(1024), dim3(256), 0, stream, a);
#endif
    const hipError_t le = hipPeekAtLastError();
    if (le != hipSuccess) fprintf(stderr, "kernel_launch: launch failed: %s\n", hipGetErrorName(le));
}
```

```cpp
#include <hip/hip_runtime.h>
#include <cstdio>
#include <cstdint>

#ifndef MK_LAUNCH_PER_PHASE
#define MK_LAUNCH_PER_PHASE 0
#endif
#ifndef MK_DBG
#define MK_DBG 0
#endif

constexpr int DM = 2048, TT = 24576, T_PROMPT = 8192, S_SAMPLE = 4096, DEPTH = 4;
constexpr int INW = 3520, INP = 3584;
constexpr int H_AQ = 0, H_AK = 768, H_AV = 1024, H_BCQ = 1280, H_BCKV = 1664, H_BKR = 1920, H_CQ = 1984, H_CK = 2496, H_CV = 3008;
constexpr int BQW = 1152, BQP = 1280, BKVW = 1536, BVW = 768;
constexpr int NEXP = 16384, PEER_H = 8, PEER_K = 16;
constexpr float EPS = 1e-5f;
constexpr float DN_ALPHA = 1.681792830507429f;
constexpr double ROPE_R = 0.7498942093324559;

namespace pg8 {
#define PG8_LAS __attribute__((address_space(3)))
typedef unsigned short bf16_t;
typedef short bf16x8 __attribute__((ext_vector_type(8)));
typedef float f32x4 __attribute__((ext_vector_type(4)));
typedef unsigned u32x4 __attribute__((ext_vector_type(4)));
constexpr int BM = 256, BK = 64, HALF = 128, HTB = HALF * BK * 2  , STAGE_BYTES = 8 * HTB, NXCD = 8, WGM = 8;

__host__ __device__ __forceinline__ int lds_byte(int r, int c) { const int st = (r >> 4) * 2 + (c >> 5), rr = r & 15, cc = c & 31, ob = rr * 64 + cc * 2; return st * 1024 + (ob ^ (((ob >> 9) & 1) << 5)); }
__host__ __device__ __forceinline__ void stage_rc(int b, int& R, int& C) { const int st = b / 1024, sb = b % 1024, swz = sb ^ (((sb >> 9) & 1) << 5); R = (st >> 1) * 16 + swz / 64; C = (st & 1) * 32 + (swz % 64) / 2; }
__host__ __device__ __forceinline__ int perm32(int rho) { const int n = rho >> 4, i = rho & 15; return 8 * (i >> 2) + 4 * n + (i & 3); }

struct Unit { int pm, pn; };
struct Gemm { const bf16_t* A; const bf16_t* Bt; int M, N, K, lda, ldb; };

struct StaticOrder {
    int nM, nN, nwg, G, c;
    __host__ __device__ void init(int M, int N, int G_, int c_) { nM = M / BM; nN = N / BM; nwg = nM * nN; G = G_; c = c_; }
    __host__ __device__ bool next(int i, Unit& u) const {
        const long L = (long)i * G + c; if (L >= nwg) return false;
        int wgid = (int)L; { const int q = nwg / NXCD, r = nwg % NXCD, xcd = wgid % NXCD, off = wgid / NXCD; wgid = (xcd < r ? xcd * (q + 1) : r * (q + 1) + (xcd - r) * q) + off; }
        const int nig = WGM * nN, gid = wgid / nig, fm = gid * WGM, gsz = (nM - fm) < WGM ? (nM - fm) : WGM;
        u.pm = fm + ((wgid % nig) % gsz); u.pn = (wgid % nig) / gsz; return true;
    }
    __device__ __forceinline__ void a_ready(const Unit&) const {}
    __device__ __forceinline__ void done(const Unit&) const {}
};

__device__ __forceinline__ unsigned cvt_pk_bf16(float lo, float hi) { unsigned r; asm volatile("v_cvt_pk_bf16_f32 %0, %1, %2" : "=v"(r) : "v"(lo), "v"(hi)); return r; }
template <class F> struct EpiRow8 {
    static constexpr bool PERM = true, AFTER_DRAIN = false; F f;
    __device__ __forceinline__ void operator()(const f32x4 (&acc)[2][2][4][2], const Unit& u, int wr, int wc, int fr, int fq) const {
        const int row0 = u.pm * BM + wr * 64 + fr, col0 = u.pn * BM + wc * 32 + 8 * fq;
#pragma unroll
        for (int ai = 0; ai < 2; ++ai)
#pragma unroll
            for (int m = 0; m < 4; ++m)
#pragma unroll
                for (int bj = 0; bj < 2; ++bj) { f(row0 + ai * HALF + m * 16, col0 + bj * HALF, acc[ai][bj][m][0], acc[ai][bj][m][1]); asm volatile("" ::: "memory"); }
    }
};
template <class Epi, class Sched, bool ALIGN_EPI = false, bool SP2 = false>
__device__ __forceinline__ void gemm_phase(PG8_LAS unsigned char* lds, const Gemm g, const Sched& S, const Epi& E) {
    int tid_ = threadIdx.x; asm volatile("" : "+v"(tid_));
    const int tid = tid_, wid = __builtin_amdgcn_readfirstlane(tid >> 6), lane = tid & 63, wr = wid >> 2, wc = wid & 3, fr = lane & 15, fq = lane >> 4;
    const int K = g.K, nt = K / BK;
    unsigned voffA[2], voffB[2];
#pragma unroll
    for (int i = 0; i < 2; ++i) { int R, C; stage_rc(tid * 16 + i * 8192, R, C); const int Rb = Epi::PERM ? ((R & ~31) + perm32(R & 31)) : R;
        voffA[i] = (unsigned)(R * g.lda + C) * 2u; voffB[i] = (unsigned)(Rb * g.ldb + C) * 2u; }
    const size_t kstep = (size_t)(BK * 2);
    const size_t hstepA = (size_t)HALF * g.lda * 2, hstepB = (size_t)HALF * g.ldb * 2;
    const size_t tstepA = 2 * hstepA, tstepB = 2 * hstepB;
    const unsigned ldsw = (unsigned)wid * 1024u;
    const int aoff = lds_byte(wr * 64 + fr, fq * 8), boff = lds_byte(wc * 32 + fr, fq * 8);
#define PG8_SA(b, h) (((b) * 2 + (h)) * HTB)
#define PG8_SB(b, h) ((4 + (b) * 2 + (h)) * HTB)
#define PG8_STAGE(bufoff, gbase, voff) do { _Pragma("unroll") for (int _i = 0; _i < 2; ++_i) \
        __builtin_amdgcn_global_load_lds((const unsigned*)((const char*)(gbase) + (voff)[_i]), (PG8_LAS unsigned*)(lds + (bufoff) + ldsw + _i * 8192), 16, 0, 0); } while (0)
#define PG8_LDA(dst, b, h) do { _Pragma("unroll") for (int m = 0; m < 4; ++m) _Pragma("unroll") for (int k = 0; k < 2; ++k) dst[m][k] = *(const PG8_LAS bf16x8*)(lds + PG8_SA(b, h) + aoff + m * 2048 + k * 1024); } while (0)
#define PG8_LDB(dst, b, h) do { _Pragma("unroll") for (int n = 0; n < 2; ++n) _Pragma("unroll") for (int k = 0; k < 2; ++k) dst[n][k] = *(const PG8_LAS bf16x8*)(lds + PG8_SB(b, h) + boff + n * 2048 + k * 1024); } while (0)
#define PG8_MMA(ai, bj, At, Bt) do { __builtin_amdgcn_s_setprio(1); _Pragma("unroll") for (int m = 0; m < 4; ++m) _Pragma("unroll") for (int n = 0; n < 2; ++n) _Pragma("unroll") for (int k = 0; k < 2; ++k) \
        acc[ai][bj][m][n] = __builtin_amdgcn_mfma_f32_16x16x32_bf16(Bt[n][k], At[m][k], acc[ai][bj][m][n], 0, 0, 0); __builtin_amdgcn_s_setprio(0); } while (0)
#define PG8_WAIT_V(n) asm volatile("s_waitcnt vmcnt(" #n ")" ::: "memory")
#define PG8_WAIT_L(n) asm volatile("s_waitcnt lgkmcnt(" #n ")" ::: "memory")
#define PG8_BAR __builtin_amdgcn_s_barrier()
#define PG8_SCHED __builtin_amdgcn_sched_barrier(0)
    Unit cur, nxt; int ui = 0;
    if (!S.next(0, cur)) return;
    f32x4 acc[2][2][4][2];
#pragma unroll
    for (int a = 0; a < 2; ++a)
#pragma unroll
        for (int b = 0; b < 2; ++b)
#pragma unroll
            for (int m = 0; m < 4; ++m)
#pragma unroll
                for (int n = 0; n < 2; ++n) acc[a][b][m][n] = (f32x4){0.f, 0.f, 0.f, 0.f};
    bf16x8 At[4][2], B0[2][2], B1[2][2];
    const char* cA = (const char*)g.A + (size_t)cur.pm * tstepA; const char* cB = (const char*)g.Bt + (size_t)cur.pn * tstepB;
    S.a_ready(cur);
    if constexpr (SP2) {
        PG8_STAGE(PG8_SB(0, 0), cB, voffB); PG8_STAGE(PG8_SB(0, 1), cB + hstepB, voffB); PG8_STAGE(PG8_SA(0, 0), cA, voffA); PG8_STAGE(PG8_SA(0, 1), cA + hstepA, voffA);
        if (wr == 1) PG8_BAR;
        PG8_WAIT_V(2); PG8_BAR;
        PG8_STAGE(PG8_SB(1, 0), cB + kstep, voffB); PG8_STAGE(PG8_SA(1, 0), cA + kstep, voffA); PG8_STAGE(PG8_SB(1, 1), cB + hstepB + kstep, voffB);
        PG8_WAIT_V(6); PG8_BAR;
    } else {
        PG8_STAGE(PG8_SB(0, 0), cB, voffB); PG8_STAGE(PG8_SA(0, 0), cA, voffA); PG8_STAGE(PG8_SB(0, 1), cB + hstepB, voffB); PG8_STAGE(PG8_SA(0, 1), cA + hstepA, voffA);
        if (wr == 1) PG8_BAR;
        PG8_WAIT_V(4); PG8_BAR;
        PG8_STAGE(PG8_SB(1, 0), cB + kstep, voffB); PG8_STAGE(PG8_SA(1, 0), cA + kstep, voffA); PG8_STAGE(PG8_SB(1, 1), cB + hstepB + kstep, voffB);
        PG8_WAIT_V(6); PG8_BAR;
    }
    for (;;) {
        const bool has_next = S.next(ui + 1, nxt);
        const char* nA = has_next ? (const char*)g.A + (size_t)nxt.pm * tstepA : cA; const char* nB = has_next ? (const char*)g.Bt + (size_t)nxt.pn * tstepB : cB;
        for (int t = 0; t < nt; t += 2) {
            const bool last = (t == nt - 2);
            const char* a1 = cA + (size_t)(t + 1) * kstep;
            const char* a2 = last ? nA : cA + (size_t)(t + 2) * kstep; const char* b2 = last ? nB : cB + (size_t)(t + 2) * kstep;
            const char* a3 = a2 + kstep; const char* b3 = b2 + kstep;
            if (last && has_next) S.a_ready(nxt);
            if constexpr (SP2) {
            PG8_LDB(B0, 0, 0); PG8_LDB(B1, 0, 1); PG8_SCHED; PG8_LDA(At, 0, 0); PG8_STAGE(PG8_SA(1, 1), a1 + hstepA, voffA);
            PG8_WAIT_V(8); PG8_WAIT_L(0); PG8_BAR; PG8_MMA(0, 0, At, B0); PG8_MMA(0, 1, At, B1); PG8_BAR; PG8_SCHED;
            PG8_LDA(At, 0, 1); PG8_STAGE(PG8_SB(0, 0), b2, voffB); PG8_STAGE(PG8_SB(0, 1), b2 + hstepB, voffB); PG8_STAGE(PG8_SA(0, 0), a2, voffA);
            PG8_WAIT_V(8); PG8_WAIT_L(0); PG8_BAR; PG8_MMA(1, 0, At, B0); PG8_MMA(1, 1, At, B1); PG8_BAR; PG8_SCHED;
            PG8_LDB(B0, 1, 0); PG8_LDB(B1, 1, 1); PG8_SCHED; PG8_LDA(At, 1, 0); PG8_STAGE(PG8_SA(0, 1), a2 + hstepA, voffA);
            PG8_WAIT_V(8); PG8_WAIT_L(0); PG8_BAR; PG8_MMA(0, 0, At, B0); PG8_MMA(0, 1, At, B1); PG8_BAR; PG8_SCHED;
            PG8_LDA(At, 1, 1); PG8_STAGE(PG8_SB(1, 0), b3, voffB); PG8_STAGE(PG8_SB(1, 1), b3 + hstepB, voffB); PG8_STAGE(PG8_SA(1, 0), a3, voffA);
            PG8_WAIT_V(8); PG8_WAIT_L(0); PG8_BAR; PG8_MMA(1, 0, At, B0); PG8_MMA(1, 1, At, B1); PG8_BAR; PG8_SCHED;
            } else {
            PG8_LDB(B0, 0, 0); PG8_SCHED; PG8_LDA(At, 0, 0); PG8_STAGE(PG8_SA(1, 1), a1 + hstepA, voffA);
            PG8_WAIT_L(8); PG8_BAR; PG8_WAIT_L(0); PG8_MMA(0, 0, At, B0); PG8_BAR; PG8_SCHED;
            PG8_LDB(B1, 0, 1); PG8_STAGE(PG8_SB(0, 0), b2, voffB);
            PG8_BAR; PG8_WAIT_L(0); PG8_MMA(0, 1, At, B1); PG8_BAR;
            PG8_LDA(At, 0, 1); PG8_STAGE(PG8_SA(0, 0), a2, voffA);
            PG8_BAR; PG8_WAIT_L(0); PG8_MMA(1, 0, At, B0); PG8_BAR; PG8_SCHED;
            PG8_STAGE(PG8_SB(0, 1), b2 + hstepB, voffB);
            PG8_WAIT_V(6); PG8_BAR; PG8_MMA(1, 1, At, B1); PG8_BAR;
            PG8_LDB(B0, 1, 0); PG8_SCHED; PG8_LDA(At, 1, 0); PG8_STAGE(PG8_SA(0, 1), a2 + hstepA, voffA);
            PG8_WAIT_L(8); PG8_BAR; PG8_WAIT_L(0); PG8_MMA(0, 0, At, B0); PG8_BAR; PG8_SCHED;
            PG8_LDB(B1, 1, 1); PG8_STAGE(PG8_SB(1, 0), b3, voffB);
            PG8_BAR; PG8_WAIT_L(0); PG8_MMA(0, 1, At, B1); PG8_BAR;
            PG8_LDA(At, 1, 1); PG8_STAGE(PG8_SA(1, 0), a3, voffA);
            PG8_BAR; PG8_WAIT_L(0); PG8_MMA(1, 0, At, B0); PG8_BAR; PG8_SCHED;
            PG8_STAGE(PG8_SB(1, 1), b3 + hstepB, voffB);
            PG8_WAIT_V(6); PG8_BAR; PG8_MMA(1, 1, At, B1); PG8_BAR;
            }
        }
        if constexpr (ALIGN_EPI) { if (wr == 0) PG8_BAR; }
        if constexpr (!Epi::AFTER_DRAIN) { E(acc, cur, wr, wc, fr, fq); S.done(cur); }
        if (!has_next) break;
#pragma unroll
        for (int a = 0; a < 2; ++a)
#pragma unroll
            for (int b = 0; b < 2; ++b)
#pragma unroll
                for (int m = 0; m < 4; ++m)
#pragma unroll
                    for (int n = 0; n < 2; ++n) acc[a][b][m][n] = (f32x4){0.f, 0.f, 0.f, 0.f};
        cur = nxt; cA = nA; cB = nB; ++ui;
        if constexpr (ALIGN_EPI) { if (wr == 1) PG8_BAR; }
    }
    PG8_WAIT_V(0);
    if constexpr (!ALIGN_EPI) { if (wr == 0) PG8_BAR; }
    PG8_BAR;
    if constexpr (Epi::AFTER_DRAIN) { E.fused(acc, cur, wr, wc, fr, fq, lds, wid, lane); S.done(cur); }
#undef PG8_SA
#undef PG8_SB
#undef PG8_STAGE
#undef PG8_LDA
#undef PG8_LDB
#undef PG8_MMA
#undef PG8_WAIT_V
#undef PG8_WAIT_L
#undef PG8_BAR
#undef PG8_SCHED
}
}

namespace att {
using pg8::bf16_t;
using bf16x8 = __attribute__((ext_vector_type(8))) short;
using s16x4  = __attribute__((ext_vector_type(4))) short;
using f32x16 = __attribute__((ext_vector_type(16))) float;
using u32x4  = __attribute__((ext_vector_type(4))) unsigned;
using f32x4_t = __attribute__((ext_vector_type(4))) float;
using f32x2_t = __attribute__((ext_vector_type(2))) float;
constexpr int NW = 8, QBLK = 32, KVBLK = 64, DV = 128;
constexpr int SHM_V = KVBLK * DV * 2;
#define ATT_SBAR() __builtin_amdgcn_sched_barrier(0)
__device__ __forceinline__ int crow(int r, int hi) { return (r & 3) + 8 * (r >> 2) + 4 * hi; }
__device__ __forceinline__ unsigned cvtpk(float lo, float hi) { unsigned r; asm volatile("v_cvt_pk_bf16_f32 %0, %1, %2" : "=v"(r) : "v"(lo), "v"(hi)); return r; }
#ifndef ATT_ACTIVE_WAVES
#define ATT_ACTIVE_WAVES 8
#endif
constexpr float THR = 8.f;

template <int DQK> struct Cfg {
  static constexpr int KROW = DQK * 2 + 16;
  static constexpr int SHM_K = KVBLK * KROW;
  static constexpr int NCH = DQK / 8;
  static constexpr int KPT = DQK / 64;
  static constexpr int ND0 = DQK / 16;
  static constexpr int LDS_BYTES = 2 * SHM_V + 2 * SHM_K + NW * 64 * 4;
};

__device__ __forceinline__ void partialSM(f32x16& p0, f32x16& p1, float& m_reg, float& mn, float& alpha, const float C, const float thr_raw) {
  float pmax = p0[0];
#pragma unroll
  for (int r = 1; r < 16; ++r) pmax = fmaxf(pmax, p0[r]);
#pragma unroll
  for (int r = 0; r < 16; ++r) pmax = fmaxf(pmax, p1[r]);
  { auto rr = __builtin_amdgcn_permlane32_swap(__float_as_uint(pmax), __float_as_uint(pmax), false, false);
    pmax = fmaxf(__uint_as_float(rr[0]), __uint_as_float(rr[1])); }
  if (__builtin_expect(__all(pmax - m_reg <= thr_raw), 1)) { mn = m_reg; alpha = 1.f; }
  else { mn = fmaxf(m_reg, pmax); alpha = __builtin_amdgcn_exp2f((m_reg - mn) * C); m_reg = mn; }
  float mnC = -mn * C;
#pragma unroll
  for (int r = 0; r < 16; ++r) p0[r] = fmaf(p0[r], C, mnC);
#pragma unroll
  for (int r = 0; r < 16; ++r) p1[r] = fmaf(p1[r], C, mnC);
#pragma unroll
  for (int r = 0; r < 16; ++r) p0[r] = __builtin_amdgcn_exp2f(p0[r]);
}
__device__ __forceinline__ void finishSM(f32x16& p0, f32x16& p1, float alpha, float& l_reg, bf16x8& pa0, bf16x8& pa1, bf16x8& pa2, bf16x8& pa3) {
#pragma unroll
  for (int r = 0; r < 16; ++r) p1[r] = __builtin_amdgcn_exp2f(p1[r]);
  float ps = 0;
#pragma unroll
  for (int r = 0; r < 16; ++r) ps += p0[r];
#pragma unroll
  for (int r = 0; r < 16; ++r) ps += p1[r];
  { auto rr = __builtin_amdgcn_permlane32_swap(__float_as_uint(ps), __float_as_uint(ps), false, false);
    ps = __uint_as_float(rr[0]) + __uint_as_float(rr[1]); }
  l_reg = l_reg * alpha + ps;
#define ATT_PK4(P, BASE, OUT) do { unsigned a0 = cvtpk(P[BASE + 0], P[BASE + 1]), a1 = cvtpk(P[BASE + 2], P[BASE + 3]);   \
    unsigned b0 = cvtpk(P[BASE + 4], P[BASE + 5]), b1 = cvtpk(P[BASE + 6], P[BASE + 7]);                              \
    auto r0 = __builtin_amdgcn_permlane32_swap(a0, b0, false, false); auto r1 = __builtin_amdgcn_permlane32_swap(a1, b1, false, false); \
    u32x4 w = {r0[0], r1[0], r0[1], r1[1]}; OUT = *reinterpret_cast<bf16x8*>(&w); } while (0)
  ATT_PK4(p0, 0, pa0); ATT_PK4(p0, 8, pa1); ATT_PK4(p1, 0, pa2); ATT_PK4(p1, 8, pa3);
#undef ATT_PK4
}
__device__ __forceinline__ void finishSM_ns(f32x16& p0, f32x16& p1, float alpha, float& l_reg, bf16x8& pa0, bf16x8& pa1, bf16x8& pa2, bf16x8& pa3) {
#pragma unroll
  for (int r = 0; r < 16; ++r) p1[r] = __builtin_amdgcn_exp2f(p1[r]);
  float ps = 0;
#pragma unroll
  for (int r = 0; r < 16; ++r) ps += p0[r];
#pragma unroll
  for (int r = 0; r < 16; ++r) ps += p1[r];
  { auto rr = __builtin_amdgcn_permlane32_swap(__float_as_uint(ps), __float_as_uint(ps), false, false);
    ps = __uint_as_float(rr[0]) + __uint_as_float(rr[1]); }
  l_reg = l_reg * alpha + ps;
#define ATT_PK4N(P, BASE, OUT) do { const u32x4 w = {cvtpk(P[BASE + 0], P[BASE + 1]), cvtpk(P[BASE + 2], P[BASE + 3]), cvtpk(P[BASE + 4], P[BASE + 5]), cvtpk(P[BASE + 6], P[BASE + 7])}; OUT = *reinterpret_cast<const bf16x8*>(&w); } while (0)
  ATT_PK4N(p0, 0, pa0); ATT_PK4N(p0, 8, pa1); ATT_PK4N(p1, 0, pa2); ATT_PK4N(p1, 8, pa3);
#undef ATT_PK4N
}
template <int DQK> __device__ __forceinline__ void qkt(f32x16& p0, f32x16& p1, const char* Ks, const bf16x8* qr, int r32, int hi) {
  constexpr int KROW = Cfg<DQK>::KROW;
  p0 = f32x16{}; p1 = f32x16{};
#pragma unroll
  for (int d0 = 0; d0 < DQK / 16; ++d0) { const int cb = (d0 * 16 + hi * 8) * 2;
    bf16x8 b0 = *reinterpret_cast<const bf16x8*>(Ks + r32 * KROW + cb);
    bf16x8 b1 = *reinterpret_cast<const bf16x8*>(Ks + (32 + r32) * KROW + cb);
    p0 = __builtin_amdgcn_mfma_f32_32x32x16_bf16(b0, qr[d0], p0, 0, 0, 0);
    p1 = __builtin_amdgcn_mfma_f32_32x32x16_bf16(b1, qr[d0], p1, 0, 0, 0); }
}
__device__ __forceinline__ int v_st(int k, int c) { const int kk = (k & ~0xC) | ((k & 4) << 1) | ((k & 8) >> 1); return ((kk >> 3) * 4 + (c >> 5)) * 512 + ((kk & 7) * 32 + (c & 31)) * 2; }
__device__ __forceinline__ int v_rd_base(int lane) { return ((lane & 3) << 3) | (((lane >> 2) & 3) << 6) | (((lane >> 4) & 1) << 5) | (((lane >> 5) & 1) << 8); }
constexpr int v_rd_off(int d0, int ks, int half) { return d0 * 512 + ks * 4096 + half * 2048; }
template <int OFF> __device__ __forceinline__ s16x4 tr_read(int vb) {
  s16x4 r; asm volatile("ds_read_b64_tr_b16 %0, %1 offset:%2" : "=&v"(r) : "v"(vb), "i"(OFF) : "memory"); return r;
}
template <int D0> __device__ __forceinline__ void pv_one(f32x16& od, int vb, bf16x8 pa0, bf16x8 pa1, bf16x8 pa2, bf16x8 pa3) {
  const s16x4 l0 = tr_read<v_rd_off(D0, 0, 0)>(vb), h0 = tr_read<v_rd_off(D0, 0, 1)>(vb), l1 = tr_read<v_rd_off(D0, 1, 0)>(vb), h1 = tr_read<v_rd_off(D0, 1, 1)>(vb);
  const s16x4 l2 = tr_read<v_rd_off(D0, 2, 0)>(vb), h2 = tr_read<v_rd_off(D0, 2, 1)>(vb), l3 = tr_read<v_rd_off(D0, 3, 0)>(vb), h3 = tr_read<v_rd_off(D0, 3, 1)>(vb);
  asm volatile("s_waitcnt lgkmcnt(0)" ::: "memory"); ATT_SBAR();
#define ATT_PK(L, H) (bf16x8){L[0], L[1], L[2], L[3], H[0], H[1], H[2], H[3]}
  od = __builtin_amdgcn_mfma_f32_32x32x16_bf16(pa0, ATT_PK(l0, h0), od, 0, 0, 0);
  od = __builtin_amdgcn_mfma_f32_32x32x16_bf16(pa1, ATT_PK(l1, h1), od, 0, 0, 0);
  od = __builtin_amdgcn_mfma_f32_32x32x16_bf16(pa2, ATT_PK(l2, h2), od, 0, 0, 0);
  od = __builtin_amdgcn_mfma_f32_32x32x16_bf16(pa3, ATT_PK(l3, h3), od, 0, 0, 0);
#undef ATT_PK
}
__device__ __forceinline__ void pv_d0(f32x16* o, int vb, bf16x8 pa0, bf16x8 pa1, bf16x8 pa2, bf16x8 pa3) {
  pv_one<0>(o[0], vb, pa0, pa1, pa2, pa3); pv_one<1>(o[1], vb, pa0, pa1, pa2, pa3); pv_one<2>(o[2], vb, pa0, pa1, pa2, pa3); pv_one<3>(o[3], vb, pa0, pa1, pa2, pa3);
}

struct OutArgs { bf16_t* Ob; int LDO; float* stash; float lam, post; const float* g; unsigned long long* tp; };

template <int DQK, int LDQ, int LDK, int LDV, int MODE, bool SIMPLE = false>
__device__ __forceinline__ void attn_body(const bf16_t* __restrict__ Qb, const bf16_t* __restrict__ Kh, const bf16_t* __restrict__ Vh,
                                          int seq, float scale, const OutArgs& oa, char* lds) {
  using CF = Cfg<DQK>;
  constexpr int KPT = CF::KPT, NCH = CF::NCH, ND0 = CF::ND0, SHM_K = CF::SHM_K, KROW = CF::KROW;
  const float C = scale * 1.4426950408889634f, thr_raw = THR / scale;
  int tid_ = threadIdx.x; asm volatile("" : "+v"(tid_));
  const int tid = tid_, wid = tid >> 6, lane = tid & 63, r32 = lane & 31, hi = lane >> 5;
  char* V_lds = lds; char* K_lds = lds + 2 * SHM_V;
  float* ws = (float*)(lds + 2 * SHM_V + 2 * SHM_K) + wid * 64; float* li_l = ws; float* al_l = ws + 32;
  float m_reg = -1e30f, l_reg = 0; f32x16 o[4] = {}; bf16x8 qr[ND0];
  const bf16_t* Qw = Qb + (long)(wid * QBLK + r32) * LDQ + hi * 8;
#pragma unroll
  for (int d0 = 0; d0 < ND0; ++d0) qr[d0] = *reinterpret_cast<const bf16x8*>(Qw + d0 * 16);
  const int sr = tid >> 4, sc = (tid & 15) * 8, vst0 = v_st(sr, sc), vst1 = v_st(32 + sr, sc);
  int kgo[KPT], klo[KPT];
#pragma unroll
  for (int i = 0; i < KPT; ++i) { const int c = tid + 512 * i, row = c / NCH, ch = c % NCH; kgo[i] = row * LDK + ch * 8; klo[i] = row * KROW + ch * 16; }
  const int vb0 = (int)(uintptr_t)V_lds + v_rd_base(lane);
  struct Slot { bf16x8 vs0, vs1; bf16x8 ks[KPT]; };
  Slot s0_, s1_;
#define ATT_SLOAD(S, k0) do { (S).vs0 = *reinterpret_cast<const bf16x8*>(&Vh[(long)((k0) + sr) * LDV + sc]); (S).vs1 = *reinterpret_cast<const bf16x8*>(&Vh[(long)((k0) + 32 + sr) * LDV + sc]); \
    _Pragma("unroll") for (int _i = 0; _i < KPT; ++_i) (S).ks[_i] = *reinterpret_cast<const bf16x8*>(&Kh[(long)(k0) * LDK + kgo[_i]]); } while (0)
#define ATT_SWRITE(b, S) do { *(bf16x8*)(V_lds + (b) * SHM_V + vst0) = (S).vs0; *(bf16x8*)(V_lds + (b) * SHM_V + vst1) = (S).vs1; \
    _Pragma("unroll") for (int _i = 0; _i < KPT; ++_i) *(bf16x8*)(K_lds + (b) * SHM_K + klo[_i]) = (S).ks[_i]; } while (0)
#define ATT_SWAIT() asm volatile("s_waitcnt vmcnt(%0)" :: "n"(2 + KPT) : "memory")
#define ATT_RESC(a) do { if (__any((a) < 1.f)) { if (hi == 0) al_l[r32] = (a); asm volatile("s_waitcnt lgkmcnt(0)" ::: "memory"); \
    _Pragma("unroll") for (int d = 0; d < 4; ++d) _Pragma("unroll") for (int r = 0; r < 16; ++r) o[d][r] *= al_l[crow(r, hi)]; } } while (0)
  bf16x8 pa0, pa1, pa2, pa3; const int NT = seq / KVBLK;
  if constexpr (SIMPLE) {
    f32x16 p0, p1; float mn, al;
    ATT_SLOAD(s0_, 0); asm volatile("s_waitcnt vmcnt(0)" ::: "memory"); ATT_SWRITE(0, s0_); ATT_SLOAD(s0_, KVBLK); __syncthreads();
    for (int j = 0; j < NT; ++j) { const int b = j & 1;
      ATT_SBAR(); qkt<DQK>(p0, p1, K_lds + b * SHM_K, qr, r32, hi);
      partialSM(p0, p1, m_reg, mn, al, C, thr_raw); ATT_RESC(al);
      finishSM(p0, p1, al, l_reg, pa0, pa1, pa2, pa3); ATT_SBAR();
      pv_d0(o, vb0 + b * SHM_V, pa0, pa1, pa2, pa3); ATT_SBAR();
      if (j + 1 < NT) { asm volatile("s_waitcnt vmcnt(0)" ::: "memory"); ATT_SWRITE(1 - b, s0_); if (j + 2 < NT) ATT_SLOAD(s0_, (j + 2) * KVBLK); }
      __syncthreads();
    }
  } else {
  f32x16 pA0, pA1, pB0, pB1; float mnA, mnB, alA, alB;
  ATT_SLOAD(s0_, 0); asm volatile("s_waitcnt vmcnt(0)" ::: "memory"); ATT_SWRITE(0, s0_); __syncthreads();
  qkt<DQK>(pA0, pA1, K_lds, qr, r32, hi); partialSM(pA0, pA1, m_reg, mnA, alA, C, thr_raw);
  ATT_SLOAD(s1_, KVBLK); if (2 < NT) ATT_SLOAD(s0_, 2 * KVBLK);
  ATT_SWAIT(); ATT_SWRITE(1, s1_); __syncthreads();
  for (int j = 1; j + 1 < NT; j += 2) {
    ATT_SBAR(); qkt<DQK>(pB0, pB1, K_lds + SHM_K, qr, r32, hi);
    finishSM(pA0, pA1, alA, l_reg, pa0, pa1, pa2, pa3); ATT_SBAR();
    ATT_SLOAD(s1_, (j + 2) * KVBLK); ATT_SBAR();
    pv_d0(o, vb0, pa0, pa1, pa2, pa3); partialSM(pB0, pB1, m_reg, mnB, alB, C, thr_raw);
    __syncthreads(); ATT_SWAIT(); ATT_SWRITE(0, s0_);
    ATT_RESC(alB); __syncthreads();
    ATT_SBAR(); qkt<DQK>(pA0, pA1, K_lds, qr, r32, hi);
    finishSM(pB0, pB1, alB, l_reg, pa0, pa1, pa2, pa3); ATT_SBAR();
    if (j + 3 < NT) ATT_SLOAD(s0_, (j + 3) * KVBLK); ATT_SBAR();
    pv_d0(o, vb0 + SHM_V, pa0, pa1, pa2, pa3); partialSM(pA0, pA1, m_reg, mnA, alA, C, thr_raw);
    __syncthreads(); ATT_SWAIT(); ATT_SWRITE(1, s1_);
    ATT_RESC(alA); __syncthreads();
  }
  ATT_SBAR(); qkt<DQK>(pB0, pB1, K_lds + SHM_K, qr, r32, hi);
  finishSM(pA0, pA1, alA, l_reg, pa0, pa1, pa2, pa3); ATT_SBAR();
  pv_d0(o, vb0, pa0, pa1, pa2, pa3); partialSM(pB0, pB1, m_reg, mnB, alB, C, thr_raw);
  __syncthreads(); ATT_RESC(alB);
  finishSM(pB0, pB1, alB, l_reg, pa0, pa1, pa2, pa3); ATT_SBAR();
  pv_d0(o, vb0 + SHM_V, pa0, pa1, pa2, pa3);
  }
  if (hi == 0) li_l[r32] = l_reg; asm volatile("s_waitcnt lgkmcnt(0)" ::: "memory");
  float rli[16];
#pragma unroll
  for (int r = 0; r < 16; ++r) rli[r] = __builtin_amdgcn_rcpf(li_l[crow(r, hi)]);
  __syncthreads();
  float* Ot = (float*)(lds + wid * 16384);
#pragma unroll
  for (int r = 0; r < 16; ++r) { const int orow = crow(r, hi);
#pragma unroll
    for (int d0 = 0; d0 < 4; ++d0) Ot[orow * 128 + d0 * 32 + r32] = o[d0][r] * rli[r]; }
  asm volatile("s_waitcnt lgkmcnt(0)" ::: "memory");
  const int er = lane >> 4, ec = (lane & 15) * 8;
  if constexpr (MODE == 0) {
    bf16_t* Ow = oa.Ob + (long)(wid * QBLK + er) * oa.LDO + ec;
#pragma unroll
    for (int k = 0; k < 8; ++k) { const float* sp = Ot + (4 * k + er) * 128 + ec; const f32x4_t a = *(const f32x4_t*)sp, b = *(const f32x4_t*)(sp + 4);
      *(u32x4*)(Ow + (long)(4 * k) * oa.LDO) = (u32x4){cvtpk(a[0], a[1]), cvtpk(a[2], a[3]), cvtpk(b[0], b[1]), cvtpk(b[2], b[3])}; }
  } else if constexpr (MODE == 1) {
    float* Sw = oa.stash + (wid * QBLK + er) * 128 + ec;
#pragma unroll
    for (int k = 0; k < 8; ++k) { const float* sp = Ot + (4 * k + er) * 128 + ec; const f32x4_t a = *(const f32x4_t*)sp, b = *(const f32x4_t*)(sp + 4);
      *(f32x4_t*)(Sw + 4 * k * 128) = a; *(f32x4_t*)(Sw + 4 * k * 128 + 4) = b; }
  } else {
    const float* Sw = oa.stash + (wid * QBLK + er) * 128 + ec; bf16_t* Ow = oa.Ob + (long)(wid * QBLK + er) * oa.LDO + ec;
    const f32x4_t g0 = *(const f32x4_t*)(oa.g + ec) * oa.post, g1 = *(const f32x4_t*)(oa.g + ec + 4) * oa.post;
#pragma unroll
    for (int k = 0; k < 8; ++k) { asm volatile("" ::: "memory"); const float* sp = Ot + (4 * k + er) * 128 + ec; f32x4_t a = *(const f32x4_t*)sp, b = *(const f32x4_t*)(sp + 4);
      a = *(const f32x4_t*)(Sw + 4 * k * 128) - oa.lam * a; b = *(const f32x4_t*)(Sw + 4 * k * 128 + 4) - oa.lam * b;
      float ss = (a[0] * a[0] + a[1] * a[1]) + (a[2] * a[2] + a[3] * a[3]) + (b[0] * b[0] + b[1] * b[1]) + (b[2] * b[2] + b[3] * b[3]);
      ss += __shfl_xor(ss, 1); ss += __shfl_xor(ss, 2); ss += __shfl_xor(ss, 4); ss += __shfl_xor(ss, 8);
      const float rn = 1.0f / sqrtf(ss * (1.0f / 128.0f) + EPS);
      a = a * rn * g0; b = b * rn * g1;
      *(u32x4*)(Ow + (long)(4 * k) * oa.LDO) = (u32x4){cvtpk(a[0], a[1]), cvtpk(a[2], a[3]), cvtpk(b[0], b[1]), cvtpk(b[2], b[3])}; }
  }
  __syncthreads();
#undef ATT_SLOAD
#undef ATT_SWRITE
#undef ATT_SWAIT
#undef ATT_RESC
}

template <int DQK, int LDQ, int LDK, int LDV, int MODE>
__device__ __forceinline__ void attn_body2(const bf16_t* __restrict__ Qb, const bf16_t* __restrict__ Kh, const bf16_t* __restrict__ Vh,
                                           int seq, float scale, const OutArgs& oa, char* lds, __attribute__((address_space(3))) unsigned char* ldsl) {
  using CF = Cfg<DQK>;
  constexpr int ND0 = CF::ND0, SHM_K = CF::SHM_K, KROW = CF::KROW, SLOT = SHM_K + SHM_V, KCH = SHM_K / 1024, NKI = (KCH + 7) / 8;
  static_assert(SHM_K % 1024 == 0 && 3 * SLOT + NW * 256 <= 131072, "attention LDS ring");
  const float C = scale * 1.4426950408889634f, thr_raw = THR / scale;
  int tid_ = threadIdx.x; asm volatile("" : "+v"(tid_));
  const int tid = tid_, wid = __builtin_amdgcn_readfirstlane(tid >> 6), lane = tid & 63, r32 = lane & 31, hi = lane >> 5;
  float* ws = (float*)(lds + 3 * SLOT) + wid * 64; float* li_l = ws; float* al_l = ws + 32;
  float m_reg = -1e30f, l_reg = 0; f32x16 o[4] = {}; bf16x8 qr[ND0];
  int ksrc[NKI], vsrc[2];
#pragma unroll
  for (int i = 0; i < NKI; ++i) { const int ob = (wid + 8 * i) * 1024 + lane * 16, row = ob / KROW, within = ob - row * KROW; ksrc[i] = (row < KVBLK ? row : 0) * LDK + (within < 2 * DQK ? within / 2 : 0); }
#pragma unroll
  for (int i = 0; i < 2; ++i) { const int gi = (2 * wid + i) * 64 + lane, c8 = (gi & 3) | (((gi >> 5) & 3) << 2), kk = ((gi >> 2) & 7) | ((gi >> 7) << 3), k = (kk & ~0xC) | ((kk & 4) << 1) | ((kk & 8) >> 1); vsrc[i] = k * LDV + c8 * 8; }
#define ATT_GLDS(g, l) __builtin_amdgcn_global_load_lds((const unsigned*)(g), (__attribute__((address_space(3))) unsigned*)(l), 16, 0, 0)
#define ATT_DMA(k0, s) do { __attribute__((address_space(3))) unsigned char* _kb = ldsl + (s) * SLOT; \
    _Pragma("unroll") for (int _i = 0; _i < NKI; ++_i) { if (wid + 8 * _i < KCH) ATT_GLDS(Kh + (long)(k0) * LDK + ksrc[_i], _kb + (wid + 8 * _i) * 1024); } \
    _Pragma("unroll") for (int _i = 0; _i < 2; ++_i) ATT_GLDS(Vh + (long)(k0) * LDV + vsrc[_i], _kb + SHM_K + (2 * wid + _i) * 1024); } while (0)
#define ATT_BAR() do { asm volatile("s_waitcnt vmcnt(0) lgkmcnt(0)" ::: "memory"); __builtin_amdgcn_s_barrier(); asm volatile("" ::: "memory"); } while (0)
#define ATT_RESC2(a) do { if (__any((a) < 1.f)) { if (hi == 0) al_l[r32] = (a); asm volatile("s_waitcnt lgkmcnt(0)" ::: "memory"); \
    _Pragma("unroll") for (int d = 0; d < 4; ++d) _Pragma("unroll") for (int r = 0; r < 16; ++r) o[d][r] *= al_l[crow(r, hi)]; } } while (0)
  const int NT = seq / KVBLK;
  ATT_DMA(0, 0); ATT_DMA(KVBLK, 1);
  const bf16_t* Qw = Qb + (long)(wid * QBLK + r32) * LDQ + hi * 8;
#pragma unroll
  for (int d0 = 0; d0 < ND0; ++d0) qr[d0] = *reinterpret_cast<const bf16x8*>(Qw + d0 * 16);
  ATT_BAR();
  const int vb0 = (int)(uintptr_t)lds + SHM_K + v_rd_base(lane);
  f32x16 pA0, pA1, pB0, pB1; float mnA, mnB, alA, alB; bf16x8 pa0, pa1, pa2, pa3;
  qkt<DQK>(pA0, pA1, lds, qr, r32, hi); partialSM(pA0, pA1, m_reg, mnA, alA, C, thr_raw);
  if (2 < NT) ATT_DMA(2 * KVBLK, 2);
  int sj = 1, sp = 0;
  for (int j = 1; j + 1 < NT; j += 2) {
    ATT_SBAR(); qkt<DQK>(pB0, pB1, lds + sj * SLOT, qr, r32, hi);
    finishSM(pA0, pA1, alA, l_reg, pa0, pa1, pa2, pa3); ATT_SBAR();
    pv_d0(o, vb0 + sp * SLOT, pa0, pa1, pa2, pa3); partialSM(pB0, pB1, m_reg, mnB, alB, C, thr_raw);
    ATT_BAR();
    if (j + 2 < NT) ATT_DMA((j + 2) * KVBLK, sp);
    ATT_RESC2(alB);
    { const int t = sp; sp = sj; sj = (sj == 2) ? 0 : sj + 1; (void)t; }
    ATT_SBAR(); qkt<DQK>(pA0, pA1, lds + sj * SLOT, qr, r32, hi);
    finishSM(pB0, pB1, alB, l_reg, pa0, pa1, pa2, pa3); ATT_SBAR();
    pv_d0(o, vb0 + sp * SLOT, pa0, pa1, pa2, pa3); partialSM(pA0, pA1, m_reg, mnA, alA, C, thr_raw);
    ATT_BAR();
    if (j + 3 < NT) ATT_DMA((j + 3) * KVBLK, sp);
    ATT_RESC2(alA);
    { sp = sj; sj = (sj == 2) ? 0 : sj + 1; }
  }
  ATT_SBAR(); qkt<DQK>(pB0, pB1, lds + sj * SLOT, qr, r32, hi);
  finishSM(pA0, pA1, alA, l_reg, pa0, pa1, pa2, pa3); ATT_SBAR();
  pv_d0(o, vb0 + sp * SLOT, pa0, pa1, pa2, pa3); partialSM(pB0, pB1, m_reg, mnB, alB, C, thr_raw);
  ATT_RESC2(alB);
  finishSM(pB0, pB1, alB, l_reg, pa0, pa1, pa2, pa3); ATT_SBAR();
  pv_d0(o, vb0 + sj * SLOT, pa0, pa1, pa2, pa3);
  if (hi == 0) li_l[r32] = l_reg; asm volatile("s_waitcnt lgkmcnt(0)" ::: "memory");
  float rli[16];
#pragma unroll
  for (int r = 0; r < 16; ++r) rli[r] = __builtin_amdgcn_rcpf(li_l[crow(r, hi)]);
  ATT_BAR();
  float* Ot = (float*)(lds + wid * 16384);
#pragma unroll
  for (int r = 0; r < 16; ++r) { const int orow = crow(r, hi);
#pragma unroll
    for (int d0 = 0; d0 < 4; ++d0) Ot[orow * 128 + d0 * 32 + r32] = o[d0][r] * rli[r]; }
  asm volatile("s_waitcnt lgkmcnt(0)" ::: "memory");
  const int er = lane >> 4, ec = (lane & 15) * 8;
  if constexpr (MODE == 0) {
    bf16_t* Ow = oa.Ob + (long)(wid * QBLK + er) * oa.LDO + ec;
#pragma unroll
    for (int k = 0; k < 8; ++k) { const float* sp2 = Ot + (4 * k + er) * 128 + ec; const f32x4_t a = *(const f32x4_t*)sp2, b = *(const f32x4_t*)(sp2 + 4);
      *(u32x4*)(Ow + (long)(4 * k) * oa.LDO) = (u32x4){cvtpk(a[0], a[1]), cvtpk(a[2], a[3]), cvtpk(b[0], b[1]), cvtpk(b[2], b[3])}; }
  } else if constexpr (MODE == 1) {
    float* Sw = oa.stash + (wid * QBLK + er) * 128 + ec;
#pragma unroll
    for (int k = 0; k < 8; ++k) { const float* sp2 = Ot + (4 * k + er) * 128 + ec; const f32x4_t a = *(const f32x4_t*)sp2, b = *(const f32x4_t*)(sp2 + 4);
      *(f32x4_t*)(Sw + 4 * k * 128) = a; *(f32x4_t*)(Sw + 4 * k * 128 + 4) = b; }
  } else {
    const float* Sw = oa.stash + (wid * QBLK + er) * 128 + ec; bf16_t* Ow = oa.Ob + (long)(wid * QBLK + er) * oa.LDO + ec;
    const f32x4_t g0 = *(const f32x4_t*)(oa.g + ec) * oa.post, g1 = *(const f32x4_t*)(oa.g + ec + 4) * oa.post;
#pragma unroll
    for (int k = 0; k < 8; ++k) { asm volatile("" ::: "memory"); const float* sp2 = Ot + (4 * k + er) * 128 + ec; f32x4_t a = *(const f32x4_t*)sp2, b = *(const f32x4_t*)(sp2 + 4);
      a = *(const f32x4_t*)(Sw + 4 * k * 128) - oa.lam * a; b = *(const f32x4_t*)(Sw + 4 * k * 128 + 4) - oa.lam * b;
      float ss = (a[0] * a[0] + a[1] * a[1]) + (a[2] * a[2] + a[3] * a[3]) + (b[0] * b[0] + b[1] * b[1]) + (b[2] * b[2] + b[3] * b[3]);
      ss += __shfl_xor(ss, 1); ss += __shfl_xor(ss, 2); ss += __shfl_xor(ss, 4); ss += __shfl_xor(ss, 8);
      const float rn = 1.0f / sqrtf(ss * (1.0f / 128.0f) + EPS);
      a = a * rn * g0; b = b * rn * g1;
      *(u32x4*)(Ow + (long)(4 * k) * oa.LDO) = (u32x4){cvtpk(a[0], a[1]), cvtpk(a[2], a[3]), cvtpk(b[0], b[1]), cvtpk(b[2], b[3])}; }
  }
  ATT_BAR();
#undef ATT_GLDS
#undef ATT_DMA
#undef ATT_BAR
#undef ATT_RESC2
}

template <int OFF> __device__ __forceinline__ bf16x8 ds_rd128(int addr) { bf16x8 r; asm volatile("ds_read_b128 %0, %1 offset:%2" : "=&v"(r) : "v"(addr), "i"(OFF) : "memory"); return r; }
template <int N> __device__ __forceinline__ void wait_lgkm() { asm volatile("s_waitcnt lgkmcnt(%0)" :: "n"(N) : "memory"); }
#define ATT_RKG(dst, g) do { dst[0] = ds_rd128<(2 * (g)) * 32>(kb); dst[1] = ds_rd128<(2 * (g)) * 32 + 32 * KROW>(kb); dst[2] = ds_rd128<(2 * (g) + 1) * 32>(kb); dst[3] = ds_rd128<(2 * (g) + 1) * 32 + 32 * KROW>(kb); } while (0)
#define ATT_MKG(src, g) do { p0 = __builtin_amdgcn_mfma_f32_32x32x16_bf16(src[0], qr[2 * (g)], p0, 0, 0, 0); p1 = __builtin_amdgcn_mfma_f32_32x32x16_bf16(src[1], qr[2 * (g)], p1, 0, 0, 0); \
    p0 = __builtin_amdgcn_mfma_f32_32x32x16_bf16(src[2], qr[2 * (g) + 1], p0, 0, 0, 0); p1 = __builtin_amdgcn_mfma_f32_32x32x16_bf16(src[3], qr[2 * (g) + 1], p1, 0, 0, 0); } while (0)
#define ATT_PKV(L, H) (bf16x8){L[0], L[1], L[2], L[3], H[0], H[1], H[2], H[3]}
#define ATT_VRD(D0, P) const s16x4 P##l0 = tr_read<v_rd_off(D0, 0, 0)>(vb), P##h0 = tr_read<v_rd_off(D0, 0, 1)>(vb), P##l1 = tr_read<v_rd_off(D0, 1, 0)>(vb), P##h1 = tr_read<v_rd_off(D0, 1, 1)>(vb), \
    P##l2 = tr_read<v_rd_off(D0, 2, 0)>(vb), P##h2 = tr_read<v_rd_off(D0, 2, 1)>(vb), P##l3 = tr_read<v_rd_off(D0, 3, 0)>(vb), P##h3 = tr_read<v_rd_off(D0, 3, 1)>(vb)
#define ATT_VMM(od, P) do { od = __builtin_amdgcn_mfma_f32_32x32x16_bf16(pa0, ATT_PKV(P##l0, P##h0), od, 0, 0, 0); od = __builtin_amdgcn_mfma_f32_32x32x16_bf16(pa1, ATT_PKV(P##l1, P##h1), od, 0, 0, 0); \
    od = __builtin_amdgcn_mfma_f32_32x32x16_bf16(pa2, ATT_PKV(P##l2, P##h2), od, 0, 0, 0); od = __builtin_amdgcn_mfma_f32_32x32x16_bf16(pa3, ATT_PKV(P##l3, P##h3), od, 0, 0, 0); } while (0)
#define ATT_W(n) do { wait_lgkm<n>(); ATT_SBAR(); } while (0)
template <int DQK, bool PV> __device__ __forceinline__ void att_mblock(f32x16& p0, f32x16& p1, f32x16* o, const bf16x8* qr, int kb, int vb, bf16x8 pa0, bf16x8 pa1, bf16x8 pa2, bf16x8 pa3) {
  constexpr int KROW = Cfg<DQK>::KROW, NG = DQK / 32;
  constexpr int WK = PV ? 8 : 0;
  bf16x8 kA[4], kB[4];
  p0 = f32x16{}; p1 = f32x16{};
  ATT_RKG(kA, 0); ATT_RKG(kB, 1);
  if constexpr (NG == 2) {
    if constexpr (PV) {
      ATT_W(4); ATT_MKG(kA, 0); ATT_SBAR(); ATT_VRD(0, a);
      ATT_W(8); ATT_MKG(kB, 1); ATT_SBAR(); ATT_VRD(1, b);
      ATT_W(8); ATT_VMM(o[0], a); ATT_SBAR(); ATT_VRD(2, c);
      ATT_W(8); ATT_VMM(o[1], b); ATT_SBAR(); ATT_VRD(3, d);
      ATT_W(8); ATT_VMM(o[2], c); ATT_SBAR();
      ATT_W(0); ATT_VMM(o[3], d);
    } else { ATT_W(4); ATT_MKG(kA, 0); ATT_SBAR(); ATT_W(0); ATT_MKG(kB, 1); }
  } else if constexpr (NG == 4) {
    ATT_W(4); ATT_MKG(kA, 0); ATT_SBAR(); ATT_RKG(kA, 2);
    ATT_W(4); ATT_MKG(kB, 1); ATT_SBAR(); ATT_RKG(kB, 3);
    if constexpr (PV) {
      ATT_W(4); ATT_MKG(kA, 2); ATT_SBAR(); ATT_VRD(0, a);
      ATT_W(8); ATT_MKG(kB, 3); ATT_SBAR(); ATT_VRD(1, b);
      ATT_W(8); ATT_VMM(o[0], a); ATT_SBAR(); ATT_VRD(2, c);
      ATT_W(8); ATT_VMM(o[1], b); ATT_SBAR(); ATT_VRD(3, d);
      ATT_W(8); ATT_VMM(o[2], c); ATT_SBAR();
      ATT_W(0); ATT_VMM(o[3], d);
    } else { ATT_W(4); ATT_MKG(kA, 2); ATT_SBAR(); ATT_W(0); ATT_MKG(kB, 3); }
  } else {
    ATT_W(4); ATT_MKG(kA, 0); ATT_SBAR(); ATT_RKG(kA, 2);
    ATT_W(4); ATT_MKG(kB, 1); ATT_SBAR(); ATT_RKG(kB, 3);
    ATT_W(4); ATT_MKG(kA, 2); ATT_SBAR(); ATT_RKG(kA, 4);
    ATT_W(4); ATT_MKG(kB, 3); ATT_SBAR(); ATT_RKG(kB, 5);
    if constexpr (PV) {
      ATT_W(4); ATT_MKG(kA, 4); ATT_SBAR(); ATT_VRD(0, a);
      ATT_W(8); ATT_MKG(kB, 5); ATT_SBAR(); ATT_VRD(1, b);
      ATT_W(8); ATT_VMM(o[0], a); ATT_SBAR(); ATT_VRD(2, c);
      ATT_W(8); ATT_VMM(o[1], b); ATT_SBAR(); ATT_VRD(3, d);
      ATT_W(8); ATT_VMM(o[2], c); ATT_SBAR();
      ATT_W(0); ATT_VMM(o[3], d);
    } else { ATT_W(4); ATT_MKG(kA, 4); ATT_SBAR(); ATT_W(0); ATT_MKG(kB, 5); }
  }
  (void)WK;
}
__device__ __forceinline__ void att_pvblock(f32x16* o, int vb, bf16x8 pa0, bf16x8 pa1, bf16x8 pa2, bf16x8 pa3) {
  ATT_VRD(0, a); ATT_VRD(1, b);
  ATT_W(8); ATT_VMM(o[0], a); ATT_SBAR(); ATT_VRD(2, c);
  ATT_W(8); ATT_VMM(o[1], b); ATT_SBAR(); ATT_VRD(3, d);
  ATT_W(8); ATT_VMM(o[2], c); ATT_SBAR();
  ATT_W(0); ATT_VMM(o[3], d);
}

template <int DQK, int LDQ, int LDK, int LDV, int MODE>
__device__ __forceinline__ void attn_body3(const bf16_t* __restrict__ Qb, const bf16_t* __restrict__ Kh, const bf16_t* __restrict__ Vh,
                                           int seq, float scale, const OutArgs& oa, char* lds, __attribute__((address_space(3))) unsigned char* ldsl) {
  using CF = Cfg<DQK>;
  constexpr int ND0 = CF::ND0, SHM_K = CF::SHM_K, KROW = CF::KROW, SLOT = SHM_K + SHM_V, KCH = SHM_K / 1024, NKI = (KCH + 7) / 8, NDMA = NKI + 2;
  static_assert(SHM_K % 1024 == 0 && 3 * SLOT + NW * 256 + 1024 <= 131072, "attention LDS ring");
  const float C = scale * 1.4426950408889634f, thr_raw = THR / scale;
  int tid_ = threadIdx.x; asm volatile("" : "+v"(tid_));
  const int tid = tid_, wid = __builtin_amdgcn_readfirstlane(tid >> 6), lane = tid & 63, r32 = lane & 31, hi = lane >> 5, grp = wid >> 2;
  float* ws = (float*)(lds + 3 * SLOT) + wid * 64; float* li_l = ws; float* al_l = ws + 32;
  float m_reg = -1e30f, l_reg = 0; f32x16 o[4] = {}; bf16x8 qr[ND0];
  int ksrc[NKI], vsrc[2];
#pragma unroll
  for (int i = 0; i < NKI; ++i) { const int ob = (wid + 8 * i) * 1024 + lane * 16, row = ob / KROW, within = ob - row * KROW; ksrc[i] = (row < KVBLK ? row : 0) * LDK + (within < 2 * DQK ? within / 2 : 0); }
#pragma unroll
  for (int i = 0; i < 2; ++i) { const int gi = (2 * wid + i) * 64 + lane, c8 = (gi & 3) | (((gi >> 5) & 3) << 2), kk = ((gi >> 2) & 7) | ((gi >> 7) << 3), k = (kk & ~0xC) | ((kk & 4) << 1) | ((kk & 8) >> 1); vsrc[i] = k * LDV + c8 * 8; }
#define ATT_GLDS(g, l) __builtin_amdgcn_global_load_lds((const unsigned*)(g), (__attribute__((address_space(3))) unsigned*)(l), 16, 0, 0)
#define ATT_DMA(k0, s) do { __attribute__((address_space(3))) unsigned char* _kb = ldsl + (s) * SLOT; \
    _Pragma("unroll") for (int _i = 0; _i < NKI; ++_i) { const int _ci = wid + 8 * _i; ATT_GLDS(Kh + (long)(k0) * LDK + ksrc[_i], _ci < KCH ? _kb + _ci * 1024 : ldsl + 3 * SLOT + NW * 256); } \
    _Pragma("unroll") for (int _i = 0; _i < 2; ++_i) ATT_GLDS(Vh + (long)(k0) * LDV + vsrc[_i], _kb + SHM_K + (2 * wid + _i) * 1024); } while (0)
#define ATT_BAR0() do { asm volatile("s_waitcnt vmcnt(0) lgkmcnt(0)" ::: "memory"); __builtin_amdgcn_s_barrier(); asm volatile("" ::: "memory"); } while (0)
#define ATT_BARN() do { asm volatile("s_waitcnt vmcnt(%0) lgkmcnt(0)" :: "n"(NDMA) : "memory"); __builtin_amdgcn_s_barrier(); asm volatile("" ::: "memory"); } while (0)
  const int NT = seq / KVBLK;
  ATT_DMA(0, 0); ATT_DMA(KVBLK, 1);
  const bf16_t* Qw = Qb + (long)(wid * QBLK + r32) * LDQ + hi * 8;
#pragma unroll
  for (int d0 = 0; d0 < ND0; ++d0) qr[d0] = *reinterpret_cast<const bf16x8*>(Qw + d0 * 16);
  ATT_BAR0();
  const int vb0 = (int)(uintptr_t)lds + SHM_K + v_rd_base(lane);
  f32x16 p0, p1; float mn, al; bf16x8 pa0 = {}, pa1 = {}, pa2 = {}, pa3 = {};
  if (grp) ATT_BAR0();
  const int kb0 = (int)(uintptr_t)lds + r32 * KROW + hi * 16;
#define ATT_VBLOCK() do { partialSM(p0, p1, m_reg, mn, al, C, thr_raw); \
    if (__any(al < 1.f)) { if (hi == 0) al_l[r32] = al; asm volatile("s_waitcnt lgkmcnt(0)" ::: "memory"); \
      _Pragma("unroll") for (int d = 0; d < 4; ++d) _Pragma("unroll") for (int r = 0; r < 16; ++r) o[d][r] *= al_l[crow(r, hi)]; } \
    finishSM(p0, p1, al, l_reg, pa0, pa1, pa2, pa3); ATT_SBAR(); } while (0)
  ATT_SBAR(); att_mblock<DQK, false>(p0, p1, o, qr, kb0, vb0, pa0, pa1, pa2, pa3); ATT_SBAR();
  if (grp == 0) ATT_BARN(); else ATT_BAR0();
  if (grp == 1 && 2 < NT) ATT_DMA(2 * KVBLK, 2);
  ATT_VBLOCK();
  if (grp == 0) ATT_BAR0(); else ATT_BARN();
  int sj = 1, sp = 0;
  for (int j = 1; j < NT; ++j) {
    if (grp == 0 && j + 1 < NT) ATT_DMA((j + 1) * KVBLK, (sj == 2) ? 0 : sj + 1);
    ATT_SBAR(); att_mblock<DQK, true>(p0, p1, o, qr, kb0 + sj * SLOT, vb0 + sp * SLOT, pa0, pa1, pa2, pa3); ATT_SBAR();
#if defined(ATT_PROBE_M)
    { f32x16 q0, q1; att_mblock<DQK, false>(q0, q1, o, qr, kb0 + sj * SLOT, vb0 + sp * SLOT, pa0, pa1, pa2, pa3); asm volatile("" :: "v"(q0), "v"(q1)); ATT_SBAR(); }
#endif
    if (grp == 0) ATT_BARN(); else ATT_BAR0();
    if (grp == 1 && j + 2 < NT) ATT_DMA((j + 2) * KVBLK, sp);
#if defined(ATT_PROBE_V)
    f32x16 q0 = p0, q1 = p1; float qm = m_reg, ql = l_reg;
#endif
    ATT_VBLOCK();
#if defined(ATT_PROBE_V)
    { float qmn, qal; bf16x8 d0_, d1_, d2_, d3_; partialSM(q0, q1, qm, qmn, qal, C, thr_raw); finishSM(q0, q1, qal, ql, d0_, d1_, d2_, d3_); asm volatile("" :: "v"(d0_), "v"(d1_), "v"(d2_), "v"(d3_), "v"(ql)); ATT_SBAR(); }
#endif
    if (grp == 0) ATT_BAR0(); else ATT_BARN();
    sp = sj; sj = (sj == 2) ? 0 : sj + 1;
  }
  att_pvblock(o, vb0 + sp * SLOT, pa0, pa1, pa2, pa3);
  if (grp == 0) ATT_BAR0();
  if (hi == 0) li_l[r32] = l_reg; asm volatile("s_waitcnt lgkmcnt(0)" ::: "memory");
  float rli[16];
#pragma unroll
  for (int r = 0; r < 16; ++r) rli[r] = __builtin_amdgcn_rcpf(li_l[crow(r, hi)]);
  ATT_BAR0();
  float* Ot = (float*)(lds + wid * 16384);
#pragma unroll
  for (int r = 0; r < 16; ++r) { const int orow = crow(r, hi);
#pragma unroll
    for (int d0 = 0; d0 < 4; ++d0) Ot[orow * 128 + d0 * 32 + r32] = o[d0][r] * rli[r]; }
  asm volatile("s_waitcnt lgkmcnt(0)" ::: "memory");
  const int er = lane >> 4, ec = (lane & 15) * 8;
  if constexpr (MODE == 0) {
    bf16_t* Ow = oa.Ob + (long)(wid * QBLK + er) * oa.LDO + ec;
#pragma unroll
    for (int k = 0; k < 8; ++k) { const float* sp2 = Ot + (4 * k + er) * 128 + ec; const f32x4_t a = *(const f32x4_t*)sp2, b = *(const f32x4_t*)(sp2 + 4);
      *(u32x4*)(Ow + (long)(4 * k) * oa.LDO) = (u32x4){cvtpk(a[0], a[1]), cvtpk(a[2], a[3]), cvtpk(b[0], b[1]), cvtpk(b[2], b[3])}; }
  } else if constexpr (MODE == 1) {
    float* Sw = oa.stash + (wid * QBLK + er) * 128 + ec;
#pragma unroll
    for (int k = 0; k < 8; ++k) { const float* sp2 = Ot + (4 * k + er) * 128 + ec; const f32x4_t a = *(const f32x4_t*)sp2, b = *(const f32x4_t*)(sp2 + 4);
      *(f32x4_t*)(Sw + 4 * k * 128) = a; *(f32x4_t*)(Sw + 4 * k * 128 + 4) = b; }
  } else {
    const float* Sw = oa.stash + (wid * QBLK + er) * 128 + ec; bf16_t* Ow = oa.Ob + (long)(wid * QBLK + er) * oa.LDO + ec;
    const f32x4_t g0 = *(const f32x4_t*)(oa.g + ec) * oa.post, g1 = *(const f32x4_t*)(oa.g + ec + 4) * oa.post;
#pragma unroll
    for (int k = 0; k < 8; ++k) { asm volatile("" ::: "memory"); const float* sp2 = Ot + (4 * k + er) * 128 + ec; f32x4_t a = *(const f32x4_t*)sp2, b = *(const f32x4_t*)(sp2 + 4);
      a = *(const f32x4_t*)(Sw + 4 * k * 128) - oa.lam * a; b = *(const f32x4_t*)(Sw + 4 * k * 128 + 4) - oa.lam * b;
      float ss = (a[0] * a[0] + a[1] * a[1]) + (a[2] * a[2] + a[3] * a[3]) + (b[0] * b[0] + b[1] * b[1]) + (b[2] * b[2] + b[3] * b[3]);
      ss += __shfl_xor(ss, 1); ss += __shfl_xor(ss, 2); ss += __shfl_xor(ss, 4); ss += __shfl_xor(ss, 8);
      const float rn = 1.0f / sqrtf(ss * (1.0f / 128.0f) + EPS);
      a = a * rn * g0; b = b * rn * g1;
      *(u32x4*)(Ow + (long)(4 * k) * oa.LDO) = (u32x4){cvtpk(a[0], a[1]), cvtpk(a[2], a[3]), cvtpk(b[0], b[1]), cvtpk(b[2], b[3])}; }
  }
  ATT_BAR0();
#undef ATT_GLDS
#undef ATT_DMA
#undef ATT_BAR0
#undef ATT_BARN
#undef ATT_VBLOCK
}

#define ATT4_SWAP(OUTA, OUTB, A, B) do { const auto _r = __builtin_amdgcn_permlane32_swap((A), (B), false, false); OUTA = _r[0]; OUTB = _r[1]; } while (0)
#define ATT4_PKSTEP(st, P, BASE, OUT) do { \
    if ((st) == 0) { ft0 = cvtpk(P[BASE + 0], P[BASE + 1]); ft1 = cvtpk(P[BASE + 2], P[BASE + 3]); } \
    if ((st) == 1) { ft2 = cvtpk(P[BASE + 4], P[BASE + 5]); ft3 = cvtpk(P[BASE + 6], P[BASE + 7]); } \
    if ((st) == 3) { const u32x4 _w = {ft0, ft1, ft2, ft3}; OUT = __builtin_bit_cast(bf16x8, _w); } } while (0)
#define ATT4_FCH(c, O0, O1) do { O1[c] = __builtin_amdgcn_exp2f(O1[c]); \
    if ((c) == 0) { accA_ = O0[0]; accB_ = 0.f; } else { accA_ += O0[c]; accB_ += O1[((c) > 0 ? (c) - 1 : 0)]; } \
    if ((c) < 4) ATT4_PKSTEP((c) & 3, O0, 0, pa0); else if ((c) < 8) ATT4_PKSTEP((c) & 3, O0, 8, pa1); else if ((c) < 12) ATT4_PKSTEP((c) & 3, O1, 0, pa2); } while (0)
#define ATT4_FT(O0, O1, alO) do { ATT4_PKSTEP(0, O1, 8, pa3); ATT4_PKSTEP(1, O1, 8, pa3); ATT4_PKSTEP(2, O1, 8, pa3); ATT4_PKSTEP(3, O1, 8, pa3); \
    float _ps = accA_ + accB_ + O1[15]; unsigned _a, _b; ATT4_SWAP(_a, _b, __float_as_uint(_ps), __float_as_uint(_ps)); _ps = __uint_as_float(_a) + __uint_as_float(_b); l_reg = l_reg * (alO) + _ps; } while (0)
#define ATT4_MAX3(a, b, c) __builtin_fmaxf(__builtin_fmaxf((a), (b)), (c))
#define ATT4_NV(i, N0, N1) ((i) < 16 ? N0[(i) & 15] : N1[(i) & 15])
#define ATT4_SCH(k, N0, N1, O0, O1, mnN, alN, alO) do { \
    if ((k) == 0) ATT4_FT(O0, O1, alO); \
    if ((k) == 1) { x0 = ATT4_MAX3(N0[0], N0[1], N0[2]); x1 = ATT4_MAX3(N0[3], N0[4], N0[5]); x2 = ATT4_MAX3(N0[6], N0[7], N0[8]); x3 = ATT4_MAX3(N0[9], N0[10], N0[11]); } \
    if ((k) == 2) { x4 = ATT4_MAX3(N0[12], N0[13], N0[14]); x5 = ATT4_MAX3(N0[15], N1[0], N1[1]); x6 = ATT4_MAX3(N1[2], N1[3], N1[4]); x7 = ATT4_MAX3(N1[5], N1[6], N1[7]); } \
    if ((k) == 3) { x8 = ATT4_MAX3(N1[8], N1[9], N1[10]); x9 = ATT4_MAX3(N1[11], N1[12], N1[13]); x10 = ATT4_MAX3(N1[13], N1[14], N1[15]);     x0 = ATT4_MAX3(x0, x1, x2); } \
    if ((k) == 4) { x1 = ATT4_MAX3(x3, x4, x5); x2 = ATT4_MAX3(x6, x7, x8); x3 = ATT4_MAX3(x9, x10, x0); x0 = ATT4_MAX3(x1, x2, x3); } \
    if ((k) == 5) { unsigned _a, _b; ATT4_SWAP(_a, _b, __float_as_uint(x0), __float_as_uint(x0)); float _pm; asm("v_max_f32 %0, %1, %2" : "=v"(_pm) : "v"(_a), "v"(_b));     \
        alN = 1.f; if (__builtin_expect(__any(_pm > THRS), 0)) { const float _dl = __builtin_fmaxf(_pm, 0.f); m_reg += _dl; alN = __builtin_amdgcn_exp2f(-_dl); \
            _Pragma("unroll") for (int _i = 0; _i < 16; ++_i) { N0[_i] -= _dl; N1[_i] -= _dl; negm[_i] = -m_reg; } } } \
    if ((k) >= 6 && (k) <= 11) { N0[2 * ((k) - 6)] = __builtin_amdgcn_exp2f(N0[2 * ((k) - 6)]); N0[2 * ((k) - 6) + 1] = __builtin_amdgcn_exp2f(N0[2 * ((k) - 6) + 1]); } \
    if ((k) >= 12 && (k) <= 15) { N0[(k)] = __builtin_amdgcn_exp2f(N0[(k)]); } } while (0)
#define ATT4_MFMA_O(od, A, B) do { od = __builtin_amdgcn_mfma_f32_32x32x16_bf16((A), (B), od, 0, 0, 0); } while (0)
#define ATT4_HALF_64(N0, N1, O0, O1, mnN, alN, alO, kb, vb) do { constexpr int KROW = 144; \
    kq[0][0] = ds_rd128<0>(kb); kq[0][1] = ds_rd128<0 + 32 * KROW>(kb); \
    kq[1][0] = ds_rd128<32>(kb); kq[1][1] = ds_rd128<32 + 32 * KROW>(kb); \
    kq[2][0] = ds_rd128<64>(kb); kq[2][1] = ds_rd128<64 + 32 * KROW>(kb); \
    wait_lgkm<4>(); ATT_SBAR(); \
    N0 = __builtin_amdgcn_mfma_f32_32x32x16_bf16(kq[0][0], qr[0], negm, 0, 0, 0); ATT4_FCH(0, O0, O1); ATT4_FCH(1, O0, O1); ATT_SBAR(); \
    N1 = __builtin_amdgcn_mfma_f32_32x32x16_bf16(kq[0][1], qr[0], negm, 0, 0, 0); ATT4_FCH(2, O0, O1); ATT4_FCH(3, O0, O1); ATT_SBAR(); \
    kq[0][0] = ds_rd128<96>(kb); kq[0][1] = ds_rd128<96 + 32 * KROW>(kb); \
    wait_lgkm<4>(); ATT_SBAR(); \
    N0 = __builtin_amdgcn_mfma_f32_32x32x16_bf16(kq[1][0], qr[1], N0, 0, 0, 0); ATT4_FCH(4, O0, O1); ATT4_FCH(5, O0, O1); ATT_SBAR(); \
    N1 = __builtin_amdgcn_mfma_f32_32x32x16_bf16(kq[1][1], qr[1], N1, 0, 0, 0); ATT4_FCH(6, O0, O1); ATT4_FCH(7, O0, O1); ATT_SBAR(); \
    vq[1][0] = tr_read<v_rd_off(0, 0, 0)>(vb); vq[1][1] = tr_read<v_rd_off(0, 0, 1)>(vb); vq[1][2] = tr_read<v_rd_off(0, 1, 0)>(vb); vq[1][3] = tr_read<v_rd_off(0, 1, 1)>(vb); \
    wait_lgkm<6>(); ATT_SBAR(); \
    N0 = __builtin_amdgcn_mfma_f32_32x32x16_bf16(kq[2][0], qr[2], N0, 0, 0, 0); ATT4_FCH(8, O0, O1); ATT4_FCH(9, O0, O1); ATT_SBAR(); \
    N1 = __builtin_amdgcn_mfma_f32_32x32x16_bf16(kq[2][1], qr[2], N1, 0, 0, 0); ATT4_FCH(10, O0, O1); ATT4_FCH(11, O0, O1); ATT_SBAR(); \
    vq[2][0] = tr_read<v_rd_off(0, 2, 0)>(vb); vq[2][1] = tr_read<v_rd_off(0, 2, 1)>(vb); vq[2][2] = tr_read<v_rd_off(0, 3, 0)>(vb); vq[2][3] = tr_read<v_rd_off(0, 3, 1)>(vb); \
    wait_lgkm<8>(); ATT_SBAR(); \
    N0 = __builtin_amdgcn_mfma_f32_32x32x16_bf16(kq[0][0], qr[3], N0, 0, 0, 0); ATT4_FCH(12, O0, O1); ATT4_FCH(13, O0, O1); ATT_SBAR(); \
    N1 = __builtin_amdgcn_mfma_f32_32x32x16_bf16(kq[0][1], qr[3], N1, 0, 0, 0); ATT4_FCH(14, O0, O1); ATT4_FCH(15, O0, O1); ATT_SBAR(); \
    vq[0][0] = tr_read<v_rd_off(1, 0, 0)>(vb); vq[0][1] = tr_read<v_rd_off(1, 0, 1)>(vb); vq[0][2] = tr_read<v_rd_off(1, 1, 0)>(vb); vq[0][3] = tr_read<v_rd_off(1, 1, 1)>(vb); \
    wait_lgkm<8>(); ATT_SBAR(); \
    ATT4_MFMA_O(o[0], pa0, ATT_PKV(vq[1][0], vq[1][1])); ATT4_SCH(0, N0, N1, O0, O1, mnN, alN, alO); ATT_SBAR(); \
    ATT4_MFMA_O(o[0], pa1, ATT_PKV(vq[1][2], vq[1][3])); ATT4_SCH(1, N0, N1, O0, O1, mnN, alN, alO); ATT_SBAR(); \
    vq[1][0] = tr_read<v_rd_off(1, 2, 0)>(vb); vq[1][1] = tr_read<v_rd_off(1, 2, 1)>(vb); vq[1][2] = tr_read<v_rd_off(1, 3, 0)>(vb); vq[1][3] = tr_read<v_rd_off(1, 3, 1)>(vb); \
    wait_lgkm<8>(); ATT_SBAR(); \
    ATT4_MFMA_O(o[0], pa2, ATT_PKV(vq[2][0], vq[2][1])); ATT4_SCH(2, N0, N1, O0, O1, mnN, alN, alO); ATT_SBAR(); \
    ATT4_MFMA_O(o[0], pa3, ATT_PKV(vq[2][2], vq[2][3])); ATT4_SCH(3, N0, N1, O0, O1, mnN, alN, alO); ATT_SBAR(); \
    vq[2][0] = tr_read<v_rd_off(2, 0, 0)>(vb); vq[2][1] = tr_read<v_rd_off(2, 0, 1)>(vb); vq[2][2] = tr_read<v_rd_off(2, 1, 0)>(vb); vq[2][3] = tr_read<v_rd_off(2, 1, 1)>(vb); \
    wait_lgkm<8>(); ATT_SBAR(); \
    ATT4_MFMA_O(o[1], pa0, ATT_PKV(vq[0][0], vq[0][1])); ATT4_SCH(4, N0, N1, O0, O1, mnN, alN, alO); ATT_SBAR(); \
    ATT4_MFMA_O(o[1], pa1, ATT_PKV(vq[0][2], vq[0][3])); ATT4_SCH(5, N0, N1, O0, O1, mnN, alN, alO); ATT_SBAR(); \
    vq[0][0] = tr_read<v_rd_off(2, 2, 0)>(vb); vq[0][1] = tr_read<v_rd_off(2, 2, 1)>(vb); vq[0][2] = tr_read<v_rd_off(2, 3, 0)>(vb); vq[0][3] = tr_read<v_rd_off(2, 3, 1)>(vb); \
    wait_lgkm<8>(); ATT_SBAR(); \
    ATT4_MFMA_O(o[1], pa2, ATT_PKV(vq[1][0], vq[1][1])); ATT4_SCH(6, N0, N1, O0, O1, mnN, alN, alO); ATT_SBAR(); \
    ATT4_MFMA_O(o[1], pa3, ATT_PKV(vq[1][2], vq[1][3])); ATT4_SCH(7, N0, N1, O0, O1, mnN, alN, alO); ATT_SBAR(); \
    vq[1][0] = tr_read<v_rd_off(3, 0, 0)>(vb); vq[1][1] = tr_read<v_rd_off(3, 0, 1)>(vb); vq[1][2] = tr_read<v_rd_off(3, 1, 0)>(vb); vq[1][3] = tr_read<v_rd_off(3, 1, 1)>(vb); \
    wait_lgkm<8>(); ATT_SBAR(); \
    ATT4_MFMA_O(o[2], pa0, ATT_PKV(vq[2][0], vq[2][1])); ATT4_SCH(8, N0, N1, O0, O1, mnN, alN, alO); ATT_SBAR(); \
    ATT4_MFMA_O(o[2], pa1, ATT_PKV(vq[2][2], vq[2][3])); ATT4_SCH(9, N0, N1, O0, O1, mnN, alN, alO); ATT_SBAR(); \
    vq[2][0] = tr_read<v_rd_off(3, 2, 0)>(vb); vq[2][1] = tr_read<v_rd_off(3, 2, 1)>(vb); vq[2][2] = tr_read<v_rd_off(3, 3, 0)>(vb); vq[2][3] = tr_read<v_rd_off(3, 3, 1)>(vb); \
    wait_lgkm<8>(); ATT_SBAR(); \
    ATT4_MFMA_O(o[2], pa2, ATT_PKV(vq[0][0], vq[0][1])); ATT4_SCH(10, N0, N1, O0, O1, mnN, alN, alO); ATT_SBAR(); \
    ATT4_MFMA_O(o[2], pa3, ATT_PKV(vq[0][2], vq[0][3])); ATT4_SCH(11, N0, N1, O0, O1, mnN, alN, alO); ATT_SBAR(); \
    wait_lgkm<4>(); ATT_SBAR(); \
    ATT4_MFMA_O(o[3], pa0, ATT_PKV(vq[1][0], vq[1][1])); ATT4_SCH(12, N0, N1, O0, O1, mnN, alN, alO); ATT_SBAR(); \
    ATT4_MFMA_O(o[3], pa1, ATT_PKV(vq[1][2], vq[1][3])); ATT4_SCH(13, N0, N1, O0, O1, mnN, alN, alO); ATT_SBAR(); \
    wait_lgkm<0>(); ATT_SBAR(); \
    ATT4_MFMA_O(o[3], pa2, ATT_PKV(vq[2][0], vq[2][1])); ATT4_SCH(14, N0, N1, O0, O1, mnN, alN, alO); ATT_SBAR(); \
    ATT4_MFMA_O(o[3], pa3, ATT_PKV(vq[2][2], vq[2][3])); ATT4_SCH(15, N0, N1, O0, O1, mnN, alN, alO); ATT_SBAR(); } while (0)
#define ATT4_HALF_128(N0, N1, O0, O1, mnN, alN, alO, kb, vb) do { constexpr int KROW = 272; \
    kq[0][0] = ds_rd128<0>(kb); kq[0][1] = ds_rd128<0 + 32 * KROW>(kb); \
    kq[1][0] = ds_rd128<32>(kb); kq[1][1] = ds_rd128<32 + 32 * KROW>(kb); \
    kq[2][0] = ds_rd128<64>(kb); kq[2][1] = ds_rd128<64 + 32 * KROW>(kb); \
    wait_lgkm<4>(); ATT_SBAR(); \
    N0 = __builtin_amdgcn_mfma_f32_32x32x16_bf16(kq[0][0], qr[0], negm, 0, 0, 0); ATT4_FCH(0, O0, O1); ATT_SBAR(); \
    N1 = __builtin_amdgcn_mfma_f32_32x32x16_bf16(kq[0][1], qr[0], negm, 0, 0, 0); ATT4_FCH(1, O0, O1); ATT_SBAR(); \
    kq[0][0] = ds_rd128<96>(kb); kq[0][1] = ds_rd128<96 + 32 * KROW>(kb); \
    wait_lgkm<4>(); ATT_SBAR(); \
    N0 = __builtin_amdgcn_mfma_f32_32x32x16_bf16(kq[1][0], qr[1], N0, 0, 0, 0); ATT4_FCH(2, O0, O1); ATT_SBAR(); \
    N1 = __builtin_amdgcn_mfma_f32_32x32x16_bf16(kq[1][1], qr[1], N1, 0, 0, 0); ATT4_FCH(3, O0, O1); ATT_SBAR(); \
    kq[1][0] = ds_rd128<128>(kb); kq[1][1] = ds_rd128<128 + 32 * KROW>(kb); \
    wait_lgkm<4>(); ATT_SBAR(); \
    N0 = __builtin_amdgcn_mfma_f32_32x32x16_bf16(kq[2][0], qr[2], N0, 0, 0, 0); ATT4_FCH(4, O0, O1); ATT_SBAR(); \
    N1 = __builtin_amdgcn_mfma_f32_32x32x16_bf16(kq[2][1], qr[2], N1, 0, 0, 0); ATT4_FCH(5, O0, O1); ATT_SBAR(); \
    kq[2][0] = ds_rd128<160>(kb); kq[2][1] = ds_rd128<160 + 32 * KROW>(kb); \
    wait_lgkm<4>(); ATT_SBAR(); \
    N0 = __builtin_amdgcn_mfma_f32_32x32x16_bf16(kq[0][0], qr[3], N0, 0, 0, 0); ATT4_FCH(6, O0, O1); ATT_SBAR(); \
    N1 = __builtin_amdgcn_mfma_f32_32x32x16_bf16(kq[0][1], qr[3], N1, 0, 0, 0); ATT4_FCH(7, O0, O1); ATT_SBAR(); \
    kq[0][0] = ds_rd128<192>(kb); kq[0][1] = ds_rd128<192 + 32 * KROW>(kb); \
    wait_lgkm<4>(); ATT_SBAR(); \
    N0 = __builtin_amdgcn_mfma_f32_32x32x16_bf16(kq[1][0], qr[4], N0, 0, 0, 0); ATT4_FCH(8, O0, O1); ATT_SBAR(); \
    N1 = __builtin_amdgcn_mfma_f32_32x32x16_bf16(kq[1][1], qr[4], N1, 0, 0, 0); ATT4_FCH(9, O0, O1); ATT_SBAR(); \
    kq[1][0] = ds_rd128<224>(kb); kq[1][1] = ds_rd128<224 + 32 * KROW>(kb); \
    wait_lgkm<4>(); ATT_SBAR(); \
    N0 = __builtin_amdgcn_mfma_f32_32x32x16_bf16(kq[2][0], qr[5], N0, 0, 0, 0); ATT4_FCH(10, O0, O1); ATT_SBAR(); \
    N1 = __builtin_amdgcn_mfma_f32_32x32x16_bf16(kq[2][1], qr[5], N1, 0, 0, 0); ATT4_FCH(11, O0, O1); ATT_SBAR(); \
    vq[2][0] = tr_read<v_rd_off(0, 0, 0)>(vb); vq[2][1] = tr_read<v_rd_off(0, 0, 1)>(vb); vq[2][2] = tr_read<v_rd_off(0, 1, 0)>(vb); vq[2][3] = tr_read<v_rd_off(0, 1, 1)>(vb); \
    wait_lgkm<6>(); ATT_SBAR(); \
    N0 = __builtin_amdgcn_mfma_f32_32x32x16_bf16(kq[0][0], qr[6], N0, 0, 0, 0); ATT4_FCH(12, O0, O1); ATT_SBAR(); \
    N1 = __builtin_amdgcn_mfma_f32_32x32x16_bf16(kq[0][1], qr[6], N1, 0, 0, 0); ATT4_FCH(13, O0, O1); ATT_SBAR(); \
    vq[0][0] = tr_read<v_rd_off(0, 2, 0)>(vb); vq[0][1] = tr_read<v_rd_off(0, 2, 1)>(vb); vq[0][2] = tr_read<v_rd_off(0, 3, 0)>(vb); vq[0][3] = tr_read<v_rd_off(0, 3, 1)>(vb); \
    wait_lgkm<8>(); ATT_SBAR(); \
    N0 = __builtin_amdgcn_mfma_f32_32x32x16_bf16(kq[1][0], qr[7], N0, 0, 0, 0); ATT4_FCH(14, O0, O1); ATT_SBAR(); \
    N1 = __builtin_amdgcn_mfma_f32_32x32x16_bf16(kq[1][1], qr[7], N1, 0, 0, 0); ATT4_FCH(15, O0, O1); ATT_SBAR(); \
    vq[1][0] = tr_read<v_rd_off(1, 0, 0)>(vb); vq[1][1] = tr_read<v_rd_off(1, 0, 1)>(vb); vq[1][2] = tr_read<v_rd_off(1, 1, 0)>(vb); vq[1][3] = tr_read<v_rd_off(1, 1, 1)>(vb); \
    wait_lgkm<8>(); ATT_SBAR(); \
    ATT4_MFMA_O(o[0], pa0, ATT_PKV(vq[2][0], vq[2][1])); ATT4_SCH(0, N0, N1, O0, O1, mnN, alN, alO); ATT_SBAR(); \
    ATT4_MFMA_O(o[0], pa1, ATT_PKV(vq[2][2], vq[2][3])); ATT4_SCH(1, N0, N1, O0, O1, mnN, alN, alO); ATT_SBAR(); \
    vq[2][0] = tr_read<v_rd_off(1, 2, 0)>(vb); vq[2][1] = tr_read<v_rd_off(1, 2, 1)>(vb); vq[2][2] = tr_read<v_rd_off(1, 3, 0)>(vb); vq[2][3] = tr_read<v_rd_off(1, 3, 1)>(vb); \
    wait_lgkm<8>(); ATT_SBAR(); \
    ATT4_MFMA_O(o[0], pa2, ATT_PKV(vq[0][0], vq[0][1])); ATT4_SCH(2, N0, N1, O0, O1, mnN, alN, alO); ATT_SBAR(); \
    ATT4_MFMA_O(o[0], pa3, ATT_PKV(vq[0][2], vq[0][3])); ATT4_SCH(3, N0, N1, O0, O1, mnN, alN, alO); ATT_SBAR(); \
    vq[0][0] = tr_read<v_rd_off(2, 0, 0)>(vb); vq[0][1] = tr_read<v_rd_off(2, 0, 1)>(vb); vq[0][2] = tr_read<v_rd_off(2, 1, 0)>(vb); vq[0][3] = tr_read<v_rd_off(2, 1, 1)>(vb); \
    wait_lgkm<8>(); ATT_SBAR(); \
    ATT4_MFMA_O(o[1], pa0, ATT_PKV(vq[1][0], vq[1][1])); ATT4_SCH(4, N0, N1, O0, O1, mnN, alN, alO); ATT_SBAR(); \
    ATT4_MFMA_O(o[1], pa1, ATT_PKV(vq[1][2], vq[1][3])); ATT4_SCH(5, N0, N1, O0, O1, mnN, alN, alO); ATT_SBAR(); \
    vq[1][0] = tr_read<v_rd_off(2, 2, 0)>(vb); vq[1][1] = tr_read<v_rd_off(2, 2, 1)>(vb); vq[1][2] = tr_read<v_rd_off(2, 3, 0)>(vb); vq[1][3] = tr_read<v_rd_off(2, 3, 1)>(vb); \
    wait_lgkm<8>(); ATT_SBAR(); \
    ATT4_MFMA_O(o[1], pa2, ATT_PKV(vq[2][0], vq[2][1])); ATT4_SCH(6, N0, N1, O0, O1, mnN, alN, alO); ATT_SBAR(); \
    ATT4_MFMA_O(o[1], pa3, ATT_PKV(vq[2][2], vq[2][3])); ATT4_SCH(7, N0, N1, O0, O1, mnN, alN, alO); ATT_SBAR(); \
    vq[2][0] = tr_read<v_rd_off(3, 0, 0)>(vb); vq[2][1] = tr_read<v_rd_off(3, 0, 1)>(vb); vq[2][2] = tr_read<v_rd_off(3, 1, 0)>(vb); vq[2][3] = tr_read<v_rd_off(3, 1, 1)>(vb); \
    wait_lgkm<8>(); ATT_SBAR(); \
    ATT4_MFMA_O(o[2], pa0, ATT_PKV(vq[0][0], vq[0][1])); ATT4_SCH(8, N0, N1, O0, O1, mnN, alN, alO); ATT_SBAR(); \
    ATT4_MFMA_O(o[2], pa1, ATT_PKV(vq[0][2], vq[0][3])); ATT4_SCH(9, N0, N1, O0, O1, mnN, alN, alO); ATT_SBAR(); \
    vq[0][0] = tr_read<v_rd_off(3, 2, 0)>(vb); vq[0][1] = tr_read<v_rd_off(3, 2, 1)>(vb); vq[0][2] = tr_read<v_rd_off(3, 3, 0)>(vb); vq[0][3] = tr_read<v_rd_off(3, 3, 1)>(vb); \
    wait_lgkm<8>(); ATT_SBAR(); \
    ATT4_MFMA_O(o[2], pa2, ATT_PKV(vq[1][0], vq[1][1])); ATT4_SCH(10, N0, N1, O0, O1, mnN, alN, alO); ATT_SBAR(); \
    ATT4_MFMA_O(o[2], pa3, ATT_PKV(vq[1][2], vq[1][3])); ATT4_SCH(11, N0, N1, O0, O1, mnN, alN, alO); ATT_SBAR(); \
    wait_lgkm<4>(); ATT_SBAR(); \
    ATT4_MFMA_O(o[3], pa0, ATT_PKV(vq[2][0], vq[2][1])); ATT4_SCH(12, N0, N1, O0, O1, mnN, alN, alO); ATT_SBAR(); \
    ATT4_MFMA_O(o[3], pa1, ATT_PKV(vq[2][2], vq[2][3])); ATT4_SCH(13, N0, N1, O0, O1, mnN, alN, alO); ATT_SBAR(); \
    wait_lgkm<0>(); ATT_SBAR(); \
    ATT4_MFMA_O(o[3], pa2, ATT_PKV(vq[0][0], vq[0][1])); ATT4_SCH(14, N0, N1, O0, O1, mnN, alN, alO); ATT_SBAR(); \
    ATT4_MFMA_O(o[3], pa3, ATT_PKV(vq[0][2], vq[0][3])); ATT4_SCH(15, N0, N1, O0, O1, mnN, alN, alO); ATT_SBAR(); } while (0)
#define ATT4_HALF_192(N0, N1, O0, O1, mnN, alN, alO, kb, vb) do { constexpr int KROW = 400; \
    kq[0][0] = ds_rd128<0>(kb); kq[0][1] = ds_rd128<0 + 32 * KROW>(kb); \
    kq[1][0] = ds_rd128<32>(kb); kq[1][1] = ds_rd128<32 + 32 * KROW>(kb); \
    wait_lgkm<2>(); ATT_SBAR(); \
    N0 = __builtin_amdgcn_mfma_f32_32x32x16_bf16(kq[0][0], qr[0], negm, 0, 0, 0); ATT4_FCH(0, O0, O1); ATT_SBAR(); \
    N1 = __builtin_amdgcn_mfma_f32_32x32x16_bf16(kq[0][1], qr[0], negm, 0, 0, 0); ATT4_FCH(1, O0, O1); ATT_SBAR(); \
    kq[0][0] = ds_rd128<64>(kb); kq[0][1] = ds_rd128<64 + 32 * KROW>(kb); \
    wait_lgkm<2>(); ATT_SBAR(); \
    N0 = __builtin_amdgcn_mfma_f32_32x32x16_bf16(kq[1][0], qr[1], N0, 0, 0, 0); ATT4_FCH(2, O0, O1); ATT_SBAR(); \
    N1 = __builtin_amdgcn_mfma_f32_32x32x16_bf16(kq[1][1], qr[1], N1, 0, 0, 0); ATT4_FCH(3, O0, O1); ATT_SBAR(); \
    kq[1][0] = ds_rd128<96>(kb); kq[1][1] = ds_rd128<96 + 32 * KROW>(kb); \
    wait_lgkm<2>(); ATT_SBAR(); \
    N0 = __builtin_amdgcn_mfma_f32_32x32x16_bf16(kq[0][0], qr[2], N0, 0, 0, 0); ATT4_FCH(4, O0, O1); ATT_SBAR(); \
    N1 = __builtin_amdgcn_mfma_f32_32x32x16_bf16(kq[0][1], qr[2], N1, 0, 0, 0); ATT4_FCH(5, O0, O1); ATT_SBAR(); \
    kq[0][0] = ds_rd128<128>(kb); kq[0][1] = ds_rd128<128 + 32 * KROW>(kb); \
    wait_lgkm<2>(); ATT_SBAR(); \
    N0 = __builtin_amdgcn_mfma_f32_32x32x16_bf16(kq[1][0], qr[3], N0, 0, 0, 0); ATT4_FCH(6, O0, O1); ATT_SBAR(); \
    N1 = __builtin_amdgcn_mfma_f32_32x32x16_bf16(kq[1][1], qr[3], N1, 0, 0, 0); ATT4_FCH(7, O0, O1); ATT_SBAR(); \
    kq[1][0] = ds_rd128<160>(kb); kq[1][1] = ds_rd128<160 + 32 * KROW>(kb); \
    wait_lgkm<2>(); ATT_SBAR(); \
    N0 = __builtin_amdgcn_mfma_f32_32x32x16_bf16(kq[0][0], qr[4], N0, 0, 0, 0); ATT4_FCH(8, O0, O1); ATT_SBAR(); \
    N1 = __builtin_amdgcn_mfma_f32_32x32x16_bf16(kq[0][1], qr[4], N1, 0, 0, 0); ATT4_FCH(9, O0, O1); ATT_SBAR(); \
    kq[0][0] = ds_rd128<192>(kb); kq[0][1] = ds_rd128<192 + 32 * KROW>(kb); \
    wait_lgkm<2>(); ATT_SBAR(); \
    N0 = __builtin_amdgcn_mfma_f32_32x32x16_bf16(kq[1][0], qr[5], N0, 0, 0, 0); ATT4_FCH(10, O0, O1); ATT_SBAR(); \
    N1 = __builtin_amdgcn_mfma_f32_32x32x16_bf16(kq[1][1], qr[5], N1, 0, 0, 0); ATT4_FCH(11, O0, O1); ATT_SBAR(); \
    kq[1][0] = ds_rd128<224>(kb); kq[1][1] = ds_rd128<224 + 32 * KROW>(kb); \
    wait_lgkm<2>(); ATT_SBAR(); \
    N0 = __builtin_amdgcn_mfma_f32_32x32x16_bf16(kq[0][0], qr[6], N0, 0, 0, 0); ATT4_FCH(12, O0, O1); ATT_SBAR(); \
    N1 = __builtin_amdgcn_mfma_f32_32x32x16_bf16(kq[0][1], qr[6], N1, 0, 0, 0); ATT4_FCH(13, O0, O1); ATT_SBAR(); \
    kq[0][0] = ds_rd128<256>(kb); kq[0][1] = ds_rd128<256 + 32 * KROW>(kb); \
    wait_lgkm<2>(); ATT_SBAR(); \
    N0 = __builtin_amdgcn_mfma_f32_32x32x16_bf16(kq[1][0], qr[7], N0, 0, 0, 0); ATT4_FCH(14, O0, O1); ATT_SBAR(); \
    N1 = __builtin_amdgcn_mfma_f32_32x32x16_bf16(kq[1][1], qr[7], N1, 0, 0, 0); ATT4_FCH(15, O0, O1); ATT_SBAR(); \
    kq[1][0] = ds_rd128<288>(kb); kq[1][1] = ds_rd128<288 + 32 * KROW>(kb); \
    wait_lgkm<2>(); ATT_SBAR(); \
    N0 = __builtin_amdgcn_mfma_f32_32x32x16_bf16(kq[0][0], qr[8], N0, 0, 0, 0);  ATT_SBAR(); \
    N1 = __builtin_amdgcn_mfma_f32_32x32x16_bf16(kq[0][1], qr[8], N1, 0, 0, 0);  ATT_SBAR(); \
    kq[0][0] = ds_rd128<320>(kb); kq[0][1] = ds_rd128<320 + 32 * KROW>(kb); \
    wait_lgkm<2>(); ATT_SBAR(); \
    N0 = __builtin_amdgcn_mfma_f32_32x32x16_bf16(kq[1][0], qr[9], N0, 0, 0, 0);  ATT_SBAR(); \
    N1 = __builtin_amdgcn_mfma_f32_32x32x16_bf16(kq[1][1], qr[9], N1, 0, 0, 0);  ATT_SBAR(); \
    kq[1][0] = ds_rd128<352>(kb); kq[1][1] = ds_rd128<352 + 32 * KROW>(kb); \
    wait_lgkm<2>(); ATT_SBAR(); \
    N0 = __builtin_amdgcn_mfma_f32_32x32x16_bf16(kq[0][0], qr[10], N0, 0, 0, 0);  ATT_SBAR(); \
    N1 = __builtin_amdgcn_mfma_f32_32x32x16_bf16(kq[0][1], qr[10], N1, 0, 0, 0);  ATT_SBAR(); \
    vq[0][0] = tr_read<v_rd_off(0, 0, 0)>(vb); vq[0][1] = tr_read<v_rd_off(0, 0, 1)>(vb); vq[0][2] = tr_read<v_rd_off(0, 1, 0)>(vb); vq[0][3] = tr_read<v_rd_off(0, 1, 1)>(vb); \
    wait_lgkm<4>(); ATT_SBAR(); \
    N0 = __builtin_amdgcn_mfma_f32_32x32x16_bf16(kq[1][0], qr[11], N0, 0, 0, 0);  ATT_SBAR(); \
    N1 = __builtin_amdgcn_mfma_f32_32x32x16_bf16(kq[1][1], qr[11], N1, 0, 0, 0);  ATT_SBAR(); \
    vq[1][0] = tr_read<v_rd_off(0, 2, 0)>(vb); vq[1][1] = tr_read<v_rd_off(0, 2, 1)>(vb); vq[1][2] = tr_read<v_rd_off(0, 3, 0)>(vb); vq[1][3] = tr_read<v_rd_off(0, 3, 1)>(vb); \
    wait_lgkm<4>(); ATT_SBAR(); \
    ATT4_MFMA_O(o[0], pa0, ATT_PKV(vq[0][0], vq[0][1])); ATT4_SCH(0, N0, N1, O0, O1, mnN, alN, alO); ATT_SBAR(); \
    ATT4_MFMA_O(o[0], pa1, ATT_PKV(vq[0][2], vq[0][3])); ATT4_SCH(1, N0, N1, O0, O1, mnN, alN, alO); ATT_SBAR(); \
    vq[0][0] = tr_read<v_rd_off(1, 0, 0)>(vb); vq[0][1] = tr_read<v_rd_off(1, 0, 1)>(vb); vq[0][2] = tr_read<v_rd_off(1, 1, 0)>(vb); vq[0][3] = tr_read<v_rd_off(1, 1, 1)>(vb); \
    wait_lgkm<4>(); ATT_SBAR(); \
    ATT4_MFMA_O(o[0], pa2, ATT_PKV(vq[1][0], vq[1][1])); ATT4_SCH(2, N0, N1, O0, O1, mnN, alN, alO); ATT_SBAR(); \
    ATT4_MFMA_O(o[0], pa3, ATT_PKV(vq[1][2], vq[1][3])); ATT4_SCH(3, N0, N1, O0, O1, mnN, alN, alO); ATT_SBAR(); \
    vq[1][0] = tr_read<v_rd_off(1, 2, 0)>(vb); vq[1][1] = tr_read<v_rd_off(1, 2, 1)>(vb); vq[1][2] = tr_read<v_rd_off(1, 3, 0)>(vb); vq[1][3] = tr_read<v_rd_off(1, 3, 1)>(vb); \
    wait_lgkm<4>(); ATT_SBAR(); \
    ATT4_MFMA_O(o[1], pa0, ATT_PKV(vq[0][0], vq[0][1])); ATT4_SCH(4, N0, N1, O0, O1, mnN, alN, alO); ATT_SBAR(); \
    ATT4_MFMA_O(o[1], pa1, ATT_PKV(vq[0][2], vq[0][3])); ATT4_SCH(5, N0, N1, O0, O1, mnN, alN, alO); ATT_SBAR(); \
    vq[0][0] = tr_read<v_rd_off(2, 0, 0)>(vb); vq[0][1] = tr_read<v_rd_off(2, 0, 1)>(vb); vq[0][2] = tr_read<v_rd_off(2, 1, 0)>(vb); vq[0][3] = tr_read<v_rd_off(2, 1, 1)>(vb); \
    wait_lgkm<4>(); ATT_SBAR(); \
    ATT4_MFMA_O(o[1], pa2, ATT_PKV(vq[1][0], vq[1][1])); ATT4_SCH(6, N0, N1, O0, O1, mnN, alN, alO); ATT_SBAR(); \
    ATT4_MFMA_O(o[1], pa3, ATT_PKV(vq[1][2], vq[1][3])); ATT4_SCH(7, N0, N1, O0, O1, mnN, alN, alO); ATT_SBAR(); \
    vq[1][0] = tr_read<v_rd_off(2, 2, 0)>(vb); vq[1][1] = tr_read<v_rd_off(2, 2, 1)>(vb); vq[1][2] = tr_read<v_rd_off(2, 3, 0)>(vb); vq[1][3] = tr_read<v_rd_off(2, 3, 1)>(vb); \
    wait_lgkm<4>(); ATT_SBAR(); \
    ATT4_MFMA_O(o[2], pa0, ATT_PKV(vq[0][0], vq[0][1])); ATT4_SCH(8, N0, N1, O0, O1, mnN, alN, alO); ATT_SBAR(); \
    ATT4_MFMA_O(o[2], pa1, ATT_PKV(vq[0][2], vq[0][3])); ATT4_SCH(9, N0, N1, O0, O1, mnN, alN, alO); ATT_SBAR(); \
    vq[0][0] = tr_read<v_rd_off(3, 0, 0)>(vb); vq[0][1] = tr_read<v_rd_off(3, 0, 1)>(vb); vq[0][2] = tr_read<v_rd_off(3, 1, 0)>(vb); vq[0][3] = tr_read<v_rd_off(3, 1, 1)>(vb); \
    wait_lgkm<4>(); ATT_SBAR(); \
    ATT4_MFMA_O(o[2], pa2, ATT_PKV(vq[1][0], vq[1][1])); ATT4_SCH(10, N0, N1, O0, O1, mnN, alN, alO); ATT_SBAR(); \
    ATT4_MFMA_O(o[2], pa3, ATT_PKV(vq[1][2], vq[1][3])); ATT4_SCH(11, N0, N1, O0, O1, mnN, alN, alO); ATT_SBAR(); \
    vq[1][0] = tr_read<v_rd_off(3, 2, 0)>(vb); vq[1][1] = tr_read<v_rd_off(3, 2, 1)>(vb); vq[1][2] = tr_read<v_rd_off(3, 3, 0)>(vb); vq[1][3] = tr_read<v_rd_off(3, 3, 1)>(vb); \
    wait_lgkm<4>(); ATT_SBAR(); \
    ATT4_MFMA_O(o[3], pa0, ATT_PKV(vq[0][0], vq[0][1])); ATT4_SCH(12, N0, N1, O0, O1, mnN, alN, alO); ATT_SBAR(); \
    ATT4_MFMA_O(o[3], pa1, ATT_PKV(vq[0][2], vq[0][3])); ATT4_SCH(13, N0, N1, O0, O1, mnN, alN, alO); ATT_SBAR(); \
    wait_lgkm<0>(); ATT_SBAR(); \
    ATT4_MFMA_O(o[3], pa2, ATT_PKV(vq[1][0], vq[1][1])); ATT4_SCH(14, N0, N1, O0, O1, mnN, alN, alO); ATT_SBAR(); \
    ATT4_MFMA_O(o[3], pa3, ATT_PKV(vq[1][2], vq[1][3])); ATT4_SCH(15, N0, N1, O0, O1, mnN, alN, alO); ATT_SBAR(); } while (0)
template <int DQK, int LDQ, int LDK, int LDV, int MODE>
__device__ __forceinline__ void attn_body4(const bf16_t* __restrict__ Qb, const bf16_t* __restrict__ Kh, const bf16_t* __restrict__ Vh,
                                           int seq, float scale, const OutArgs& oa, char* lds, __attribute__((address_space(3))) unsigned char* ldsl) {
  using CF = Cfg<DQK>;
  constexpr int ND0 = CF::ND0, SHM_K = CF::SHM_K, KROW = CF::KROW, SLOT = SHM_K + SHM_V, KCH = SHM_K / 1024, NKI = (KCH + 7) / 8;
  static_assert(SHM_K % 1024 == 0 && 3 * SLOT + NW * 256 <= 131072, "attention LDS ring");
  const float QS = scale * 1.4426950408889634f;
  constexpr float C = 1.0f, THRS = THR * 1.4426950408889634f; const float thr_raw = THRS;
  int tid_ = threadIdx.x; asm volatile("" : "+v"(tid_));
  const int tid = tid_, wid = __builtin_amdgcn_readfirstlane(tid >> 6), lane = tid & 63, r32 = lane & 31, hi = lane >> 5;
  float* ws = (float*)(lds + 3 * SLOT) + wid * 64; float* li_l = ws; float* al_l = ws + 32;
  float m_reg = -1e30f, l_reg = 0; f32x16 o[4] = {}; bf16x8 qr[ND0];
  int ksrc[NKI], vsrc[2];
#pragma unroll
  for (int i = 0; i < NKI; ++i) { const int ob = (wid + 8 * i) * 1024 + lane * 16, row = ob / KROW, within = ob - row * KROW; ksrc[i] = (row < KVBLK ? row : 0) * LDK + (within < 2 * DQK ? within / 2 : 0); }
#pragma unroll
  for (int i = 0; i < 2; ++i) { const int gi = (2 * wid + i) * 64 + lane, c8 = (gi & 3) | (((gi >> 5) & 3) << 2), kk = ((gi >> 2) & 7) | ((gi >> 7) << 3), k = kk; vsrc[i] = k * LDV + c8 * 8; }
#define ATT_GLDS(g, l) __builtin_amdgcn_global_load_lds((const unsigned*)(g), (__attribute__((address_space(3))) unsigned*)(l), 16, 0, 0)
#define ATT_DMA(k0, s) do { __attribute__((address_space(3))) unsigned char* _kb = ldsl + (s) * SLOT; \
    _Pragma("unroll") for (int _i = 0; _i < NKI; ++_i) { if (wid + 8 * _i < KCH) ATT_GLDS(Kh + (long)(k0) * LDK + ksrc[_i], _kb + (wid + 8 * _i) * 1024); } \
    _Pragma("unroll") for (int _i = 0; _i < 2; ++_i) ATT_GLDS(Vh + (long)(k0) * LDV + vsrc[_i], _kb + SHM_K + (2 * wid + _i) * 1024); } while (0)
#define ATT_BAR() do { asm volatile("s_waitcnt vmcnt(0) lgkmcnt(0)" ::: "memory"); __builtin_amdgcn_s_barrier(); asm volatile("" ::: "memory"); } while (0)
#define ATT_RESC2(a) do { if (__any((a) < 1.f)) { if (hi == 0) al_l[r32] = (a); asm volatile("s_waitcnt lgkmcnt(0)" ::: "memory"); \
    _Pragma("unroll") for (int d = 0; d < 4; ++d) _Pragma("unroll") for (int r = 0; r < 16; ++r) o[d][r] *= al_l[crow(r, hi)]; } } while (0)
  const int NT = seq / KVBLK;
  ATT_DMA(0, 0); ATT_DMA(KVBLK, 1);
  const bf16_t* Qw = Qb + (long)(wid * QBLK + r32) * LDQ + hi * 8;
#pragma unroll
  for (int d0 = 0; d0 < ND0; ++d0) { const u32x4 qw = *reinterpret_cast<const u32x4*>(Qw + d0 * 16); u32x4 qo;
#pragma unroll
    for (int e = 0; e < 4; ++e) qo[e] = cvtpk(__uint_as_float(qw[e] << 16) * QS, __uint_as_float(qw[e] & 0xffff0000u) * QS);
    qr[d0] = __builtin_bit_cast(bf16x8, qo); }
  ATT_BAR();
  const int vb0 = (int)(uintptr_t)lds + SHM_K + v_rd_base(lane);
  f32x16 pA0, pA1, pB0, pB1; float mnA, mnB, alA, alB; bf16x8 pa0, pa1, pa2, pa3;
  qkt<DQK>(pA0, pA1, lds, qr, r32, hi); partialSM(pA0, pA1, m_reg, mnA, alA, C, thr_raw);
  if (2 < NT) ATT_DMA(2 * KVBLK, 2);
  const int kb0 = (int)(uintptr_t)lds + r32 * KROW + hi * 16;
  bf16x8 kq[3][2]; s16x4 vq[3][4]; unsigned ft0, ft1, ft2, ft3, fr0, fr1; float accA_, accB_, mnC_, x0, x1, x2, x3, x4, x5, x6, x7, x8, x9, x10;
#define ATT4_HALF(N0, N1, O0, O1, mnN, alN, alO, kb, vb) do { if constexpr (DQK == 64) ATT4_HALF_64(N0, N1, O0, O1, mnN, alN, alO, kb, vb); \
    else if constexpr (DQK == 128) ATT4_HALF_128(N0, N1, O0, O1, mnN, alN, alO, kb, vb); else ATT4_HALF_192(N0, N1, O0, O1, mnN, alN, alO, kb, vb); } while (0)
#if defined(ATT_TPROBE)
  unsigned long long tp_acc = 0, tp_t0 = 0;
#define ATT_TP0() do { tp_t0 = __builtin_amdgcn_s_memrealtime(); asm volatile("s_waitcnt lgkmcnt(0)" ::: "memory"); } while (0)
#define ATT_TP1() do { const unsigned long long _t1 = __builtin_amdgcn_s_memrealtime(); asm volatile("s_waitcnt lgkmcnt(0)" ::: "memory"); tp_acc += _t1 - tp_t0; } while (0)
  if (ATT_TPROBE == 2) ATT_TP0();
#else
#define ATT_TP0() do {} while (0)
#define ATT_TP1() do {} while (0)
#endif
#if defined(ATT_PRIO)
  if (wid >= 4) __builtin_amdgcn_s_setprio(1);
#endif
  f32x16 negm;
#pragma unroll
  for (int i = 0; i < 16; ++i) negm[i] = -m_reg;
  int sj = 1, sp = 0;
  for (int j = 1; j + 1 < NT; j += 2) {
    ATT_SBAR(); ATT4_HALF(pB0, pB1, pA0, pA1, mnB, alB, alA, kb0 + sj * SLOT, vb0 + sp * SLOT);
#if defined(ATT_TPROBE)
    if (ATT_TPROBE == 1) ATT_TP0();
#endif
    ATT_BAR();
#if defined(ATT_TPROBE)
    if (ATT_TPROBE == 1) ATT_TP1();
#endif
    if (j + 2 < NT) ATT_DMA((j + 2) * KVBLK, sp);
    ATT_RESC2(alB);
    { sp = sj; sj = (sj == 2) ? 0 : sj + 1; }
    ATT_SBAR(); ATT4_HALF(pA0, pA1, pB0, pB1, mnA, alA, alB, kb0 + sj * SLOT, vb0 + sp * SLOT);
#if defined(ATT_TPROBE)
    if (ATT_TPROBE == 1) ATT_TP0();
#endif
    ATT_BAR();
#if defined(ATT_TPROBE)
    if (ATT_TPROBE == 1) ATT_TP1();
#endif
    if (j + 3 < NT) ATT_DMA((j + 3) * KVBLK, sp);
    ATT_RESC2(alA);
    { sp = sj; sj = (sj == 2) ? 0 : sj + 1; }
  }
#if defined(ATT_TPROBE)
  if (ATT_TPROBE == 2) ATT_TP1();
  if (blockIdx.x == 0 && tid == 0) atomicAdd(oa.tp, tp_acc);
#endif
#if defined(ATT_PRIO)
  __builtin_amdgcn_s_setprio(0);
#endif
  ATT_SBAR(); qkt<DQK>(pB0, pB1, lds + sj * SLOT, qr, r32, hi);
  finishSM_ns(pA0, pA1, alA, l_reg, pa0, pa1, pa2, pa3); ATT_SBAR();
  pv_d0(o, vb0 + sp * SLOT, pa0, pa1, pa2, pa3); partialSM(pB0, pB1, m_reg, mnB, alB, C, thr_raw);
  ATT_RESC2(alB);
  finishSM_ns(pB0, pB1, alB, l_reg, pa0, pa1, pa2, pa3); ATT_SBAR();
  pv_d0(o, vb0 + sj * SLOT, pa0, pa1, pa2, pa3);
  if (hi == 0) li_l[r32] = l_reg; asm volatile("s_waitcnt lgkmcnt(0)" ::: "memory");
  float rli[16];
#pragma unroll
  for (int r = 0; r < 16; ++r) rli[r] = __builtin_amdgcn_rcpf(li_l[crow(r, hi)]);
  ATT_BAR();
  float* Ot = (float*)(lds + wid * 16384);
#pragma unroll
  for (int r = 0; r < 16; ++r) { const int orow = crow(r, hi);
#pragma unroll
    for (int d0 = 0; d0 < 4; ++d0) Ot[orow * 128 + d0 * 32 + r32] = o[d0][r] * rli[r]; }
  asm volatile("s_waitcnt lgkmcnt(0)" ::: "memory");
  const int er = lane >> 4, ec = (lane & 15) * 8;
  if constexpr (MODE == 0) {
    bf16_t* Ow = oa.Ob + (long)(wid * QBLK + er) * oa.LDO + ec;
#pragma unroll
    for (int k = 0; k < 8; ++k) { const float* sp2 = Ot + (4 * k + er) * 128 + ec; const f32x4_t a = *(const f32x4_t*)sp2, b = *(const f32x4_t*)(sp2 + 4);
      *(u32x4*)(Ow + (long)(4 * k) * oa.LDO) = (u32x4){cvtpk(a[0], a[1]), cvtpk(a[2], a[3]), cvtpk(b[0], b[1]), cvtpk(b[2], b[3])}; }
  } else if constexpr (MODE == 1) {
    float* Sw = oa.stash + (wid * QBLK + er) * 128 + ec;
#pragma unroll
    for (int k = 0; k < 8; ++k) { const float* sp2 = Ot + (4 * k + er) * 128 + ec; const f32x4_t a = *(const f32x4_t*)sp2, b = *(const f32x4_t*)(sp2 + 4);
      *(f32x4_t*)(Sw + 4 * k * 128) = a; *(f32x4_t*)(Sw + 4 * k * 128 + 4) = b; }
  } else {
    const float* Sw = oa.stash + (wid * QBLK + er) * 128 + ec; bf16_t* Ow = oa.Ob + (long)(wid * QBLK + er) * oa.LDO + ec;
    const f32x4_t g0 = *(const f32x4_t*)(oa.g + ec) * oa.post, g1 = *(const f32x4_t*)(oa.g + ec + 4) * oa.post;
    f32x4_t sa[8], sb[8];
#pragma unroll
    for (int k = 0; k < 8; ++k) { sa[k] = *(const f32x4_t*)(Sw + 4 * k * 128); sb[k] = *(const f32x4_t*)(Sw + 4 * k * 128 + 4); }
#pragma unroll
    for (int k = 0; k < 8; ++k) { asm volatile("" ::: "memory"); const float* sp2 = Ot + (4 * k + er) * 128 + ec; f32x4_t a = *(const f32x4_t*)sp2, b = *(const f32x4_t*)(sp2 + 4);
      a = sa[k] - oa.lam * a; b = sb[k] - oa.lam * b;
      float ss = (a[0] * a[0] + a[1] * a[1]) + (a[2] * a[2] + a[3] * a[3]) + (b[0] * b[0] + b[1] * b[1]) + (b[2] * b[2] + b[3] * b[3]);
      ss += __shfl_xor(ss, 1); ss += __shfl_xor(ss, 2); ss += __shfl_xor(ss, 4); ss += __shfl_xor(ss, 8);
      const float rn = 1.0f / sqrtf(ss * (1.0f / 128.0f) + EPS);
      a = a * rn * g0; b = b * rn * g1;
      *(u32x4*)(Ow + (long)(4 * k) * oa.LDO) = (u32x4){cvtpk(a[0], a[1]), cvtpk(a[2], a[3]), cvtpk(b[0], b[1]), cvtpk(b[2], b[3])}; }
  }
  ATT_BAR();
#undef ATT_GLDS
#undef ATT_DMA
#undef ATT_BAR
#undef ATT_RESC2
#undef ATT4_HALF
}
}

#define GAS __attribute__((address_space(1)))
#define LAS __attribute__((address_space(3)))
typedef unsigned short bf16;
typedef unsigned v4u __attribute__((ext_vector_type(4)));
typedef unsigned v2u __attribute__((ext_vector_type(2)));
typedef float f32x4 __attribute__((ext_vector_type(4)));
typedef float f32x2 __attribute__((ext_vector_type(2)));
typedef __bf16 bf16x2_t __attribute__((ext_vector_type(2)));
typedef GAS unsigned gu32;
#define RLX_AGENT __ATOMIC_RELAXED, __HIP_MEMORY_SCOPE_AGENT
#define LDS_WAIT() asm volatile("s_waitcnt lgkmcnt(0)" ::: "memory")
#define VM_WAIT() asm volatile("s_waitcnt vmcnt(0)" ::: "memory")
__device__ __forceinline__ unsigned pk2(float lo, float hi) { unsigned r; asm volatile("v_cvt_pk_bf16_f32 %0, %1, %2" : "=v"(r) : "v"(lo), "v"(hi)); return r; }
__device__ __forceinline__ float bflo(unsigned w) { return __uint_as_float(w << 16); }
__device__ __forceinline__ float bfhi(unsigned w) { return __uint_as_float(w & 0xffff0000u); }
__device__ __forceinline__ float dot2bf(unsigned a, unsigned b, float acc) { return __builtin_amdgcn_fdot2_f32_bf16(__builtin_bit_cast(bf16x2_t, a), __builtin_bit_cast(bf16x2_t, b), acc, false); }
__device__ __forceinline__ float wave_sum(float v) {
#pragma unroll
    for (int o = 1; o < 64; o <<= 1) v += __shfl_xor(v, o);
    return v;
}

#define XB_TMO      128
#define XB_XCNT(j)  (256  + 64 * (j))
#define XB_XSUB(j)  (1280 + 64 * (j))
#define XB_XGEN(j)  (2304 + 64 * (j))
#define XB_TOP      3328
#define XB_TOPGEN   3392
#define XCD_BAR_WORDS 3456
#define XB_SPIN_CAP (1u << 18)

__device__ __forceinline__ unsigned xb_ld(unsigned* p)              { return __hip_atomic_load(p, __ATOMIC_RELAXED, __HIP_MEMORY_SCOPE_AGENT); }
__device__ __forceinline__ unsigned xb_add(unsigned* p, unsigned v) { return __hip_atomic_fetch_add(p, v, __ATOMIC_RELAXED, __HIP_MEMORY_SCOPE_AGENT); }
__device__ __forceinline__ unsigned xb_xcc_id() { return (unsigned)__builtin_amdgcn_s_getreg((3 << 11) | 20) & 0xFu; }
#define XB_SPIN(cond, bar) do { unsigned _sp = 0; while (cond) { __builtin_amdgcn_s_sleep(1); \
    if ((++_sp & 255u) == 0u) { if (xb_ld(&(bar)[XB_TMO])) break; if (_sp > XB_SPIN_CAP) { atomicAdd(&(bar)[XB_TMO], 1u); break; } } } } while (0)

struct XcdBarrier {
    unsigned* bar; unsigned x;
    volatile LAS unsigned* st;
};

__device__ __forceinline__ XcdBarrier xcd_barrier_post(unsigned* bar, volatile LAS unsigned* st) {
    XcdBarrier b; b.bar = bar; b.x = xb_xcc_id(); b.st = st;
    if (threadIdx.x == 0) (void)xb_add(&bar[XB_XCNT(b.x)], 1u);
    return b;
}
__device__ __forceinline__ void xcd_barrier_complete(unsigned* bar, unsigned x, unsigned& nloc, unsigned& nx) {
    const unsigned G = gridDim.x * gridDim.y * gridDim.z;
    unsigned sum, cnt, mine, sp = 0u;
    for (;;) {
        sum = 0u; cnt = 0u; mine = 0u;
#pragma unroll
        for (unsigned j = 0; j < 16; ++j) { const unsigned c = xb_ld(&bar[XB_XCNT(j)]); sum += c; cnt += (c > 0u) ? 1u : 0u; mine = (j == x) ? c : mine; }
        if (sum == G) break;
        __builtin_amdgcn_s_sleep(1);
        if ((++sp & 255u) == 0u) { if (xb_ld(&bar[XB_TMO])) break; if (sp > XB_SPIN_CAP) { atomicAdd(&bar[XB_TMO], 1u); break; } }
    }
    nloc = mine > 0u ? mine : 1u; nx = cnt > 0u ? cnt : 1u;
}

__device__ __forceinline__ void xcd_barrier(const XcdBarrier& b) {
    asm volatile("s_waitcnt vmcnt(0)" ::: "memory");
    __syncthreads();
    if (threadIdx.x == 0) {
        unsigned* bar = b.bar;
        __builtin_amdgcn_s_waitcnt(0);
        unsigned nloc = b.st[0], nx = b.st[1];
        if (nloc == 0u) { xcd_barrier_complete(bar, b.x, nloc, nx); b.st[0] = nloc; b.st[1] = nx; }
        const unsigned old = xb_add(&bar[XB_XSUB(b.x)], 1u);
        const unsigned gen = old / nloc;
        if (old + 1u == (gen + 1u) * nloc) {
            __builtin_amdgcn_fence(__ATOMIC_RELEASE, "agent");
            asm volatile("s_waitcnt vmcnt(0)" ::: "memory");
            const unsigned og = xb_add(&bar[XB_TOP], 1u);
            const unsigned tg = og / nx;
            if (og + 1u == (tg + 1u) * nx) xb_add(&bar[XB_TOPGEN], 1u);
            else XB_SPIN(xb_ld(&bar[XB_TOPGEN]) == tg, bar);
            __builtin_amdgcn_fence(__ATOMIC_ACQUIRE, "agent");
            xb_add(&bar[XB_XGEN(b.x)], 1u);
            asm volatile("s_waitcnt vmcnt(0)" ::: "memory");
        } else {
            XB_SPIN(xb_ld(&bar[XB_XGEN(b.x)]) == gen, bar);
            __builtin_amdgcn_fence(__ATOMIC_ACQUIRE, "agent");
            asm volatile("s_waitcnt vmcnt(0)" ::: "memory");
        }
    }
    __syncthreads();
}


constexpr size_t MiB = 1u << 20;
constexpr size_t WS_CTL = 0, CTL_BYTES = 1 * MiB;
constexpr size_t WS_ROPE = 1 * MiB;
constexpr size_t WS_WIN = 4 * MiB;
constexpr size_t WS_WUQ = 60 * MiB;
constexpr size_t WS_WUKV = 64 * MiB;
constexpr size_t WS_WO = 68 * MiB;
constexpr size_t WS_WQ = 100 * MiB;
constexpr size_t WS_SUBK = 132 * MiB;
constexpr size_t WS_U = 134 * MiB;
constexpr size_t WS_V = 262 * MiB;
constexpr size_t WS_USC = 390 * MiB, WS_VSC = 391 * MiB;
constexpr size_t WS_X = 646 * MiB;
constexpr size_t WS_X1 = 742 * MiB;
constexpr size_t WS_H = 838 * MiB;
constexpr size_t WS_BQ = 1006 * MiB;
constexpr size_t WS_BK = 1060 * MiB;
constexpr size_t WS_BV = 1114 * MiB;
constexpr size_t WS_AO = 1150 * MiB;
constexpr size_t WS_Y = 1246 * MiB;
constexpr size_t WS_SKD = 1438 * MiB;
constexpr size_t WS_WQS = 1470 * MiB;
constexpr size_t WQS_LAYER = (size_t)2048 * 2048 + 2048;
constexpr size_t WS_STASH = 1534 * MiB;
constexpr size_t WS_EID = 518 * MiB, WS_GATEV = 530 * MiB, WS_USCT = 542 * MiB, WS_WT = 554 * MiB;
constexpr size_t WS_X8 = 566 * MiB;
constexpr size_t WS_XS = 614 * MiB;
constexpr size_t WS_PD = 1566 * MiB;
constexpr size_t WS_END = 1758 * MiB;
#if MK_DBG
constexpr size_t WS_SC = WS_END, WS_NEED = WS_END + 192 * MiB;
#else
constexpr size_t WS_SC = WS_Y, WS_NEED = WS_END;
#endif
constexpr int CW_BAR = 4096;
constexpr int CW_QUEUE = 8192;
constexpr int CW_SQ = 12288;
constexpr int CW_DBG = 16384;

constexpr int RING_BYTES = 131072;
constexpr int MISC_OFF = RING_BYTES;
constexpr int LDS_BYTES = 147456;

struct Args { const float* in[23]; float* out; unsigned char* ws; int ph_lo, ph_hi; float lam_init[DEPTH]; };

struct Frame {
    LAS unsigned char* lds; char* lds_g;
    gu32* ctl; unsigned char* ws;
    int tid, lane, wave, gw, ngw;
};

template <int MODE> __device__ __forceinline__ int rowmap(int n) {
    if (MODE == 0) return n;
    const int head = n / 192, w = n - head * 192; if (w < 128) return n;
    const int e = w - 128, s = e >> 5, f = e & 31; return head * 192 + 128 + 2 * f + s;
}
template <int MODE> __device__ __forceinline__ void transpose_item(const float* W, int K, int N, bf16* WT, LAS float* scr, int item, int lane) {
    const int nblk = N / 32, kb = item / nblk, nb = item % nblk, k0 = 64 * kb, n0 = 32 * nb;
#pragma unroll 8
    for (int i = 0; i < 32; ++i) { const int kk = 2 * i + (lane >> 5); scr[kk * 33 + (lane & 31)] = W[(size_t)(k0 + kk) * N + n0 + (lane & 31)]; }
    LDS_WAIT(); asm volatile("" ::: "memory");
    const int c = lane & 7;
#pragma unroll
    for (int j = 0; j < 4; ++j) { const int n = (lane >> 3) + 8 * j; const LAS float* s = scr + (8 * c) * 33 + n;
        v4u o; o.x = pk2(s[0 * 33], s[1 * 33]); o.y = pk2(s[2 * 33], s[3 * 33]); o.z = pk2(s[4 * 33], s[5 * 33]); o.w = pk2(s[6 * 33], s[7 * 33]);
        *(v4u*)(WT + (size_t)rowmap<MODE>(n0 + n) * K + k0 + 8 * c) = o; }
    LDS_WAIT(); asm volatile("" ::: "memory");
}
__device__ __forceinline__ void sincos_d(double a, float& c, float& s) {
    const double q = __builtin_rint(a * 0.6366197723675814); const double y = a - q * 1.5707963267948966 - q * 6.123233995736766e-17;
    const double y2 = y * y;
    double sp = -7.647163731819816e-13; sp = sp * y2 + 1.6059043836821613e-10; sp = sp * y2 - 2.505210838544172e-08; sp = sp * y2 + 2.7557319223985893e-06;
    sp = sp * y2 - 1.984126984126984e-04; sp = sp * y2 + 8.333333333333333e-03; sp = sp * y2 - 1.6666666666666666e-01; sp = y + y * y2 * sp;
    double cp = 4.779477332387385e-14; cp = cp * y2 - 1.1470745597729725e-11; cp = cp * y2 + 2.08767569878681e-09; cp = cp * y2 - 2.755731922398589e-07;
    cp = cp * y2 + 2.48015873015873e-05; cp = cp * y2 - 1.388888888888889e-03; cp = cp * y2 + 4.1666666666666664e-02; cp = cp * y2 - 0.5; cp = 1.0 + y2 * cp;
    const int qi = (int)((long long)q & 3);
    const double sv = (qi & 1) ? cp : sp, cv = (qi & 1) ? sp : cp;
    s = (float)((qi & 2) ? -sv : sv); c = (float)(((qi + 1) & 2) ? -cv : cv);
}
__device__ __forceinline__ void p0_prologue(Frame& F, const Args& A) {
    LAS float* scr = (LAS float*)(F.lds + F.wave * 16384);
    constexpr int I_IN = 32 * 110, I_UQ = 6 * 36, I_UKV = 4 * 48, I_O = 32 * 64, I_L = I_IN + I_UQ + I_UKV + I_O;
    for (int it = F.gw; it < DEPTH * I_L; it += F.ngw) {
        const int l = it / I_L; int r = it - l * I_L;
        if (r < I_IN) { transpose_item<0>(A.in[2] + (size_t)l * DM * INW, DM, INW, (bf16*)(F.ws + WS_WIN) + (size_t)l * INP * DM, scr, r, F.lane); continue; } r -= I_IN;
        if (r < I_UQ) { transpose_item<1>(A.in[7] + (size_t)l * 384 * BQW, 384, BQW, (bf16*)(F.ws + WS_WUQ) + (size_t)l * BQP * 384, scr, r, F.lane); continue; } r -= I_UQ;
        if (r < I_UKV) { transpose_item<0>(A.in[8] + (size_t)l * 256 * BKVW, 256, BKVW, (bf16*)(F.ws + WS_WUKV) + (size_t)l * BKVW * 256, scr, r, F.lane); continue; } r -= I_UKV;
        transpose_item<0>(A.in[14] + (size_t)l * DM * DM, DM, DM, (bf16*)(F.ws + WS_WO) + (size_t)l * DM * DM, scr, r, F.lane);
    }
    const size_t gt = (size_t)blockIdx.x * 512 + F.tid, ngt = (size_t)gridDim.x * 512;
    for (size_t i = gt; i < (size_t)DEPTH * 64 * DM / 8; i += ngt) { const size_t l = i / (64 * DM / 8), o = i % (64 * DM / 8);
        *(v4u*)((bf16*)(F.ws + WS_WIN) + (l * INP + INW) * DM + o * 8) = (v4u){0u, 0u, 0u, 0u}; }
    for (size_t i = gt; i < (size_t)DEPTH * 128 * 384 / 8; i += ngt) { const size_t l = i / (128 * 384 / 8), o = i % (128 * 384 / 8);
        *(v4u*)((bf16*)(F.ws + WS_WUQ) + (l * BQP + BQW) * 384 + o * 8) = (v4u){0u, 0u, 0u, 0u}; }
    for (size_t i = gt; i < (size_t)DEPTH * DM * DM / 8; i += ngt) { const float* sp = A.in[17] + i * 8; const f32x4 a = *(const f32x4*)sp, b = *(const f32x4*)(sp + 4);
        *(v4u*)((bf16*)(F.ws + WS_WQ) + i * 8) = (v4u){pk2(a.x, a.y), pk2(a.z, a.w), pk2(b.x, b.y), pk2(b.z, b.w)}; }
    for (size_t i = gt; i < (size_t)DEPTH * DM * DM / 8; i += ngt) { const size_t l = i / (DM * DM / 8), o = i % (DM * DM / 8), r = o / (DM / 8), k = (o % (DM / 8)) * 8;
        v4u w = (v4u){0u, 0u, 0u, 0u};
        if ((r >> 7) == (k >> 7)) { const int m = (int)((r >> 7) & 1); const float* sp = A.in[18] + ((l * 2 + m) * 128 + (r & 127)) * 128 + (k & 127); const f32x4 a = *(const f32x4*)sp, b = *(const f32x4*)(sp + 4);
            w = (v4u){pk2(a.x, a.y), pk2(a.z, a.w), pk2(b.x, b.y), pk2(b.z, b.w)}; }
        *(v4u*)((bf16*)(F.ws + WS_SKD) + (l * DM + r) * DM + k) = w; }
    for (int r = F.gw; r < 2 * DEPTH * NEXP; r += F.ngw) { const int tb = r >= DEPTH * NEXP, rr = tb ? r - DEPTH * NEXP : r;
        const float* src = A.in[19 + tb] + (size_t)rr * DM + F.lane * 4; f32x4 v[8]; float am = 0.f;
#pragma unroll
        for (int j = 0; j < 8; ++j) { v[j] = __builtin_nontemporal_load((const f32x4*)(src + 256 * j)); am = fmaxf(am, fmaxf(fmaxf(fabsf(v[j][0]), fabsf(v[j][1])), fmaxf(fabsf(v[j][2]), fabsf(v[j][3])))); }
#pragma unroll
        for (int o = 1; o < 64; o <<= 1) am = fmaxf(am, __shfl_xor(am, o));
        unsigned w[8]; float sci;
        if (tb) {
            int ex = (int)((__float_as_uint(am) >> 23) & 0xffu) - 126; if (ex < -100 || ex > 100) ex = 0;
            const float sc = __uint_as_float((unsigned)(127 + 7 - ex) << 23); sci = __uint_as_float((unsigned)(127 + ex - 7) << 23);
#pragma unroll
            for (int j = 0; j < 8; ++j) { unsigned q = 0u; q = __builtin_amdgcn_cvt_pk_fp8_f32(v[j][0] * sc, v[j][1] * sc, q, false); q = __builtin_amdgcn_cvt_pk_fp8_f32(v[j][2] * sc, v[j][3] * sc, q, true); w[j] = q; }
        } else {
            const float sc = am > 1e-30f ? 127.0f / am : 0.f; sci = am * (1.0f / 127.0f);
#pragma unroll
            for (int j = 0; j < 8; ++j) { const int q0 = (int)__builtin_rintf(v[j][0] * sc), q1 = (int)__builtin_rintf(v[j][1] * sc), q2 = (int)__builtin_rintf(v[j][2] * sc), q3 = (int)__builtin_rintf(v[j][3] * sc);
                w[j] = (unsigned)(q0 & 0xff) | ((unsigned)(q1 & 0xff) << 8) | ((unsigned)(q2 & 0xff) << 16) | ((unsigned)(q3 & 0xff) << 24); }
        }
        const size_t lyr = (size_t)rr / NEXP, ex_ = (size_t)rr % NEXP;
        unsigned char* dst = F.ws + (tb ? WS_V : WS_U) + lyr * NEXP * DM + (size_t)(F.lane >> 5) * (NEXP * 128) + ex_ * 128 + (F.lane & 31) * 4;
#pragma unroll
        for (int j = 0; j < 8; ++j) *(unsigned*)(dst + (size_t)(2 * j) * (NEXP * 128)) = w[j];
        if (F.lane == 0) ((float*)(F.ws + (tb ? WS_VSC : WS_USC)))[rr] = sci; }
    for (size_t i = gt; i < (size_t)TT * DM / 8; i += ngt) { const size_t np = (size_t)T_PROMPT * DM / 8;
        const float* s = (i < np) ? A.in[0] + i * 8 : A.in[1] + (i - np) * 8; const f32x4 a = *(const f32x4*)s, b = *(const f32x4*)(s + 4);
        *(v4u*)((bf16*)(F.ws + WS_X) + i * 8) = (v4u){pk2(a.x, a.y), pk2(a.z, a.w), pk2(b.x, b.y), pk2(b.z, b.w)}; }
    for (size_t i = gt; i < (size_t)8192 * 32; i += ngt) { const int p = (int)(i >> 5), f = (int)(i & 31); double inv = 1.0; for (int k = 0; k < f; ++k) inv *= ROPE_R;
        float c, s; sincos_d((double)p * inv, c, s); ((f32x2*)(F.ws + WS_ROPE))[i] = (f32x2){c, s}; }
}

__device__ __forceinline__ void tok_seq(int t, int& s0, int& slen, int& pos) {
    if (t < T_PROMPT) { s0 = 0; slen = T_PROMPT; pos = t; } else { const int r = t - T_PROMPT; s0 = T_PROMPT + (r / S_SAMPLE) * S_SAMPLE; slen = S_SAMPLE; pos = r % S_SAMPLE; }
}
#define UNPACK8(W_, X_, O_) do { X_[O_ + 0] = bflo((W_)[0]); X_[O_ + 1] = bfhi((W_)[0]); X_[O_ + 2] = bflo((W_)[1]); X_[O_ + 3] = bfhi((W_)[1]); X_[O_ + 4] = bflo((W_)[2]); X_[O_ + 5] = bfhi((W_)[2]); X_[O_ + 6] = bflo((W_)[3]); X_[O_ + 7] = bfhi((W_)[3]); } while (0)
#define PACK8(X_, O_) ((v4u){pk2(X_[O_ + 0], X_[O_ + 1]), pk2(X_[O_ + 2], X_[O_ + 3]), pk2(X_[O_ + 4], X_[O_ + 5]), pk2(X_[O_ + 6], X_[O_ + 7])})

__device__ __forceinline__ void phase_prep(Frame& F, const Args& A, int l) {
    const float* qn_g = A.in[3] + l * 128; const float* kn_g = A.in[4] + l * 128; const float* qa_g = A.in[5] + l * 384; const float* kva_g = A.in[6] + l * 256;
    const f32x2* rope = (const f32x2*)(F.ws + WS_ROPE);
    bf16* H = (bf16*)(F.ws + WS_H); bf16* BK = (bf16*)(F.ws + WS_BK);
    int tid_ = threadIdx.x; asm volatile("" : "+v"(tid_)); const int lane = tid_ & 63;
    float g16[16], qa8[8], kva8[8];
    {   const float* gp = ((lane >> 3) < 6 ? qn_g : kn_g) + (lane & 7) * 16;
#pragma unroll
        for (int i = 0; i < 16; ++i) g16[i] = gp[i];
#pragma unroll
        for (int i = 0; i < 8; ++i) { qa8[i] = lane < 48 ? qa_g[lane * 8 + i] : 0.f; kva8[i] = lane < 32 ? kva_g[lane * 8 + i] : 0.f; } }
    const int l8 = lane & 7;
    struct Row { v4u w0, w1, c0, c1, wq, wkv, wkr; f32x4 rv; int pos; };
    auto fetch = [&](int t, Row& r) { int s0, slen; tok_seq(t, s0, slen, r.pos); const bf16* hrow = H + (size_t)t * INP;
        r.w0 = *(const v4u*)(hrow + lane * 16); r.w1 = *(const v4u*)(hrow + lane * 16 + 8); r.c0 = *(const v4u*)(hrow + H_CQ + lane * 16); r.c1 = *(const v4u*)(hrow + H_CQ + lane * 16 + 8);
        r.wq = (v4u){0u, 0u, 0u, 0u}; if (lane < 48) r.wq = *(const v4u*)(hrow + H_BCQ + lane * 8);
        r.wkv = (v4u){0u, 0u, 0u, 0u}; if (lane < 32) r.wkv = *(const v4u*)(hrow + H_BCKV + lane * 8);
        r.wkr = *(const v4u*)(hrow + H_BKR + l8 * 8);
        const int rrow = lane < 16 || lane >= 48 ? r.pos : lane < 32 ? (r.pos >> 6) : (r.pos & 63);
        r.rv = *(const f32x4*)((const float*)rope + (size_t)rrow * 64 + (lane & 15) * 4); };
    auto one = [&](int t, const Row& r, LAS unsigned char* rslot) {
        bf16* hrow = H + (size_t)t * INP;
        *(LAS f32x4*)(rslot + lane * 16) = r.rv; __builtin_amdgcn_wave_barrier();
        {
            float x[16]; UNPACK8(r.w0, x, 0); UNPACK8(r.w1, x, 8);
            float ss = 0.f;
#pragma unroll
            for (int i = 0; i < 16; ++i) ss += x[i] * x[i];
            ss += __shfl_xor(ss, 1); ss += __shfl_xor(ss, 2); ss += __shfl_xor(ss, 4);
            const float rinv = 1.0f / sqrtf(ss * (1.0f / 128.0f) + EPS);
            const int j = lane & 7;
            const LAS f32x2* tb = (const LAS f32x2*)(rslot + (j < 4 ? 256 : 512) + (j & 1) * 128); const bool first = (j & 2) == 0;
#pragma unroll
            for (int i = 0; i < 16; ++i) x[i] = x[i] * rinv * g16[i];
#pragma unroll
            for (int i = 0; i < 16; ++i) { const float pr = __shfl_xor(x[i], 2); const f32x2 cs = tb[i]; x[i] = first ? x[i] * cs.x - pr * cs.y : x[i] * cs.x + pr * cs.y; }
            *(v4u*)(hrow + lane * 16) = PACK8(x, 0); *(v4u*)(hrow + lane * 16 + 8) = PACK8(x, 8);
        }
        {
            bf16* cp = hrow + H_CQ + lane * 16;
            float x[16]; UNPACK8(r.c0, x, 0); UNPACK8(r.c1, x, 8);
            const int j = lane & 3; const LAS f32x2* tb = (const LAS f32x2*)(rslot + (j & 1) * 128); const bool first = (j & 2) == 0;
#pragma unroll
            for (int i = 0; i < 16; ++i) { const float pr = __shfl_xor(x[i], 2); const f32x2 cs = tb[i]; x[i] = first ? x[i] * cs.x - pr * cs.y : x[i] * cs.x + pr * cs.y; }
            *(v4u*)cp = PACK8(x, 0); *(v4u*)(cp + 8) = PACK8(x, 8);
        }
        {
            float x[8]; UNPACK8(r.wq, x, 0); float ss = 0.f;
#pragma unroll
            for (int i = 0; i < 8; ++i) ss += x[i] * x[i];
            ss = wave_sum(ss); float rinv = 1.0f / sqrtf(ss * (1.0f / 384.0f) + EPS);
            if (lane < 48) {
#pragma unroll
                for (int i = 0; i < 8; ++i) x[i] = x[i] * rinv * qa8[i];
                *(v4u*)(hrow + H_BCQ + lane * 8) = PACK8(x, 0); }
            UNPACK8(r.wkv, x, 0); ss = 0.f;
#pragma unroll
            for (int i = 0; i < 8; ++i) ss += x[i] * x[i];
            ss = wave_sum(ss); rinv = 1.0f / sqrtf(ss * (1.0f / 256.0f) + EPS);
            if (lane < 32) {
#pragma unroll
                for (int i = 0; i < 8; ++i) x[i] = x[i] * rinv * kva8[i];
                *(v4u*)(hrow + H_BCKV + lane * 8) = PACK8(x, 0); }
            UNPACK8(r.wkr, x, 0);
            const LAS f32x2* tb = (const LAS f32x2*)(rslot + (l8 & 3) * 64); const bool first = l8 < 4; float o2[8];
#pragma unroll
            for (int i = 0; i < 8; ++i) { const float pr = __shfl_xor(x[i], 4); const f32x2 cs = tb[i]; x[i] = first ? x[i] * cs.x - pr * cs.y : x[i] * cs.x + pr * cs.y; }
#pragma unroll
            for (int i = 0; i < 8; ++i) o2[i] = __shfl_xor(x[i], 4);
            if (lane < 4) {
                const v4u a = (v4u){pk2(x[0], o2[0]), pk2(x[1], o2[1]), pk2(x[2], o2[2]), pk2(x[3], o2[3])}, b = (v4u){pk2(x[4], o2[4]), pk2(x[5], o2[5]), pk2(x[6], o2[6]), pk2(x[7], o2[7])};
                bf16* kp = BK + (size_t)t * BQW + 128 + lane * 16;
#pragma unroll
                for (int h = 0; h < 6; ++h) { *(v4u*)(kp + h * 192) = a; *(v4u*)(kp + h * 192 + 8) = b; }
            }
        } };
    for (int ta = F.gw; ta < TT; ta += 2 * F.ngw) { const int tb = ta + F.ngw;
        Row ra, rb; fetch(ta, ra); if (tb < TT) fetch(tb, rb);
        one(ta, ra, F.lds + F.wave * 2048); if (tb < TT) one(tb, rb, F.lds + F.wave * 2048 + 1024);
    }
}

struct StoreBf16 {
    bf16* O; int ldc, ncols;
    __device__ __forceinline__ void operator()(int row, int col, f32x4 v0, f32x4 v1) const {
        if (col < ncols) *(v4u*)(O + (size_t)row * ldc + col) = (v4u){pk2(v0[0], v0[1]), pk2(v0[2], v0[3]), pk2(v1[0], v1[1]), pk2(v1[2], v1[3])}; }
};
struct StoreF32 {
    float* O; int ldc;
    __device__ __forceinline__ void operator()(int row, int col, f32x4 v0, f32x4 v1) const { float* p = O + (size_t)row * ldc + col; *(f32x4*)p = v0; *(f32x4*)(p + 4) = v1; }
};
struct StoreMlaQ {
    bf16* O; const f32x2* rope;
    __device__ __forceinline__ void operator()(int row, int col, f32x4 v0, f32x4 v1) const {
        if (col >= BQW) return;
        const int w = col % 192;
        if (w >= 128) { int s0, slen, pos; tok_seq(row, s0, slen, pos); const f32x2* tb = rope + pos * 32 + ((w - 128) >> 1);
            const f32x2 c0 = tb[0], c1 = tb[1], c2 = tb[2], c3 = tb[3];
            const f32x4 a = v0, b = v1;
            v0[0] = a[0] * c0.x - a[1] * c0.y; v0[1] = a[1] * c0.x + a[0] * c0.y; v0[2] = a[2] * c1.x - a[3] * c1.y; v0[3] = a[3] * c1.x + a[2] * c1.y;
            v1[0] = b[0] * c2.x - b[1] * c2.y; v1[1] = b[1] * c2.x + b[0] * c2.y; v1[2] = b[2] * c3.x - b[3] * c3.y; v1[3] = b[3] * c3.x + b[2] * c3.y; }
        *(v4u*)(O + (size_t)row * BQW + col) = (v4u){pk2(v0[0], v0[1]), pk2(v0[2], v0[3]), pk2(v1[0], v1[1]), pk2(v1[2], v1[3])}; }
};
struct EpiMlaQ {
    static constexpr bool PERM = true, AFTER_DRAIN = false; bf16* O; const f32x2* rope;
    __device__ __forceinline__ void operator()(const pg8::f32x4 (&acc)[2][2][4][2], const pg8::Unit& u, int wr, int wc, int fr, int fq) const {
        const int row0 = u.pm * pg8::BM + wr * 64 + fr, col0 = u.pn * pg8::BM + wc * 32 + 8 * fq;
#pragma unroll
        for (int ai = 0; ai < 2; ++ai) { f32x4 cs[8][2];
#pragma unroll
            for (int m = 0; m < 4; ++m)
#pragma unroll
                for (int bj = 0; bj < 2; ++bj) { const int row = row0 + ai * pg8::HALF + m * 16, col = col0 + bj * pg8::HALF, w = col % 192;
                    cs[2 * m + bj][0] = (f32x4){1.f, 0.f, 1.f, 0.f}; cs[2 * m + bj][1] = (f32x4){1.f, 0.f, 1.f, 0.f};
                    if (col < BQW && w >= 128) { int s0, slen, pos; tok_seq(row, s0, slen, pos); const f32x4* tb = (const f32x4*)(rope + pos * 32 + ((w - 128) >> 1)); cs[2 * m + bj][0] = tb[0]; cs[2 * m + bj][1] = tb[1]; } }
#pragma unroll
            for (int m = 0; m < 4; ++m)
#pragma unroll
                for (int bj = 0; bj < 2; ++bj) { const int row = row0 + ai * pg8::HALF + m * 16, col = col0 + bj * pg8::HALF; if (col >= BQW) continue;
                    const pg8::f32x4 a = acc[ai][bj][m][0], b = acc[ai][bj][m][1]; const f32x4 c01 = cs[2 * m + bj][0], c23 = cs[2 * m + bj][1];
                    *(v4u*)(O + (size_t)row * BQW + col) = (v4u){pk2(a[0] * c01[0] - a[1] * c01[1], a[1] * c01[0] + a[0] * c01[1]), pk2(a[2] * c01[2] - a[3] * c01[3], a[3] * c01[2] + a[2] * c01[3]),
                                                                 pk2(b[0] * c23[0] - b[1] * c23[1], b[1] * c23[0] + b[0] * c23[1]), pk2(b[2] * c23[2] - b[3] * c23[3], b[3] * c23[2] + b[2] * c23[3])}; }
            asm volatile("" ::: "memory"); }
    }
};
struct StoreMlaKV {
    bf16* BK; bf16* BV;
    __device__ __forceinline__ void operator()(int row, int col, f32x4 v0, f32x4 v1) const {
        const int head = col >> 8, w = col & 255; bf16* p = (w < 128) ? BK + (size_t)row * BQW + head * 192 + w : BV + (size_t)row * BVW + head * 128 + (w - 128);
        *(v4u*)p = (v4u){pk2(v0[0], v0[1]), pk2(v0[2], v0[3]), pk2(v1[0], v1[1]), pk2(v1[2], v1[3])}; }
};
struct StoreResid {
    bf16* Y; const bf16* X;
    __device__ __forceinline__ void operator()(int row, int col, f32x4 v0, f32x4 v1) const {
        const v4u xw = *(const v4u*)(X + (size_t)row * DM + col); float x[8]; UNPACK8(xw, x, 0);
        *(v4u*)(Y + (size_t)row * DM + col) = (v4u){pk2(DN_ALPHA * x[0] + v0[0], DN_ALPHA * x[1] + v0[1]), pk2(DN_ALPHA * x[2] + v0[2], DN_ALPHA * x[3] + v0[3]),
                                                    pk2(DN_ALPHA * x[4] + v1[0], DN_ALPHA * x[5] + v1[1]), pk2(DN_ALPHA * x[6] + v1[2], DN_ALPHA * x[7] + v1[3])}; }
};
struct EpiResid {
    static constexpr bool PERM = true, AFTER_DRAIN = false; bf16* Y; const bf16* X;
    __device__ __forceinline__ void operator()(const pg8::f32x4 (&acc)[2][2][4][2], const pg8::Unit& u, int wr, int wc, int fr, int fq) const {
        const int row0 = u.pm * pg8::BM + wr * 64 + fr, col0 = u.pn * pg8::BM + wc * 32 + 8 * fq;
#pragma unroll
        for (int ai = 0; ai < 2; ++ai) { v4u xw[8];
#pragma unroll
            for (int m = 0; m < 4; ++m)
#pragma unroll
                for (int bj = 0; bj < 2; ++bj) xw[2 * m + bj] = *(const v4u*)(X + (size_t)(row0 + ai * pg8::HALF + m * 16) * DM + col0 + bj * pg8::HALF);
#pragma unroll
            for (int m = 0; m < 4; ++m)
#pragma unroll
                for (int bj = 0; bj < 2; ++bj) { float x[8]; UNPACK8(xw[2 * m + bj], x, 0); const pg8::f32x4 v0 = acc[ai][bj][m][0], v1 = acc[ai][bj][m][1];
                    *(v4u*)(Y + (size_t)(row0 + ai * pg8::HALF + m * 16) * DM + col0 + bj * pg8::HALF) = (v4u){pk2(DN_ALPHA * x[0] + v0[0], DN_ALPHA * x[1] + v0[1]), pk2(DN_ALPHA * x[2] + v0[2], DN_ALPHA * x[3] + v0[3]),
                                                                                                              pk2(DN_ALPHA * x[4] + v1[0], DN_ALPHA * x[5] + v1[1]), pk2(DN_ALPHA * x[6] + v1[2], DN_ALPHA * x[7] + v1[3])}; }
            asm volatile("" ::: "memory"); }
    }
};
struct FoldOrder {
    int G, c;
    __device__ __forceinline__ bool next(int i, pg8::Unit& u) const { const int idx = i * G + c; if (idx >= DEPTH * 64) return false; const int l = idx >> 6, r = idx & 63; u.pm = l * 8 + (r >> 3); u.pn = l * 8 + (r & 7); return true; }
    __device__ __forceinline__ void a_ready(const pg8::Unit&) const {}
    __device__ __forceinline__ void done(const pg8::Unit&) const {}
};
constexpr int P1_MOVED = 64;
struct P1Order {
    pg8::StaticOrder S; int G, c;
    __device__ __forceinline__ void init(int G_, int c_) { S.init(TT, INP - 256, G_, c_); G = G_; c = c_; }
    __device__ __forceinline__ bool next(int i, pg8::Unit& u) const { if (S.next(i, u)) return true; const int e = i * G + c - S.nwg; if (e >= TT / 256 - P1_MOVED) return false; u.pm = P1_MOVED + e; u.pn = INP / 256 - 1; return true; }
    __device__ __forceinline__ void a_ready(const pg8::Unit&) const {}
    __device__ __forceinline__ void done(const pg8::Unit&) const {}
};
struct MovedOrder {
    int G, c;
    __device__ __forceinline__ bool next(int i, pg8::Unit& u) const { const int L = i * G + c; if (L >= P1_MOVED) return false; u.pm = L; u.pn = INP / 256 - 1; return true; }
    __device__ __forceinline__ void a_ready(const pg8::Unit&) const {}
    __device__ __forceinline__ void done(const pg8::Unit&) const {}
};
template <class F, class Sched> __device__ __forceinline__ void run_gemm_s(Frame& Fr, const bf16* Aop, int lda, const bf16* Bt, int M, int N, int K, const F& f, const Sched& S) {
    int Kv = K; asm volatile("" : "+s"(Kv));
    pg8::Gemm g{Aop, Bt, M, N, Kv, lda, K}; pg8::EpiRow8<F> E{f};
    pg8::gemm_phase<pg8::EpiRow8<F>, Sched, true, true>(Fr.lds, g, S, E);
}
template <class F> __device__ __forceinline__ void run_gemm(Frame& Fr, const bf16* Aop, int lda, const bf16* Bt, int M, int N, int K, const F& f, int skip = 0) {
    int Kv = K; asm volatile("" : "+s"(Kv));
    pg8::Gemm g{Aop, Bt, M, N, Kv, lda, K}; pg8::StaticOrder S; S.init(M, N, (int)gridDim.x - skip, (int)blockIdx.x >= skip ? (int)blockIdx.x - skip : (1 << 29));
    pg8::EpiRow8<F> E{f};
    pg8::gemm_phase<pg8::EpiRow8<F>, pg8::StaticOrder, true, true>(Fr.lds, g, S, E);
}

#ifndef ATTN_V2
#define ATTN_V2 1
#endif
#if ATTN_V2
#ifndef ATTN_V3
#define ATTN_V3 4
#endif
#if ATTN_V3 == 4
#define ATTN_FN attn_body4
#elif ATTN_V3 == 3
#define ATTN_FN attn_body3
#else
#define ATTN_FN attn_body2
#endif
#define ATTN_X
#define ATTN_L , F.lds
#else
#define ATTN_FN attn_body
#define ATTN_X , true
#define ATTN_L
#endif
__device__ __forceinline__ int queue_next(Frame& F, gu32* q) {
    volatile LAS unsigned* W = (volatile LAS unsigned*)(F.lds + MISC_OFF) + 4;
    __syncthreads();
    if (threadIdx.x == 0) W[0] = __hip_atomic_fetch_add(q, 1u, RLX_AGENT);
    __syncthreads();
    return (int)W[0];
}
__device__ __forceinline__ int queue_pass(Frame& F, unsigned nxt) {
    volatile LAS unsigned* W = (volatile LAS unsigned*)(F.lds + MISC_OFF) + 4;
    __syncthreads();
    if (threadIdx.x == 0) W[0] = nxt;
    __syncthreads();
    return (int)W[0];
}
__device__ __forceinline__ unsigned queue_mask(Frame& F, gu32* q0, unsigned N, int tid  ) {
    volatile LAS unsigned* W = (volatile LAS unsigned*)(F.lds + MISC_OFF) + 4;
    __syncthreads();
    if (tid < 64) { const unsigned c = tid < 16 ? __hip_atomic_load(q0 + 16 * tid, RLX_AGENT) : N; const unsigned long long m = __ballot(c < N); if (tid == 0) W[0] = (unsigned)m; }
    __syncthreads();
    return W[0];
}
constexpr int AQR = 32 * ATT_ACTIVE_WAVES, APB = T_PROMPT / AQR, ASB = S_SAMPLE / AQR;
__device__ __forceinline__ void att_unit(int u, int NH, int& head, int& t0, int& s0, int& slen) {
    if (u < NH * APB) { head = u / APB; s0 = 0; slen = T_PROMPT; t0 = (u % APB) * AQR; }
    else { const int v = u - NH * APB, sq = v / (NH * ASB), r = v % (NH * ASB); head = r / ASB; s0 = T_PROMPT + sq * S_SAMPLE; slen = S_SAMPLE; t0 = s0 + (r % ASB) * AQR; }
}
__device__ __forceinline__ void phase_attn(Frame& F, const Args& A, int l, int rep = 0) {
    const bf16* H = (const bf16*)(F.ws + WS_H); bf16* AO = (bf16*)(F.ws + WS_AO);
    float d1 = 0.f, d2 = 0.f;
    for (int i = 0; i < 64; ++i) { d1 += A.in[9][l * 64 + i] * A.in[10][l * 64 + i]; d2 += A.in[11][l * 64 + i] * A.in[12][l * 64 + i]; }
    const float lam_init = A.lam_init[l];
    const float lam = __uint_as_float(__builtin_amdgcn_readfirstlane(__float_as_uint(expf(d1) - expf(d2) + lam_init)));
#ifndef AT_EN
#define AT_EN 7
#endif
#ifndef MK_REP_TYPES
#define MK_REP_TYPES 7
#endif
    const int at_en = (rep == 0) ? AT_EN : MK_REP_TYPES;
    if (at_en & 1) {
        float* stash = (float*)(F.ws + WS_STASH) + (size_t)blockIdx.x * 256 * 128;
        for (;;) { const int u = queue_next(F, F.ctl + CW_QUEUE + 64 * (3 * l + 0) + 16 * rep); if (u >= 4 * APB + 4 * 4 * ASB) break;
            int head, t0, s0, slen; att_unit(u, 4, head, t0, s0, slen);
            att::OutArgs oa{AO + (size_t)t0 * DM + 1536 + head * 128, DM, stash, lam, 1.0f - lam_init, A.in[13] + l * 128, (unsigned long long*)(F.ws + WS_CTL) + 12000};
            att::ATTN_FN<64, INP, INP, INP, 1 ATTN_X>(H + (size_t)t0 * INP + H_CQ + head * 128, H + (size_t)s0 * INP + H_CK + head * 128, H + (size_t)s0 * INP + H_CV + head * 128, slen, 0.125f, oa, F.lds_g ATTN_L);
            att::ATTN_FN<64, INP, INP, INP, 2 ATTN_X>(H + (size_t)t0 * INP + H_CQ + head * 128 + 64, H + (size_t)s0 * INP + H_CK + head * 128 + 64, H + (size_t)s0 * INP + H_CV + head * 128, slen, 0.125f, oa, F.lds_g ATTN_L);
        }
    }
    if (at_en & 2) {
        const bf16* BQ = (const bf16*)(F.ws + WS_BQ); const bf16* BK = (const bf16*)(F.ws + WS_BK); const bf16* BV = (const bf16*)(F.ws + WS_BV);
        for (;;) { const int u = queue_next(F, F.ctl + CW_QUEUE + 64 * (3 * l + 1) + 16 * rep); if (u >= 6 * APB + 4 * 6 * ASB) break;
            int head, t0, s0, slen; att_unit(u, 6, head, t0, s0, slen);
            att::OutArgs oa{AO + (size_t)t0 * DM + 768 + head * 128, DM, nullptr, 0.f, 0.f, nullptr, (unsigned long long*)(F.ws + WS_CTL) + 12000};
            att::ATTN_FN<192, BQW, BQW, BVW, 0 ATTN_X>(BQ + (size_t)t0 * BQW + head * 192, BK + (size_t)s0 * BQW + head * 192, BV + (size_t)s0 * BVW + head * 128, slen, 0.07216878364870322f, oa, F.lds_g ATTN_L);
        }
    }
    if (at_en & 4) {
        for (;;) { const int u = queue_next(F, F.ctl + CW_QUEUE + 64 * (3 * l + 2) + 16 * rep); if (u >= 6 * APB + 4 * 6 * ASB) break;
            int head, t0, s0, slen; att_unit(u, 6, head, t0, s0, slen); const int kvh = head / 3;
            att::OutArgs oa{AO + (size_t)t0 * DM + head * 128, DM, nullptr, 0.f, 0.f, nullptr, (unsigned long long*)(F.ws + WS_CTL) + 12000};
            att::ATTN_FN<128, INP, INP, INP, 0 ATTN_X>(H + (size_t)t0 * INP + H_AQ + head * 128, H + (size_t)s0 * INP + H_AK + kvh * 128, H + (size_t)s0 * INP + H_AV + kvh * 128, slen, 0.08838834764831845f, oa, F.lds_g ATTN_L);
        }
    }
}

__device__ __forceinline__ void phase_ln1(Frame& F, const Args& A, int l) {
    int tid_ = threadIdx.x; asm volatile("" : "+v"(tid_)); const int lane = tid_ & 63;
    const bf16* Y = (const bf16*)(F.ws + WS_Y); bf16* X1 = (bf16*)(F.ws + WS_X1); const float* g = A.in[15] + l * DM; const float* b = A.in[16] + l * DM;
    float gg[32], bb[32];
#pragma unroll
    for (int j = 0; j < 4; ++j) { const int c0 = j * 512 + lane * 8; const f32x4 ga = *(const f32x4*)(g + c0), gb = *(const f32x4*)(g + c0 + 4), ba = *(const f32x4*)(b + c0), bc = *(const f32x4*)(b + c0 + 4);
#pragma unroll
        for (int i = 0; i < 4; ++i) { gg[8 * j + i] = ga[i]; gg[8 * j + 4 + i] = gb[i]; bb[8 * j + i] = ba[i]; bb[8 * j + 4 + i] = bc[i]; } }
    for (int ta = F.gw; ta < TT; ta += 2 * F.ngw) { const int tb = ta + F.ngw < TT ? ta + F.ngw : ta;
        v4u ya[4], yb[4];
#pragma unroll
        for (int j = 0; j < 4; ++j) ya[j] = *(const v4u*)(Y + (size_t)ta * DM + j * 512 + lane * 8);
#pragma unroll
        for (int j = 0; j < 4; ++j) yb[j] = *(const v4u*)(Y + (size_t)tb * DM + j * 512 + lane * 8);
        auto one = [&](int t, const v4u (&yw)[4]) {
            float v[32];
#pragma unroll
            for (int j = 0; j < 4; ++j) UNPACK8(yw[j], v, 8 * j);
            float s = 0.f;
    #pragma unroll
            for (int i = 0; i < 32; ++i) s += v[i];
            const float mean = wave_sum(s) * (1.0f / DM); float q = 0.f;
    #pragma unroll
            for (int i = 0; i < 32; ++i) { v[i] -= mean; q += v[i] * v[i]; }
            const float rstd = 1.0f / sqrtf(wave_sum(q) * (1.0f / DM) + EPS);
            float am = 0.f;
    #pragma unroll
            for (int j = 0; j < 4; ++j) { const int c0 = j * 512 + lane * 8;
    #pragma unroll
                for (int i = 0; i < 8; ++i) { v[8 * j + i] = v[8 * j + i] * rstd * gg[8 * j + i] + bb[8 * j + i]; am = fmaxf(am, fabsf(v[8 * j + i])); }
                *(v4u*)(X1 + (size_t)t * DM + c0) = PACK8(v, 8 * j); }
    #pragma unroll
            for (int o = 1; o < 64; o <<= 1) am = fmaxf(am, __shfl_xor(am, o));
            const float sc = am > 1e-30f ? 127.0f / am : 0.f;
    #pragma unroll
            for (int j = 0; j < 4; ++j) { unsigned q[2];
    #pragma unroll
                for (int hh = 0; hh < 2; ++hh) { const int q0 = (int)__builtin_rintf(v[8 * j + 4 * hh] * sc), q1 = (int)__builtin_rintf(v[8 * j + 4 * hh + 1] * sc), q2 = (int)__builtin_rintf(v[8 * j + 4 * hh + 2] * sc), q3 = (int)__builtin_rintf(v[8 * j + 4 * hh + 3] * sc);
                    q[hh] = (unsigned)(q0 & 0xff) | ((unsigned)(q1 & 0xff) << 8) | ((unsigned)(q2 & 0xff) << 16) | ((unsigned)(q3 & 0xff) << 24); }
                *(v2u*)(F.ws + WS_X8 + (size_t)t * DM + j * 512 + lane * 8) = (v2u){q[0], q[1]}; }
            if (lane == 0) ((float*)(F.ws + WS_XS))[t] = am * (1.0f / 127.0f);
        };
        one(ta, ya); one(tb, yb);
    }
}

#define PEER_CVT(wd, f0, f1) do { f0 = __builtin_amdgcn_cvt_pk_f32_fp8((int)(wd), false); f1 = __builtin_amdgcn_cvt_pk_f32_fp8((int)(wd), true); } while (0)
#define DPP_STEP8(c, ctrl) do { _Pragma("unroll") for (int _h = 0; _h < 8; ++_h) c[_h] += __builtin_amdgcn_update_dpp(0, c[_h], ctrl, 0xf, 0xf, true); } while (0)
__device__ __forceinline__ void sum32x8(int (&c)[8]) {
    DPP_STEP8(c, 0xB1); DPP_STEP8(c, 0x4E); DPP_STEP8(c, 0x141); DPP_STEP8(c, 0x140);
#pragma unroll
    for (int h = 0; h < 8; ++h) { const auto r = __builtin_amdgcn_permlane16_swap((unsigned)c[h], (unsigned)c[h], false, false); c[h] = (int)(r[0] + r[1]); } }
__device__ __forceinline__ void sum64x8(int (&c)[8]) {
    sum32x8(c);
#pragma unroll
    for (int h = 0; h < 8; ++h) { const auto r = __builtin_amdgcn_permlane32_swap((unsigned)c[h], (unsigned)c[h], false, false); c[h] = (int)(r[0] + r[1]); } }
__device__ __forceinline__ float funkey(unsigned k) { return __uint_as_float((k & 0x80000000u) ? (k ^ 0x80000000u) : ~k); }
__device__ __forceinline__ unsigned fkey(float f) { const unsigned u = __float_as_uint(f); return u ^ ((unsigned)((int)u >> 31) | 0x80000000u); }
#define DPPI(v, ctrl) __builtin_amdgcn_update_dpp(0, (v), (ctrl), 0xf, 0xf, true)
#define DPPU(v, ctrl) ((unsigned)__builtin_amdgcn_update_dpp(0, (int)(v), (ctrl), 0xf, 0xf, true))
__device__ __forceinline__ unsigned umax_(unsigned a, unsigned b) { return a > b ? a : b; }
__device__ __forceinline__ unsigned umin_(unsigned a, unsigned b) { return a < b ? a : b; }
#define TOPK_BISECT(NK, KEYS, DPPSUM) do { na = 0x7fff; _Pragma("unroll 1") for (;;) { const unsigned d = hi - lo; if (!__any(na != 16 && d != 0u)) break; \
            const unsigned cv = lo + (d >> 1) + (d & 1u); int c = 0; \
            _Pragma("unroll") for (int i = 0; i < (NK); ++i) c += (int)((KEYS)[i] >= cv); \
            DPPSUM; const bool ok = c >= 16; lo = ok ? cv : lo; hi = ok ? hi : cv - 1u; na = ok ? c : na; } } while (0)
__device__ __forceinline__ void phase_peer_topk(Frame& F, const Args& A, int l) {
    const float* SC = (const float*)(F.ws + WS_SC);
    const float* Usc = (const float*)(F.ws + WS_USC) + l * NEXP; const float* Vsc = (const float*)(F.ws + WS_VSC) + l * NEXP;
    int tid_ = threadIdx.x; asm volatile("" : "+v"(tid_)); const int lane = tid_ & 63;
    LAS unsigned* selk = (LAS unsigned*)(F.lds + F.wave * 16384);
    LAS int* seli = (LAS int*)(F.lds + F.wave * 16384 + 1024);
    LAS int* eid = (LAS int*)(F.lds + F.wave * 16384 + 2048);
    LAS float* gate = (LAS float*)(F.lds + F.wave * 16384 + 2560);
    LAS float* dummy = (LAS float*)(F.lds + F.wave * 16384 + 4096) + lane;
    LAS f32x2* ssp = (LAS f32x2*)(F.lds + F.wave * 16384 + 8192);
    const int q8c = lane & 7;
    const unsigned cw0 = q8c == 0 ? 0x20100800u : q8c == 1 ? 0x21110901u : q8c == 2 ? 0x22120a02u : q8c == 3 ? 0x23130b03u : q8c == 4 ? 0x24140c04u : q8c == 5 ? 0x30150d05u : q8c == 6 ? 0x31160e06u : 0x32170f07u;
    const unsigned cw1 = q8c == 0 ? 0x00e07033u : q8c == 1 ? 0x00f07140u : q8c == 2 ? 0x00008041u : q8c == 3 ? 0x00009042u : q8c == 4 ? 0x0000a050u : q8c == 5 ? 0x0000b051u : q8c == 6 ? 0x0000c060u : 0x0000d061u;
    f32x4 nx[8]; size_t pgo = 0; int pee0 = 0, pee1 = 0; float pg0 = 0.f, pg1 = 0.f, psu0 = 0.f, psu1 = 0.f, psv0 = 0.f, psv1 = 0.f;
#define TK_LD4(dst, ptr, OFF) asm volatile("global_load_dwordx4 %0, %1, off offset:" #OFF : "=v"(dst) : "v"(ptr) : "memory")
#define TK_LD1(dst, ptr) asm volatile("global_load_dword %0, %1, off" : "=v"(dst) : "v"(ptr) : "memory")
#define TK_LDNX(tt) do { const float* _sp = SC + (size_t)(tt) * 2048 + lane * 32; TK_LD4(nx[0], _sp, 0); TK_LD4(nx[1], _sp, 16); TK_LD4(nx[2], _sp, 32); TK_LD4(nx[3], _sp, 48); \
        TK_LD4(nx[4], _sp, 64); TK_LD4(nx[5], _sp, 80); TK_LD4(nx[6], _sp, 96); TK_LD4(nx[7], _sp, 112); } while (0)
    if (F.gw < TT) { TK_LDNX(F.gw);
        TK_LD1(psu0, Usc + lane); TK_LD1(psu1, Usc + lane + 64); TK_LD1(psv0, Vsc + lane); TK_LD1(psv1, Vsc + lane + 64); }
#define TOPK_FLUSH(N) do { asm volatile("s_waitcnt vmcnt(" #N ")" : "+v"(psu0), "+v"(psu1), "+v"(psv0), "+v"(psv1) :: "memory"); ((int*)(F.ws + WS_EID))[pgo] = pee0; ((int*)(F.ws + WS_EID))[pgo + 64] = pee1; ((float*)(F.ws + WS_GATEV))[pgo] = pg0 * psv0; ((float*)(F.ws + WS_GATEV))[pgo + 64] = pg1 * psv1; \
        ((float*)(F.ws + WS_USCT))[pgo] = psu0; ((float*)(F.ws + WS_USCT))[pgo + 64] = psu1; } while (0)
#pragma unroll 1
    for (int t = F.gw; t < TT; t += F.ngw) {
        unsigned kk[32]; unsigned lo, hi; int na;
        {
            asm volatile("s_waitcnt vmcnt(4)" : "+v"(nx[0]), "+v"(nx[1]), "+v"(nx[2]), "+v"(nx[3]), "+v"(nx[4]), "+v"(nx[5]), "+v"(nx[6]), "+v"(nx[7]) :: "memory");
#pragma unroll
            for (int j = 0; j < 8; ++j) {
#pragma unroll
                for (int c = 0; c < 4; ++c) { kk[4 * j + c] = fkey(nx[j][c]); asm volatile("" : "+v"(kk[4 * j + c])); } }
            const int tn = t + F.ngw < TT ? t + F.ngw : t; TK_LDNX(tn);
        }
        {   unsigned gm[4];
#pragma unroll
            for (int b = 0; b < 4; ++b) { unsigned m = kk[8 * b];
#pragma unroll
                for (int i = 1; i < 8; ++i) m = umax_(m, kk[8 * b + i]);
                gm[b] = m; }
            unsigned mx = umax_(umax_(gm[0], gm[1]), umax_(gm[2], gm[3])), mn = umin_(umin_(gm[0], gm[1]), umin_(gm[2], gm[3]));
            mx = umax_(mx, DPPU(mx, 0xB1)); mx = umax_(mx, DPPU(mx, 0x4E)); mn = umin_(mn, DPPU(mn, 0xB1)); mn = umin_(mn, DPPU(mn, 0x4E));
            lo = mn; hi = mx; }
        TOPK_BISECT(32, kk, (c += DPPI(c, 0xB1), c += DPPI(c, 0x4E)));
        if (t != F.gw) TOPK_FLUSH(8);
        {
            const unsigned pv = lo; int cl = 0;
#pragma unroll
            for (int i = 0; i < 32; ++i) cl += (int)(kk[i] >= pv);
            const int q = lane & 3; const int c1 = DPPI(cl, 0x90), c2 = DPPI(cl, 0x40), c3 = DPPI(cl, 0x00);
            int pos = (q >= 1 ? c1 : 0) + (q >= 2 ? c2 : 0) + (q >= 3 ? c3 : 0);
            const int lb = (lane >> 2) * 16, ib = q * 32;
#pragma unroll
            for (int i = 0; i < 32; ++i) { const bool f = kk[i] >= pv; const bool w = f && pos < 16;
                LAS unsigned* pvv = w ? selk + lb + pos : (LAS unsigned*)dummy; LAS int* pii = w ? seli + lb + pos : (LAS int*)dummy;
                *pvv = kk[i]; asm volatile("" ::: "memory"); *pii = ib + i; asm volatile("" ::: "memory"); pos += (int)f; }
        }
        LDS_WAIT(); asm volatile("" ::: "memory");
        {
            const int g = lane >> 2, q = lane & 3; const LAS v4u* sk4 = (const LAS v4u*)(selk + g * 16);
            const v4u y0 = sk4[0], y1 = sk4[1], y2 = sk4[2], y3 = sk4[3], xm = sk4[q]; const v4u xi = *(const LAS v4u*)(seli + g * 16 + 4 * q);
            int rk[4] = {0, 0, 0, 0};
#define RK_BLK(Y, qp) do { const unsigned adj = (qp) < q ? 1u : 0u; _Pragma("unroll") for (int c = 0; c < 4; ++c) { const unsigned cmpv = xm[c] - adj; \
                _Pragma("unroll") for (int cp = 0; cp < 4; ++cp) rk[c] += (int)((Y)[cp] > cmpv); } } while (0)
            RK_BLK(y0, 0); RK_BLK(y1, 1); RK_BLK(y2, 2); RK_BLK(y3, 3);
            rk[1] += (int)(xm[0] == xm[1]); rk[2] += (int)(xm[0] == xm[2]) + (int)(xm[1] == xm[2]); rk[3] += (int)(xm[0] == xm[3]) + (int)(xm[1] == xm[3]) + (int)(xm[2] == xm[3]);
#pragma unroll
            for (int c = 0; c < 4; ++c) { ssp[g * 16 + rk[c]] = (f32x2){funkey(xm[c]), __int_as_float((int)xi[c])}; asm volatile("" ::: "memory"); }
        }
        LDS_WAIT(); asm volatile("" ::: "memory");
        const int hd = lane >> 3, q8 = lane & 7; unsigned k2[7]; float s2[7]; int e2[7];
        {   const LAS f32x2* pa = ssp + hd * 32; const LAS f32x2* pb = pa + 16;
#pragma unroll
            for (int s = 0; s < 7; ++s) { const unsigned code = ((s < 4 ? cw0 >> (8 * s) : cw1 >> (8 * (s - 4))) & 0xffu); const f32x2 ea = pa[code >> 4], eb = pb[code & 15u];
                s2[s] = ea[0] + eb[0]; k2[s] = fkey(s2[s]); e2[s] = __float_as_int(ea[1]) * 128 + __float_as_int(eb[1]); }
            k2[6] = q8 < 2 ? k2[6] : 0u;
            const float a0 = pa[0][0], a3 = pa[3][0], a15 = pa[15][0], b0 = pb[0][0], b3 = pb[3][0], b15 = pb[15][0];
            hi = fkey(a0 + b0); lo = umax_(fkey(a3 + b3), umax_(fkey(a0 + b15), fkey(a15 + b0))); }
        TOPK_BISECT(7, k2, (c += DPPI(c, 0xB1), c += DPPI(c, 0x4E), c += DPPI(c, 0x141)));
        {   const unsigned pv = lo; int cl = 0;
#pragma unroll
            for (int i = 0; i < 7; ++i) cl += (int)(k2[i] >= pv);
            const int q = lane & 3; const int c1 = DPPI(cl, 0x90), c2 = DPPI(cl, 0x40), c3 = DPPI(cl, 0x00);
            int qt = cl; qt += DPPI(qt, 0xB1); qt += DPPI(qt, 0x4E); const int lowq = DPPI(qt, 0x141);
            int pos = (q >= 1 ? c1 : 0) + (q >= 2 ? c2 : 0) + (q >= 3 ? c3 : 0) + ((lane & 4) ? lowq : 0);
            const int lb = hd * 16;
#pragma unroll
            for (int i = 0; i < 7; ++i) { const bool f = k2[i] >= pv; const bool w = f && pos < 16;
                LAS float* pg = w ? gate + lb + pos : dummy; LAS int* pe = w ? eid + lb + pos : (LAS int*)dummy;
                *pg = s2[i]; asm volatile("" ::: "memory"); *pe = e2[i]; asm volatile("" ::: "memory"); pos += (int)f; }
        }
        LDS_WAIT(); asm volatile("" ::: "memory");
        {   float gq[2]; int eq[2];
#pragma unroll
            for (int qq = 0; qq < 2; ++qq) { const int e = lane + 64 * qq; const float sc = gate[e]; float mx = sc;
                mx = fmaxf(mx, __shfl_xor(mx, 1)); mx = fmaxf(mx, __shfl_xor(mx, 2)); mx = fmaxf(mx, __shfl_xor(mx, 4)); mx = fmaxf(mx, __shfl_xor(mx, 8));
                const float ex = __expf(sc - mx); float sm = ex;
                sm += __shfl_xor(sm, 1); sm += __shfl_xor(sm, 2); sm += __shfl_xor(sm, 4); sm += __shfl_xor(sm, 8);
                eq[qq] = eid[e]; gq[qq] = ex / sm; }
            pgo = (size_t)t * 128 + lane; pee0 = eq[0]; pee1 = eq[1]; pg0 = gq[0]; pg1 = gq[1]; TK_LD1(psu0, Usc + eq[0]); TK_LD1(psu1, Usc + eq[1]); TK_LD1(psv0, Vsc + eq[0]); TK_LD1(psv1, Vsc + eq[1]); }
        LDS_WAIT(); asm volatile("" ::: "memory");
    }
    if (F.gw < TT) TOPK_FLUSH(0);
}

#define SL_DEC16(Rv, fv) do { _Pragma("unroll") for (int _k = 0; _k < 4; ++_k) { f32x2 _a, _b; PEER_CVT((Rv)[_k], _a, _b); fv[4 * _k] = _a[0]; fv[4 * _k + 1] = _a[1]; fv[4 * _k + 2] = _b[0]; fv[4 * _k + 3] = _b[1]; } } while (0)
#define SL_LOADE(EB, tt) do { EB[0] = *(const v2u*)(EID + (size_t)(tt) * 128 + lane * 2); } while (0)
#define SL_SPREAD(OUT4, IN2, slot) do { *(LAS v2u*)((slot) + lane * 8) = (IN2); __builtin_amdgcn_wave_barrier(); const LAS v4u* _sp = (const LAS v4u*)((slot) + g * 64); OUT4[0] = _sp[0]; OUT4[1] = _sp[1]; OUT4[2] = _sp[2]; OUT4[3] = _sp[3]; } while (0)
#define SL_LOADR(R, EB, tbl) do { v4u _e[4]; SL_SPREAD(_e, EB[0], slot_e); _Pragma("unroll") for (int _i = 0; _i < 16; ++_i) R[_i] = *(const v4u*)((tbl) + (_e[_i >> 2][_i & 3] * 128u + coff)); } while (0)
#ifndef PEER_TPW
#define PEER_TPW 32
#endif
__device__ __forceinline__ void phase_peer_u(Frame& F, const Args& A, int l, int rep = 0) {
    int tid_ = threadIdx.x; asm volatile("" : "+v"(tid_)); const int lane = tid_ & 63, g = lane >> 3, j = lane & 7;
    LAS unsigned char* slot_e = F.lds + F.wave * 2048;
    const unsigned char* Ut = F.ws + WS_U + (size_t)l * NEXP * DM; const unsigned char* X8 = F.ws + WS_X8; const unsigned* EID = (const unsigned*)(F.ws + WS_EID);
    float* PD = (float*)(F.ws + WS_PD);
    const int xcd = (int)(xb_xcc_id() & 7u);
    unsigned avail = 0xffffu;
    for (int kk = 0; kk < 16; ++kk) { const int s = (2 * xcd + kk) & 15; const unsigned coff = (unsigned)(s * (NEXP * 128) + j * 16);
        if (kk == 2) avail = queue_mask(F, F.ctl + CW_SQ + 16 * ((2 * l + 0) * 16) + 8 * rep, TT / (8 * PEER_TPW), tid_);
        if (!((avail >> s) & 1u)) continue;
        gu32* qs = F.ctl + CW_SQ + 16 * ((2 * l + 0) * 16 + s) + 8 * rep;
        for (int it = queue_next(F, qs); it < TT / (8 * PEER_TPW);) { unsigned nxt = 0u; if (tid_ == 0) nxt = __hip_atomic_fetch_add(qs, 1u, RLX_AGENT);
            const int tb = it * (8 * PEER_TPW) + F.wave * PEER_TPW;
            v4u R0[16], R1[16], XA[1], XB[1]; v2u EB[1];
#define SU_LOADX(XV, tt) do { XV[0] = *(const v4u*)(X8 + (size_t)(tt) * DM + s * 128 + j * 16); } while (0)
#define SU_COMP(R, XV, tt) do { float p[16]; \
                _Pragma("unroll") for (int _i = 0; _i < 16; ++_i) { int ia = 0; _Pragma("unroll") for (int _k = 0; _k < 4; ++_k) ia = __builtin_amdgcn_sdot4((int)R[_i][_k], (int)XV[0][_k], ia, false); \
                    float acc = (float)ia; asm volatile("" : "+v"(acc)); p[_i] = acc; } \
                float q8[8], q4[4], q2[2]; \
                { const bool b = (lane & 4) != 0; _Pragma("unroll") for (int _i = 0; _i < 8; ++_i) { const float keep = b ? p[_i + 8] : p[_i], send = b ? p[_i] : p[_i + 8]; q8[_i] = keep + __shfl_xor(send, 4); } } \
                { const bool b = (lane & 2) != 0; _Pragma("unroll") for (int _i = 0; _i < 4; ++_i) { const float keep = b ? q8[_i + 4] : q8[_i], send = b ? q8[_i] : q8[_i + 4]; q4[_i] = keep + __shfl_xor(send, 2); } } \
                { const bool b = (lane & 1) != 0; _Pragma("unroll") for (int _i = 0; _i < 2; ++_i) { const float keep = b ? q4[_i + 2] : q4[_i], send = b ? q4[_i] : q4[_i + 2]; q2[_i] = keep + __shfl_xor(send, 1); } } \
                *(f32x2*)(PD + ((size_t)s * TT + (tt)) * 128 + 2 * lane) = (f32x2){q2[0], q2[1]}; } while (0)
            SL_LOADE(EB, tb); SU_LOADX(XA, tb); SL_LOADR(R0, EB, Ut); SL_LOADE(EB, tb + 1); SU_LOADX(XB, tb + 1);
#pragma unroll 1
            for (int k = 0; k < PEER_TPW; k += 2) {
                SL_LOADR(R1, EB, Ut); if (k + 2 < PEER_TPW) SL_LOADE(EB, tb + k + 2);
                __builtin_amdgcn_sched_barrier(0);
                SU_COMP(R0, XA, tb + k); if (k + 2 < PEER_TPW) SU_LOADX(XA, tb + k + 2);
                __builtin_amdgcn_sched_barrier(0);
                if (k + 2 < PEER_TPW) SL_LOADR(R0, EB, Ut); if (k + 3 < PEER_TPW) SL_LOADE(EB, tb + k + 3);
                __builtin_amdgcn_sched_barrier(0);
                SU_COMP(R1, XB, tb + k + 1); if (k + 3 < PEER_TPW) SU_LOADX(XB, tb + k + 3);
                __builtin_amdgcn_sched_barrier(0);
            }
            it = queue_pass(F, nxt);
        }
    }
}
__device__ __forceinline__ void phase_peer_w(Frame& F, const Args& A, int l) {
    int tid_ = threadIdx.x; asm volatile("" : "+v"(tid_)); const int lane = tid_ & 63;
    const float* PD = (const float*)(F.ws + WS_PD); const float* G = (const float*)(F.ws + WS_GATEV); const float* US = (const float*)(F.ws + WS_USCT); float* W = (float*)(F.ws + WS_WT);
    struct In { f32x2 p[16], us, gv; float xs; };
    auto fetch = [&](int t, In& r) {
#pragma unroll
        for (int s = 0; s < 16; ++s) r.p[s] = *(const f32x2*)(PD + ((size_t)s * TT + t) * 128 + 2 * lane);
        r.us = *(const f32x2*)(US + (size_t)t * 128 + 2 * lane); r.gv = *(const f32x2*)(G + (size_t)t * 128 + 2 * lane); r.xs = ((const float*)(F.ws + WS_XS))[t]; };
    auto one = [&](int t, const In& r) { f32x2 a = (f32x2){0.f, 0.f};
#pragma unroll
        for (int s = 0; s < 16; ++s) a += r.p[s];
        const float h0 = a[0] * r.us[0] * r.xs, h1 = a[1] * r.us[1] * r.xs;
        *(f32x2*)(W + (size_t)t * 128 + 2 * lane) = (f32x2){r.gv[0] * 0.5f * h0 * (1.0f + erff(h0 * 0.7071067811865476f)), r.gv[1] * 0.5f * h1 * (1.0f + erff(h1 * 0.7071067811865476f))}; };
    for (int ta = F.gw; ta < TT; ta += 2 * F.ngw) { const int tb = ta + F.ngw < TT ? ta + F.ngw : ta;
        In ra, rb; fetch(ta, ra); fetch(tb, rb); one(ta, ra); one(tb, rb); }
}
__device__ __forceinline__ void phase_peer_v(Frame& F, const Args& A, int l, int rep = 0) {
    int tid_ = threadIdx.x; asm volatile("" : "+v"(tid_)); const int lane = tid_ & 63, g = lane >> 3, j = lane & 7;
    LAS unsigned char* slot_e = F.lds + F.wave * 2048; LAS unsigned char* slot_w = slot_e + 512;
    const unsigned char* Vt = F.ws + WS_V + (size_t)l * NEXP * DM; const unsigned* EID = (const unsigned*)(F.ws + WS_EID); const float* W = (const float*)(F.ws + WS_WT);
    bf16* YP = (bf16*)(F.ws + WS_Y);
    const int xcd = (int)(xb_xcc_id() & 7u);
    unsigned avail = 0xffffu;
    for (int kk = 0; kk < 16; ++kk) { const int s = (2 * xcd + kk) & 15; const unsigned coff = (unsigned)(s * (NEXP * 128) + j * 16);
        if (kk == 2) avail = queue_mask(F, F.ctl + CW_SQ + 16 * ((2 * l + 1) * 16) + 8 * rep, TT / (8 * PEER_TPW), tid_);
        if (!((avail >> s) & 1u)) continue;
        gu32* qs = F.ctl + CW_SQ + 16 * ((2 * l + 1) * 16 + s) + 8 * rep;
        for (int it = queue_next(F, qs); it < TT / (8 * PEER_TPW);) { unsigned nxt = 0u; if (tid_ == 0) nxt = __hip_atomic_fetch_add(qs, 1u, RLX_AGENT);
            const int tb = it * (8 * PEER_TPW) + F.wave * PEER_TPW;
            v4u R0[16], R1[16]; v2u EB[1], WA[1], WB[1];
#define SV_LOADW(WV, tt) do { WV[0] = *(const v2u*)(W + (size_t)(tt) * 128 + lane * 2); } while (0)
#define SV_DEC(Rv, fv) do { _Pragma("unroll") for (int _k = 0; _k < 4; ++_k) { PEER_CVT((Rv)[_k], fv[2 * _k], fv[2 * _k + 1]); } } while (0)
#define SV_COMP(R, WV, tt) do { f32x2 y2[8]; _Pragma("unroll") for (int _k = 0; _k < 8; ++_k) y2[_k] = (f32x2){0.f, 0.f}; \
                v4u _w4[4]; SL_SPREAD(_w4, WV[0], slot_w); \
                f32x2 fd[2][8]; SV_DEC(R[0], fd[0]);     \
                _Pragma("unroll") for (int _i = 0; _i < 16; ++_i) { const float wi = __uint_as_float(_w4[_i >> 2][_i & 3]); const f32x2 w2 = (f32x2){wi, wi}; \
                    if (_i + 1 < 16) SV_DEC(R[(_i + 1) & 15], fd[(_i + 1) & 1]); \
                    _Pragma("unroll") for (int _k = 0; _k < 8; ++_k) y2[_k] = w2 * fd[_i & 1][_k] + y2[_k]; \
                    asm volatile("" : "+v"(y2[0]), "+v"(y2[1]), "+v"(y2[2]), "+v"(y2[3]), "+v"(y2[4]), "+v"(y2[5]), "+v"(y2[6]), "+v"(y2[7])); } \
                float y[16]; _Pragma("unroll") for (int _k = 0; _k < 8; ++_k) { y[2 * _k] = y2[_k][0]; y[2 * _k + 1] = y2[_k][1]; } \
                float z8[8], z4[4], z2[2]; \
                { const bool b = (lane & 32) != 0; _Pragma("unroll") for (int _i = 0; _i < 8; ++_i) { const float keep = b ? y[_i + 8] : y[_i], send = b ? y[_i] : y[_i + 8]; z8[_i] = keep + __shfl_xor(send, 32); } } \
                { const bool b = (lane & 16) != 0; _Pragma("unroll") for (int _i = 0; _i < 4; ++_i) { const float keep = b ? z8[_i + 4] : z8[_i], send = b ? z8[_i] : z8[_i + 4]; z4[_i] = keep + __shfl_xor(send, 16); } } \
                { const bool b = (lane & 8) != 0; _Pragma("unroll") for (int _i = 0; _i < 2; ++_i) { const float keep = b ? z4[_i + 2] : z4[_i], send = b ? z4[_i] : z4[_i + 2]; z2[_i] = keep + __shfl_xor(send, 8); } } \
                *(unsigned*)(YP + (size_t)(tt) * DM + s * 128 + j * 16 + 2 * g) = pk2(z2[0], z2[1]); } while (0)
            SL_LOADE(EB, tb); SV_LOADW(WA, tb); SL_LOADR(R0, EB, Vt); SL_LOADE(EB, tb + 1); SV_LOADW(WB, tb + 1);
#pragma unroll 1
            for (int k = 0; k < PEER_TPW; k += 2) {
                SL_LOADR(R1, EB, Vt); if (k + 2 < PEER_TPW) SL_LOADE(EB, tb + k + 2);
                __builtin_amdgcn_sched_barrier(0);
                SV_COMP(R0, WA, tb + k); if (k + 2 < PEER_TPW) SV_LOADW(WA, tb + k + 2);
                __builtin_amdgcn_sched_barrier(0);
                if (k + 2 < PEER_TPW) SL_LOADR(R0, EB, Vt); if (k + 3 < PEER_TPW) SL_LOADE(EB, tb + k + 3);
                __builtin_amdgcn_sched_barrier(0);
                SV_COMP(R1, WB, tb + k + 1); if (k + 3 < PEER_TPW) SV_LOADW(WB, tb + k + 3);
                __builtin_amdgcn_sched_barrier(0);
            }
            it = queue_pass(F, nxt);
        }
    }
}
template <bool FOLD = false> __device__ __forceinline__ void ln2_range(Frame& F, const Args& A, int l, int t_first, int t_step, int t_end) {
    int tid_ = threadIdx.x; asm volatile("" : "+v"(tid_)); const int lane = tid_ & 63;
    const bf16* YP = (const bf16*)(F.ws + WS_Y); const bf16* X1 = (const bf16*)(F.ws + WS_X1); bf16* Xn = (bf16*)(F.ws + WS_X); const float* g2 = A.in[21] + l * DM; const float* b2 = A.in[22] + l * DM;
    float gg[32], bb[32];
#pragma unroll
    for (int jj = 0; jj < 4; ++jj) { const int c0 = jj * 512 + lane * 8; const f32x4 ga = *(const f32x4*)(g2 + c0), gb = *(const f32x4*)(g2 + c0 + 4), ba = *(const f32x4*)(b2 + c0), bc = *(const f32x4*)(b2 + c0 + 4);
#pragma unroll
        for (int i = 0; i < 4; ++i) { gg[8 * jj + i] = ga[i]; gg[8 * jj + 4 + i] = gb[i]; bb[8 * jj + i] = ba[i]; bb[8 * jj + 4 + i] = bc[i]; } }
    for (int ta = t_first; ta < t_end; ta += 2 * t_step) { const int tb = ta + t_step < t_end ? ta + t_step : ta;
        v4u ya[4], xa[4], yb[4], xb[4];
#pragma unroll
        for (int jj = 0; jj < 4; ++jj) { const int c0 = jj * 512 + lane * 8; ya[jj] = *(const v4u*)(YP + (size_t)ta * DM + c0); if constexpr (!FOLD) xa[jj] = *(const v4u*)(X1 + (size_t)ta * DM + c0); else xa[jj] = (v4u){0u, 0u, 0u, 0u}; }
#pragma unroll
        for (int jj = 0; jj < 4; ++jj) { const int c0 = jj * 512 + lane * 8; yb[jj] = *(const v4u*)(YP + (size_t)tb * DM + c0); if constexpr (!FOLD) xb[jj] = *(const v4u*)(X1 + (size_t)tb * DM + c0); else xb[jj] = (v4u){0u, 0u, 0u, 0u}; }
        auto one = [&](int t, const v4u (&yw)[4], const v4u (&xw)[4]) {
            float v[32];
#pragma unroll
            for (int jj = 0; jj < 4; ++jj) { float y[8], x[8]; UNPACK8(yw[jj], y, 0); UNPACK8(xw[jj], x, 0);
#pragma unroll
                for (int i = 0; i < 8; ++i) v[8 * jj + i] = FOLD ? y[i] : DN_ALPHA * x[i] + y[i]; }
            float sm = 0.f;
#pragma unroll
            for (int i = 0; i < 32; ++i) sm += v[i];
            const float mean = wave_sum(sm) * (1.0f / DM); float qq = 0.f;
#pragma unroll
            for (int i = 0; i < 32; ++i) { v[i] -= mean; qq += v[i] * v[i]; }
            const float rstd = 1.0f / sqrtf(wave_sum(qq) * (1.0f / DM) + EPS);
#pragma unroll
            for (int jj = 0; jj < 4; ++jj) { const int c0 = jj * 512 + lane * 8; float o[8];
#pragma unroll
                for (int i = 0; i < 8; ++i) o[i] = v[8 * jj + i] * rstd * gg[8 * jj + i] + bb[8 * jj + i];
                if (l == DEPTH - 1) { float* op = A.out + (size_t)t * DM + c0; *(f32x4*)op = (f32x4){o[0], o[1], o[2], o[3]}; *(f32x4*)(op + 4) = (f32x4){o[4], o[5], o[6], o[7]}; }
                else *(v4u*)(Xn + (size_t)t * DM + c0) = PACK8(o, 0); } };
        one(ta, ya, xa); one(tb, yb, xb);
    }
}

__device__ __forceinline__ void phase_ln2(Frame& F, const Args& A, int l) { ln2_range(F, A, l, F.gw, F.ngw, TT); }

#ifndef PF_NT
#define PF_NT 0
#endif
#if PF_NT
#define PF_YST(p, v) __builtin_nontemporal_store((v), (p))
#else
#define PF_YST(p, v) (*(p) = (v))
#endif
#ifndef PF_XSTAGE
#define PF_XSTAGE 1
#endif
#ifndef PF_FOLD
#define PF_FOLD 0
#endif
#ifndef PF_LN2
#define PF_LN2 1
#endif
#ifndef PF_DYN
#define PF_DYN 0
#endif
#ifndef PF_SYNC
#define PF_SYNC 0
#endif
#ifndef PF_TPW
#define PF_TPW 12
#endif
static_assert(!PF_FOLD || PF_LN2, "the folded residual needs the in-chunk LN2");
constexpr int PF_CT = 8 * PF_TPW, PF_NCH = TT / PF_CT, PF_PER_XCD = PF_NCH / 8;
static_assert(TT % PF_CT == 0 && PF_NCH % 8 == 0 && (PF_TPW % 2) == 0, "PEER chunking");
__device__ __forceinline__ void peer_fused_chunk(Frame& F, const Args& A, int l, int chunk) {
    int tid_ = threadIdx.x; asm volatile("" : "+v"(tid_)); const int lane = tid_ & 63, g = lane >> 3, j = lane & 7;
    const unsigned char* Ut = F.ws + WS_U + (size_t)l * NEXP * DM; const unsigned char* Vt = F.ws + WS_V + (size_t)l * NEXP * DM; const unsigned char* X8 = F.ws + WS_X8;
    const unsigned* EID = (const unsigned*)(F.ws + WS_EID); bf16* YP = (bf16*)(F.ws + WS_Y);
    LAS unsigned char* ids = F.lds + F.wave * 16384; LAS unsigned char* wl = ids + PF_TPW * 512;
    const int tb0 = chunk * PF_CT + F.wave * PF_TPW;
#if PF_SYNC
    unsigned* const psync = (unsigned*)(F.ctl + CW_SQ + 16 * ((2 * l) * 16 + (int)(xb_xcc_id() & 7u)));
    const unsigned pnw = 8u * ((volatile LAS unsigned*)(F.lds + MISC_OFF))[0]; unsigned ptarget = 0u; const bool pon = (int)gridDim.x == PF_NCH && pnw != 0u;
#define PF_PACE() do { if (pon) { ptarget += pnw; if (lane == 0) (void)xb_add(psync, 1u); \
        for (int _i = 0; _i < 256; ++_i) { if ((unsigned)__builtin_amdgcn_readfirstlane((int)xb_ld(psync)) >= ptarget) break; __builtin_amdgcn_s_sleep(1); } } } while (0)
#else
#define PF_PACE() do {} while (0)
#endif
    {   v2u e[PF_TPW];
#pragma unroll
        for (int k = 0; k < PF_TPW; ++k) e[k] = *(const v2u*)(EID + (size_t)(tb0 + k) * 128 + lane * 2);
#pragma unroll
        for (int k = 0; k < PF_TPW; ++k) *(LAS v2u*)(ids + k * 512 + lane * 8) = e[k];
        __builtin_amdgcn_wave_barrier(); }
    v4u R0[16], R1[16];
#define PF_LOADR(R, k, s_, tbl) do { const LAS v4u* _ip = (const LAS v4u*)(ids + (k) * 512 + g * 64); const v4u _e0 = _ip[0], _e1 = _ip[1], _e2 = _ip[2], _e3 = _ip[3]; const unsigned _co = (unsigned)(s_) * (unsigned)(NEXP * 128) + (unsigned)(j * 16); \
        R[0] = *(const v4u*)((tbl) + (_e0[0] * 128u + _co)); R[1] = *(const v4u*)((tbl) + (_e0[1] * 128u + _co)); R[2] = *(const v4u*)((tbl) + (_e0[2] * 128u + _co)); R[3] = *(const v4u*)((tbl) + (_e0[3] * 128u + _co)); \
        R[4] = *(const v4u*)((tbl) + (_e1[0] * 128u + _co)); R[5] = *(const v4u*)((tbl) + (_e1[1] * 128u + _co)); R[6] = *(const v4u*)((tbl) + (_e1[2] * 128u + _co)); R[7] = *(const v4u*)((tbl) + (_e1[3] * 128u + _co)); \
        R[8] = *(const v4u*)((tbl) + (_e2[0] * 128u + _co)); R[9] = *(const v4u*)((tbl) + (_e2[1] * 128u + _co)); R[10] = *(const v4u*)((tbl) + (_e2[2] * 128u + _co)); R[11] = *(const v4u*)((tbl) + (_e2[3] * 128u + _co)); \
        R[12] = *(const v4u*)((tbl) + (_e3[0] * 128u + _co)); R[13] = *(const v4u*)((tbl) + (_e3[1] * 128u + _co)); R[14] = *(const v4u*)((tbl) + (_e3[2] * 128u + _co)); R[15] = *(const v4u*)((tbl) + (_e3[3] * 128u + _co)); } while (0)
#pragma unroll
    for (int k = 0; k < PF_TPW; ++k) *(LAS f32x2*)(wl + k * 512 + lane * 8) = (f32x2){0.f, 0.f};
    {   v4u XA, XB;
#if PF_XSTAGE
        LAS unsigned char* xst = wl + PF_TPW * 512;
        static_assert(PF_TPW <= 16 && 2 * PF_TPW * 512 + 2 * PF_TPW * 128 <= 16384, "x stage");
        v4u PA, PB;
        const int tkb = 8 + g < PF_TPW ? 8 + g : PF_TPW - 1;
#define PF_XREQ(s_) do { PA = *(const v4u*)(X8 + (size_t)(tb0 + g) * DM + (s_) * 128 + j * 16); PB = *(const v4u*)(X8 + (size_t)(tb0 + tkb) * DM + (s_) * 128 + j * 16); } while (0)
#define PF_XPUT(s_) do { LAS unsigned char* _xb = xst + ((s_) & 1) * (PF_TPW * 128); *(LAS v4u*)(_xb + g * 128 + j * 16) = PA; *(LAS v4u*)(_xb + tkb * 128 + j * 16) = PB; } while (0)
#define PF_LOADX(XV, k, s_) do { XV = *(const LAS v4u*)(xst + ((s_) & 1) * (PF_TPW * 128) + (k) * 128 + j * 16); } while (0)
        PF_XREQ(0); PF_XPUT(0); PF_XREQ(1);
#else
#define PF_XREQ(s_) do {} while (0)
#define PF_XPUT(s_) do {} while (0)
#define PF_LOADX(XV, k, s_) do { XV = *(const v4u*)(X8 + (size_t)(tb0 + (k)) * DM + (s_) * 128 + j * 16); } while (0)
#endif
#define PF_UCOMP(R, XV, k) do { LAS f32x2* _ap = (LAS f32x2*)(wl + (k) * 512 + lane * 8); const f32x2 _a = *_ap; float p[16]; \
            _Pragma("unroll") for (int _i = 0; _i < 16; ++_i) { int ia = 0; _Pragma("unroll") for (int _k = 0; _k < 4; ++_k) ia = __builtin_amdgcn_sdot4((int)R[_i][_k], (int)XV[_k], ia, false); \
                float a_ = (float)ia; asm volatile("" : "+v"(a_)); p[_i] = a_; } \
            float q8[8], q4[4], q2[2]; \
              \
            { const bool b = (lane & 4) != 0; _Pragma("unroll") for (int _i = 0; _i < 8; ++_i) { const float keep = b ? p[_i + 8] : p[_i], send = b ? p[_i] : p[_i + 8]; q8[_i] = keep + __int_as_float(__builtin_amdgcn_update_dpp(0, __float_as_int(send), 0x141, 0xf, 0xf, true)); } } \
            { const bool b = (lane & 2) != 0; _Pragma("unroll") for (int _i = 0; _i < 4; ++_i) { const float keep = b ? q8[_i + 4] : q8[_i], send = b ? q8[_i] : q8[_i + 4]; q4[_i] = keep + __int_as_float(__builtin_amdgcn_update_dpp(0, __float_as_int(send), 0x4E, 0xf, 0xf, true)); } } \
            { const bool b = (lane & 1) != 0; _Pragma("unroll") for (int _i = 0; _i < 2; ++_i) { const float keep = b ? q4[_i + 2] : q4[_i], send = b ? q4[_i] : q4[_i + 2]; q2[_i] = keep + __int_as_float(__builtin_amdgcn_update_dpp(0, __float_as_int(send), 0xB1, 0xf, 0xf, true)); } } \
            *_ap = (f32x2){_a[0] + q2[0], _a[1] + q2[1]}; } while (0)
        PF_LOADR(R0, 0, 0, Ut); PF_LOADX(XA, 0, 0);
#pragma unroll 1
        for (int s = 0, k = 0; s < 16;) {
            if (PF_SYNC && k == 0 && s != 0 && (s % (PF_SYNC ? PF_SYNC : 1)) == 0) PF_PACE();
            if (PF_XSTAGE && k == PF_TPW - 2 && s + 1 < 16) PF_XPUT(s + 1);
            if (PF_XSTAGE && k == 0 && s != 0 && s + 1 < 16) PF_XREQ(s + 1);
            PF_LOADR(R1, k + 1, s, Ut); PF_LOADX(XB, k + 1, s);
            __builtin_amdgcn_sched_barrier(0);
            PF_UCOMP(R0, XA, k);
            __builtin_amdgcn_sched_barrier(0);
            const int k2 = k + 2 < PF_TPW ? k + 2 : 0, s2 = k + 2 < PF_TPW ? s : s + 1;
            if (s2 < 16) { PF_LOADR(R0, k2, s2, Ut); PF_LOADX(XA, k2, s2); }
            __builtin_amdgcn_sched_barrier(0);
            PF_UCOMP(R1, XB, k + 1);
            __builtin_amdgcn_sched_barrier(0);
            k = k2; s = s2;
        }
    }
    {   const float* G = (const float*)(F.ws + WS_GATEV); const float* US = (const float*)(F.ws + WS_USCT); const float* XS = (const float*)(F.ws + WS_XS);
        {   constexpr int k0 = 0; f32x2 us[PF_TPW], gv[PF_TPW]; float xs[PF_TPW];
#pragma unroll
            for (int u = 0; u < PF_TPW; ++u) { us[u] = *(const f32x2*)(US + (size_t)(tb0 + k0 + u) * 128 + 2 * lane); gv[u] = *(const f32x2*)(G + (size_t)(tb0 + k0 + u) * 128 + 2 * lane); xs[u] = XS[tb0 + k0 + u]; }
#pragma unroll
            for (int u = 0; u < PF_TPW; ++u) { LAS f32x2* ap = (LAS f32x2*)(wl + (k0 + u) * 512 + lane * 8); const f32x2 a = *ap; const float h0 = a[0] * us[u][0] * xs[u], h1 = a[1] * us[u][1] * xs[u];
                *ap = (f32x2){gv[u][0] * 0.5f * h0 * (1.0f + erff(h0 * 0.7071067811865476f)), gv[u][1] * 0.5f * h1 * (1.0f + erff(h1 * 0.7071067811865476f))}; } }
        __builtin_amdgcn_wave_barrier(); }
    {
#define PF_LOADXP(XP, k, s_) do {} while (0)
        LAS unsigned char* xvs = wl + PF_TPW * 512; v4u Q[3];
        static_assert(!PF_FOLD || PF_TPW * 256 == 3 * 64 * 16, "x1 stage: 3 requests of 64 x 16 B per slice");
#define PF_VREQ(s_) do { if (PF_FOLD) { _Pragma("unroll") for (int _i = 0; _i < 3; ++_i) { const int _c = _i * 64 + lane; Q[_i] = *(const v4u*)((const bf16*)(F.ws + WS_X1) + (size_t)(tb0 + (_c >> 4)) * DM + (s_) * 128 + (_c & 15) * 8); } } } while (0)
#define PF_VPUT() do { if (PF_FOLD) { _Pragma("unroll") for (int _i = 0; _i < 3; ++_i) *(LAS v4u*)(xvs + (_i * 64 + lane) * 16) = Q[_i]; } } while (0)
#define PF_VCOMP(R, XP, k, s_) do { unsigned _xp = 0u; if (PF_FOLD) _xp = *(const LAS unsigned*)(xvs + (k) * 256 + j * 32 + g * 4); f32x2 y2[8]; _Pragma("unroll") for (int _k = 0; _k < 8; ++_k) y2[_k] = (f32x2){0.f, 0.f}; \
            const LAS v4u* _wp = (const LAS v4u*)(wl + (k) * 512 + g * 64); v4u _w4[4]; _w4[0] = _wp[0]; _w4[1] = _wp[1]; _w4[2] = _wp[2]; _w4[3] = _wp[3]; \
            f32x2 fd[2][8]; SV_DEC(R[0], fd[0]); \
            _Pragma("unroll") for (int _i = 0; _i < 16; ++_i) { const float wi = __uint_as_float(_w4[_i >> 2][_i & 3]); const f32x2 w2 = (f32x2){wi, wi}; \
                if (_i + 1 < 16) SV_DEC(R[(_i + 1) & 15], fd[(_i + 1) & 1]); \
                _Pragma("unroll") for (int _k = 0; _k < 8; ++_k) y2[_k] = w2 * fd[_i & 1][_k] + y2[_k]; \
                asm volatile("" : "+v"(y2[0]), "+v"(y2[1]), "+v"(y2[2]), "+v"(y2[3]), "+v"(y2[4]), "+v"(y2[5]), "+v"(y2[6]), "+v"(y2[7])); } \
            float y[16]; _Pragma("unroll") for (int _k = 0; _k < 8; ++_k) { y[2 * _k] = y2[_k][0]; y[2 * _k + 1] = y2[_k][1]; } \
            float z8[8], z4[4], z2[2]; \
              \
            _Pragma("unroll") for (int _i = 0; _i < 8; ++_i) { const auto _r = __builtin_amdgcn_permlane32_swap(__float_as_uint(y[_i]), __float_as_uint(y[_i + 8]), false, false); z8[_i] = __uint_as_float(_r[0]) + __uint_as_float(_r[1]); } \
            _Pragma("unroll") for (int _i = 0; _i < 4; ++_i) { const auto _r = __builtin_amdgcn_permlane16_swap(__float_as_uint(z8[_i]), __float_as_uint(z8[_i + 4]), false, false); z4[_i] = __uint_as_float(_r[0]) + __uint_as_float(_r[1]); } \
            { const bool b = (lane & 8) != 0; _Pragma("unroll") for (int _i = 0; _i < 2; ++_i) { const float keep = b ? z4[_i + 2] : z4[_i], send = b ? z4[_i] : z4[_i + 2]; z2[_i] = keep + __int_as_float(__builtin_amdgcn_update_dpp(0, __float_as_int(send), 0x128, 0xf, 0xf, true)); } }     \
            if (PF_FOLD) { z2[0] += DN_ALPHA * __uint_as_float(_xp << 16); z2[1] += DN_ALPHA * __uint_as_float(_xp & 0xffff0000u); } \
            PF_YST((unsigned*)(YP + (size_t)(tb0 + (k)) * DM + (s_) * 128 + j * 16 + 2 * g), pk2(z2[0], z2[1])); } while (0)
        unsigned XP0 = 0u, XP1 = 0u;
        PF_VREQ(0); PF_VPUT(); PF_VREQ(1);
        PF_LOADR(R0, 0, 0, Vt); PF_LOADXP(XP0, 0, 0);
#pragma unroll 1
        for (int s = 0, k = 0; s < 16;) {
            if (PF_SYNC && k == 0 && (s % (PF_SYNC ? PF_SYNC : 1)) == 0) PF_PACE();
            if (PF_FOLD && k == 0 && s != 0) { PF_VPUT(); if (s + 1 < 16) PF_VREQ(s + 1); }
            PF_LOADR(R1, k + 1, s, Vt); PF_LOADXP(XP1, k + 1, s);
            __builtin_amdgcn_sched_barrier(0);
            PF_VCOMP(R0, XP0, k, s);
            __builtin_amdgcn_sched_barrier(0);
            const int k2 = k + 2 < PF_TPW ? k + 2 : 0, s2 = k + 2 < PF_TPW ? s : s + 1;
            if (s2 < 16) { PF_LOADR(R0, k2, s2, Vt); PF_LOADXP(XP0, k2, s2); }
            __builtin_amdgcn_sched_barrier(0);
            PF_VCOMP(R1, XP1, k + 1, s);
            __builtin_amdgcn_sched_barrier(0);
            k = k2; s = s2;
        }
    }
#if PF_LN2
    asm volatile("s_waitcnt vmcnt(0)" ::: "memory");
    ln2_range<PF_FOLD != 0>(F, A, l, tb0, 1, tb0 + PF_TPW);
#endif
}
__device__ __forceinline__ void peer_fused_chunk_dyn(Frame& F, const Args& A, int l, int chunk) {
    int tid_ = threadIdx.x; asm volatile("" : "+v"(tid_)); const int lane = tid_ & 63, g = lane >> 3, j = lane & 7;
    const unsigned char* Ut = F.ws + WS_U + (size_t)l * NEXP * DM; const unsigned char* Vt = F.ws + WS_V + (size_t)l * NEXP * DM; const unsigned char* X8 = F.ws + WS_X8;
    const unsigned* EID = (const unsigned*)(F.ws + WS_EID); bf16* YP = (bf16*)(F.ws + WS_Y);
    LAS unsigned char* ids = F.lds; LAS unsigned char* wl = ids + PF_CT * 512;
    volatile LAS unsigned* dctr = (volatile LAS unsigned*)(F.lds + MISC_OFF) + 6;
    const int tb0 = chunk * PF_CT, kw0 = F.wave * PF_TPW;
    if (tid_ == 0) { dctr[0] = 0u; dctr[1] = 0u; }
    {   v2u e[PF_TPW];
#pragma unroll
        for (int k = 0; k < PF_TPW; ++k) e[k] = *(const v2u*)(EID + (size_t)(tb0 + kw0 + k) * 128 + lane * 2);
#pragma unroll
        for (int k = 0; k < PF_TPW; ++k) *(LAS v2u*)(ids + (kw0 + k) * 512 + lane * 8) = e[k];
        __builtin_amdgcn_wave_barrier(); }
    v4u R0[16], R1[16];
#define PD_LOADR(R, k, s_, tbl) do { const LAS v4u* _ip = (const LAS v4u*)(ids + (k) * 512 + g * 64); const v4u _e0 = _ip[0], _e1 = _ip[1], _e2 = _ip[2], _e3 = _ip[3]; const unsigned _co = (unsigned)(s_) * (unsigned)(NEXP * 128) + (unsigned)(j * 16); \
        R[0] = *(const v4u*)((tbl) + (_e0[0] * 128u + _co)); R[1] = *(const v4u*)((tbl) + (_e0[1] * 128u + _co)); R[2] = *(const v4u*)((tbl) + (_e0[2] * 128u + _co)); R[3] = *(const v4u*)((tbl) + (_e0[3] * 128u + _co)); \
        R[4] = *(const v4u*)((tbl) + (_e1[0] * 128u + _co)); R[5] = *(const v4u*)((tbl) + (_e1[1] * 128u + _co)); R[6] = *(const v4u*)((tbl) + (_e1[2] * 128u + _co)); R[7] = *(const v4u*)((tbl) + (_e1[3] * 128u + _co)); \
        R[8] = *(const v4u*)((tbl) + (_e2[0] * 128u + _co)); R[9] = *(const v4u*)((tbl) + (_e2[1] * 128u + _co)); R[10] = *(const v4u*)((tbl) + (_e2[2] * 128u + _co)); R[11] = *(const v4u*)((tbl) + (_e2[3] * 128u + _co)); \
        R[12] = *(const v4u*)((tbl) + (_e3[0] * 128u + _co)); R[13] = *(const v4u*)((tbl) + (_e3[1] * 128u + _co)); R[14] = *(const v4u*)((tbl) + (_e3[2] * 128u + _co)); R[15] = *(const v4u*)((tbl) + (_e3[3] * 128u + _co)); } while (0)
#pragma unroll
    for (int k = 0; k < PF_TPW; ++k) *(LAS f32x2*)(wl + (kw0 + k) * 512 + lane * 8) = (f32x2){0.f, 0.f};
    __syncthreads();
    {   v4u XA, XB;
#define PD_LOADX(XV, k, s_) do { XV = *(const v4u*)(X8 + (size_t)(tb0 + (k)) * DM + (s_) * 128 + j * 16); } while (0)
#define PD_UCOMP(R, XV, k) do { float p[16]; \
            _Pragma("unroll") for (int _i = 0; _i < 16; ++_i) { int ia = 0; _Pragma("unroll") for (int _k = 0; _k < 4; ++_k) ia = __builtin_amdgcn_sdot4((int)R[_i][_k], (int)XV[_k], ia, false); \
                float a_ = (float)ia; asm volatile("" : "+v"(a_)); p[_i] = a_; } \
            float q8[8], q4[4], q2[2]; \
            { const bool b = (lane & 4) != 0; _Pragma("unroll") for (int _i = 0; _i < 8; ++_i) { const float keep = b ? p[_i + 8] : p[_i], send = b ? p[_i] : p[_i + 8]; q8[_i] = keep + __shfl_xor(send, 4); } } \
            { const bool b = (lane & 2) != 0; _Pragma("unroll") for (int _i = 0; _i < 4; ++_i) { const float keep = b ? q8[_i + 4] : q8[_i], send = b ? q8[_i] : q8[_i + 4]; q4[_i] = keep + __shfl_xor(send, 2); } } \
            { const bool b = (lane & 1) != 0; _Pragma("unroll") for (int _i = 0; _i < 2; ++_i) { const float keep = b ? q4[_i + 2] : q4[_i], send = b ? q4[_i] : q4[_i + 2]; q2[_i] = keep + __shfl_xor(send, 1); } } \
            LAS float* _ap = (LAS float*)(wl + (k) * 512 + lane * 8); (void)__hip_atomic_fetch_add(_ap, q2[0], __ATOMIC_RELAXED, __HIP_MEMORY_SCOPE_WORKGROUP); (void)__hip_atomic_fetch_add(_ap + 1, q2[1], __ATOMIC_RELAXED, __HIP_MEMORY_SCOPE_WORKGROUP); } while (0)
#define PD_GRAB(c) ({ unsigned _t = 0u; if (lane == 0) _t = __hip_atomic_fetch_add((LAS unsigned*)(c), 1u, __ATOMIC_RELAXED, __HIP_MEMORY_SCOPE_WORKGROUP); (int)__builtin_amdgcn_readfirstlane((int)_t); })
        constexpr int NP = PF_CT / 2, NI = 16 * NP;
        int i0 = PD_GRAB(dctr);
        if (i0 < NI) { const int s = i0 / NP, pr = i0 - s * NP; PD_LOADR(R0, 2 * pr, s, Ut); PD_LOADX(XA, 2 * pr, s); }
#pragma unroll 1
        while (i0 < NI) { const int s = i0 / NP, pr = i0 - s * NP;
            PD_LOADR(R1, 2 * pr + 1, s, Ut); PD_LOADX(XB, 2 * pr + 1, s);
            const int i1 = PD_GRAB(dctr);
            __builtin_amdgcn_sched_barrier(0);
            PD_UCOMP(R0, XA, 2 * pr);
            __builtin_amdgcn_sched_barrier(0);
            if (i1 < NI) { const int s1 = i1 / NP, pr1 = i1 - s1 * NP; PD_LOADR(R0, 2 * pr1, s1, Ut); PD_LOADX(XA, 2 * pr1, s1); }
            __builtin_amdgcn_sched_barrier(0);
            PD_UCOMP(R1, XB, 2 * pr + 1);
            __builtin_amdgcn_sched_barrier(0);
            i0 = i1;
        }
    }
    __syncthreads();
    {   const float* G = (const float*)(F.ws + WS_GATEV); const float* US = (const float*)(F.ws + WS_USCT); const float* XS = (const float*)(F.ws + WS_XS);
#pragma unroll 1
        for (int k0 = 0; k0 < PF_TPW; k0 += 4) { f32x2 us[4], gv[4]; float xs[4];
#pragma unroll
            for (int u = 0; u < 4; ++u) { us[u] = *(const f32x2*)(US + (size_t)(tb0 + kw0 + k0 + u) * 128 + 2 * lane); gv[u] = *(const f32x2*)(G + (size_t)(tb0 + kw0 + k0 + u) * 128 + 2 * lane); xs[u] = XS[tb0 + kw0 + k0 + u]; }
#pragma unroll
            for (int u = 0; u < 4; ++u) { LAS f32x2* ap = (LAS f32x2*)(wl + (kw0 + k0 + u) * 512 + lane * 8); const f32x2 a = *ap; const float h0 = a[0] * us[u][0] * xs[u], h1 = a[1] * us[u][1] * xs[u];
                *ap = (f32x2){gv[u][0] * 0.5f * h0 * (1.0f + erff(h0 * 0.7071067811865476f)), gv[u][1] * 0.5f * h1 * (1.0f + erff(h1 * 0.7071067811865476f))}; } }
    }
    __syncthreads();
    {
#define PD_VCOMP(R, k, s_) do { f32x2 y2[8]; _Pragma("unroll") for (int _k = 0; _k < 8; ++_k) y2[_k] = (f32x2){0.f, 0.f}; \
            const LAS v4u* _wp = (const LAS v4u*)(wl + (k) * 512 + g * 64); v4u _w4[4]; _w4[0] = _wp[0]; _w4[1] = _wp[1]; _w4[2] = _wp[2]; _w4[3] = _wp[3]; \
            f32x2 fd[2][8]; SV_DEC(R[0], fd[0]); \
            _Pragma("unroll") for (int _i = 0; _i < 16; ++_i) { const float wi = __uint_as_float(_w4[_i >> 2][_i & 3]); const f32x2 w2 = (f32x2){wi, wi}; \
                if (_i + 1 < 16) SV_DEC(R[(_i + 1) & 15], fd[(_i + 1) & 1]); \
                _Pragma("unroll") for (int _k = 0; _k < 8; ++_k) y2[_k] = w2 * fd[_i & 1][_k] + y2[_k]; \
                asm volatile("" : "+v"(y2[0]), "+v"(y2[1]), "+v"(y2[2]), "+v"(y2[3]), "+v"(y2[4]), "+v"(y2[5]), "+v"(y2[6]), "+v"(y2[7])); } \
            float y[16]; _Pragma("unroll") for (int _k = 0; _k < 8; ++_k) { y[2 * _k] = y2[_k][0]; y[2 * _k + 1] = y2[_k][1]; } \
            float z8[8], z4[4], z2[2]; \
            { const bool b = (lane & 32) != 0; _Pragma("unroll") for (int _i = 0; _i < 8; ++_i) { const float keep = b ? y[_i + 8] : y[_i], send = b ? y[_i] : y[_i + 8]; z8[_i] = keep + __shfl_xor(send, 32); } } \
            { const bool b = (lane & 16) != 0; _Pragma("unroll") for (int _i = 0; _i < 4; ++_i) { const float keep = b ? z8[_i + 4] : z8[_i], send = b ? z8[_i] : z8[_i + 4]; z4[_i] = keep + __shfl_xor(send, 16); } } \
            { const bool b = (lane & 8) != 0; _Pragma("unroll") for (int _i = 0; _i < 2; ++_i) { const float keep = b ? z4[_i + 2] : z4[_i], send = b ? z4[_i] : z4[_i + 2]; z2[_i] = keep + __shfl_xor(send, 8); } } \
            *(unsigned*)(YP + (size_t)(tb0 + (k)) * DM + (s_) * 128 + j * 16 + 2 * g) = pk2(z2[0], z2[1]); } while (0)
        constexpr int NP = PF_CT / 2, NI = 16 * NP;
        int i0 = PD_GRAB(dctr + 1);
        if (i0 < NI) { const int s = i0 / NP, pr = i0 - s * NP; PD_LOADR(R0, 2 * pr, s, Vt); }
#pragma unroll 1
        while (i0 < NI) { const int s = i0 / NP, pr = i0 - s * NP;
            PD_LOADR(R1, 2 * pr + 1, s, Vt);
            const int i1 = PD_GRAB(dctr + 1);
            __builtin_amdgcn_sched_barrier(0);
            PD_VCOMP(R0, 2 * pr, s);
            __builtin_amdgcn_sched_barrier(0);
            if (i1 < NI) { const int s1 = i1 / NP, pr1 = i1 - s1 * NP; PD_LOADR(R0, 2 * pr1, s1, Vt); }
            __builtin_amdgcn_sched_barrier(0);
            PD_VCOMP(R1, 2 * pr + 1, s);
            __builtin_amdgcn_sched_barrier(0);
            i0 = i1;
        }
    }
    asm volatile("s_waitcnt vmcnt(0)" ::: "memory");
    __syncthreads();
    ln2_range(F, A, l, tb0 + kw0, 1, tb0 + kw0 + PF_TPW);
    __syncthreads();
}
__device__ __forceinline__ void phase_peer_fused(Frame& F, const Args& A, int l) {
#if PF_DYN
    for (int c = (int)blockIdx.x; c < PF_NCH; c += (int)gridDim.x) peer_fused_chunk_dyn(F, A, l, c);
#else
    for (int c = (int)blockIdx.x; c < PF_NCH; c += (int)gridDim.x) peer_fused_chunk(F, A, l, c);
#endif
}

#ifndef MK_TPROBE
#define MK_TPROBE 0
#endif
#ifndef MK_DPROBE
#define MK_DPROBE 0
#endif
#ifndef MK_DPROBE_BLK
#define MK_DPROBE_BLK 0
#endif
#if MK_DPROBE
#define TP_B() const unsigned long long _r0 = __builtin_amdgcn_s_memrealtime()
#define TP_E(kind) do { if ((kind) == MK_DPROBE - 1) dp_acc += __builtin_amdgcn_s_memrealtime() - _r0; } while (0)
#elif MK_TPROBE
#define TP_B() const unsigned long long _m0 = __builtin_amdgcn_s_memtime(), _r0 = __builtin_amdgcn_s_memrealtime()
#define TP_E(kind) do { if (blockIdx.x == 0 && threadIdx.x == 0) { float* _tp = (float*)(F.ws + WS_CTL) + CW_DBG + 64; atomicAdd(_tp + 2 * (kind), (float)(__builtin_amdgcn_s_memtime() - _m0)); atomicAdd(_tp + 2 * (kind) + 1, (float)(__builtin_amdgcn_s_memrealtime() - _r0)); } } while (0)
#else
#define TP_B() do {} while (0)
#define TP_E(kind) do {} while (0)
#endif
#ifndef MK_DPROBE_SEAMS
#define MK_DPROBE_SEAMS 0x1ff
#endif
#if MK_DPROBE
#define XBAR() do { const unsigned long long _b0 = __builtin_amdgcn_s_memrealtime(); xcd_barrier(bar); if (MK_DPROBE == 15 && (MK_DPROBE_SEAMS == 0x1ff || (bar_no >= 2 && ((MK_DPROBE_SEAMS >> ((bar_no - 2) % 9)) & 1)))) dp_acc += __builtin_amdgcn_s_memrealtime() - _b0; ++bar_no; } while (0)
#else
#define XBAR() do { TP_B(); xcd_barrier(bar); TP_E(14); } while (0)
#endif
constexpr int NPL = 9, NPHASE = 1 + DEPTH * NPL;
__global__ void __launch_bounds__(512, 2) fwd_kernel(Args args) {
    extern __shared__ __attribute__((aligned(16))) unsigned char lds[];
    Frame F;
    F.lds = (LAS unsigned char*)lds; F.lds_g = (char*)lds;
    F.tid = threadIdx.x; F.lane = F.tid & 63; F.wave = __builtin_amdgcn_readfirstlane(F.tid >> 6);
    F.gw = blockIdx.x * 8 + F.wave; F.ngw = gridDim.x * 8;
    F.ws = args.ws; F.ctl = (gu32*)(args.ws + WS_CTL);
    volatile LAS unsigned* MISC = (volatile LAS unsigned*)(F.lds + MISC_OFF);
    if (F.tid < 32) MISC[F.tid] = 0u;
    __syncthreads();
    const int lo = args.ph_lo, hi = args.ph_hi;
#if MK_DPROBE
    unsigned long long dp_acc = 0; int bar_no = 0;
#endif
    XcdBarrier bar; bar.bar = (unsigned*)(F.ctl + CW_BAR); bar.x = 0; bar.st = MISC;
    bar = xcd_barrier_post((unsigned*)(F.ctl + CW_BAR), MISC);
#ifndef PH_EN
#define PH_EN 0x3ff
#endif
#ifndef MK_REP_ATTN
#define MK_REP_ATTN 0
#endif
#ifndef MK_REP_PEER
#define MK_REP_PEER 0
#endif
#ifndef MK_REP_GEMM
#define MK_REP_GEMM 0
#endif
#define IN(k) (lo <= (k) && (k) < hi)
#define EN(b) ((PH_EN >> (b)) & 1)
#define SEAM(k) do { if (IN(k) && IN((k) + 1)) XBAR(); } while (0)
    const bf16* X = (const bf16*)(F.ws + WS_X); const bf16* X1 = (const bf16*)(F.ws + WS_X1); bf16* H = (bf16*)(F.ws + WS_H);

#if MK_TPROBE
    const unsigned long long _km0 = __builtin_amdgcn_s_memtime(), _kr0 = __builtin_amdgcn_s_memrealtime();
#endif
    if (EN(9) && IN(0)) { TP_B(); p0_prologue(F, args); { XBAR(); }
        { int Kv = DM; asm volatile("" : "+s"(Kv)); pg8::Gemm g{(const bf16*)(F.ws + WS_SKD), (const bf16*)(F.ws + WS_WQ), DEPTH * DM, DEPTH * DM, Kv, DM, DM};
          FoldOrder S{(int)gridDim.x, (int)blockIdx.x}; pg8::EpiRow8<StoreBf16> E{StoreBf16{(bf16*)(F.ws + WS_WQS), DM, DEPTH * DM}};
          pg8::gemm_phase<pg8::EpiRow8<StoreBf16>, FoldOrder, true, true>(F.lds, g, S, E); }
        TP_E(13); SEAM(0); }

    for (int l = 0; l < DEPTH; ++l) {
        const int pb = 1 + NPL * l;
        if (EN(0) && IN(pb + 0)) { TP_B(); int nrep = 1 + MK_REP_GEMM; asm volatile("" : "+s"(nrep));
#pragma unroll 1
            for (int rep = 0; rep < nrep; ++rep) { if (rep) { XBAR(); } P1Order S1; S1.init((int)gridDim.x, (int)blockIdx.x); run_gemm_s(F, X, DM, (const bf16*)(F.ws + WS_WIN) + (size_t)l * INP * DM, TT, INP, DM, StoreBf16{H, INP, INP}, S1); }
            TP_E(0); SEAM(pb + 0); }
        if (EN(1) && IN(pb + 1)) { TP_B(); phase_prep(F, args, l); TP_E(1); SEAM(pb + 1); }
        if (EN(2) && IN(pb + 2)) { TP_B();
            const int skip = (int)gridDim.x > 2 * P1_MOVED ? P1_MOVED : 0;
            run_gemm_s(F, X, DM, (const bf16*)(F.ws + WS_WIN) + (size_t)l * INP * DM, TT, INP, DM, StoreBf16{H, INP, INP}, MovedOrder{(int)gridDim.x, (int)blockIdx.x});
            { int Kv = 384; asm volatile("" : "+s"(Kv)); pg8::Gemm g{H + H_BCQ, (const bf16*)(F.ws + WS_WUQ) + (size_t)l * BQP * 384, TT, BQP, Kv, INP, 384};
              pg8::StaticOrder S; S.init(TT, BQP, (int)gridDim.x - skip, (int)blockIdx.x >= skip ? (int)blockIdx.x - skip : (1 << 29)); EpiMlaQ E{(bf16*)(F.ws + WS_BQ), (const f32x2*)(F.ws + WS_ROPE)};
              pg8::gemm_phase<EpiMlaQ, pg8::StaticOrder, true, true>(F.lds, g, S, E); }
            run_gemm(F, H + H_BCKV, INP, (const bf16*)(F.ws + WS_WUKV) + (size_t)l * BKVW * 256, TT, BKVW, 256, StoreMlaKV{(bf16*)(F.ws + WS_BK), (bf16*)(F.ws + WS_BV)}, skip);
            TP_E(2); SEAM(pb + 2); }
        if (EN(3) && IN(pb + 3)) { TP_B(); int nrep = 1 + MK_REP_ATTN; asm volatile("" : "+s"(nrep));
#pragma unroll 1
            for (int rep = 0; rep < nrep; ++rep) { if (rep) { XBAR(); } phase_attn(F, args, l, rep); }
            TP_E(3); SEAM(pb + 3); }
        if (EN(4) && IN(pb + 4)) { TP_B(); { int Kv = DM; asm volatile("" : "+s"(Kv)); pg8::Gemm g{(const bf16*)(F.ws + WS_AO), (const bf16*)(F.ws + WS_WO) + (size_t)l * DM * DM, TT, DM, Kv, DM, DM};
              pg8::StaticOrder S; S.init(TT, DM, (int)gridDim.x, (int)blockIdx.x); EpiResid E{(bf16*)(F.ws + WS_Y), X}; pg8::gemm_phase<EpiResid, pg8::StaticOrder, true, true>(F.lds, g, S, E); } TP_E(4); SEAM(pb + 4); }
        if (EN(5) && IN(pb + 5)) { TP_B(); phase_ln1(F, args, l); TP_E(5); SEAM(pb + 5); }
        if (EN(6) && IN(pb + 6)) { TP_B(); run_gemm(F, X1, DM, (const bf16*)(F.ws + WS_WQS) + (size_t)l * WQS_LAYER, TT, DM, DM, StoreF32{(float*)(F.ws + WS_SC), DM}); TP_E(6); SEAM(pb + 6); }
        if (EN(8) && IN(pb + 8)) {
#ifndef MK_REP_TOPK
#define MK_REP_TOPK 0
#endif
#ifndef MK_REP_PU
#define MK_REP_PU 0
#endif
#ifndef MK_REP_PV
#define MK_REP_PV 0
#endif
            { int nrep = 1 + MK_REP_TOPK; asm volatile("" : "+s"(nrep));
#pragma unroll 1
              for (int rep = 0; rep < nrep; ++rep) { { TP_B(); phase_peer_topk(F, args, l); TP_E(8); } XBAR(); } }
#ifndef PEER_FUSED
#define PEER_FUSED 1
#endif
#if PEER_FUSED
            { TP_B(); phase_peer_fused(F, args, l); TP_E(9); }
#if !PF_LN2
            XBAR();
            { TP_B(); phase_ln2(F, args, l); TP_E(12); }
#endif
#else
            { int nrep = 1 + MK_REP_PU; asm volatile("" : "+s"(nrep));
#pragma unroll 1
              for (int rep = 0; rep < nrep; ++rep) { { TP_B(); phase_peer_u(F, args, l, rep); TP_E(9); } XBAR(); } }
            { TP_B(); phase_peer_w(F, args, l); TP_E(10); } XBAR();
            { int nrep = 1 + MK_REP_PV; asm volatile("" : "+s"(nrep));
#pragma unroll 1
              for (int rep = 0; rep < nrep; ++rep) { { TP_B(); phase_peer_v(F, args, l, rep); TP_E(11); } XBAR(); } }
            { TP_B(); phase_ln2(F, args, l); TP_E(12); }
#endif
            SEAM(pb + 8); }
    }
#if MK_DPROBE && defined(MK_DSTRAG)
    if (threadIdx.x == 0) { unsigned* D = (unsigned*)(F.ws + WS_CTL) + CW_DBG + 256; __hip_atomic_store(D + blockIdx.x, (unsigned)dp_acc, RLX_AGENT); __hip_atomic_store(D + 512 + blockIdx.x, xb_xcc_id() & 7u, RLX_AGENT);
        __builtin_amdgcn_fence(__ATOMIC_RELEASE, "agent"); (void)xb_add(D + 1100, 1u);
        if (blockIdx.x == 0) { for (int i = 0; i < 200000 && xb_ld(D + 1100) < gridDim.x; ++i) __builtin_amdgcn_s_sleep(8);
            __builtin_amdgcn_fence(__ATOMIC_ACQUIRE, "agent");
            unsigned long long sum = 0; unsigned mx = 0; for (unsigned w = 0; w < gridDim.x; ++w) { const unsigned t = xb_ld(D + w); sum += t; mx = t > mx ? t : mx; }
            const unsigned mean = (unsigned)(sum / gridDim.x); unsigned mask = 0, cnt = 0;
            for (unsigned w = 0; w < gridDim.x; ++w) { const unsigned t = xb_ld(D + w); if ((unsigned long long)t * 100 > (unsigned long long)mean * 108) { ++cnt; mask |= 1u << xb_ld(D + 512 + w); } }
            const unsigned val = MK_DSTRAG == 1 ? mask : MK_DSTRAG == 2 ? cnt : (unsigned)(((unsigned long long)mx * 1000) / (mean ? mean : 1)) - 1000u;
            const unsigned long long t0 = __builtin_amdgcn_s_memrealtime(); while (__builtin_amdgcn_s_memrealtime() - t0 < 10000ull * val) __builtin_amdgcn_s_sleep(8); } }
#elif MK_DPROBE
    if (blockIdx.x == MK_DPROBE_BLK && threadIdx.x == 0) { const unsigned long long t0 = __builtin_amdgcn_s_memrealtime(); while (__builtin_amdgcn_s_memrealtime() - t0 < 4 * dp_acc) __builtin_amdgcn_s_sleep(8); }
#endif
#if defined(ATT_TPROBE)
    if (blockIdx.x == 0 && threadIdx.x == 0) { const unsigned long long T = __hip_atomic_load((unsigned long long*)(F.ws + WS_CTL) + 12000, __ATOMIC_RELAXED, __HIP_MEMORY_SCOPE_AGENT); const unsigned long long t0 = __builtin_amdgcn_s_memrealtime(); while (__builtin_amdgcn_s_memrealtime() - t0 < 4 * T) __builtin_amdgcn_s_sleep(8); }
#endif
#if MK_TPROBE
    if (blockIdx.x == 0 && threadIdx.x == 0) { float* _tp = (float*)(F.ws + WS_CTL) + CW_DBG + 64; _tp[30] = (float)(__builtin_amdgcn_s_memtime() - _km0); _tp[31] = (float)(__builtin_amdgcn_s_memrealtime() - _kr0); }
#endif
#undef IN
#undef SEAM
}

#if MK_TPROBE
__global__ void __launch_bounds__(256) tprobe_scale(Args A) {
    const float* tp = (const float*)(A.ws + WS_CTL) + CW_DBG + 64; const int kind = (MK_TPROBE & 31) - 1, mode = MK_TPROBE >> 5;
    const float v = (mode == 0) ? 0.01f * tp[2 * kind] / fmaxf(tp[2 * kind + 1], 1.f) : tp[2 * kind + 1] / fmaxf(tp[31], 1.f);
    const float s = 1.0f + 0.02f * __builtin_rintf(v * 50.0f);
    for (size_t i = (size_t)blockIdx.x * 256 + threadIdx.x; i < (size_t)TT * DM; i += (size_t)gridDim.x * 256) A.out[i] *= s;
}
#endif
extern "C" void kernel_launch(void* const* d_in, const int* in_sizes, int n_in, void* d_out, int out_size, void* d_ws, size_t ws_size, hipStream_t stream) {
    static int grid = 0;
    if (grid == 0) {
        if (n_in != 23 || in_sizes[0] != T_PROMPT * DM || in_sizes[1] != (TT - T_PROMPT) * DM || out_size != TT * DM || ws_size < WS_NEED) {
            fprintf(stderr, "kernel_launch: shape mismatch (n_in %d, in0 %d, in1 %d, out %d, ws %zu need %zu); nothing launched\n", n_in, n_in > 0 ? in_sizes[0] : -1, n_in > 1 ? in_sizes[1] : -1, out_size, ws_size, (size_t)WS_NEED); grid = -1; return; }
        int dev = 0, cus = 0, per_cu = 0;
        if (hipGetDevice(&dev) != hipSuccess || hipDeviceGetAttribute(&cus, hipDeviceAttributeMultiprocessorCount, dev) != hipSuccess) { fprintf(stderr, "kernel_launch: device query failed\n"); grid = -1; return; }
        if (hipFuncSetAttribute((const void*)fwd_kernel, hipFuncAttributeMaxDynamicSharedMemorySize, LDS_BYTES) != hipSuccess) { fprintf(stderr, "kernel_launch: hipFuncSetAttribute failed\n"); grid = -1; return; }
        if (hipOccupancyMaxActiveBlocksPerMultiprocessor(&per_cu, (const void*)fwd_kernel, 512, LDS_BYTES) != hipSuccess || per_cu < 1) { fprintf(stderr, "kernel_launch: occupancy query says %d blocks per CU\n", per_cu); }
        (void)hipGetLastError();
        grid = cus;
    }
    if (grid < 0) return;
    if (hipMemsetAsync((char*)d_ws + WS_CTL, 0, CTL_BYTES, stream) != hipSuccess) { fprintf(stderr, "kernel_launch: memset failed\n"); return; }
    Args a{};
    for (int i = 0; i < 23; ++i) a.in[i] = (const float*)d_in[i];
    a.out = (float*)d_out; a.ws = (unsigned char*)d_ws;
    for (int l = 0; l < DEPTH; ++l) a.lam_init[l] = 0.8f - 0.6f * expf(-0.3f * (float)l);
#if MK_LAUNCH_PER_PHASE
    for (int k = 0; k < NPHASE; ++k) { a.ph_lo = k; a.ph_hi = k + 1; hipLaunchKernelGGL(fwd_kernel, dim3(grid), dim3(512), LDS_BYTES, stream, a); }
#else
    a.ph_lo = 0; a.ph_hi = NPHASE; hipLaunchKernelGGL(fwd_kernel, dim3(grid), dim3(512), LDS_BYTES, stream, a);
#endif
#if MK_DBG
    if (MK_DBG & 1) hipLaunchKernelGGL(dbg_h, dim3(48), dim3(256), 0, stream, a);
    if (MK_DBG & 2) hipLaunchKernelGGL(dbg_mla, dim3(48), dim3(256), 0, stream, a);
    if (MK_DBG & 28) hipLaunchKernelGGL(dbg_attn, dim3(64), dim3(256), 0, stream, a);
    if (MK_DBG & 224) hipLaunchKernelGGL(dbg_gemms, dim3(48), dim3(256), 0, stream, a);
    if (MK_DBG & 256) hipLaunchKernelGGL(dbg_peer, dim3(48), dim3(256), 0, stream, a);
    hipLaunchKernelGGL(dbg_scale, dim3(1024), dim3(256), 0, stream, a);
#endif
#if MK_TPROBE
    hipLaunchKernelGGL(tprobe_scale, dim3(1024), dim3(256), 0, stream, a);
#endif
    const hipError_t le = hipPeekAtLastError();
    if (le != hipSuccess) fprintf(stderr, "kernel_launch: launch failed: %s\n", hipGetErrorName(le));
}
```

```cpp
#include <hip/hip_runtime.h>
#include <cstdio>
#include <cstdint>

#ifndef MK_LAUNCH_PER_PHASE
#define MK_LAUNCH_PER_PHASE 0
#endif
#ifndef MK_DBG
#define MK_DBG 0
#endif

constexpr int DM = 2048, TT = 24576, T_PROMPT = 8192, S_SAMPLE = 4096, DEPTH = 4;
constexpr int INW = 3520, INP = 3584;
constexpr int H_AQ = 0, H_AK = 768, H_AV = 1024, H_BCQ = 1280, H_BCKV = 1664, H_BKR = 1920, H_CQ = 1984, H_CK = 2496, H_CV = 3008;
constexpr int BQW = 1152, BQP = 1280, BKVW = 1536, BVW = 768;
constexpr int NEXP = 16384, PEER_H = 8, PEER_K = 16;
constexpr float EPS = 1e-5f;
constexpr float DN_ALPHA = 1.681792830507429f;
constexpr double ROPE_R = 0.7498942093324559;

namespace pg8 {
#define PG8_LAS __attribute__((address_space(3)))
typedef unsigned short bf16_t;
typedef short bf16x8 __attribute__((ext_vector_type(8)));
typedef float f32x4 __attribute__((ext_vector_type(4)));
typedef unsigned u32x4 __attribute__((ext_vector_type(4)));
constexpr int BM = 256, BK = 64, HALF = 128, HTB = HALF * BK * 2  , STAGE_BYTES = 8 * HTB, NXCD = 8, WGM = 8;

__host__ __device__ __forceinline__ int lds_byte(int r, int c) { const int st = (r >> 4) * 2 + (c >> 5), rr = r & 15, cc = c & 31, ob = rr * 64 + cc * 2; return st * 1024 + (ob ^ (((ob >> 9) & 1) << 5)); }
__host__ __device__ __forceinline__ void stage_rc(int b, int& R, int& C) { const int st = b / 1024, sb = b % 1024, swz = sb ^ (((sb >> 9) & 1) << 5); R = (st >> 1) * 16 + swz / 64; C = (st & 1) * 32 + (swz % 64) / 2; }
__host__ __device__ __forceinline__ int perm32(int rho) { const int n = rho >> 4, i = rho & 15; return 8 * (i >> 2) + 4 * n + (i & 3); }

struct Unit { int pm, pn; };
struct Gemm { const bf16_t* A; const bf16_t* Bt; int M, N, K, lda, ldb; };

struct StaticOrder {
    int nM, nN, nwg, G, c;
    __host__ __device__ void init(int M, int N, int G_, int c_) { nM = M / BM; nN = N / BM; nwg = nM * nN; G = G_; c = c_; }
    __host__ __device__ bool next(int i, Unit& u) const {
        const long L = (long)i * G + c; if (L >= nwg) return false;
        int wgid = (int)L; { const int q = nwg / NXCD, r = nwg % NXCD, xcd = wgid % NXCD, off = wgid / NXCD; wgid = (xcd < r ? xcd * (q + 1) : r * (q + 1) + (xcd - r) * q) + off; }
        const int nig = WGM * nN, gid = wgid / nig, fm = gid * WGM, gsz = (nM - fm) < WGM ? (nM - fm) : WGM;
        u.pm = fm + ((wgid % nig) % gsz); u.pn = (wgid % nig) / gsz; return true;
    }
    __device__ __forceinline__ void a_ready(const Unit&) const {}
    __device__ __forceinline__ void done(const Unit&) const {}
};

__device__ __forceinline__ unsigned cvt_pk_bf16(float lo, float hi) { unsigned r; asm volatile("v_cvt_pk_bf16_f32 %0, %1, %2" : "=v"(r) : "v"(lo), "v"(hi)); return r; }
template <class F> struct EpiRow8 {
    static constexpr bool PERM = true, AFTER_DRAIN = false; F f;
    __device__ __forceinline__ void operator()(const f32x4 (&acc)[2][2][4][2], const Unit& u, int wr, int wc, int fr, int fq) const {
        const int row0 = u.pm * BM + wr * 64 + fr, col0 = u.pn * BM + wc * 32 + 8 * fq;
#pragma unroll
        for (int ai = 0; ai < 2; ++ai)
#pragma unroll
            for (int m = 0; m < 4; ++m)
#pragma unroll
                for (int bj = 0; bj < 2; ++bj) { f(row0 + ai * HALF + m * 16, col0 + bj * HALF, acc[ai][bj][m][0], acc[ai][bj][m][1]); asm volatile("" ::: "memory"); }
    }
};
template <class Epi, class Sched, bool ALIGN_EPI = false, bool SP2 = false>
__device__ __forceinline__ void gemm_phase(PG8_LAS unsigned char* lds, const Gemm g, const Sched& S, const Epi& E) {
    int tid_ = threadIdx.x; asm volatile("" : "+v"(tid_));
    const int tid = tid_, wid = __builtin_amdgcn_readfirstlane(tid >> 6), lane = tid & 63, wr = wid >> 2, wc = wid & 3, fr = lane & 15, fq = lane >> 4;
    const int K = g.K, nt = K / BK;
    unsigned voffA[2], voffB[2];
#pragma unroll
    for (int i = 0; i < 2; ++i) { int R, C; stage_rc(tid * 16 + i * 8192, R, C); const int Rb = Epi::PERM ? ((R & ~31) + perm32(R & 31)) : R;
        voffA[i] = (unsigned)(R * g.lda + C) * 2u; voffB[i] = (unsigned)(Rb * g.ldb + C) * 2u; }
    const size_t kstep = (size_t)(BK * 2);
    const size_t hstepA = (size_t)HALF * g.lda * 2, hstepB = (size_t)HALF * g.ldb * 2;
    const size_t tstepA = 2 * hstepA, tstepB = 2 * hstepB;
    const unsigned ldsw = (unsigned)wid * 1024u;
    const int aoff = lds_byte(wr * 64 + fr, fq * 8), boff = lds_byte(wc * 32 + fr, fq * 8);
#define PG8_SA(b, h) (((b) * 2 + (h)) * HTB)
#define PG8_SB(b, h) ((4 + (b) * 2 + (h)) * HTB)
#define PG8_STAGE(bufoff, gbase, voff) do { _Pragma("unroll") for (int _i = 0; _i < 2; ++_i) \
        __builtin_amdgcn_global_load_lds((const unsigned*)((const char*)(gbase) + (voff)[_i]), (PG8_LAS unsigned*)(lds + (bufoff) + ldsw + _i * 8192), 16, 0, 0); } while (0)
#define PG8_LDA(dst, b, h) do { _Pragma("unroll") for (int m = 0; m < 4; ++m) _Pragma("unroll") for (int k = 0; k < 2; ++k) dst[m][k] = *(const PG8_LAS bf16x8*)(lds + PG8_SA(b, h) + aoff + m * 2048 + k * 1024); } while (0)
#define PG8_LDB(dst, b, h) do { _Pragma("unroll") for (int n = 0; n < 2; ++n) _Pragma("unroll") for (int k = 0; k < 2; ++k) dst[n][k] = *(const PG8_LAS bf16x8*)(lds + PG8_SB(b, h) + boff + n * 2048 + k * 1024); } while (0)
#define PG8_MMA(ai, bj, At, Bt) do { __builtin_amdgcn_s_setprio(1); _Pragma("unroll") for (int m = 0; m < 4; ++m) _Pragma("unroll") for (int n = 0; n < 2; ++n) _Pragma("unroll") for (int k = 0; k < 2; ++k) \
        acc[ai][bj][m][n] = __builtin_amdgcn_mfma_f32_16x16x32_bf16(Bt[n][k], At[m][k], acc[ai][bj][m][n], 0, 0, 0); __builtin_amdgcn_s_setprio(0); } while (0)
#define PG8_WAIT_V(n) asm volatile("s_waitcnt vmcnt(" #n ")" ::: "memory")
#define PG8_WAIT_L(n) asm volatile("s_waitcnt lgkmcnt(" #n ")" ::: "memory")
#define PG8_BAR __builtin_amdgcn_s_barrier()
#define PG8_SCHED __builtin_amdgcn_sched_barrier(0)
    Unit cur, nxt; int ui = 0;
    if (!S.next(0, cur)) return;
    f32x4 acc[2][2][4][2];
#pragma unroll
    for (int a = 0; a < 2; ++a)
#pragma unroll
        for (int b = 0; b < 2; ++b)
#pragma unroll
            for (int m = 0; m < 4; ++m)
#pragma unroll
                for (int n = 0; n < 2; ++n) acc[a][b][m][n] = (f32x4){0.f, 0.f, 0.f, 0.f};
    bf16x8 At[4][2], B0[2][2], B1[2][2];
    const char* cA = (const char*)g.A + (size_t)cur.pm * tstepA; const char* cB = (const char*)g.Bt + (size_t)cur.pn * tstepB;
    S.a_ready(cur);
    if constexpr (SP2) {
        PG8_STAGE(PG8_SB(0, 0), cB, voffB); PG8_STAGE(PG8_SB(0, 1), cB + hstepB, voffB); PG8_STAGE(PG8_SA(0, 0), cA, voffA); PG8_STAGE(PG8_SA(0, 1), cA + hstepA, voffA);
        if (wr == 1) PG8_BAR;
        PG8_WAIT_V(2); PG8_BAR;
        PG8_STAGE(PG8_SB(1, 0), cB + kstep, voffB); PG8_STAGE(PG8_SA(1, 0), cA + kstep, voffA); PG8_STAGE(PG8_SB(1, 1), cB + hstepB + kstep, voffB);
        PG8_WAIT_V(6); PG8_BAR;
    } else {
        PG8_STAGE(PG8_SB(0, 0), cB, voffB); PG8_STAGE(PG8_SA(0, 0), cA, voffA); PG8_STAGE(PG8_SB(0, 1), cB + hstepB, voffB); PG8_STAGE(PG8_SA(0, 1), cA + hstepA, voffA);
        if (wr == 1) PG8_BAR;
        PG8_WAIT_V(4); PG8_BAR;
        PG8_STAGE(PG8_SB(1, 0), cB + kstep, voffB); PG8_STAGE(PG8_SA(1, 0), cA + kstep, voffA); PG8_STAGE(PG8_SB(1, 1), cB + hstepB + kstep, voffB);
        PG8_WAIT_V(6); PG8_BAR;
    }
    for (;;) {
        const bool has_next = S.next(ui + 1, nxt);
        const char* nA = has_next ? (const char*)g.A + (size_t)nxt.pm * tstepA : cA; const char* nB = has_next ? (const char*)g.Bt + (size_t)nxt.pn * tstepB : cB;
        for (int t = 0; t < nt; t += 2) {
            const bool last = (t == nt - 2);
            const char* a1 = cA + (size_t)(t + 1) * kstep;
            const char* a2 = last ? nA : cA + (size_t)(t + 2) * kstep; const char* b2 = last ? nB : cB + (size_t)(t + 2) * kstep;
            const char* a3 = a2 + kstep; const char* b3 = b2 + kstep;
            if (last && has_next) S.a_ready(nxt);
            if constexpr (SP2) {
            PG8_LDB(B0, 0, 0); PG8_LDB(B1, 0, 1); PG8_SCHED; PG8_LDA(At, 0, 0); PG8_STAGE(PG8_SA(1, 1), a1 + hstepA, voffA);
            PG8_WAIT_V(8); PG8_WAIT_L(0); PG8_BAR; PG8_MMA(0, 0, At, B0); PG8_MMA(0, 1, At, B1); PG8_BAR; PG8_SCHED;
            PG8_LDA(At, 0, 1); PG8_STAGE(PG8_SB(0, 0), b2, voffB); PG8_STAGE(PG8_SB(0, 1), b2 + hstepB, voffB); PG8_STAGE(PG8_SA(0, 0), a2, voffA);
            PG8_WAIT_V(8); PG8_WAIT_L(0); PG8_BAR; PG8_MMA(1, 0, At, B0); PG8_MMA(1, 1, At, B1); PG8_BAR; PG8_SCHED;
            PG8_LDB(B0, 1, 0); PG8_LDB(B1, 1, 1); PG8_SCHED; PG8_LDA(At, 1, 0); PG8_STAGE(PG8_SA(0, 1), a2 + hstepA, voffA);
            PG8_WAIT_V(8); PG8_WAIT_L(0); PG8_BAR; PG8_MMA(0, 0, At, B0); PG8_MMA(0, 1, At, B1); PG8_BAR; PG8_SCHED;
            PG8_LDA(At, 1, 1); PG8_STAGE(PG8_SB(1, 0), b3, voffB); PG8_STAGE(PG8_SB(1, 1), b3 + hstepB, voffB); PG8_STAGE(PG8_SA(1, 0), a3, voffA);
            PG8_WAIT_V(8); PG8_WAIT_L(0); PG8_BAR; PG8_MMA(1, 0, At, B0); PG8_MMA(1, 1, At, B1); PG8_BAR; PG8_SCHED;
            } else {
            PG8_LDB(B0, 0, 0); PG8_SCHED; PG8_LDA(At, 0, 0); PG8_STAGE(PG8_SA(1, 1), a1 + hstepA, voffA);
            PG8_WAIT_L(8); PG8_BAR; PG8_WAIT_L(0); PG8_MMA(0, 0, At, B0); PG8_BAR; PG8_SCHED;
            PG8_LDB(B1, 0, 1); PG8_STAGE(PG8_SB(0, 0), b2, voffB);
            PG8_BAR; PG8_WAIT_L(0); PG8_MMA(0, 1, At, B1); PG8_BAR;
            PG8_LDA(At, 0, 1); PG8_STAGE(PG8_SA(0, 0), a2, voffA);
            PG8_BAR; PG8_WAIT_L(0); PG8_MMA(1, 0, At, B0); PG8_BAR; PG8_SCHED;
            PG8_STAGE(PG8_SB(0, 1), b2 + hstepB, voffB);
            PG8_WAIT_V(6); PG8_BAR; PG8_MMA(1, 1, At, B1); PG8_BAR;
            PG8_LDB(B0, 1, 0); PG8_SCHED; PG8_LDA(At, 1, 0); PG8_STAGE(PG8_SA(0, 1), a2 + hstepA, voffA);
            PG8_WAIT_L(8); PG8_BAR; PG8_WAIT_L(0); PG8_MMA(0, 0, At, B0); PG8_BAR; PG8_SCHED;
            PG8_LDB(B1, 1, 1); PG8_STAGE(PG8_SB(1, 0), b3, voffB);
            PG8_BAR; PG8_WAIT_L(0); PG8_MMA(0, 1, At, B1); PG8_BAR;
            PG8_LDA(At, 1, 1); PG8_STAGE(PG8_SA(1, 0), a3, voffA);
            PG8_BAR; PG8_WAIT_L(0); PG8_MMA(1, 0, At, B0); PG8_BAR; PG8_SCHED;
            PG8_STAGE(PG8_SB(1, 1), b3 + hstepB, voffB);
            PG8_WAIT_V(6); PG8_BAR; PG8_MMA(1, 1, At, B1); PG8_BAR;
            }
        }
        if constexpr (ALIGN_EPI) { if (wr == 0) PG8_BAR; }
        if constexpr (!Epi::AFTER_DRAIN) { E(acc, cur, wr, wc, fr, fq); S.done(cur); }
        if (!has_next) break;
#pragma unroll
        for (int a = 0; a < 2; ++a)
#pragma unroll
            for (int b = 0; b < 2; ++b)
#pragma unroll
                for (int m = 0; m < 4; ++m)
#pragma unroll
                    for (int n = 0; n < 2; ++n) acc[a][b][m][n] = (f32x4){0.f, 0.f, 0.f, 0.f};
        cur = nxt; cA = nA; cB = nB; ++ui;
        if constexpr (ALIGN_EPI) { if (wr == 1) PG8_BAR; }
    }
    PG8_WAIT_V(0);
    if constexpr (!ALIGN_EPI) { if (wr == 0) PG8_BAR; }
    PG8_BAR;
    if constexpr (Epi::AFTER_DRAIN) { E.fused(acc, cur, wr, wc, fr, fq, lds, wid, lane); S.done(cur); }
#undef PG8_SA
#undef PG8_SB
#undef PG8_STAGE
#undef PG8_LDA
#undef PG8_LDB
#undef PG8_MMA
#undef PG8_WAIT_V
#undef PG8_WAIT_L
#undef PG8_BAR
#undef PG8_SCHED
}
}

namespace att {
using pg8::bf16_t;
using bf16x8 = __attribute__((ext_vector_type(8))) short;
using s16x4  = __attribute__((ext_vector_type(4))) short;
using f32x16 = __attribute__((ext_vector_type(16))) float;
using u32x4  = __attribute__((ext_vector_type(4))) unsigned;
using f32x4_t = __attribute__((ext_vector_type(4))) float;
using f32x2_t = __attribute__((ext_vector_type(2))) float;
constexpr int NW = 8, QBLK = 32, KVBLK = 64, DV = 128;
constexpr int SHM_V = KVBLK * DV * 2;
#define ATT_SBAR() __builtin_amdgcn_sched_barrier(0)
__device__ __forceinline__ int crow(int r, int hi) { return (r & 3) + 8 * (r >> 2) + 4 * hi; }
__device__ __forceinline__ unsigned cvtpk(float lo, float hi) { unsigned r; asm volatile("v_cvt_pk_bf16_f32 %0, %1, %2" : "=v"(r) : "v"(lo), "v"(hi)); return r; }
#ifndef ATT_ACTIVE_WAVES
#define ATT_ACTIVE_WAVES 8
#endif
constexpr float THR = 8.f;

template <int DQK> struct Cfg {
  static constexpr int KROW = DQK * 2 + 16;
  static constexpr int SHM_K = KVBLK * KROW;
  static constexpr int NCH = DQK / 8;
  static constexpr int KPT = DQK / 64;
  static constexpr int ND0 = DQK / 16;
  static constexpr int LDS_BYTES = 2 * SHM_V + 2 * SHM_K + NW * 64 * 4;
};

__device__ __forceinline__ void partialSM(f32x16& p0, f32x16& p1, float& m_reg, float& mn, float& alpha, const float C, const float thr_raw) {
  float pmax = p0[0];
#pragma unroll
  for (int r = 1; r < 16; ++r) pmax = fmaxf(pmax, p0[r]);
#pragma unroll
  for (int r = 0; r < 16; ++r) pmax = fmaxf(pmax, p1[r]);
  { auto rr = __builtin_amdgcn_permlane32_swap(__float_as_uint(pmax), __float_as_uint(pmax), false, false);
    pmax = fmaxf(__uint_as_float(rr[0]), __uint_as_float(rr[1])); }
  if (__builtin_expect(__all(pmax - m_reg <= thr_raw), 1)) { mn = m_reg; alpha = 1.f; }
  else { mn = fmaxf(m_reg, pmax); alpha = __builtin_amdgcn_exp2f((m_reg - mn) * C); m_reg = mn; }
  float mnC = -mn * C;
#pragma unroll
  for (int r = 0; r < 16; ++r) p0[r] = fmaf(p0[r], C, mnC);
#pragma unroll
  for (int r = 0; r < 16; ++r) p1[r] = fmaf(p1[r], C, mnC);
#pragma unroll
  for (int r = 0; r < 16; ++r) p0[r] = __builtin_amdgcn_exp2f(p0[r]);
}
__device__ __forceinline__ void finishSM(f32x16& p0, f32x16& p1, float alpha, float& l_reg, bf16x8& pa0, bf16x8& pa1, bf16x8& pa2, bf16x8& pa3) {
#pragma unroll
  for (int r = 0; r < 16; ++r) p1[r] = __builtin_amdgcn_exp2f(p1[r]);
  float ps = 0;
#pragma unroll
  for (int r = 0; r < 16; ++r) ps += p0[r];
#pragma unroll
  for (int r = 0; r < 16; ++r) ps += p1[r];
  { auto rr = __builtin_amdgcn_permlane32_swap(__float_as_uint(ps), __float_as_uint(ps), false, false);
    ps = __uint_as_float(rr[0]) + __uint_as_float(rr[1]); }
  l_reg = l_reg * alpha + ps;
#define ATT_PK4(P, BASE, OUT) do { unsigned a0 = cvtpk(P[BASE + 0], P[BASE + 1]), a1 = cvtpk(P[BASE + 2], P[BASE + 3]);   \
    unsigned b0 = cvtpk(P[BASE + 4], P[BASE + 5]), b1 = cvtpk(P[BASE + 6], P[BASE + 7]);                              \
    auto r0 = __builtin_amdgcn_permlane32_swap(a0, b0, false, false); auto r1 = __builtin_amdgcn_permlane32_swap(a1, b1, false, false); \
    u32x4 w = {r0[0], r1[0], r0[1], r1[1]}; OUT = *reinterpret_cast<bf16x8*>(&w); } while (0)
  ATT_PK4(p0, 0, pa0); ATT_PK4(p0, 8, pa1); ATT_PK4(p1, 0, pa2); ATT_PK4(p1, 8, pa3);
#undef ATT_PK4
}
__device__ __forceinline__ void finishSM_ns(f32x16& p0, f32x16& p1, float alpha, float& l_reg, bf16x8& pa0, bf16x8& pa1, bf16x8& pa2, bf16x8& pa3) {
#pragma unroll
  for (int r = 0; r < 16; ++r) p1[r] = __builtin_amdgcn_exp2f(p1[r]);
  float ps = 0;
#pragma unroll
  for (int r = 0; r < 16; ++r) ps += p0[r];
#pragma unroll
  for (int r = 0; r < 16; ++r) ps += p1[r];
  { auto rr = __builtin_amdgcn_permlane32_swap(__float_as_uint(ps), __float_as_uint(ps), false, false);
    ps = __uint_as_float(rr[0]) + __uint_as_float(rr[1]); }
  l_reg = l_reg * alpha + ps;
#define ATT_PK4N(P, BASE, OUT) do { const u32x4 w = {cvtpk(P[BASE + 0], P[BASE + 1]), cvtpk(P[BASE + 2], P[BASE + 3]), cvtpk(P[BASE + 4], P[BASE + 5]), cvtpk(P[BASE + 6], P[BASE + 7])}; OUT = *reinterpret_cast<const bf16x8*>(&w); } while (0)
  ATT_PK4N(p0, 0, pa0); ATT_PK4N(p0, 8, pa1); ATT_PK4N(p1, 0, pa2); ATT_PK4N(p1, 8, pa3);
#undef ATT_PK4N
}
template <int DQK> __device__ __forceinline__ void qkt(f32x16& p0, f32x16& p1, const char* Ks, const bf16x8* qr, int r32, int hi) {
  constexpr int KROW = Cfg<DQK>::KROW;
  p0 = f32x16{}; p1 = f32x16{};
#pragma unroll
  for (int d0 = 0; d0 < DQK / 16; ++d0) { const int cb = (d0 * 16 + hi * 8) * 2;
    bf16x8 b0 = *reinterpret_cast<const bf16x8*>(Ks + r32 * KROW + cb);
    bf16x8 b1 = *reinterpret_cast<const bf16x8*>(Ks + (32 + r32) * KROW + cb);
    p0 = __builtin_amdgcn_mfma_f32_32x32x16_bf16(b0, qr[d0], p0, 0, 0, 0);
    p1 = __builtin_amdgcn_mfma_f32_32x32x16_bf16(b1, qr[d0], p1, 0, 0, 0); }
}
__device__ __forceinline__ int v_st(int k, int c) { const int kk = (k & ~0xC) | ((k & 4) << 1) | ((k & 8) >> 1); return ((kk >> 3) * 4 + (c >> 5)) * 512 + ((kk & 7) * 32 + (c & 31)) * 2; }
__device__ __forceinline__ int v_rd_base(int lane) { return ((lane & 3) << 3) | (((lane >> 2) & 3) << 6) | (((lane >> 4) & 1) << 5) | (((lane >> 5) & 1) << 8); }
constexpr int v_rd_off(int d0, int ks, int half) { return d0 * 512 + ks * 4096 + half * 2048; }
template <int OFF> __device__ __forceinline__ s16x4 tr_read(int vb) {
  s16x4 r; asm volatile("ds_read_b64_tr_b16 %0, %1 offset:%2" : "=&v"(r) : "v"(vb), "i"(OFF) : "memory"); return r;
}
template <int D0> __device__ __forceinline__ void pv_one(f32x16& od, int vb, bf16x8 pa0, bf16x8 pa1, bf16x8 pa2, bf16x8 pa3) {
  const s16x4 l0 = tr_read<v_rd_off(D0, 0, 0)>(vb), h0 = tr_read<v_rd_off(D0, 0, 1)>(vb), l1 = tr_read<v_rd_off(D0, 1, 0)>(vb), h1 = tr_read<v_rd_off(D0, 1, 1)>(vb);
  const s16x4 l2 = tr_read<v_rd_off(D0, 2, 0)>(vb), h2 = tr_read<v_rd_off(D0, 2, 1)>(vb), l3 = tr_read<v_rd_off(D0, 3, 0)>(vb), h3 = tr_read<v_rd_off(D0, 3, 1)>(vb);
  asm volatile("s_waitcnt lgkmcnt(0)" ::: "memory"); ATT_SBAR();
#define ATT_PK(L, H) (bf16x8){L[0], L[1], L[2], L[3], H[0], H[1], H[2], H[3]}
  od = __builtin_amdgcn_mfma_f32_32x32x16_bf16(pa0, ATT_PK(l0, h0), od, 0, 0, 0);
  od = __builtin_amdgcn_mfma_f32_32x32x16_bf16(pa1, ATT_PK(l1, h1), od, 0, 0, 0);
  od = __builtin_amdgcn_mfma_f32_32x32x16_bf16(pa2, ATT_PK(l2, h2), od, 0, 0, 0);
  od = __builtin_amdgcn_mfma_f32_32x32x16_bf16(pa3, ATT_PK(l3, h3), od, 0, 0, 0);
#undef ATT_PK
}
__device__ __forceinline__ void pv_d0(f32x16* o, int vb, bf16x8 pa0, bf16x8 pa1, bf16x8 pa2, bf16x8 pa3) {
  pv_one<0>(o[0], vb, pa0, pa1, pa2, pa3); pv_one<1>(o[1], vb, pa0, pa1, pa2, pa3); pv_one<2>(o[2], vb, pa0, pa1, pa2, pa3); pv_one<3>(o[3], vb, pa0, pa1, pa2, pa3);
}

struct OutArgs { bf16_t* Ob; int LDO; float* stash; float lam, post; const float* g; unsigned long long* tp; };

template <int DQK, int LDQ, int LDK, int LDV, int MODE, bool SIMPLE = false>
__device__ __forceinline__ void attn_body(const bf16_t* __restrict__ Qb, const bf16_t* __restrict__ Kh, const bf16_t* __restrict__ Vh,
                                          int seq, float scale, const OutArgs& oa, char* lds) {
  using CF = Cfg<DQK>;
  constexpr int KPT = CF::KPT, NCH = CF::NCH, ND0 = CF::ND0, SHM_K = CF::SHM_K, KROW = CF::KROW;
  const float C = scale * 1.4426950408889634f, thr_raw = THR / scale;
  int tid_ = threadIdx.x; asm volatile("" : "+v"(tid_));
  const int tid = tid_, wid = tid >> 6, lane = tid & 63, r32 = lane & 31, hi = lane >> 5;
  char* V_lds = lds; char* K_lds = lds + 2 * SHM_V;
  float* ws = (float*)(lds + 2 * SHM_V + 2 * SHM_K) + wid * 64; float* li_l = ws; float* al_l = ws + 32;
  float m_reg = -1e30f, l_reg = 0; f32x16 o[4] = {}; bf16x8 qr[ND0];
  const bf16_t* Qw = Qb + (long)(wid * QBLK + r32) * LDQ + hi * 8;
#pragma unroll
  for (int d0 = 0; d0 < ND0; ++d0) qr[d0] = *reinterpret_cast<const bf16x8*>(Qw + d0 * 16);
  const int sr = tid >> 4, sc = (tid & 15) * 8, vst0 = v_st(sr, sc), vst1 = v_st(32 + sr, sc);
  int kgo[KPT], klo[KPT];
#pragma unroll
  for (int i = 0; i < KPT; ++i) { const int c = tid + 512 * i, row = c / NCH, ch = c % NCH; kgo[i] = row * LDK + ch * 8; klo[i] = row * KROW + ch * 16; }
  const int vb0 = (int)(uintptr_t)V_lds + v_rd_base(lane);
  struct Slot { bf16x8 vs0, vs1; bf16x8 ks[KPT]; };
  Slot s0_, s1_;
#define ATT_SLOAD(S, k0) do { (S).vs0 = *reinterpret_cast<const bf16x8*>(&Vh[(long)((k0) + sr) * LDV + sc]); (S).vs1 = *reinterpret_cast<const bf16x8*>(&Vh[(long)((k0) + 32 + sr) * LDV + sc]); \
    _Pragma("unroll") for (int _i = 0; _i < KPT; ++_i) (S).ks[_i] = *reinterpret_cast<const bf16x8*>(&Kh[(long)(k0) * LDK + kgo[_i]]); } while (0)
#define ATT_SWRITE(b, S) do { *(bf16x8*)(V_lds + (b) * SHM_V + vst0) = (S).vs0; *(bf16x8*)(V_lds + (b) * SHM_V + vst1) = (S).vs1; \
    _Pragma("unroll") for (int _i = 0; _i < KPT; ++_i) *(bf16x8*)(K_lds + (b) * SHM_K + klo[_i]) = (S).ks[_i]; } while (0)
#define ATT_SWAIT() asm volatile("s_waitcnt vmcnt(%0)" :: "n"(2 + KPT) : "memory")
#define ATT_RESC(a) do { if (__any((a) < 1.f)) { if (hi == 0) al_l[r32] = (a); asm volatile("s_waitcnt lgkmcnt(0)" ::: "memory"); \
    _Pragma("unroll") for (int d = 0; d < 4; ++d) _Pragma("unroll") for (int r = 0; r < 16; ++r) o[d][r] *= al_l[crow(r, hi)]; } } while (0)
  bf16x8 pa0, pa1, pa2, pa3; const int NT = seq / KVBLK;
  if constexpr (SIMPLE) {
    f32x16 p0, p1; float mn, al;
    ATT_SLOAD(s0_, 0); asm volatile("s_waitcnt vmcnt(0)" ::: "memory"); ATT_SWRITE(0, s0_); ATT_SLOAD(s0_, KVBLK); __syncthreads();
    for (int j = 0; j < NT; ++j) { const int b = j & 1;
      ATT_SBAR(); qkt<DQK>(p0, p1, K_lds + b * SHM_K, qr, r32, hi);
      partialSM(p0, p1, m_reg, mn, al, C, thr_raw); ATT_RESC(al);
      finishSM(p0, p1, al, l_reg, pa0, pa1, pa2, pa3); ATT_SBAR();
      pv_d0(o, vb0 + b * SHM_V, pa0, pa1, pa2, pa3); ATT_SBAR();
      if (j + 1 < NT) { asm volatile("s_waitcnt vmcnt(0)" ::: "memory"); ATT_SWRITE(1 - b, s0_); if (j + 2 < NT) ATT_SLOAD(s0_, (j + 2) * KVBLK); }
      __syncthreads();
    }
  } else {
  f32x16 pA0, pA1, pB0, pB1; float mnA, mnB, alA, alB;
  ATT_SLOAD(s0_, 0); asm volatile("s_waitcnt vmcnt(0)" ::: "memory"); ATT_SWRITE(0, s0_); __syncthreads();
  qkt<DQK>(pA0, pA1, K_lds, qr, r32, hi); partialSM(pA0, pA1, m_reg, mnA, alA, C, thr_raw);
  ATT_SLOAD(s1_, KVBLK); if (2 < NT) ATT_SLOAD(s0_, 2 * KVBLK);
  ATT_SWAIT(); ATT_SWRITE(1, s1_); __syncthreads();
  for (int j = 1; j + 1 < NT; j += 2) {
    ATT_SBAR(); qkt<DQK>(pB0, pB1, K_lds + SHM_K, qr, r32, hi);
    finishSM(pA0, pA1, alA, l_reg, pa0, pa1, pa2, pa3); ATT_SBAR();
    ATT_SLOAD(s1_, (j + 2) * KVBLK); ATT_SBAR();
    pv_d0(o, vb0, pa0, pa1, pa2, pa3); partialSM(pB0, pB1, m_reg, mnB, alB, C, thr_raw);
    __syncthreads(); ATT_SWAIT(); ATT_SWRITE(0, s0_);
    ATT_RESC(alB); __syncthreads();
    ATT_SBAR(); qkt<DQK>(pA0, pA1, K_lds, qr, r32, hi);
    finishSM(pB0, pB1, alB, l_reg, pa0, pa1, pa2, pa3); ATT_SBAR();
    if (j + 3 < NT) ATT_SLOAD(s0_, (j + 3) * KVBLK); ATT_SBAR();
    pv_d0(o, vb0 + SHM_V, pa0, pa1, pa2, pa3); partialSM(pA0, pA1, m_reg, mnA, alA, C, thr_raw);
    __syncthreads(); ATT_SWAIT(); ATT_SWRITE(1, s1_);
    ATT_RESC(alA); __syncthreads();
  }
  ATT_SBAR(); qkt<DQK>(pB0, pB1, K_lds + SHM_K, qr, r32, hi);
  finishSM(pA0, pA1, alA, l_reg, pa0, pa1, pa2, pa3); ATT_SBAR();
  pv_d0(o, vb0, pa0, pa1, pa2, pa3); partialSM(pB0, pB1, m_reg, mnB, alB, C, thr_raw);
  __syncthreads(); ATT_RESC(alB);
  finishSM(pB0, pB1, alB, l_reg, pa0, pa1, pa2, pa3); ATT_SBAR();
  pv_d0(o, vb0 + SHM_V, pa0, pa1, pa2, pa3);
  }
  if (hi == 0) li_l[r32] = l_reg; asm volatile("s_waitcnt lgkmcnt(0)" ::: "memory");
  float rli[16];
#pragma unroll
  for (int r = 0; r < 16; ++r) rli[r] = __builtin_amdgcn_rcpf(li_l[crow(r, hi)]);
  __syncthreads();
  float* Ot = (float*)(lds + wid * 16384);
#pragma unroll
  for (int r = 0; r < 16; ++r) { const int orow = crow(r, hi);
#pragma unroll
    for (int d0 = 0; d0 < 4; ++d0) Ot[orow * 128 + d0 * 32 + r32] = o[d0][r] * rli[r]; }
  asm volatile("s_waitcnt lgkmcnt(0)" ::: "memory");
  const int er = lane >> 4, ec = (lane & 15) * 8;
  if constexpr (MODE == 0) {
    bf16_t* Ow = oa.Ob + (long)(wid * QBLK + er) * oa.LDO + ec;
#pragma unroll
    for (int k = 0; k < 8; ++k) { const float* sp = Ot + (4 * k + er) * 128 + ec; const f32x4_t a = *(const f32x4_t*)sp, b = *(const f32x4_t*)(sp + 4);
      *(u32x4*)(Ow + (long)(4 * k) * oa.LDO) = (u32x4){cvtpk(a[0], a[1]), cvtpk(a[2], a[3]), cvtpk(b[0], b[1]), cvtpk(b[2], b[3])}; }
  } else if constexpr (MODE == 1) {
    float* Sw = oa.stash + (wid * QBLK + er) * 128 + ec;
#pragma unroll
    for (int k = 0; k < 8; ++k) { const float* sp = Ot + (4 * k + er) * 128 + ec; const f32x4_t a = *(const f32x4_t*)sp, b = *(const f32x4_t*)(sp + 4);
      *(f32x4_t*)(Sw + 4 * k * 128) = a; *(f32x4_t*)(Sw + 4 * k * 128 + 4) = b; }
  } else {
    const float* Sw = oa.stash + (wid * QBLK + er) * 128 + ec; bf16_t* Ow = oa.Ob + (long)(wid * QBLK + er) * oa.LDO + ec;
    const f32x4_t g0 = *(const f32x4_t*)(oa.g + ec) * oa.post, g1 = *(const f32x4_t*)(oa.g + ec + 4) * oa.post;
#pragma unroll
    for (int k = 0; k < 8; ++k) { asm volatile("" ::: "memory"); const float* sp = Ot + (4 * k + er) * 128 + ec; f32x4_t a = *(const f32x4_t*)sp, b = *(const f32x4_t*)(sp + 4);
      a = *(const f32x4_t*)(Sw + 4 * k * 128) - oa.lam * a; b = *(const f32x4_t*)(Sw + 4 * k * 128 + 4) - oa.lam * b;
      float ss = (a[0] * a[0] + a[1] * a[1]) + (a[2] * a[2] + a[3] * a[3]) + (b[0] * b[0] + b[1] * b[1]) + (b[2] * b[2] + b[3] * b[3]);
      ss += __shfl_xor(ss, 1); ss += __shfl_xor(ss, 2); ss += __shfl_xor(ss, 4); ss += __shfl_xor(ss, 8);
      const float rn = 1.0f / sqrtf(ss * (1.0f / 128.0f) + EPS);
      a = a * rn * g0; b = b * rn * g1;
      *(u32x4*)(Ow + (long)(4 * k) * oa.LDO) = (u32x4){cvtpk(a[0], a[1]), cvtpk(a[2], a[3]), cvtpk(b[0], b[1]), cvtpk(b[2], b[3])}; }
  }
  __syncthreads();
#undef ATT_SLOAD
#undef ATT_SWRITE
#undef ATT_SWAIT
#undef ATT_RESC
}

template <int DQK, int LDQ, int LDK, int LDV, int MODE>
__device__ __forceinline__ void attn_body2(const bf16_t* __restrict__ Qb, const bf16_t* __restrict__ Kh, const bf16_t* __restrict__ Vh,
                                           int seq, float scale, const OutArgs& oa, char* lds, __attribute__((address_space(3))) unsigned char* ldsl) {
  using CF = Cfg<DQK>;
  constexpr int ND0 = CF::ND0, SHM_K = CF::SHM_K, KROW = CF::KROW, SLOT = SHM_K + SHM_V, KCH = SHM_K / 1024, NKI = (KCH + 7) / 8;
  static_assert(SHM_K % 1024 == 0 && 3 * SLOT + NW * 256 <= 131072, "attention LDS ring");
  const float C = scale * 1.4426950408889634f, thr_raw = THR / scale;
  int tid_ = threadIdx.x; asm volatile("" : "+v"(tid_));
  const int tid = tid_, wid = __builtin_amdgcn_readfirstlane(tid >> 6), lane = tid & 63, r32 = lane & 31, hi = lane >> 5;
  float* ws = (float*)(lds + 3 * SLOT) + wid * 64; float* li_l = ws; float* al_l = ws + 32;
  float m_reg = -1e30f, l_reg = 0; f32x16 o[4] = {}; bf16x8 qr[ND0];
  int ksrc[NKI], vsrc[2];
#pragma unroll
  for (int i = 0; i < NKI; ++i) { const int ob = (wid + 8 * i) * 1024 + lane * 16, row = ob / KROW, within = ob - row * KROW; ksrc[i] = (row < KVBLK ? row : 0) * LDK + (within < 2 * DQK ? within / 2 : 0); }
#pragma unroll
  for (int i = 0; i < 2; ++i) { const int gi = (2 * wid + i) * 64 + lane, c8 = (gi & 3) | (((gi >> 5) & 3) << 2), kk = ((gi >> 2) & 7) | ((gi >> 7) << 3), k = (kk & ~0xC) | ((kk & 4) << 1) | ((kk & 8) >> 1); vsrc[i] = k * LDV + c8 * 8; }
#define ATT_GLDS(g, l) __builtin_amdgcn_global_load_lds((const unsigned*)(g), (__attribute__((address_space(3))) unsigned*)(l), 16, 0, 0)
#define ATT_DMA(k0, s) do { __attribute__((address_space(3))) unsigned char* _kb = ldsl + (s) * SLOT; \
    _Pragma("unroll") for (int _i = 0; _i < NKI; ++_i) { if (wid + 8 * _i < KCH) ATT_GLDS(Kh + (long)(k0) * LDK + ksrc[_i], _kb + (wid + 8 * _i) * 1024); } \
    _Pragma("unroll") for (int _i = 0; _i < 2; ++_i) ATT_GLDS(Vh + (long)(k0) * LDV + vsrc[_i], _kb + SHM_K + (2 * wid + _i) * 1024); } while (0)
#define ATT_BAR() do { asm volatile("s_waitcnt vmcnt(0) lgkmcnt(0)" ::: "memory"); __builtin_amdgcn_s_barrier(); asm volatile("" ::: "memory"); } while (0)
#define ATT_RESC2(a) do { if (__any((a) < 1.f)) { if (hi == 0) al_l[r32] = (a); asm volatile("s_waitcnt lgkmcnt(0)" ::: "memory"); \
    _Pragma("unroll") for (int d = 0; d < 4; ++d) _Pragma("unroll") for (int r = 0; r < 16; ++r) o[d][r] *= al_l[crow(r, hi)]; } } while (0)
  const int NT = seq / KVBLK;
  ATT_DMA(0, 0); ATT_DMA(KVBLK, 1);
  const bf16_t* Qw = Qb + (long)(wid * QBLK + r32) * LDQ + hi * 8;
#pragma unroll
  for (int d0 = 0; d0 < ND0; ++d0) qr[d0] = *reinterpret_cast<const bf16x8*>(Qw + d0 * 16);
  ATT_BAR();
  const int vb0 = (int)(uintptr_t)lds + SHM_K + v_rd_base(lane);
  f32x16 pA0, pA1, pB0, pB1; float mnA, mnB, alA, alB; bf16x8 pa0, pa1, pa2, pa3;
  qkt<DQK>(pA0, pA1, lds, qr, r32, hi); partialSM(pA0, pA1, m_reg, mnA, alA, C, thr_raw);
  if (2 < NT) ATT_DMA(2 * KVBLK, 2);
  int sj = 1, sp = 0;
  for (int j = 1; j + 1 < NT; j += 2) {
    ATT_SBAR(); qkt<DQK>(pB0, pB1, lds + sj * SLOT, qr, r32, hi);
    finishSM(pA0, pA1, alA, l_reg, pa0, pa1, pa2, pa3); ATT_SBAR();
    pv_d0(o, vb0 + sp * SLOT, pa0, pa1, pa2, pa3); partialSM(pB0, pB1, m_reg, mnB, alB, C, thr_raw);
    ATT_BAR();
    if (j + 2 < NT) ATT_DMA((j + 2) * KVBLK, sp);
    ATT_RESC2(alB);
    { const int t = sp; sp = sj; sj = (sj == 2) ? 0 : sj + 1; (void)t; }
    ATT_SBAR(); qkt<DQK>(pA0, pA1, lds + sj * SLOT, qr, r32, hi);
    finishSM(pB0, pB1, alB, l_reg, pa0, pa1, pa2, pa3); ATT_SBAR();
    pv_d0(o, vb0 + sp * SLOT, pa0, pa1, pa2, pa3); partialSM(pA0, pA1, m_reg, mnA, alA, C, thr_raw);
    ATT_BAR();
    if (j + 3 < NT) ATT_DMA((j + 3) * KVBLK, sp);
    ATT_RESC2(alA);
    { sp = sj; sj = (sj == 2) ? 0 : sj + 1; }
  }
  ATT_SBAR(); qkt<DQK>(pB0, pB1, lds + sj * SLOT, qr, r32, hi);
  finishSM(pA0, pA1, alA, l_reg, pa0, pa1, pa2, pa3); ATT_SBAR();
  pv_d0(o, vb0 + sp * SLOT, pa0, pa1, pa2, pa3); partialSM(pB0, pB1, m_reg, mnB, alB, C, thr_raw);
  ATT_RESC2(alB);
  finishSM(pB0, pB1, alB, l_reg, pa0, pa1, pa2, pa3); ATT_SBAR();
  pv_d0(o, vb0 + sj * SLOT, pa0, pa1, pa2, pa3);
  if (hi == 0) li_l[r32] = l_reg; asm volatile("s_waitcnt lgkmcnt(0)" ::: "memory");
  float rli[16];
#pragma unroll
  for (int r = 0; r < 16; ++r) rli[r] = __builtin_amdgcn_rcpf(li_l[crow(r, hi)]);
  ATT_BAR();
  float* Ot = (float*)(lds + wid * 16384);
#pragma unroll
  for (int r = 0; r < 16; ++r) { const int orow = crow(r, hi);
#pragma unroll
    for (int d0 = 0; d0 < 4; ++d0) Ot[orow * 128 + d0 * 32 + r32] = o[d0][r] * rli[r]; }
  asm volatile("s_waitcnt lgkmcnt(0)" ::: "memory");
  const int er = lane >> 4, ec = (lane & 15) * 8;
  if constexpr (MODE == 0) {
    bf16_t* Ow = oa.Ob + (long)(wid * QBLK + er) * oa.LDO + ec;
#pragma unroll
    for (int k = 0; k < 8; ++k) { const float* sp2 = Ot + (4 * k + er) * 128 + ec; const f32x4_t a = *(const f32x4_t*)sp2, b = *(const f32x4_t*)(sp2 + 4);
      *(u32x4*)(Ow + (long)(4 * k) * oa.LDO) = (u32x4){cvtpk(a[0], a[1]), cvtpk(a[2], a[3]), cvtpk(b[0], b[1]), cvtpk(b[2], b[3])}; }
  } else if constexpr (MODE == 1) {
    float* Sw = oa.stash + (wid * QBLK + er) * 128 + ec;
#pragma unroll
    for (int k = 0; k < 8; ++k) { const float* sp2 = Ot + (4 * k + er) * 128 + ec; const f32x4_t a = *(const f32x4_t*)sp2, b = *(const f32x4_t*)(sp2 + 4);
      *(f32x4_t*)(Sw + 4 * k * 128) = a; *(f32x4_t*)(Sw + 4 * k * 128 + 4) = b; }
  } else {
    const float* Sw = oa.stash + (wid * QBLK + er) * 128 + ec; bf16_t* Ow = oa.Ob + (long)(wid * QBLK + er) * oa.LDO + ec;
    const f32x4_t g0 = *(const f32x4_t*)(oa.g + ec) * oa.post, g1 = *(const f32x4_t*)(oa.g + ec + 4) * oa.post;
#pragma unroll
    for (int k = 0; k < 8; ++k) { asm volatile("" ::: "memory"); const float* sp2 = Ot + (4 * k + er) * 128 + ec; f32x4_t a = *(const f32x4_t*)sp2, b = *(const f32x4_t*)(sp2 + 4);
      a = *(const f32x4_t*)(Sw + 4 * k * 128) - oa.lam * a; b = *(const f32x4_t*)(Sw + 4 * k * 128 + 4) - oa.lam * b;
      float ss = (a[0] * a[0] + a[1] * a[1]) + (a[2] * a[2] + a[3] * a[3]) + (b[0] * b[0] + b[1] * b[1]) + (b[2] * b[2] + b[3] * b[3]);
      ss += __shfl_xor(ss, 1); ss += __shfl_xor(ss, 2); ss += __shfl_xor(ss, 4); ss += __shfl_xor(ss, 8);
      const float rn = 1.0f / sqrtf(ss * (1.0f / 128.0f) + EPS);
      a = a * rn * g0; b = b * rn * g1;
      *(u32x4*)(Ow + (long)(4 * k) * oa.LDO) = (u32x4){cvtpk(a[0], a[1]), cvtpk(a[2], a[3]), cvtpk(b[0], b[1]), cvtpk(b[2], b[3])}; }
  }
  ATT_BAR();
#undef ATT_GLDS
#undef ATT_DMA
#undef ATT_BAR
#undef ATT_RESC2
}

template <int OFF> __device__ __forceinline__ bf16x8 ds_rd128(int addr) { bf16x8 r; asm volatile("ds_read_b128 %0, %1 offset:%2" : "=&v"(r) : "v"(addr), "i"(OFF) : "memory"); return r; }
template <int N> __device__ __forceinline__ void wait_lgkm() { asm volatile("s_waitcnt lgkmcnt(%0)" :: "n"(N) : "memory"); }
#define ATT_RKG(dst, g) do { dst[0] = ds_rd128<(2 * (g)) * 32>(kb); dst[1] = ds_rd128<(2 * (g)) * 32 + 32 * KROW>(kb); dst[2] = ds_rd128<(2 * (g) + 1) * 32>(kb); dst[3] = ds_rd128<(2 * (g) + 1) * 32 + 32 * KROW>(kb); } while (0)
#define ATT_MKG(src, g) do { p0 = __builtin_amdgcn_mfma_f32_32x32x16_bf16(src[0], qr[2 * (g)], p0, 0, 0, 0); p1 = __builtin_amdgcn_mfma_f32_32x32x16_bf16(src[1], qr[2 * (g)], p1, 0, 0, 0); \
    p0 = __builtin_amdgcn_mfma_f32_32x32x16_bf16(src[2], qr[2 * (g) + 1], p0, 0, 0, 0); p1 = __builtin_amdgcn_mfma_f32_32x32x16_bf16(src[3], qr[2 * (g) + 1], p1, 0, 0, 0); } while (0)
#define ATT_PKV(L, H) (bf16x8){L[0], L[1], L[2], L[3], H[0], H[1], H[2], H[3]}
#define ATT_VRD(D0, P) const s16x4 P##l0 = tr_read<v_rd_off(D0, 0, 0)>(vb), P##h0 = tr_read<v_rd_off(D0, 0, 1)>(vb), P##l1 = tr_read<v_rd_off(D0, 1, 0)>(vb), P##h1 = tr_read<v_rd_off(D0, 1, 1)>(vb), \
    P##l2 = tr_read<v_rd_off(D0, 2, 0)>(vb), P##h2 = tr_read<v_rd_off(D0, 2, 1)>(vb), P##l3 = tr_read<v_rd_off(D0, 3, 0)>(vb), P##h3 = tr_read<v_rd_off(D0, 3, 1)>(vb)
#define ATT_VMM(od, P) do { od = __builtin_amdgcn_mfma_f32_32x32x16_bf16(pa0, ATT_PKV(P##l0, P##h0), od, 0, 0, 0); od = __builtin_amdgcn_mfma_f32_32x32x16_bf16(pa1, ATT_PKV(P##l1, P##h1), od, 0, 0, 0); \
    od = __builtin_amdgcn_mfma_f32_32x32x16_bf16(pa2, ATT_PKV(P##l2, P##h2), od, 0, 0, 0); od = __builtin_amdgcn_mfma_f32_32x32x16_bf16(pa3, ATT_PKV(P##l3, P##h3), od, 0, 0, 0); } while (0)
#define ATT_W(n) do { wait_lgkm<n>(); ATT_SBAR(); } while (0)
template <int DQK, bool PV> __device__ __forceinline__ void att_mblock(f32x16& p0, f32x16& p1, f32x16* o, const bf16x8* qr, int kb, int vb, bf16x8 pa0, bf16x8 pa1, bf16x8 pa2, bf16x8 pa3) {
  constexpr int KROW = Cfg<DQK>::KROW, NG = DQK / 32;
  constexpr int WK = PV ? 8 : 0;
  bf16x8 kA[4], kB[4];
  p0 = f32x16{}; p1 = f32x16{};
  ATT_RKG(kA, 0); ATT_RKG(kB, 1);
  if constexpr (NG == 2) {
    if constexpr (PV) {
      ATT_W(4); ATT_MKG(kA, 0); ATT_SBAR(); ATT_VRD(0, a);
      ATT_W(8); ATT_MKG(kB, 1); ATT_SBAR(); ATT_VRD(1, b);
      ATT_W(8); ATT_VMM(o[0], a); ATT_SBAR(); ATT_VRD(2, c);
      ATT_W(8); ATT_VMM(o[1], b); ATT_SBAR(); ATT_VRD(3, d);
      ATT_W(8); ATT_VMM(o[2], c); ATT_SBAR();
      ATT_W(0); ATT_VMM(o[3], d);
    } else { ATT_W(4); ATT_MKG(kA, 0); ATT_SBAR(); ATT_W(0); ATT_MKG(kB, 1); }
  } else if constexpr (NG == 4) {
    ATT_W(4); ATT_MKG(kA, 0); ATT_SBAR(); ATT_RKG(kA, 2);
    ATT_W(4); ATT_MKG(kB, 1); ATT_SBAR(); ATT_RKG(kB, 3);
    if constexpr (PV) {
      ATT_W(4); ATT_MKG(kA, 2); ATT_SBAR(); ATT_VRD(0, a);
      ATT_W(8); ATT_MKG(kB, 3); ATT_SBAR(); ATT_VRD(1, b);
      ATT_W(8); ATT_VMM(o[0], a); ATT_SBAR(); ATT_VRD(2, c);
      ATT_W(8); ATT_VMM(o[1], b); ATT_SBAR(); ATT_VRD(3, d);
      ATT_W(8); ATT_VMM(o[2], c); ATT_SBAR();
      ATT_W(0); ATT_VMM(o[3], d);
    } else { ATT_W(4); ATT_MKG(kA, 2); ATT_SBAR(); ATT_W(0); ATT_MKG(kB, 3); }
  } else {
    ATT_W(4); ATT_MKG(kA, 0); ATT_SBAR(); ATT_RKG(kA, 2);
    ATT_W(4); ATT_MKG(kB, 1); ATT_SBAR(); ATT_RKG(kB, 3);
    ATT_W(4); ATT_MKG(kA, 2); ATT_SBAR(); ATT_RKG(kA, 4);
    ATT_W(4); ATT_MKG(kB, 3); ATT_SBAR(); ATT_RKG(kB, 5);
    if constexpr (PV) {
      ATT_W(4); ATT_MKG(kA, 4); ATT_SBAR(); ATT_VRD(0, a);
      ATT_W(8); ATT_MKG(kB, 5); ATT_SBAR(); ATT_VRD(1, b);
      ATT_W(8); ATT_VMM(o[0], a); ATT_SBAR(); ATT_VRD(2, c);
      ATT_W(8); ATT_VMM(o[1], b); ATT_SBAR(); ATT_VRD(3, d);
      ATT_W(8); ATT_VMM(o[2], c); ATT_SBAR();
      ATT_W(0); ATT_VMM(o[3], d);
    } else { ATT_W(4); ATT_MKG(kA, 4); ATT_SBAR(); ATT_W(0); ATT_MKG(kB, 5); }
  }
  (void)WK;
}
__device__ __forceinline__ void att_pvblock(f32x16* o, int vb, bf16x8 pa0, bf16x8 pa1, bf16x8 pa2, bf16x8 pa3) {
  ATT_VRD(0, a); ATT_VRD(1, b);
  ATT_W(8); ATT_VMM(o[0], a); ATT_SBAR(); ATT_VRD(2, c);
  ATT_W(8); ATT_VMM(o[1], b); ATT_SBAR(); ATT_VRD(3, d);
  ATT_W(8); ATT_VMM(o[2], c); ATT_SBAR();
  ATT_W(0); ATT_VMM(o[3], d);
}

template <int DQK, int LDQ, int LDK, int LDV, int MODE>
__device__ __forceinline__ void attn_body3(const bf16_t* __restrict__ Qb, const bf16_t* __restrict__ Kh, const bf16_t* __restrict__ Vh,
                                           int seq, float scale, const OutArgs& oa, char* lds, __attribute__((address_space(3))) unsigned char* ldsl) {
  using CF = Cfg<DQK>;
  constexpr int ND0 = CF::ND0, SHM_K = CF::SHM_K, KROW = CF::KROW, SLOT = SHM_K + SHM_V, KCH = SHM_K / 1024, NKI = (KCH + 7) / 8, NDMA = NKI + 2;
  static_assert(SHM_K % 1024 == 0 && 3 * SLOT + NW * 256 + 1024 <= 131072, "attention LDS ring");
  const float C = scale * 1.4426950408889634f, thr_raw = THR / scale;
  int tid_ = threadIdx.x; asm volatile("" : "+v"(tid_));
  const int tid = tid_, wid = __builtin_amdgcn_readfirstlane(tid >> 6), lane = tid & 63, r32 = lane & 31, hi = lane >> 5, grp = wid >> 2;
  float* ws = (float*)(lds + 3 * SLOT) + wid * 64; float* li_l = ws; float* al_l = ws + 32;
  float m_reg = -1e30f, l_reg = 0; f32x16 o[4] = {}; bf16x8 qr[ND0];
  int ksrc[NKI], vsrc[2];
#pragma unroll
  for (int i = 0; i < NKI; ++i) { const int ob = (wid + 8 * i) * 1024 + lane * 16, row = ob / KROW, within = ob - row * KROW; ksrc[i] = (row < KVBLK ? row : 0) * LDK + (within < 2 * DQK ? within / 2 : 0); }
#pragma unroll
  for (int i = 0; i < 2; ++i) { const int gi = (2 * wid + i) * 64 + lane, c8 = (gi & 3) | (((gi >> 5) & 3) << 2), kk = ((gi >> 2) & 7) | ((gi >> 7) << 3), k = (kk & ~0xC) | ((kk & 4) << 1) | ((kk & 8) >> 1); vsrc[i] = k * LDV + c8 * 8; }
#define ATT_GLDS(g, l) __builtin_amdgcn_global_load_lds((const unsigned*)(g), (__attribute__((address_space(3))) unsigned*)(l), 16, 0, 0)
#define ATT_DMA(k0, s) do { __attribute__((address_space(3))) unsigned char* _kb = ldsl + (s) * SLOT; \
    _Pragma("unroll") for (int _i = 0; _i < NKI; ++_i) { const int _ci = wid + 8 * _i; ATT_GLDS(Kh + (long)(k0) * LDK + ksrc[_i], _ci < KCH ? _kb + _ci * 1024 : ldsl + 3 * SLOT + NW * 256); } \
    _Pragma("unroll") for (int _i = 0; _i < 2; ++_i) ATT_GLDS(Vh + (long)(k0) * LDV + vsrc[_i], _kb + SHM_K + (2 * wid + _i) * 1024); } while (0)
#define ATT_BAR0() do { asm volatile("s_waitcnt vmcnt(0) lgkmcnt(0)" ::: "memory"); __builtin_amdgcn_s_barrier(); asm volatile("" ::: "memory"); } while (0)
#define ATT_BARN() do { asm volatile("s_waitcnt vmcnt(%0) lgkmcnt(0)" :: "n"(NDMA) : "memory"); __builtin_amdgcn_s_barrier(); asm volatile("" ::: "memory"); } while (0)
  const int NT = seq / KVBLK;
  ATT_DMA(0, 0); ATT_DMA(KVBLK, 1);
  const bf16_t* Qw = Qb + (long)(wid * QBLK + r32) * LDQ + hi * 8;
#pragma unroll
  for (int d0 = 0; d0 < ND0; ++d0) qr[d0] = *reinterpret_cast<const bf16x8*>(Qw + d0 * 16);
  ATT_BAR0();
  const int vb0 = (int)(uintptr_t)lds + SHM_K + v_rd_base(lane);
  f32x16 p0, p1; float mn, al; bf16x8 pa0 = {}, pa1 = {}, pa2 = {}, pa3 = {};
  if (grp) ATT_BAR0();
  const int kb0 = (int)(uintptr_t)lds + r32 * KROW + hi * 16;
#define ATT_VBLOCK() do { partialSM(p0, p1, m_reg, mn, al, C, thr_raw); \
    if (__any(al < 1.f)) { if (hi == 0) al_l[r32] = al; asm volatile("s_waitcnt lgkmcnt(0)" ::: "memory"); \
      _Pragma("unroll") for (int d = 0; d < 4; ++d) _Pragma("unroll") for (int r = 0; r < 16; ++r) o[d][r] *= al_l[crow(r, hi)]; } \
    finishSM(p0, p1, al, l_reg, pa0, pa1, pa2, pa3); ATT_SBAR(); } while (0)
  ATT_SBAR(); att_mblock<DQK, false>(p0, p1, o, qr, kb0, vb0, pa0, pa1, pa2, pa3); ATT_SBAR();
  if (grp == 0) ATT_BARN(); else ATT_BAR0();
  if (grp == 1 && 2 < NT) ATT_DMA(2 * KVBLK, 2);
  ATT_VBLOCK();
  if (grp == 0) ATT_BAR0(); else ATT_BARN();
  int sj = 1, sp = 0;
  for (int j = 1; j < NT; ++j) {
    if (grp == 0 && j + 1 < NT) ATT_DMA((j + 1) * KVBLK, (sj == 2) ? 0 : sj + 1);
    ATT_SBAR(); att_mblock<DQK, true>(p0, p1, o, qr, kb0 + sj * SLOT, vb0 + sp * SLOT, pa0, pa1, pa2, pa3); ATT_SBAR();
#if defined(ATT_PROBE_M)
    { f32x16 q0, q1; att_mblock<DQK, false>(q0, q1, o, qr, kb0 + sj * SLOT, vb0 + sp * SLOT, pa0, pa1, pa2, pa3); asm volatile("" :: "v"(q0), "v"(q1)); ATT_SBAR(); }
#endif
    if (grp == 0) ATT_BARN(); else ATT_BAR0();
    if (grp == 1 && j + 2 < NT) ATT_DMA((j + 2) * KVBLK, sp);
#if defined(ATT_PROBE_V)
    f32x16 q0 = p0, q1 = p1; float qm = m_reg, ql = l_reg;
#endif
    ATT_VBLOCK();
#if defined(ATT_PROBE_V)
    { float qmn, qal; bf16x8 d0_, d1_, d2_, d3_; partialSM(q0, q1, qm, qmn, qal, C, thr_raw); finishSM(q0, q1, qal, ql, d0_, d1_, d2_, d3_); asm volatile("" :: "v"(d0_), "v"(d1_), "v"(d2_), "v"(d3_), "v"(ql)); ATT_SBAR(); }
#endif
    if (grp == 0) ATT_BAR0(); else ATT_BARN();
    sp = sj; sj = (sj == 2) ? 0 : sj + 1;
  }
  att_pvblock(o, vb0 + sp * SLOT, pa0, pa1, pa2, pa3);
  if (grp == 0) ATT_BAR0();
  if (hi == 0) li_l[r32] = l_reg; asm volatile("s_waitcnt lgkmcnt(0)" ::: "memory");
  float rli[16];
#pragma unroll
  for (int r = 0; r < 16; ++r) rli[r] = __builtin_amdgcn_rcpf(li_l[crow(r, hi)]);
  ATT_BAR0();
  float* Ot = (float*)(lds + wid * 16384);
#pragma unroll
  for (int r = 0; r < 16; ++r) { const int orow = crow(r, hi);
#pragma unroll
    for (int d0 = 0; d0 < 4; ++d0) Ot[orow * 128 + d0 * 32 + r32] = o[d0][r] * rli[r]; }
  asm volatile("s_waitcnt lgkmcnt(0)" ::: "memory");
  const int er = lane >> 4, ec = (lane & 15) * 8;
  if constexpr (MODE == 0) {
    bf16_t* Ow = oa.Ob + (long)(wid * QBLK + er) * oa.LDO + ec;
#pragma unroll
    for (int k = 0; k < 8; ++k) { const float* sp2 = Ot + (4 * k + er) * 128 + ec; const f32x4_t a = *(const f32x4_t*)sp2, b = *(const f32x4_t*)(sp2 + 4);
      *(u32x4*)(Ow + (long)(4 * k) * oa.LDO) = (u32x4){cvtpk(a[0], a[1]), cvtpk(a[2], a[3]), cvtpk(b[0], b[1]), cvtpk(b[2], b[3])}; }
  } else if constexpr (MODE == 1) {
    float* Sw = oa.stash + (wid * QBLK + er) * 128 + ec;
#pragma unroll
    for (int k = 0; k < 8; ++k) { const float* sp2 = Ot + (4 * k + er) * 128 + ec; const f32x4_t a = *(const f32x4_t*)sp2, b = *(const f32x4_t*)(sp2 + 4);
      *(f32x4_t*)(Sw + 4 * k * 128) = a; *(f32x4_t*)(Sw + 4 * k * 128 + 4) = b; }
  } else {
    const float* Sw = oa.stash + (wid * QBLK + er) * 128 + ec; bf16_t* Ow = oa.Ob + (long)(wid * QBLK + er) * oa.LDO + ec;
    const f32x4_t g0 = *(const f32x4_t*)(oa.g + ec) * oa.post, g1 = *(const f32x4_t*)(oa.g + ec + 4) * oa.post;
#pragma unroll
    for (int k = 0; k < 8; ++k) { asm volatile("" ::: "memory"); const float* sp2 = Ot + (4 * k + er) * 128 + ec; f32x4_t a = *(const f32x4_t*)sp2, b = *(const f32x4_t*)(sp2 + 4);
      a = *(const f32x4_t*)(Sw + 4 * k * 128) - oa.lam * a; b = *(const f32x4_t*)(Sw + 4 * k * 128 + 4) - oa.lam * b;
      float ss = (a[0] * a[0] + a[1] * a[1]) + (a[2] * a[2] + a[3] * a[3]) + (b[0] * b[0] + b[1] * b[1]) + (b[2] * b[2] + b[3] * b[3]);
      ss += __shfl_xor(ss, 1); ss += __shfl_xor(ss, 2); ss += __shfl_xor(ss, 4); ss += __shfl_xor(ss, 8);
      const float rn = 1.0f / sqrtf(ss * (1.0f / 128.0f) + EPS);
      a = a * rn * g0; b = b * rn * g1;
      *(u32x4*)(Ow + (long)(4 * k) * oa.LDO) = (u32x4){cvtpk(a[0], a[1]), cvtpk(a[2], a[3]), cvtpk(b[0], b[1]), cvtpk(b[2], b[3])}; }
  }
  ATT_BAR0();
#undef ATT_GLDS
#undef ATT_DMA
#undef ATT_BAR0
#undef ATT_BARN
#undef ATT_VBLOCK
}

#define ATT4_SWAP(OUTA, OUTB, A, B) do { const auto _r = __builtin_amdgcn_permlane32_swap((A), (B), false, false); OUTA = _r[0]; OUTB = _r[1]; } while (0)
#define ATT4_PKSTEP(st, P, BASE, OUT) do { \
    if ((st) == 0) { ft0 = cvtpk(P[BASE + 0], P[BASE + 1]); ft1 = cvtpk(P[BASE + 2], P[BASE + 3]); } \
    if ((st) == 1) { ft2 = cvtpk(P[BASE + 4], P[BASE + 5]); ft3 = cvtpk(P[BASE + 6], P[BASE + 7]); } \
    if ((st) == 3) { const u32x4 _w = {ft0, ft1, ft2, ft3}; OUT = __builtin_bit_cast(bf16x8, _w); } } while (0)
#define ATT4_FCH(c, O0, O1) do { O1[c] = __builtin_amdgcn_exp2f(O1[c]); \
    if ((c) == 0) { accA_ = O0[0]; accB_ = 0.f; } else { accA_ += O0[c]; accB_ += O1[((c) > 0 ? (c) - 1 : 0)]; } \
    if ((c) < 4) ATT4_PKSTEP((c) & 3, O0, 0, pa0); else if ((c) < 8) ATT4_PKSTEP((c) & 3, O0, 8, pa1); else if ((c) < 12) ATT4_PKSTEP((c) & 3, O1, 0, pa2); } while (0)
#define ATT4_FT(O0, O1, alO) do { ATT4_PKSTEP(0, O1, 8, pa3); ATT4_PKSTEP(1, O1, 8, pa3); ATT4_PKSTEP(2, O1, 8, pa3); ATT4_PKSTEP(3, O1, 8, pa3); \
    float _ps = accA_ + accB_ + O1[15]; unsigned _a, _b; ATT4_SWAP(_a, _b, __float_as_uint(_ps), __float_as_uint(_ps)); _ps = __uint_as_float(_a) + __uint_as_float(_b); l_reg = l_reg * (alO) + _ps; } while (0)
#define ATT4_MAX3(a, b, c) __builtin_fmaxf(__builtin_fmaxf((a), (b)), (c))
#define ATT4_NV(i, N0, N1) ((i) < 16 ? N0[(i) & 15] : N1[(i) & 15])
#define ATT4_SCH(k, N0, N1, O0, O1, mnN, alN, alO) do { \
    if ((k) == 0) ATT4_FT(O0, O1, alO); \
    if ((k) == 1) { x0 = ATT4_MAX3(N0[0], N0[1], N0[2]); x1 = ATT4_MAX3(N0[3], N0[4], N0[5]); x2 = ATT4_MAX3(N0[6], N0[7], N0[8]); x3 = ATT4_MAX3(N0[9], N0[10], N0[11]); } \
    if ((k) == 2) { x4 = ATT4_MAX3(N0[12], N0[13], N0[14]); x5 = ATT4_MAX3(N0[15], N1[0], N1[1]); x6 = ATT4_MAX3(N1[2], N1[3], N1[4]); x7 = ATT4_MAX3(N1[5], N1[6], N1[7]); } \
    if ((k) == 3) { x8 = ATT4_MAX3(N1[8], N1[9], N1[10]); x9 = ATT4_MAX3(N1[11], N1[12], N1[13]); x10 = ATT4_MAX3(N1[13], N1[14], N1[15]);     x0 = ATT4_MAX3(x0, x1, x2); } \
    if ((k) == 4) { x1 = ATT4_MAX3(x3, x4, x5); x2 = ATT4_MAX3(x6, x7, x8); x3 = ATT4_MAX3(x9, x10, x0); x0 = ATT4_MAX3(x1, x2, x3); } \
    if ((k) == 5) { unsigned _a, _b; ATT4_SWAP(_a, _b, __float_as_uint(x0), __float_as_uint(x0)); float _pm; asm("v_max_f32 %0, %1, %2" : "=v"(_pm) : "v"(_a), "v"(_b));     \
        alN = 1.f; if (__builtin_expect(__any(_pm > THRS), 0)) { const float _dl = __builtin_fmaxf(_pm, 0.f); m_reg += _dl; alN = __builtin_amdgcn_exp2f(-_dl); \
            _Pragma("unroll") for (int _i = 0; _i < 16; ++_i) { N0[_i] -= _dl; N1[_i] -= _dl; negm[_i] = -m_reg; } } } \
    if ((k) >= 6 && (k) <= 11) { N0[2 * ((k) - 6)] = __builtin_amdgcn_exp2f(N0[2 * ((k) - 6)]); N0[2 * ((k) - 6) + 1] = __builtin_amdgcn_exp2f(N0[2 * ((k) - 6) + 1]); } \
    if ((k) >= 12 && (k) <= 15) { N0[(k)] = __builtin_amdgcn_exp2f(N0[(k)]); } } while (0)
#define ATT4_MFMA_O(od, A, B) do { od = __builtin_amdgcn_mfma_f32_32x32x16_bf16((A), (B), od, 0, 0, 0); } while (0)
#define ATT4_HALF_64(N0, N1, O0, O1, mnN, alN, alO, kb, vb) do { constexpr int KROW = 144; \
    kq[0][0] = ds_rd128<0>(kb); kq[0][1] = ds_rd128<0 + 32 * KROW>(kb); \
    kq[1][0] = ds_rd128<32>(kb); kq[1][1] = ds_rd128<32 + 32 * KROW>(kb); \
    kq[2][0] = ds_rd128<64>(kb); kq[2][1] = ds_rd128<64 + 32 * KROW>(kb); \
    wait_lgkm<4>(); ATT_SBAR(); \
    N0 = __builtin_amdgcn_mfma_f32_32x32x16_bf16(kq[0][0], qr[0], negm, 0, 0, 0); ATT4_FCH(0, O0, O1); ATT4_FCH(1, O0, O1); ATT_SBAR(); \
    N1 = __builtin_amdgcn_mfma_f32_32x32x16_bf16(kq[0][1], qr[0], negm, 0, 0, 0); ATT4_FCH(2, O0, O1); ATT4_FCH(3, O0, O1); ATT_SBAR(); \
    kq[0][0] = ds_rd128<96>(kb); kq[0][1] = ds_rd128<96 + 32 * KROW>(kb); \
    wait_lgkm<4>(); ATT_SBAR(); \
    N0 = __builtin_amdgcn_mfma_f32_32x32x16_bf16(kq[1][0], qr[1], N0, 0, 0, 0); ATT4_FCH(4, O0, O1); ATT4_FCH(5, O0, O1); ATT_SBAR(); \
    N1 = __builtin_amdgcn_mfma_f32_32x32x16_bf16(kq[1][1], qr[1], N1, 0, 0, 0); ATT4_FCH(6, O0, O1); ATT4_FCH(7, O0, O1); ATT_SBAR(); \
    vq[1][0] = tr_read<v_rd_off(0, 0, 0)>(vb); vq[1][1] = tr_read<v_rd_off(0, 0, 1)>(vb); vq[1][2] = tr_read<v_rd_off(0, 1, 0)>(vb); vq[1][3] = tr_read<v_rd_off(0, 1, 1)>(vb); \
    wait_lgkm<6>(); ATT_SBAR(); \
    N0 = __builtin_amdgcn_mfma_f32_32x32x16_bf16(kq[2][0], qr[2], N0, 0, 0, 0); ATT4_FCH(8, O0, O1); ATT4_FCH(9, O0, O1); ATT_SBAR(); \
    N1 = __builtin_amdgcn_mfma_f32_32x32x16_bf16(kq[2][1], qr[2], N1, 0, 0, 0); ATT4_FCH(10, O0, O1); ATT4_FCH(11, O0, O1); ATT_SBAR(); \
    vq[2][0] = tr_read<v_rd_off(0, 2, 0)>(vb); vq[2][1] = tr_read<v_rd_off(0, 2, 1)>(vb); vq[2][2] = tr_read<v_rd_off(0, 3, 0)>(vb); vq[2][3] = tr_read<v_rd_off(0, 3, 1)>(vb); \
    wait_lgkm<8>(); ATT_SBAR(); \
    N0 = __builtin_amdgcn_mfma_f32_32x32x16_bf16(kq[0][0], qr[3], N0, 0, 0, 0); ATT4_FCH(12, O0, O1); ATT4_FCH(13, O0, O1); ATT_SBAR(); \
    N1 = __builtin_amdgcn_mfma_f32_32x32x16_bf16(kq[0][1], qr[3], N1, 0, 0, 0); ATT4_FCH(14, O0, O1); ATT4_FCH(15, O0, O1); ATT_SBAR(); \
    vq[0][0] = tr_read<v_rd_off(1, 0, 0)>(vb); vq[0][1] = tr_read<v_rd_off(1, 0, 1)>(vb); vq[0][2] = tr_read<v_rd_off(1, 1, 0)>(vb); vq[0][3] = tr_read<v_rd_off(1, 1, 1)>(vb); \
    wait_lgkm<8>(); ATT_SBAR(); \
    ATT4_MFMA_O(o[0], pa0, ATT_PKV(vq[1][0], vq[1][1])); ATT4_SCH(0, N0, N1, O0, O1, mnN, alN, alO); ATT_SBAR(); \
    ATT4_MFMA_O(o[0], pa1, ATT_PKV(vq[1][2], vq[1][3])); ATT4_SCH(1, N0, N1, O0, O1, mnN, alN, alO); ATT_SBAR(); \
    vq[1][0] = tr_read<v_rd_off(1, 2, 0)>(vb); vq[1][1] = tr_read<v_rd_off(1, 2, 1)>(vb); vq[1][2] = tr_read<v_rd_off(1, 3, 0)>(vb); vq[1][3] = tr_read<v_rd_off(1, 3, 1)>(vb); \
    wait_lgkm<8>(); ATT_SBAR(); \
    ATT4_MFMA_O(o[0], pa2, ATT_PKV(vq[2][0], vq[2][1])); ATT4_SCH(2, N0, N1, O0, O1, mnN, alN, alO); ATT_SBAR(); \
    ATT4_MFMA_O(o[0], pa3, ATT_PKV(vq[2][2], vq[2][3])); ATT4_SCH(3, N0, N1, O0, O1, mnN, alN, alO); ATT_SBAR(); \
    vq[2][0] = tr_read<v_rd_off(2, 0, 0)>(vb); vq[2][1] = tr_read<v_rd_off(2, 0, 1)>(vb); vq[2][2] = tr_read<v_rd_off(2, 1, 0)>(vb); vq[2][3] = tr_read<v_rd_off(2, 1, 1)>(vb); \
    wait_lgkm<8>(); ATT_SBAR(); \
    ATT4_MFMA_O(o[1], pa0, ATT_PKV(vq[0][0], vq[0][1])); ATT4_SCH(4, N0, N1, O0, O1, mnN, alN, alO); ATT_SBAR(); \
    ATT4_MFMA_O(o[1], pa1, ATT_PKV(vq[0][2], vq[0][3])); ATT4_SCH(5, N0, N1, O0, O1, mnN, alN, alO); ATT_SBAR(); \
    vq[0][0] = tr_read<v_rd_off(2, 2, 0)>(vb); vq[0][1] = tr_read<v_rd_off(2, 2, 1)>(vb); vq[0][2] = tr_read<v_rd_off(2, 3, 0)>(vb); vq[0][3] = tr_read<v_rd_off(2, 3, 1)>(vb); \
    wait_lgkm<8>(); ATT_SBAR(); \
    ATT4_MFMA_O(o[1], pa2, ATT_PKV(vq[1][0], vq[1][1])); ATT4_SCH(6, N0, N1, O0, O1, mnN, alN, alO); ATT_SBAR(); \
    ATT4_MFMA_O(o[1], pa3, ATT_PKV(vq[1][2], vq[1][3])); ATT4_SCH(7, N0, N1, O0, O1, mnN, alN, alO); ATT_SBAR(); \
    vq[1][0] = tr_read<v_rd_off(3, 0, 0)>(vb); vq[1][1] = tr_read<v_rd_off(3, 0, 1)>(vb); vq[1][2] = tr_read<v_rd_off(3, 1, 0)>(vb); vq[1][3] = tr_read<v_rd_off(3, 1, 1)>(vb); \
    wait_lgkm<8>(); ATT_SBAR(); \
    ATT4_MFMA_O(o[2], pa0, ATT_PKV(vq[2][0], vq[2][1])); ATT4_SCH(8, N0, N1, O0, O1, mnN, alN, alO); ATT_SBAR(); \
    ATT4_MFMA_O(o[2], pa1, ATT_PKV(vq[2][2], vq[2][3])); ATT4_SCH(9, N0, N1, O0, O1, mnN, alN, alO); ATT_SBAR(); \
    vq[2][0] = tr_read<v_rd_off(3, 2, 0)>(vb); vq[2][1] = tr_read<v_rd_off(3, 2, 1)>(vb); vq[2][2] = tr_read<v_rd_off(3, 3, 0)>(vb); vq[2][3] = tr_read<v_rd_off(3, 3, 1)>(vb); \
    wait_lgkm<8>(); ATT_SBAR(); \
    ATT4_MFMA_O(o[2], pa2, ATT_PKV(vq[0][0], vq[0][1])); ATT4_SCH(10, N0, N1, O0, O1, mnN, alN, alO); ATT_SBAR(); \
    ATT4_MFMA_O(o[2], pa3, ATT_PKV(vq[0][2], vq[0][3])); ATT4_SCH(11, N0, N1, O0, O1, mnN, alN, alO); ATT_SBAR(); \
    wait_lgkm<4>(); ATT_SBAR(); \
    ATT4_MFMA_O(o[3], pa0, ATT_PKV(vq[1][0], vq[1][1])); ATT4_SCH(12, N0, N1, O0, O1, mnN, alN, alO); ATT_SBAR(); \
    ATT4_MFMA_O(o[3], pa1, ATT_PKV(vq[1][2], vq[1][3])); ATT4_SCH(13, N0, N1, O0, O1, mnN, alN, alO); ATT_SBAR(); \
    wait_lgkm<0>(); ATT_SBAR(); \
    ATT4_MFMA_O(o[3], pa2, ATT_PKV(vq[2][0], vq[2][1])); ATT4_SCH(14, N0, N1, O0, O1, mnN, alN, alO); ATT_SBAR(); \
    ATT4_MFMA_O(o[3], pa3, ATT_PKV(vq[2][2], vq[2][3])); ATT4_SCH(15, N0, N1, O0, O1, mnN, alN, alO); ATT_SBAR(); } while (0)
#define ATT4_HALF_128(N0, N1, O0, O1, mnN, alN, alO, kb, vb) do { constexpr int KROW = 272; \
    kq[0][0] = ds_rd128<0>(kb); kq[0][1] = ds_rd128<0 + 32 * KROW>(kb); \
    kq[1][0] = ds_rd128<32>(kb); kq[1][1] = ds_rd128<32 + 32 * KROW>(kb); \
    kq[2][0] = ds_rd128<64>(kb); kq[2][1] = ds_rd128<64 + 32 * KROW>(kb); \
    wait_lgkm<4>(); ATT_SBAR(); \
    N0 = __builtin_amdgcn_mfma_f32_32x32x16_bf16(kq[0][0], qr[0], negm, 0, 0, 0); ATT4_FCH(0, O0, O1); ATT_SBAR(); \
    N1 = __builtin_amdgcn_mfma_f32_32x32x16_bf16(kq[0][1], qr[0], negm, 0, 0, 0); ATT4_FCH(1, O0, O1); ATT_SBAR(); \
    kq[0][0] = ds_rd128<96>(kb); kq[0][1] = ds_rd128<96 + 32 * KROW>(kb); \
    wait_lgkm<4>(); ATT_SBAR(); \
    N0 = __builtin_amdgcn_mfma_f32_32x32x16_bf16(kq[1][0], qr[1], N0, 0, 0, 0); ATT4_FCH(2, O0, O1); ATT_SBAR(); \
    N1 = __builtin_amdgcn_mfma_f32_32x32x16_bf16(kq[1][1], qr[1], N1, 0, 0, 0); ATT4_FCH(3, O0, O1); ATT_SBAR(); \
    kq[1][0] = ds_rd128<128>(kb); kq[1][1] = ds_rd128<128 + 32 * KROW>(kb); \
    wait_lgkm<4>(); ATT_SBAR(); \
    N0 = __builtin_amdgcn_mfma_f32_32x32x16_bf16(kq[2][0], qr[2], N0, 0, 0, 0); ATT4_FCH(4, O0, O1); ATT_SBAR(); \
    N1 = __builtin_amdgcn_mfma_f32_32x32x16_bf16(kq[2][1], qr[2], N1, 0, 0, 0); ATT4_FCH(5, O0, O1); ATT_SBAR(); \
    kq[2][0] = ds_rd128<160>(kb); kq[2][1] = ds_rd128<160 + 32 * KROW>(kb); \
    wait_lgkm<4>(); ATT_SBAR(); \
    N0 = __builtin_amdgcn_mfma_f32_32x32x16_bf16(kq[0][0], qr[3], N0, 0, 0, 0); ATT4_FCH(6, O0, O1); ATT_SBAR(); \
    N1 = __builtin_amdgcn_mfma_f32_32x32x16_bf16(kq[0][1], qr[3], N1, 0, 0, 0); ATT4_FCH(7, O0, O1); ATT_SBAR(); \
    kq[0][0] = ds_rd128<192>(kb); kq[0][1] = ds_rd128<192 + 32 * KROW>(kb); \
    wait_lgkm<4>(); ATT_SBAR(); \
    N0 = __builtin_amdgcn_mfma_f32_32x32x16_bf16(kq[1][0], qr[4], N0, 0, 0, 0); ATT4_FCH(8, O0, O1); ATT_SBAR(); \
    N1 = __builtin_amdgcn_mfma_f32_32x32x16_bf16(kq[1][1], qr[4], N1, 0, 0, 0); ATT4_FCH(9, O0, O1); ATT_SBAR(); \
    kq[1][0] = ds_rd128<224>(kb); kq[1][1] = ds_rd128<224 + 32 * KROW>(kb); \
    wait_lgkm<4>(); ATT_SBAR(); \
    N0 = __builtin_amdgcn_mfma_f32_32x32x16_bf16(kq[2][0], qr[5], N0, 0, 0, 0); ATT4_FCH(10, O0, O1); ATT_SBAR(); \
    N1 = __builtin_amdgcn_mfma_f32_32x32x16_bf16(kq[2][1], qr[5], N1, 0, 0, 0); ATT4_FCH(11, O0, O1); ATT_SBAR(); \
    vq[2][0] = tr_read<v_rd_off(0, 0, 0)>(vb); vq[2][1] = tr_read<v_rd_off(0, 0, 1)>(vb); vq[2][2] = tr_read<v_rd_off(0, 1, 0)>(vb); vq[2][3] = tr_read<v_rd_off(0, 1, 1)>(vb); \
    wait_lgkm<6>(); ATT_SBAR(); \
    N0 = __builtin_amdgcn_mfma_f32_32x32x16_bf16(kq[0][0], qr[6], N0, 0, 0, 0); ATT4_FCH(12, O0, O1); ATT_SBAR(); \
    N1 = __builtin_amdgcn_mfma_f32_32x32x16_bf16(kq[0][1], qr[6], N1, 0, 0, 0); ATT4_FCH(13, O0, O1); ATT_SBAR(); \
    vq[0][0] = tr_read<v_rd_off(0, 2, 0)>(vb); vq[0][1] = tr_read<v_rd_off(0, 2, 1)>(vb); vq[0][2] = tr_read<v_rd_off(0, 3, 0)>(vb); vq[0][3] = tr_read<v_rd_off(0, 3, 1)>(vb); \
    wait_lgkm<8>(); ATT_SBAR(); \
    N0 = __builtin_amdgcn_mfma_f32_32x32x16_bf16(kq[1][0], qr[7], N0, 0, 0, 0); ATT4_FCH(14, O0, O1); ATT_SBAR(); \
    N1 = __builtin_amdgcn_mfma_f32_32x32x16_bf16(kq[1][1], qr[7], N1, 0, 0, 0); ATT4_FCH(15, O0, O1); ATT_SBAR(); \
    vq[1][0] = tr_read<v_rd_off(1, 0, 0)>(vb); vq[1][1] = tr_read<v_rd_off(1, 0, 1)>(vb); vq[1][2] = tr_read<v_rd_off(1, 1, 0)>(vb); vq[1][3] = tr_read<v_rd_off(1, 1, 1)>(vb); \
    wait_lgkm<8>(); ATT_SBAR(); \
    ATT4_MFMA_O(o[0], pa0, ATT_PKV(vq[2][0], vq[2][1])); ATT4_SCH(0, N0, N1, O0, O1, mnN, alN, alO); ATT_SBAR(); \
    ATT4_MFMA_O(o[0], pa1, ATT_PKV(vq[2][2], vq[2][3])); ATT4_SCH(1, N0, N1, O0, O1, mnN, alN, alO); ATT_SBAR(); \
    vq[2][0] = tr_read<v_rd_off(1, 2, 0)>(vb); vq[2][1] = tr_read<v_rd_off(1, 2, 1)>(vb); vq[2][2] = tr_read<v_rd_off(1, 3, 0)>(vb); vq[2][3] = tr_read<v_rd_off(1, 3, 1)>(vb); \
    wait_lgkm<8>(); ATT_SBAR(); \
    ATT4_MFMA_O(o[0], pa2, ATT_PKV(vq[0][0], vq[0][1])); ATT4_SCH(2, N0, N1, O0, O1, mnN, alN, alO); ATT_SBAR(); \
    ATT4_MFMA_O(o[0], pa3, ATT_PKV(vq[0][2], vq[0][3])); ATT4_SCH(3, N0, N1, O0, O1, mnN, alN, alO); ATT_SBAR(); \
    vq[0][0] = tr_read<v_rd_off(2, 0, 0)>(vb); vq[0][1] = tr_read<v_rd_off(2, 0, 1)>(vb); vq[0][2] = tr_read<v_rd_off(2, 1, 0)>(vb); vq[0][3] = tr_read<v_rd_off(2, 1, 1)>(vb); \
    wait_lgkm<8>(); ATT_SBAR(); \
    ATT4_MFMA_O(o[1], pa0, ATT_PKV(vq[1][0], vq[1][1])); ATT4_SCH(4, N0, N1, O0, O1, mnN, alN, alO); ATT_SBAR(); \
    ATT4_MFMA_O(o[1], pa1, ATT_PKV(vq[1][2], vq[1][3])); ATT4_SCH(5, N0, N1, O0, O1, mnN, alN, alO); ATT_SBAR(); \
    vq[1][0] = tr_read<v_rd_off(2, 2, 0)>(vb); vq[1][1] = tr_read<v_rd_off(2, 2, 1)>(vb); vq[1][2] = tr_read<v_rd_off(2, 3, 0)>(vb); vq[1][3] = tr_read<v_rd_off(2, 3, 1)>(vb); \
    wait_lgkm<8>(); ATT_SBAR(); \
    ATT4_MFMA_O(o[1], pa2, ATT_PKV(vq[2][0], vq[2][1])); ATT4_SCH(6, N0, N1, O0, O1, mnN, alN, alO); ATT_SBAR(); \
    ATT4_MFMA_O(o[1], pa3, ATT_PKV(vq[2][2], vq[2][3])); ATT4_SCH(7, N0, N1, O0, O1, mnN, alN, alO); ATT_SBAR(); \
    vq[2][0] = tr_read<v_rd_off(3, 0, 0)>(vb); vq[2][1] = tr_read<v_rd_off(3, 0, 1)>(vb); vq[2][2] = tr_read<v_rd_off(3, 1, 0)>(vb); vq[2][3] = tr_read<v_rd_off(3, 1, 1)>(vb); \
    wait_lgkm<8>(); ATT_SBAR(); \
    ATT4_MFMA_O(o[2], pa0, ATT_PKV(vq[0][0], vq[0][1])); ATT4_SCH(8, N0, N1, O0, O1, mnN, alN, alO); ATT_SBAR(); \
    ATT4_MFMA_O(o[2], pa1, ATT_PKV(vq[0][2], vq[0][3])); ATT4_SCH(9, N0, N1, O0, O1, mnN, alN, alO); ATT_SBAR(); \
    vq[0][0] = tr_read<v_rd_off(3, 2, 0)>(vb); vq[0][1] = tr_read<v_rd_off(3, 2, 1)>(vb); vq[0][2] = tr_read<v_rd_off(3, 3, 0)>(vb); vq[0][3] = tr_read<v_rd_off(3, 3, 1)>(vb); \
    wait_lgkm<8>(); ATT_SBAR(); \
    ATT4_MFMA_O(o[2], pa2, ATT_PKV(vq[1][0], vq[1][1])); ATT4_SCH(10, N0, N1, O0, O1, mnN, alN, alO); ATT_SBAR(); \
    ATT4_MFMA_O(o[2], pa3, ATT_PKV(vq[1][2], vq[1][3])); ATT4_SCH(11, N0, N1, O0, O1, mnN, alN, alO); ATT_SBAR(); \
    wait_lgkm<4>(); ATT_SBAR(); \
    ATT4_MFMA_O(o[3], pa0, ATT_PKV(vq[2][0], vq[2][1])); ATT4_SCH(12, N0, N1, O0, O1, mnN, alN, alO); ATT_SBAR(); \
    ATT4_MFMA_O(o[3], pa1, ATT_PKV(vq[2][2], vq[2][3])); ATT4_SCH(13, N0, N1, O0, O1, mnN, alN, alO); ATT_SBAR(); \
    wait_lgkm<0>(); ATT_SBAR(); \
    ATT4_MFMA_O(o[3], pa2, ATT_PKV(vq[0][0], vq[0][1])); ATT4_SCH(14, N0, N1, O0, O1, mnN, alN, alO); ATT_SBAR(); \
    ATT4_MFMA_O(o[3], pa3, ATT_PKV(vq[0][2], vq[0][3])); ATT4_SCH(15, N0, N1, O0, O1, mnN, alN, alO); ATT_SBAR(); } while (0)
#define ATT4_HALF_192(N0, N1, O0, O1, mnN, alN, alO, kb, vb) do { constexpr int KROW = 400; \
    kq[0][0] = ds_rd128<0>(kb); kq[0][1] = ds_rd128<0 + 32 * KROW>(kb); \
    kq[1][0] = ds_rd128<32>(kb); kq[1][1] = ds_rd128<32 + 32 * KROW>(kb); \
    wait_lgkm<2>(); ATT_SBAR(); \
    N0 = __builtin_amdgcn_mfma_f32_32x32x16_bf16(kq[0][0], qr[0], negm, 0, 0, 0); ATT4_FCH(0, O0, O1); ATT_SBAR(); \
    N1 = __builtin_amdgcn_mfma_f32_32x32x16_bf16(kq[0][1], qr[0], negm, 0, 0, 0); ATT4_FCH(1, O0, O1); ATT_SBAR(); \
    kq[0][0] = ds_rd128<64>(kb); kq[0][1] = ds_rd128<64 + 32 * KROW>(kb); \
    wait_lgkm<2>(); ATT_SBAR(); \
    N0 = __builtin_amdgcn_mfma_f32_32x32x16_bf16(kq[1][0], qr[1], N0, 0, 0, 0); ATT4_FCH(2, O0, O1); ATT_SBAR(); \
    N1 = __builtin_amdgcn_mfma_f32_32x32x16_bf16(kq[1][1], qr[1], N1, 0, 0, 0); ATT4_FCH(3, O0, O1); ATT_SBAR(); \
    kq[1][0] = ds_rd128<96>(kb); kq[1][1] = ds_rd128<96 + 32 * KROW>(kb); \
    wait_lgkm<2>(); ATT_SBAR(); \
    N0 = __builtin_amdgcn_mfma_f32_32x32x16_bf16(kq[0][0], qr[2], N0, 0, 0, 0); ATT4_FCH(4, O0, O1); ATT_SBAR(); \
    N1 = __builtin_amdgcn_mfma_f32_32x32x16_bf16(kq[0][1], qr[2], N1, 0, 0, 0); ATT4_FCH(5, O0, O1); ATT_SBAR(); \
    kq[0][0] = ds_rd128<128>(kb); kq[0][1] = ds_rd128<128 + 32 * KROW>(kb); \
    wait_lgkm<2>(); ATT_SBAR(); \
    N0 = __builtin_amdgcn_mfma_f32_32x32x16_bf16(kq[1][0], qr[3], N0, 0, 0, 0); ATT4_FCH(6, O0, O1); ATT_SBAR(); \
    N1 = __builtin_amdgcn_mfma_f32_32x32x16_bf16(kq[1][1], qr[3], N1, 0, 0, 0); ATT4_FCH(7, O0, O1); ATT_SBAR(); \
    kq[1][0] = ds_rd128<160>(kb); kq[1][1] = ds_rd128<160 + 32 * KROW>(kb); \
    wait_lgkm<2>(); ATT_SBAR(); \
    N0 = __builtin_amdgcn_mfma_f32_32x32x16_bf16(kq[0][0], qr[4], N0, 0, 0, 0); ATT4_FCH(8, O0, O1); ATT_SBAR(); \
    N1 = __builtin_amdgcn_mfma_f32_32x32x16_bf16(kq[0][1], qr[4], N1, 0, 0, 0); ATT4_FCH(9, O0, O1); ATT_SBAR(); \
    kq[0][0] = ds_rd128<192>(kb); kq[0][1] = ds_rd128<192 + 32 * KROW>(kb); \
    wait_lgkm<2>(); ATT_SBAR(); \
    N0 = __builtin_amdgcn_mfma_f32_32x32x16_bf16(kq[1][0], qr[5], N0, 0, 0, 0); ATT4_FCH(10, O0, O1); ATT_SBAR(); \
    N1 = __builtin_amdgcn_mfma_f32_32x32x16_bf16(kq[1][1], qr[5], N1, 0, 0, 0); ATT4_FCH(11, O0, O1); ATT_SBAR(); \
    kq[1][0] = ds_rd128<224>(kb); kq[1][1] = ds_rd128<224 + 32 * KROW>(kb); \
    wait_lgkm<2>(); ATT_SBAR(); \
    N0 = __builtin_amdgcn_mfma_f32_32x32x16_bf16(kq[0][0], qr[6], N0, 0, 0, 0); ATT4_FCH(12, O0, O1); ATT_SBAR(); \
    N1 = __builtin_amdgcn_mfma_f32_32x32x16_bf16(kq[0][1], qr[6], N1, 0, 0, 0); ATT4_FCH(13, O0, O1); ATT_SBAR(); \
    kq[0][0] = ds_rd128<256>(kb); kq[0][1] = ds_rd128<256 + 32 * KROW>(kb); \
    wait_lgkm<2>(); ATT_SBAR(); \
    N0 = __builtin_amdgcn_mfma_f32_32x32x16_bf16(kq[1][0], qr[7], N0, 0, 0, 0); ATT4_FCH(14, O0, O1); ATT_SBAR(); \
    N1 = __builtin_amdgcn_mfma_f32_32x32x16_bf16(kq[1][1], qr[7], N1, 0, 0, 0); ATT4_FCH(15, O0, O1); ATT_SBAR(); \
    kq[1][0] = ds_rd128<288>(kb); kq[1][1] = ds_rd128<288 + 32 * KROW>(kb); \
    wait_lgkm<2>(); ATT_SBAR(); \
    N0 = __builtin_amdgcn_mfma_f32_32x32x16_bf16(kq[0][0], qr[8], N0, 0, 0, 0);  ATT_SBAR(); \
    N1 = __builtin_amdgcn_mfma_f32_32x32x16_bf16(kq[0][1], qr[8], N1, 0, 0, 0);  ATT_SBAR(); \
    kq[0][0] = ds_rd128<320>(kb); kq[0][1] = ds_rd128<320 + 32 * KROW>(kb); \
    wait_lgkm<2>(); ATT_SBAR(); \
    N0 = __builtin_amdgcn_mfma_f32_32x32x16_bf16(kq[1][0], qr[9], N0, 0, 0, 0);  ATT_SBAR(); \
    N1 = __builtin_amdgcn_mfma_f32_32x32x16_bf16(kq[1][1], qr[9], N1, 0, 0, 0);  ATT_SBAR(); \
    kq[1][0] = ds_rd128<352>(kb); kq[1][1] = ds_rd128<352 + 32 * KROW>(kb); \
    wait_lgkm<2>(); ATT_SBAR(); \
    N0 = __builtin_amdgcn_mfma_f32_32x32x16_bf16(kq[0][0], qr[10], N0, 0, 0, 0);  ATT_SBAR(); \
    N1 = __builtin_amdgcn_mfma_f32_32x32x16_bf16(kq[0][1], qr[10], N1, 0, 0, 0);  ATT_SBAR(); \
    vq[0][0] = tr_read<v_rd_off(0, 0, 0)>(vb); vq[0][1] = tr_read<v_rd_off(0, 0, 1)>(vb); vq[0][2] = tr_read<v_rd_off(0, 1, 0)>(vb); vq[0][3] = tr_read<v_rd_off(0, 1, 1)>(vb); \
    wait_lgkm<4>(); ATT_SBAR(); \
    N0 = __builtin_amdgcn_mfma_f32_32x32x16_bf16(kq[1][0], qr[11], N0, 0, 0, 0);  ATT_SBAR(); \
    N1 = __builtin_amdgcn_mfma_f32_32x32x16_bf16(kq[1][1], qr[11], N1, 0, 0, 0);  ATT_SBAR(); \
    vq[1][0] = tr_read<v_rd_off(0, 2, 0)>(vb); vq[1][1] = tr_read<v_rd_off(0, 2, 1)>(vb); vq[1][2] = tr_read<v_rd_off(0, 3, 0)>(vb); vq[1][3] = tr_read<v_rd_off(0, 3, 1)>(vb); \
    wait_lgkm<4>(); ATT_SBAR(); \
    ATT4_MFMA_O(o[0], pa0, ATT_PKV(vq[0][0], vq[0][1])); ATT4_SCH(0, N0, N1, O0, O1, mnN, alN, alO); ATT_SBAR(); \
    ATT4_MFMA_O(o[0], pa1, ATT_PKV(vq[0][2], vq[0][3])); ATT4_SCH(1, N0, N1, O0, O1, mnN, alN, alO); ATT_SBAR(); \
    vq[0][0] = tr_read<v_rd_off(1, 0, 0)>(vb); vq[0][1] = tr_read<v_rd_off(1, 0, 1)>(vb); vq[0][2] = tr_read<v_rd_off(1, 1, 0)>(vb); vq[0][3] = tr_read<v_rd_off(1, 1, 1)>(vb); \
    wait_lgkm<4>(); ATT_SBAR(); \
    ATT4_MFMA_O(o[0], pa2, ATT_PKV(vq[1][0], vq[1][1])); ATT4_SCH(2, N0, N1, O0, O1, mnN, alN, alO); ATT_SBAR(); \
    ATT4_MFMA_O(o[0], pa3, ATT_PKV(vq[1][2], vq[1][3])); ATT4_SCH(3, N0, N1, O0, O1, mnN, alN, alO); ATT_SBAR(); \
    vq[1][0] = tr_read<v_rd_off(1, 2, 0)>(vb); vq[1][1] = tr_read<v_rd_off(1, 2, 1)>(vb); vq[1][2] = tr_read<v_rd_off(1, 3, 0)>(vb); vq[1][3] = tr_read<v_rd_off(1, 3, 1)>(vb); \
    wait_lgkm<4>(); ATT_SBAR(); \
    ATT4_MFMA_O(o[1], pa0, ATT_PKV(vq[0][0], vq[0][1])); ATT4_SCH(4, N0, N1, O0, O1, mnN, alN, alO); ATT_SBAR(); \
    ATT4_MFMA_O(o[1], pa1, ATT_PKV(vq[0][2], vq[0][3])); ATT4_SCH(5, N0, N1, O0, O1, mnN, alN, alO); ATT_SBAR(); \
    vq[0][0] = tr_read<v_rd_off(2, 0, 0)>(vb); vq[0][1] = tr_read<v_rd_off(2, 0, 1)>(vb); vq[0][2] = tr_read<v_rd_off(2, 1, 0)>(vb); vq[0][3] = tr_read<v_rd_off(2, 1, 1)>(vb); \
    wait_lgkm<4>(); ATT_SBAR(); \
    ATT4_MFMA_O(o[1], pa2, ATT_PKV(vq[1][0], vq[1][1])); ATT4_SCH(6, N0, N1, O0, O1, mnN, alN, alO); ATT_SBAR(); \
    ATT4_MFMA_O(o[1], pa3, ATT_PKV(vq[1][2], vq[1][3])); ATT4_SCH(7, N0, N1, O0, O1, mnN, alN, alO); ATT_SBAR(); \
    vq[1][0] = tr_read<v_rd_off(2, 2, 0)>(vb); vq[1][1] = tr_read<v_rd_off(2, 2, 1)>(vb); vq[1][2] = tr_read<v_rd_off(2, 3, 0)>(vb); vq[1][3] = tr_read<v_rd_off(2, 3, 1)>(vb); \
    wait_lgkm<4>(); ATT_SBAR(); \
    ATT4_MFMA_O(o[2], pa0, ATT_PKV(vq[0][0], vq[0][1])); ATT4_SCH(8, N0, N1, O0, O1, mnN, alN, alO); ATT_SBAR(); \
    ATT4_MFMA_O(o[2], pa1, ATT_PKV(vq[0][2], vq[0][3])); ATT4_SCH(9, N0, N1, O0, O1, mnN, alN, alO); ATT_SBAR(); \
    vq[0][0] = tr_read<v_rd_off(3, 0, 0)>(vb); vq[0][1] = tr_read<v_rd_off(3, 0, 1)>(vb); vq[0][2] = tr_read<v_rd_off(3, 1, 0)>(vb); vq[0][3] = tr_read<v_rd_off(3, 1, 1)>(vb); \
    wait_lgkm<4>(); ATT_SBAR(); \
    ATT4_MFMA_O(o[2], pa2, ATT_PKV(vq[1][0], vq[1][1])); ATT4_SCH(10, N0, N1, O0, O1, mnN, alN, alO); ATT_SBAR(); \
    ATT4_MFMA_O(o[2], pa3, ATT_PKV(vq[1][2], vq[1][3])); ATT4_SCH(11, N0, N1, O0, O1, mnN, alN, alO); ATT_SBAR(); \
    vq[1][0] = tr_read<v_rd_off(3, 2, 0)>(vb); vq[1][1] = tr_read<v_rd_off(3, 2, 1)>(vb); vq[1][2] = tr_read<v_rd_off(3, 3, 0)>(vb); vq[1][3] = tr_read<v_rd_off(3, 3, 1)>(vb); \
    wait_lgkm<4>(); ATT_SBAR(); \
    ATT4_MFMA_O(o[3], pa0, ATT_PKV(vq[0][0], vq[0][1])); ATT4_SCH(12, N0, N1, O0, O1, mnN, alN, alO); ATT_SBAR(); \
    ATT4_MFMA_O(o[3], pa1, ATT_PKV(vq[0][2], vq[0][3])); ATT4_SCH(13, N0, N1, O0, O1, mnN, alN, alO); ATT_SBAR(); \
    wait_lgkm<0>(); ATT_SBAR(); \
    ATT4_MFMA_O(o[3], pa2, ATT_PKV(vq[1][0], vq[1][1])); ATT4_SCH(14, N0, N1, O0, O1, mnN, alN, alO); ATT_SBAR(); \
    ATT4_MFMA_O(o[3], pa3, ATT_PKV(vq[1][2], vq[1][3])); ATT4_SCH(15, N0, N1, O0, O1, mnN, alN, alO); ATT_SBAR(); } while (0)
template <int DQK, int LDQ, int LDK, int LDV, int MODE>
__device__ __forceinline__ void attn_body4(const bf16_t* __restrict__ Qb, const bf16_t* __restrict__ Kh, const bf16_t* __restrict__ Vh,
                                           int seq, float scale, const OutArgs& oa, char* lds, __attribute__((address_space(3))) unsigned char* ldsl) {
  using CF = Cfg<DQK>;
  constexpr int ND0 = CF::ND0, SHM_K = CF::SHM_K, KROW = CF::KROW, SLOT = SHM_K + SHM_V, KCH = SHM_K / 1024, NKI = (KCH + 7) / 8;
  static_assert(SHM_K % 1024 == 0 && 3 * SLOT + NW * 256 <= 131072, "attention LDS ring");
  const float QS = scale * 1.4426950408889634f;
  constexpr float C = 1.0f, THRS = THR * 1.4426950408889634f; const float thr_raw = THRS;
  int tid_ = threadIdx.x; asm volatile("" : "+v"(tid_));
  const int tid = tid_, wid = __builtin_amdgcn_readfirstlane(tid >> 6), lane = tid & 63, r32 = lane & 31, hi = lane >> 5;
  float* ws = (float*)(lds + 3 * SLOT) + wid * 64; float* li_l = ws; float* al_l = ws + 32;
  float m_reg = -1e30f, l_reg = 0; f32x16 o[4] = {}; bf16x8 qr[ND0];
  int ksrc[NKI], vsrc[2];
#pragma unroll
  for (int i = 0; i < NKI; ++i) { const int ob = (wid + 8 * i) * 1024 + lane * 16, row = ob / KROW, within = ob - row * KROW; ksrc[i] = (row < KVBLK ? row : 0) * LDK + (within < 2 * DQK ? within / 2 : 0); }
#pragma unroll
  for (int i = 0; i < 2; ++i) { const int gi = (2 * wid + i) * 64 + lane, c8 = (gi & 3) | (((gi >> 5) & 3) << 2), kk = ((gi >> 2) & 7) | ((gi >> 7) << 3), k = kk; vsrc[i] = k * LDV + c8 * 8; }
#define ATT_GLDS(g, l) __builtin_amdgcn_global_load_lds((const unsigned*)(g), (__attribute__((address_space(3))) unsigned*)(l), 16, 0, 0)
#define ATT_DMA(k0, s) do { __attribute__((address_space(3))) unsigned char* _kb = ldsl + (s) * SLOT; \
    _Pragma("unroll") for (int _i = 0; _i < NKI; ++_i) { if (wid + 8 * _i < KCH) ATT_GLDS(Kh + (long)(k0) * LDK + ksrc[_i], _kb + (wid + 8 * _i) * 1024); } \
    _Pragma("unroll") for (int _i = 0; _i < 2; ++_i) ATT_GLDS(Vh + (long)(k0) * LDV + vsrc[_i], _kb + SHM_K + (2 * wid + _i) * 1024); } while (0)
#define ATT_BAR() do { asm volatile("s_waitcnt vmcnt(0) lgkmcnt(0)" ::: "memory"); __builtin_amdgcn_s_barrier(); asm volatile("" ::: "memory"); } while (0)
#define ATT_RESC2(a) do { if (__any((a) < 1.f)) { if (hi == 0) al_l[r32] = (a); asm volatile("s_waitcnt lgkmcnt(0)" ::: "memory"); \
    _Pragma("unroll") for (int d = 0; d < 4; ++d) _Pragma("unroll") for (int r = 0; r < 16; ++r) o[d][r] *= al_l[crow(r, hi)]; } } while (0)
  const int NT = seq / KVBLK;
  ATT_DMA(0, 0); ATT_DMA(KVBLK, 1);
  const bf16_t* Qw = Qb + (long)(wid * QBLK + r32) * LDQ + hi * 8;
#pragma unroll
  for (int d0 = 0; d0 < ND0; ++d0) { const u32x4 qw = *reinterpret_cast<const u32x4*>(Qw + d0 * 16); u32x4 qo;
#pragma unroll
    for (int e = 0; e < 4; ++e) qo[e] = cvtpk(__uint_as_float(qw[e] << 16) * QS, __uint_as_float(qw[e] & 0xffff0000u) * QS);
    qr[d0] = __builtin_bit_cast(bf16x8, qo); }
  ATT_BAR();
  const int vb0 = (int)(uintptr_t)lds + SHM_K + v_rd_base(lane);
  f32x16 pA0, pA1, pB0, pB1; float mnA, mnB, alA, alB; bf16x8 pa0, pa1, pa2, pa3;
  qkt<DQK>(pA0, pA1, lds, qr, r32, hi); partialSM(pA0, pA1, m_reg, mnA, alA, C, thr_raw);
  if (2 < NT) ATT_DMA(2 * KVBLK, 2);
  const int kb0 = (int)(uintptr_t)lds + r32 * KROW + hi * 16;
  bf16x8 kq[3][2]; s16x4 vq[3][4]; unsigned ft0, ft1, ft2, ft3, fr0, fr1; float accA_, accB_, mnC_, x0, x1, x2, x3, x4, x5, x6, x7, x8, x9, x10;
#define ATT4_HALF(N0, N1, O0, O1, mnN, alN, alO, kb, vb) do { if constexpr (DQK == 64) ATT4_HALF_64(N0, N1, O0, O1, mnN, alN, alO, kb, vb); \
    else if constexpr (DQK == 128) ATT4_HALF_128(N0, N1, O0, O1, mnN, alN, alO, kb, vb); else ATT4_HALF_192(N0, N1, O0, O1, mnN, alN, alO, kb, vb); } while (0)
#if defined(ATT_TPROBE)
  unsigned long long tp_acc = 0, tp_t0 = 0;
#define ATT_TP0() do { tp_t0 = __builtin_amdgcn_s_memrealtime(); asm volatile("s_waitcnt lgkmcnt(0)" ::: "memory"); } while (0)
#define ATT_TP1() do { const unsigned long long _t1 = __builtin_amdgcn_s_memrealtime(); asm volatile("s_waitcnt lgkmcnt(0)" ::: "memory"); tp_acc += _t1 - tp_t0; } while (0)
  if (ATT_TPROBE == 2) ATT_TP0();
#else
#define ATT_TP0() do {} while (0)
#define ATT_TP1() do {} while (0)
#endif
#if defined(ATT_PRIO)
  if (wid >= 4) __builtin_amdgcn_s_setprio(1);
#endif
  f32x16 negm;
#pragma unroll
  for (int i = 0; i < 16; ++i) negm[i] = -m_reg;
  int sj = 1, sp = 0;
  for (int j = 1; j + 1 < NT; j += 2) {
    ATT_SBAR(); ATT4_HALF(pB0, pB1, pA0, pA1, mnB, alB, alA, kb0 + sj * SLOT, vb0 + sp * SLOT);
#if defined(ATT_TPROBE)
    if (ATT_TPROBE == 1) ATT_TP0();
#endif
    ATT_BAR();
#if defined(ATT_TPROBE)
    if (ATT_TPROBE == 1) ATT_TP1();
#endif
    if (j + 2 < NT) ATT_DMA((j + 2) * KVBLK, sp);
    ATT_RESC2(alB);
    { sp = sj; sj = (sj == 2) ? 0 : sj + 1; }
    ATT_SBAR(); ATT4_HALF(pA0, pA1, pB0, pB1, mnA, alA, alB, kb0 + sj * SLOT, vb0 + sp * SLOT);
#if defined(ATT_TPROBE)
    if (ATT_TPROBE == 1) ATT_TP0();
#endif
    ATT_BAR();
#if defined(ATT_TPROBE)
    if (ATT_TPROBE == 1) ATT_TP1();
#endif
    if (j + 3 < NT) ATT_DMA((j + 3) * KVBLK, sp);
    ATT_RESC2(alA);
    { sp = sj; sj = (sj == 2) ? 0 : sj + 1; }
  }
#if defined(ATT_TPROBE)
  if (ATT_TPROBE == 2) ATT_TP1();
  if (blockIdx.x == 0 && tid == 0) atomicAdd(oa.tp, tp_acc);
#endif
#if defined(ATT_PRIO)
  __builtin_amdgcn_s_setprio(0);
#endif
  ATT_SBAR(); qkt<DQK>(pB0, pB1, lds + sj * SLOT, qr, r32, hi);
  finishSM_ns(pA0, pA1, alA, l_reg, pa0, pa1, pa2, pa3); ATT_SBAR();
  pv_d0(o, vb0 + sp * SLOT, pa0, pa1, pa2, pa3); partialSM(pB0, pB1, m_reg, mnB, alB, C, thr_raw);
  ATT_RESC2(alB);
  finishSM_ns(pB0, pB1, alB, l_reg, pa0, pa1, pa2, pa3); ATT_SBAR();
  pv_d0(o, vb0 + sj * SLOT, pa0, pa1, pa2, pa3);
  if (hi == 0) li_l[r32] = l_reg; asm volatile("s_waitcnt lgkmcnt(0)" ::: "memory");
  float rli[16];
#pragma unroll
  for (int r = 0; r < 16; ++r) rli[r] = __builtin_amdgcn_rcpf(li_l[crow(r, hi)]);
  ATT_BAR();
  float* Ot = (float*)(lds + wid * 16384);
#pragma unroll
  for (int r = 0; r < 16; ++r) { const int orow = crow(r, hi);
#pragma unroll
    for (int d0 = 0; d0 < 4; ++d0) Ot[orow * 128 + d0 * 32 + r32] = o[d0][r] * rli[r]; }
  asm volatile("s_waitcnt lgkmcnt(0)" ::: "memory");
  const int er = lane >> 4, ec = (lane & 15) * 8;
  if constexpr (MODE == 0) {
    bf16_t* Ow = oa.Ob + (long)(wid * QBLK + er) * oa.LDO + ec;
#pragma unroll
    for (int k = 0; k < 8; ++k) { const float* sp2 = Ot + (4 * k + er) * 128 + ec; const f32x4_t a = *(const f32x4_t*)sp2, b = *(const f32x4_t*)(sp2 + 4);
      *(u32x4*)(Ow + (long)(4 * k) * oa.LDO) = (u32x4){cvtpk(a[0], a[1]), cvtpk(a[2], a[3]), cvtpk(b[0], b[1]), cvtpk(b[2], b[3])}; }
  } else if constexpr (MODE == 1) {
    float* Sw = oa.stash + (wid * QBLK + er) * 128 + ec;
#pragma unroll
    for (int k = 0; k < 8; ++k) { const float* sp2 = Ot + (4 * k + er) * 128 + ec; const f32x4_t a = *(const f32x4_t*)sp2, b = *(const f32x4_t*)(sp2 + 4);
      *(f32x4_t*)(Sw + 4 * k * 128) = a; *(f32x4_t*)(Sw + 4 * k * 128 + 4) = b; }
  } else {
    const float* Sw = oa.stash + (wid * QBLK + er) * 128 + ec; bf16_t* Ow = oa.Ob + (long)(wid * QBLK + er) * oa.LDO + ec;
    const f32x4_t g0 = *(const f32x4_t*)(oa.g + ec) * oa.post, g1 = *(const f32x4_t*)(oa.g + ec + 4) * oa.post;
    f32x4_t sa[8], sb[8];
#pragma unroll
    for (int k = 0; k < 8; ++k) { sa[k] = *(const f32x4_t*)(Sw + 4 * k * 128); sb[k] = *(const f32x4_t*)(Sw + 4 * k * 128 + 4); }
#pragma unroll
    for (int k = 0; k < 8; ++k) { asm volatile("" ::: "memory"); const float* sp2 = Ot + (4 * k + er) * 128 + ec; f32x4_t a = *(const f32x4_t*)sp2, b = *(const f32x4_t*)(sp2 + 4);
      a = sa[k] - oa.lam * a; b = sb[k] - oa.lam * b;
      float ss = (a[0] * a[0] + a[1] * a[1]) + (a[2] * a[2] + a[3] * a[3]) + (b[0] * b[0] + b[1] * b[1]) + (b[2] * b[2] + b[3] * b[3]);
      ss += __shfl_xor(ss, 1); ss += __shfl_xor(ss, 2); ss += __shfl_xor(ss, 4); ss += __shfl_xor(ss, 8);
      const float rn = 1.0f / sqrtf(ss * (1.0f / 128.0f) + EPS);
      a = a * rn * g0; b = b * rn * g1;
      *(u32x4*)(Ow + (long)(4 * k) * oa.LDO) = (u32x4){cvtpk(a[0], a[1]), cvtpk(a[2], a[3]), cvtpk(b[0], b[1]), cvtpk(b[2], b[3])}; }
  }
  ATT_BAR();
#undef ATT_GLDS
#undef ATT_DMA
#undef ATT_BAR
#undef ATT_RESC2
#undef ATT4_HALF
}
}

#define GAS __attribute__((address_space(1)))
#define LAS __attribute__((address_space(3)))
typedef unsigned short bf16;
typedef unsigned v4u __attribute__((ext_vector_type(4)));
typedef unsigned v2u __attribute__((ext_vector_type(2)));
typedef float f32x4 __attribute__((ext_vector_type(4)));
typedef float f32x2 __attribute__((ext_vector_type(2)));
typedef __bf16 bf16x2_t __attribute__((ext_vector_type(2)));
typedef GAS unsigned gu32;
#define RLX_AGENT __ATOMIC_RELAXED, __HIP_MEMORY_SCOPE_AGENT
#define LDS_WAIT() asm volatile("s_waitcnt lgkmcnt(0)" ::: "memory")
#define VM_WAIT() asm volatile("s_waitcnt vmcnt(0)" ::: "memory")
__device__ __forceinline__ unsigned pk2(float lo, float hi) { unsigned r; asm volatile("v_cvt_pk_bf16_f32 %0, %1, %2" : "=v"(r) : "v"(lo), "v"(hi)); return r; }
__device__ __forceinline__ float bflo(unsigned w) { return __uint_as_float(w << 16); }
__device__ __forceinline__ float bfhi(unsigned w) { return __uint_as_float(w & 0xffff0000u); }
__device__ __forceinline__ float dot2bf(unsigned a, unsigned b, float acc) { return __builtin_amdgcn_fdot2_f32_bf16(__builtin_bit_cast(bf16x2_t, a), __builtin_bit_cast(bf16x2_t, b), acc, false); }
#define DPPF(v, ctrl) __int_as_float(__builtin_amdgcn_update_dpp(0, __float_as_int(v), (ctrl), 0xf, 0xf, true))
__device__ __forceinline__ float wave_sum(float v) {
    v += DPPF(v, 0xB1); v += DPPF(v, 0x4E); v += DPPF(v, 0x141); v += DPPF(v, 0x140);
    { const auto r = __builtin_amdgcn_permlane16_swap(__float_as_uint(v), __float_as_uint(v), false, false); v = __uint_as_float(r[0]) + __uint_as_float(r[1]); }
    { const auto r = __builtin_amdgcn_permlane32_swap(__float_as_uint(v), __float_as_uint(v), false, false); v = __uint_as_float(r[0]) + __uint_as_float(r[1]); }
    return v;
}
__device__ __forceinline__ float wave_max(float v) {
    v = fmaxf(v, DPPF(v, 0xB1)); v = fmaxf(v, DPPF(v, 0x4E)); v = fmaxf(v, DPPF(v, 0x141)); v = fmaxf(v, DPPF(v, 0x140));
    { const auto r = __builtin_amdgcn_permlane16_swap(__float_as_uint(v), __float_as_uint(v), false, false); v = fmaxf(__uint_as_float(r[0]), __uint_as_float(r[1])); }
    { const auto r = __builtin_amdgcn_permlane32_swap(__float_as_uint(v), __float_as_uint(v), false, false); v = fmaxf(__uint_as_float(r[0]), __uint_as_float(r[1])); }
    return v;
}

#define XB_TMO      128
#define XB_XCNT(j)  (256  + 64 * (j))
#define XB_XSUB(j)  (1280 + 64 * (j))
#define XB_XGEN(j)  (2304 + 64 * (j))
#define XB_TOP      3328
#define XB_TOPGEN   3392
#define XCD_BAR_WORDS 3456
#define XB_SPIN_CAP (1u << 18)

__device__ __forceinline__ unsigned xb_ld(unsigned* p)              { return __hip_atomic_load(p, __ATOMIC_RELAXED, __HIP_MEMORY_SCOPE_AGENT); }
__device__ __forceinline__ unsigned xb_add(unsigned* p, unsigned v) { return __hip_atomic_fetch_add(p, v, __ATOMIC_RELAXED, __HIP_MEMORY_SCOPE_AGENT); }
__device__ __forceinline__ unsigned xb_xcc_id() { return (unsigned)__builtin_amdgcn_s_getreg((3 << 11) | 20) & 0xFu; }
#define XB_SPIN(cond, bar) do { unsigned _sp = 0; while (cond) { __builtin_amdgcn_s_sleep(1); \
    if ((++_sp & 255u) == 0u) { if (xb_ld(&(bar)[XB_TMO])) break; if (_sp > XB_SPIN_CAP) { atomicAdd(&(bar)[XB_TMO], 1u); break; } } } } while (0)

struct XcdBarrier {
    unsigned* bar; unsigned x;
    volatile LAS unsigned* st;
};

__device__ __forceinline__ XcdBarrier xcd_barrier_post(unsigned* bar, volatile LAS unsigned* st) {
    XcdBarrier b; b.bar = bar; b.x = xb_xcc_id(); b.st = st;
    if (threadIdx.x == 0) (void)xb_add(&bar[XB_XCNT(b.x)], 1u);
    return b;
}
__device__ __forceinline__ void xcd_barrier_complete(unsigned* bar, unsigned x, unsigned& nloc, unsigned& nx) {
    const unsigned G = gridDim.x * gridDim.y * gridDim.z;
    unsigned sum, cnt, mine, sp = 0u;
    for (;;) {
        sum = 0u; cnt = 0u; mine = 0u;
#pragma unroll
        for (unsigned j = 0; j < 16; ++j) { const unsigned c = xb_ld(&bar[XB_XCNT(j)]); sum += c; cnt += (c > 0u) ? 1u : 0u; mine = (j == x) ? c : mine; }
        if (sum == G) break;
        __builtin_amdgcn_s_sleep(1);
        if ((++sp & 255u) == 0u) { if (xb_ld(&bar[XB_TMO])) break; if (sp > XB_SPIN_CAP) { atomicAdd(&bar[XB_TMO], 1u); break; } }
    }
    nloc = mine > 0u ? mine : 1u; nx = cnt > 0u ? cnt : 1u;
}

__device__ __forceinline__ void xcd_barrier(const XcdBarrier& b) {
    asm volatile("s_waitcnt vmcnt(0)" ::: "memory");
    __syncthreads();
    if (threadIdx.x == 0) {
        unsigned* bar = b.bar;
        __builtin_amdgcn_s_waitcnt(0);
        unsigned nloc = b.st[0], nx = b.st[1];
        if (nloc == 0u) { xcd_barrier_complete(bar, b.x, nloc, nx); b.st[0] = nloc; b.st[1] = nx; }
        const unsigned old = xb_add(&bar[XB_XSUB(b.x)], 1u);
        const unsigned gen = old / nloc;
        if (old + 1u == (gen + 1u) * nloc) {
            __builtin_amdgcn_fence(__ATOMIC_RELEASE, "agent");
            asm volatile("s_waitcnt vmcnt(0)" ::: "memory");
            const unsigned og = xb_add(&bar[XB_TOP], 1u);
            const unsigned tg = og / nx;
            if (og + 1u == (tg + 1u) * nx) xb_add(&bar[XB_TOPGEN], 1u);
            else XB_SPIN(xb_ld(&bar[XB_TOPGEN]) == tg, bar);
            __builtin_amdgcn_fence(__ATOMIC_ACQUIRE, "agent");
            xb_add(&bar[XB_XGEN(b.x)], 1u);
            asm volatile("s_waitcnt vmcnt(0)" ::: "memory");
        } else {
            XB_SPIN(xb_ld(&bar[XB_XGEN(b.x)]) == gen, bar);
            __builtin_amdgcn_fence(__ATOMIC_ACQUIRE, "agent");
            asm volatile("s_waitcnt vmcnt(0)" ::: "memory");
        }
    }
    __syncthreads();
}


constexpr size_t MiB = 1u << 20;
constexpr size_t WS_CTL = 0, CTL_BYTES = 1 * MiB;
constexpr size_t WS_ROPE = 1 * MiB;
constexpr size_t WS_WIN = 4 * MiB;
constexpr size_t WS_WUQ = 60 * MiB;
constexpr size_t WS_WUKV = 64 * MiB;
constexpr size_t WS_WO = 68 * MiB;
constexpr size_t WS_WQ = 100 * MiB;
constexpr size_t WS_SUBK = 132 * MiB;
constexpr size_t WS_U = 134 * MiB;
constexpr size_t WS_V = 262 * MiB;
constexpr size_t WS_USC = 390 * MiB, WS_VSC = 391 * MiB;
constexpr size_t WS_X = 646 * MiB;
constexpr size_t WS_X1 = 742 * MiB;
constexpr size_t WS_H = 838 * MiB;
constexpr size_t WS_BQ = 1006 * MiB;
constexpr size_t WS_BK = 1060 * MiB;
constexpr size_t WS_BV = 1114 * MiB;
constexpr size_t WS_AO = 1150 * MiB;
constexpr size_t WS_Y = 1246 * MiB;
constexpr size_t WS_SKD = 1438 * MiB;
constexpr size_t WS_WQS = 1470 * MiB;
constexpr size_t WQS_LAYER = (size_t)2048 * 2048 + 2048;
constexpr size_t WS_STASH = 1534 * MiB;
constexpr size_t WS_EID = 518 * MiB, WS_GATEV = 530 * MiB, WS_USCT = 542 * MiB, WS_WT = 554 * MiB;
constexpr size_t WS_X8 = 566 * MiB;
constexpr size_t WS_XS = 614 * MiB;
constexpr size_t WS_PD = 1566 * MiB;
constexpr size_t WS_END = 1758 * MiB;
#if MK_DBG
constexpr size_t WS_SC = WS_END, WS_NEED = WS_END + 192 * MiB;
#else
constexpr size_t WS_SC = WS_Y, WS_NEED = WS_END;
#endif
constexpr int CW_BAR = 4096;
constexpr int CW_QUEUE = 8192;
constexpr int CW_SQ = 12288;
constexpr int CW_DBG = 16384;

constexpr int RING_BYTES = 131072;
constexpr int MISC_OFF = RING_BYTES;
constexpr int LDS_BYTES = 147456;

struct Args { const float* in[23]; float* out; unsigned char* ws; int ph_lo, ph_hi; float lam_init[DEPTH]; };

struct Frame {
    LAS unsigned char* lds; char* lds_g;
    gu32* ctl; unsigned char* ws;
    int tid, lane, wave, gw, ngw;
};

template <int MODE> __device__ __forceinline__ int rowmap(int n) {
    if (MODE == 0) return n;
    const int head = n / 192, w = n - head * 192; if (w < 128) return n;
    const int e = w - 128, s = e >> 5, f = e & 31; return head * 192 + 128 + 2 * f + s;
}
template <int MODE> __device__ __forceinline__ void transpose_item(const float* W, int K, int N, bf16* WT, LAS float* scr, int item, int lane) {
    const int nblk = N / 32, kb = item / nblk, nb = item % nblk, k0 = 64 * kb, n0 = 32 * nb;
#pragma unroll 8
    for (int i = 0; i < 32; ++i) { const int kk = 2 * i + (lane >> 5); scr[kk * 33 + (lane & 31)] = W[(size_t)(k0 + kk) * N + n0 + (lane & 31)]; }
    LDS_WAIT(); asm volatile("" ::: "memory");
    const int c = lane & 7;
#pragma unroll
    for (int j = 0; j < 4; ++j) { const int n = (lane >> 3) + 8 * j; const LAS float* s = scr + (8 * c) * 33 + n;
        v4u o; o.x = pk2(s[0 * 33], s[1 * 33]); o.y = pk2(s[2 * 33], s[3 * 33]); o.z = pk2(s[4 * 33], s[5 * 33]); o.w = pk2(s[6 * 33], s[7 * 33]);
        *(v4u*)(WT + (size_t)rowmap<MODE>(n0 + n) * K + k0 + 8 * c) = o; }
    LDS_WAIT(); asm volatile("" ::: "memory");
}
__device__ __forceinline__ void sincos_d(double a, float& c, float& s) {
    const double q = __builtin_rint(a * 0.6366197723675814); const double y = a - q * 1.5707963267948966 - q * 6.123233995736766e-17;
    const double y2 = y * y;
    double sp = -7.647163731819816e-13; sp = sp * y2 + 1.6059043836821613e-10; sp = sp * y2 - 2.505210838544172e-08; sp = sp * y2 + 2.7557319223985893e-06;
    sp = sp * y2 - 1.984126984126984e-04; sp = sp * y2 + 8.333333333333333e-03; sp = sp * y2 - 1.6666666666666666e-01; sp = y + y * y2 * sp;
    double cp = 4.779477332387385e-14; cp = cp * y2 - 1.1470745597729725e-11; cp = cp * y2 + 2.08767569878681e-09; cp = cp * y2 - 2.755731922398589e-07;
    cp = cp * y2 + 2.48015873015873e-05; cp = cp * y2 - 1.388888888888889e-03; cp = cp * y2 + 4.1666666666666664e-02; cp = cp * y2 - 0.5; cp = 1.0 + y2 * cp;
    const int qi = (int)((long long)q & 3);
    const double sv = (qi & 1) ? cp : sp, cv = (qi & 1) ? sp : cp;
    s = (float)((qi & 2) ? -sv : sv); c = (float)(((qi + 1) & 2) ? -cv : cv);
}
__device__ __forceinline__ void p0_prologue(Frame& F, const Args& A) {
    LAS float* scr = (LAS float*)(F.lds + F.wave * 16384);
    constexpr int I_IN = 32 * 110, I_UQ = 6 * 36, I_UKV = 4 * 48, I_O = 32 * 64, I_L = I_IN + I_UQ + I_UKV + I_O;
    for (int it = F.gw; it < DEPTH * I_L; it += F.ngw) {
        const int l = it / I_L; int r = it - l * I_L;
        if (r < I_IN) { transpose_item<0>(A.in[2] + (size_t)l * DM * INW, DM, INW, (bf16*)(F.ws + WS_WIN) + (size_t)l * INP * DM, scr, r, F.lane); continue; } r -= I_IN;
        if (r < I_UQ) { transpose_item<1>(A.in[7] + (size_t)l * 384 * BQW, 384, BQW, (bf16*)(F.ws + WS_WUQ) + (size_t)l * BQP * 384, scr, r, F.lane); continue; } r -= I_UQ;
        if (r < I_UKV) { transpose_item<0>(A.in[8] + (size_t)l * 256 * BKVW, 256, BKVW, (bf16*)(F.ws + WS_WUKV) + (size_t)l * BKVW * 256, scr, r, F.lane); continue; } r -= I_UKV;
        transpose_item<0>(A.in[14] + (size_t)l * DM * DM, DM, DM, (bf16*)(F.ws + WS_WO) + (size_t)l * DM * DM, scr, r, F.lane);
    }
    const size_t gt = (size_t)blockIdx.x * 512 + F.tid, ngt = (size_t)gridDim.x * 512;
    for (size_t i = gt; i < (size_t)DEPTH * 64 * DM / 8; i += ngt) { const size_t l = i / (64 * DM / 8), o = i % (64 * DM / 8);
        *(v4u*)((bf16*)(F.ws + WS_WIN) + (l * INP + INW) * DM + o * 8) = (v4u){0u, 0u, 0u, 0u}; }
    for (size_t i = gt; i < (size_t)DEPTH * 128 * 384 / 8; i += ngt) { const size_t l = i / (128 * 384 / 8), o = i % (128 * 384 / 8);
        *(v4u*)((bf16*)(F.ws + WS_WUQ) + (l * BQP + BQW) * 384 + o * 8) = (v4u){0u, 0u, 0u, 0u}; }
    for (size_t i = gt; i < (size_t)DEPTH * DM * DM / 8; i += ngt) { const float* sp = A.in[17] + i * 8; const f32x4 a = *(const f32x4*)sp, b = *(const f32x4*)(sp + 4);
        *(v4u*)((bf16*)(F.ws + WS_WQ) + i * 8) = (v4u){pk2(a.x, a.y), pk2(a.z, a.w), pk2(b.x, b.y), pk2(b.z, b.w)}; }
    for (size_t i = gt; i < (size_t)DEPTH * DM * DM / 8; i += ngt) { const size_t l = i / (DM * DM / 8), o = i % (DM * DM / 8), r = o / (DM / 8), k = (o % (DM / 8)) * 8;
        v4u w = (v4u){0u, 0u, 0u, 0u};
        if ((r >> 7) == (k >> 7)) { const int m = (int)((r >> 7) & 1); const float* sp = A.in[18] + ((l * 2 + m) * 128 + (r & 127)) * 128 + (k & 127); const f32x4 a = *(const f32x4*)sp, b = *(const f32x4*)(sp + 4);
            w = (v4u){pk2(a.x, a.y), pk2(a.z, a.w), pk2(b.x, b.y), pk2(b.z, b.w)}; }
        *(v4u*)((bf16*)(F.ws + WS_SKD) + (l * DM + r) * DM + k) = w; }
    for (int r = F.gw; r < 2 * DEPTH * NEXP; r += F.ngw) { const int tb = r >= DEPTH * NEXP, rr = tb ? r - DEPTH * NEXP : r;
        const float* src = A.in[19 + tb] + (size_t)rr * DM + F.lane * 4; f32x4 v[8]; float am = 0.f;
#pragma unroll
        for (int j = 0; j < 8; ++j) { v[j] = __builtin_nontemporal_load((const f32x4*)(src + 256 * j)); am = fmaxf(am, fmaxf(fmaxf(fabsf(v[j][0]), fabsf(v[j][1])), fmaxf(fabsf(v[j][2]), fabsf(v[j][3])))); }
        am = wave_max(am);
        unsigned w[8]; float sci;
        if (tb) {
            int ex = (int)((__float_as_uint(am) >> 23) & 0xffu) - 126; if (ex < -100 || ex > 100) ex = 0;
            const float sc = __uint_as_float((unsigned)(127 + 7 - ex) << 23); sci = __uint_as_float((unsigned)(127 + ex - 7) << 23);
#pragma unroll
            for (int j = 0; j < 8; ++j) { unsigned q = 0u; q = __builtin_amdgcn_cvt_pk_fp8_f32(v[j][0] * sc, v[j][1] * sc, q, false); q = __builtin_amdgcn_cvt_pk_fp8_f32(v[j][2] * sc, v[j][3] * sc, q, true); w[j] = q; }
        } else {
            const float sc = am > 1e-30f ? 127.0f / am : 0.f; sci = am * (1.0f / 127.0f);
#pragma unroll
            for (int j = 0; j < 8; ++j) { const int q0 = (int)__builtin_rintf(v[j][0] * sc), q1 = (int)__builtin_rintf(v[j][1] * sc), q2 = (int)__builtin_rintf(v[j][2] * sc), q3 = (int)__builtin_rintf(v[j][3] * sc);
                w[j] = (unsigned)(q0 & 0xff) | ((unsigned)(q1 & 0xff) << 8) | ((unsigned)(q2 & 0xff) << 16) | ((unsigned)(q3 & 0xff) << 24); }
        }
        const size_t lyr = (size_t)rr / NEXP, ex_ = (size_t)rr % NEXP;
        unsigned char* dst = F.ws + (tb ? WS_V : WS_U) + lyr * NEXP * DM + (size_t)(F.lane >> 5) * (NEXP * 128) + ex_ * 128 + (F.lane & 31) * 4;
#pragma unroll
        for (int j = 0; j < 8; ++j) *(unsigned*)(dst + (size_t)(2 * j) * (NEXP * 128)) = w[j];
        if (F.lane == 0) ((float*)(F.ws + (tb ? WS_VSC : WS_USC)))[rr] = sci; }
    for (size_t i = gt; i < (size_t)TT * DM / 8; i += ngt) { const size_t np = (size_t)T_PROMPT * DM / 8;
        const float* s = (i < np) ? A.in[0] + i * 8 : A.in[1] + (i - np) * 8; const f32x4 a = *(const f32x4*)s, b = *(const f32x4*)(s + 4);
        *(v4u*)((bf16*)(F.ws + WS_X) + i * 8) = (v4u){pk2(a.x, a.y), pk2(a.z, a.w), pk2(b.x, b.y), pk2(b.z, b.w)}; }
    for (size_t i = gt; i < (size_t)8192 * 32; i += ngt) { const int p = (int)(i >> 5), f = (int)(i & 31); double inv = 1.0; for (int k = 0; k < f; ++k) inv *= ROPE_R;
        float c, s; sincos_d((double)p * inv, c, s); ((f32x2*)(F.ws + WS_ROPE))[i] = (f32x2){c, s}; }
}

__device__ __forceinline__ void tok_seq(int t, int& s0, int& slen, int& pos) {
    if (t < T_PROMPT) { s0 = 0; slen = T_PROMPT; pos = t; } else { const int r = t - T_PROMPT; s0 = T_PROMPT + (r / S_SAMPLE) * S_SAMPLE; slen = S_SAMPLE; pos = r % S_SAMPLE; }
}
#define UNPACK8(W_, X_, O_) do { X_[O_ + 0] = bflo((W_)[0]); X_[O_ + 1] = bfhi((W_)[0]); X_[O_ + 2] = bflo((W_)[1]); X_[O_ + 3] = bfhi((W_)[1]); X_[O_ + 4] = bflo((W_)[2]); X_[O_ + 5] = bfhi((W_)[2]); X_[O_ + 6] = bflo((W_)[3]); X_[O_ + 7] = bfhi((W_)[3]); } while (0)
#define PACK8(X_, O_) ((v4u){pk2(X_[O_ + 0], X_[O_ + 1]), pk2(X_[O_ + 2], X_[O_ + 3]), pk2(X_[O_ + 4], X_[O_ + 5]), pk2(X_[O_ + 6], X_[O_ + 7])})

__device__ __forceinline__ void phase_prep(Frame& F, const Args& A, int l) {
    const float* qn_g = A.in[3] + l * 128; const float* kn_g = A.in[4] + l * 128; const float* qa_g = A.in[5] + l * 384; const float* kva_g = A.in[6] + l * 256;
    const f32x2* rope = (const f32x2*)(F.ws + WS_ROPE);
    bf16* H = (bf16*)(F.ws + WS_H); bf16* BK = (bf16*)(F.ws + WS_BK);
    int tid_ = threadIdx.x; asm volatile("" : "+v"(tid_)); const int lane = tid_ & 63;
    float g16[16], qa8[8], kva8[8];
    {   const float* gp = ((lane >> 3) < 6 ? qn_g : kn_g) + (lane & 7) * 16;
#pragma unroll
        for (int i = 0; i < 16; ++i) g16[i] = gp[i];
#pragma unroll
        for (int i = 0; i < 8; ++i) { qa8[i] = lane < 48 ? qa_g[lane * 8 + i] : 0.f; kva8[i] = lane < 32 ? kva_g[lane * 8 + i] : 0.f; } }
    const int l8 = lane & 7;
    struct Row { v4u w0, w1, c0, c1, wq, wkv, wkr; f32x4 rv; int pos; };
    auto fetch = [&](int t, Row& r) { int s0, slen; tok_seq(t, s0, slen, r.pos); const bf16* hrow = H + (size_t)t * INP;
        r.w0 = *(const v4u*)(hrow + lane * 16); r.w1 = *(const v4u*)(hrow + lane * 16 + 8); r.c0 = *(const v4u*)(hrow + H_CQ + lane * 16); r.c1 = *(const v4u*)(hrow + H_CQ + lane * 16 + 8);
        r.wq = (v4u){0u, 0u, 0u, 0u}; if (lane < 48) r.wq = *(const v4u*)(hrow + H_BCQ + lane * 8);
        r.wkv = (v4u){0u, 0u, 0u, 0u}; if (lane < 32) r.wkv = *(const v4u*)(hrow + H_BCKV + lane * 8);
        r.wkr = *(const v4u*)(hrow + H_BKR + l8 * 8);
        const int rrow = lane < 16 || lane >= 48 ? r.pos : lane < 32 ? (r.pos >> 6) : (r.pos & 63);
        r.rv = *(const f32x4*)((const float*)rope + (size_t)rrow * 64 + (lane & 15) * 4); };
    auto one = [&](int t, const Row& r, LAS unsigned char* rslot) {
        bf16* hrow = H + (size_t)t * INP;
        *(LAS f32x4*)(rslot + lane * 16) = r.rv; __builtin_amdgcn_wave_barrier();
        {
            float x[16]; UNPACK8(r.w0, x, 0); UNPACK8(r.w1, x, 8);
            float ss = 0.f;
#pragma unroll
            for (int i = 0; i < 16; ++i) ss += x[i] * x[i];
            ss += DPPF(ss, 0xB1); ss += DPPF(ss, 0x4E); ss += DPPF(ss, 0x141);
            const float rinv = 1.0f / sqrtf(ss * (1.0f / 128.0f) + EPS);
            const int j = lane & 7;
            const LAS f32x2* tb = (const LAS f32x2*)(rslot + (j < 4 ? 256 : 512) + (j & 1) * 128); const bool first = (j & 2) == 0;
#pragma unroll
            for (int i = 0; i < 16; ++i) x[i] = x[i] * rinv * g16[i];
#pragma unroll
            for (int i = 0; i < 16; ++i) { const float pr = DPPF(x[i], 0x4E); const f32x2 cs = tb[i]; x[i] = first ? x[i] * cs.x - pr * cs.y : x[i] * cs.x + pr * cs.y; }
            *(v4u*)(hrow + lane * 16) = PACK8(x, 0); *(v4u*)(hrow + lane * 16 + 8) = PACK8(x, 8);
        }
        {
            bf16* cp = hrow + H_CQ + lane * 16;
            float x[16]; UNPACK8(r.c0, x, 0); UNPACK8(r.c1, x, 8);
            const int j = lane & 3; const LAS f32x2* tb = (const LAS f32x2*)(rslot + (j & 1) * 128); const bool first = (j & 2) == 0;
#pragma unroll
            for (int i = 0; i < 16; ++i) { const float pr = DPPF(x[i], 0x4E); const f32x2 cs = tb[i]; x[i] = first ? x[i] * cs.x - pr * cs.y : x[i] * cs.x + pr * cs.y; }
            *(v4u*)cp = PACK8(x, 0); *(v4u*)(cp + 8) = PACK8(x, 8);
        }
        {
            float x[8]; UNPACK8(r.wq, x, 0); float ss = 0.f;
#pragma unroll
            for (int i = 0; i < 8; ++i) ss += x[i] * x[i];
            ss = wave_sum(ss); float rinv = 1.0f / sqrtf(ss * (1.0f / 384.0f) + EPS);
            if (lane < 48) {
#pragma unroll
                for (int i = 0; i < 8; ++i) x[i] = x[i] * rinv * qa8[i];
                *(v4u*)(hrow + H_BCQ + lane * 8) = PACK8(x, 0); }
            UNPACK8(r.wkv, x, 0); ss = 0.f;
#pragma unroll
            for (int i = 0; i < 8; ++i) ss += x[i] * x[i];
            ss = wave_sum(ss); rinv = 1.0f / sqrtf(ss * (1.0f / 256.0f) + EPS);
            if (lane < 32) {
#pragma unroll
                for (int i = 0; i < 8; ++i) x[i] = x[i] * rinv * kva8[i];
                *(v4u*)(hrow + H_BCKV + lane * 8) = PACK8(x, 0); }
            UNPACK8(r.wkr, x, 0);
            const LAS f32x2* tb = (const LAS f32x2*)(rslot + (l8 & 3) * 64); const bool first = l8 < 4; float o2[8];
#pragma unroll
            for (int i = 0; i < 8; ++i) { const float pr = __shfl_xor(x[i], 4); const f32x2 cs = tb[i]; x[i] = first ? x[i] * cs.x - pr * cs.y : x[i] * cs.x + pr * cs.y; }
#pragma unroll
            for (int i = 0; i < 8; ++i) o2[i] = __shfl_xor(x[i], 4);
            if (lane < 4) {
                const v4u a = (v4u){pk2(x[0], o2[0]), pk2(x[1], o2[1]), pk2(x[2], o2[2]), pk2(x[3], o2[3])}, b = (v4u){pk2(x[4], o2[4]), pk2(x[5], o2[5]), pk2(x[6], o2[6]), pk2(x[7], o2[7])};
                bf16* kp = BK + (size_t)t * BQW + 128 + lane * 16;
#pragma unroll
                for (int h = 0; h < 6; ++h) { *(v4u*)(kp + h * 192) = a; *(v4u*)(kp + h * 192 + 8) = b; }
            }
        } };
    for (int ta = F.gw; ta < TT; ta += 2 * F.ngw) { const int tb = ta + F.ngw;
        Row ra, rb; fetch(ta, ra); if (tb < TT) fetch(tb, rb);
        one(ta, ra, F.lds + F.wave * 2048); if (tb < TT) one(tb, rb, F.lds + F.wave * 2048 + 1024);
    }
}

struct StoreBf16 {
    bf16* O; int ldc, ncols;
    __device__ __forceinline__ void operator()(int row, int col, f32x4 v0, f32x4 v1) const {
        if (col < ncols) *(v4u*)(O + (size_t)row * ldc + col) = (v4u){pk2(v0[0], v0[1]), pk2(v0[2], v0[3]), pk2(v1[0], v1[1]), pk2(v1[2], v1[3])}; }
};
struct StoreF32 {
    float* O; int ldc;
    __device__ __forceinline__ void operator()(int row, int col, f32x4 v0, f32x4 v1) const { float* p = O + (size_t)row * ldc + col; *(f32x4*)p = v0; *(f32x4*)(p + 4) = v1; }
};
struct StoreMlaQ {
    bf16* O; const f32x2* rope;
    __device__ __forceinline__ void operator()(int row, int col, f32x4 v0, f32x4 v1) const {
        if (col >= BQW) return;
        const int w = col % 192;
        if (w >= 128) { int s0, slen, pos; tok_seq(row, s0, slen, pos); const f32x2* tb = rope + pos * 32 + ((w - 128) >> 1);
            const f32x2 c0 = tb[0], c1 = tb[1], c2 = tb[2], c3 = tb[3];
            const f32x4 a = v0, b = v1;
            v0[0] = a[0] * c0.x - a[1] * c0.y; v0[1] = a[1] * c0.x + a[0] * c0.y; v0[2] = a[2] * c1.x - a[3] * c1.y; v0[3] = a[3] * c1.x + a[2] * c1.y;
            v1[0] = b[0] * c2.x - b[1] * c2.y; v1[1] = b[1] * c2.x + b[0] * c2.y; v1[2] = b[2] * c3.x - b[3] * c3.y; v1[3] = b[3] * c3.x + b[2] * c3.y; }
        *(v4u*)(O + (size_t)row * BQW + col) = (v4u){pk2(v0[0], v0[1]), pk2(v0[2], v0[3]), pk2(v1[0], v1[1]), pk2(v1[2], v1[3])}; }
};
struct EpiMlaQ {
    static constexpr bool PERM = true, AFTER_DRAIN = false; bf16* O; const f32x2* rope;
    __device__ __forceinline__ void operator()(const pg8::f32x4 (&acc)[2][2][4][2], const pg8::Unit& u, int wr, int wc, int fr, int fq) const {
        const int row0 = u.pm * pg8::BM + wr * 64 + fr, col0 = u.pn * pg8::BM + wc * 32 + 8 * fq;
#pragma unroll
        for (int ai = 0; ai < 2; ++ai) { f32x4 cs[8][2];
#pragma unroll
            for (int m = 0; m < 4; ++m)
#pragma unroll
                for (int bj = 0; bj < 2; ++bj) { const int row = row0 + ai * pg8::HALF + m * 16, col = col0 + bj * pg8::HALF, w = col % 192;
                    cs[2 * m + bj][0] = (f32x4){1.f, 0.f, 1.f, 0.f}; cs[2 * m + bj][1] = (f32x4){1.f, 0.f, 1.f, 0.f};
                    if (col < BQW && w >= 128) { int s0, slen, pos; tok_seq(row, s0, slen, pos); const f32x4* tb = (const f32x4*)(rope + pos * 32 + ((w - 128) >> 1)); cs[2 * m + bj][0] = tb[0]; cs[2 * m + bj][1] = tb[1]; } }
#pragma unroll
            for (int m = 0; m < 4; ++m)
#pragma unroll
                for (int bj = 0; bj < 2; ++bj) { const int row = row0 + ai * pg8::HALF + m * 16, col = col0 + bj * pg8::HALF; if (col >= BQW) continue;
                    const pg8::f32x4 a = acc[ai][bj][m][0], b = acc[ai][bj][m][1]; const f32x4 c01 = cs[2 * m + bj][0], c23 = cs[2 * m + bj][1];
                    *(v4u*)(O + (size_t)row * BQW + col) = (v4u){pk2(a[0] * c01[0] - a[1] * c01[1], a[1] * c01[0] + a[0] * c01[1]), pk2(a[2] * c01[2] - a[3] * c01[3], a[3] * c01[2] + a[2] * c01[3]),
                                                                 pk2(b[0] * c23[0] - b[1] * c23[1], b[1] * c23[0] + b[0] * c23[1]), pk2(b[2] * c23[2] - b[3] * c23[3], b[3] * c23[2] + b[2] * c23[3])}; }
            asm volatile("" ::: "memory"); }
    }
};
struct StoreMlaKV {
    bf16* BK; bf16* BV;
    __device__ __forceinline__ void operator()(int row, int col, f32x4 v0, f32x4 v1) const {
        const int head = col >> 8, w = col & 255; bf16* p = (w < 128) ? BK + (size_t)row * BQW + head * 192 + w : BV + (size_t)row * BVW + head * 128 + (w - 128);
        *(v4u*)p = (v4u){pk2(v0[0], v0[1]), pk2(v0[2], v0[3]), pk2(v1[0], v1[1]), pk2(v1[2], v1[3])}; }
};
struct StoreResid {
    bf16* Y; const bf16* X;
    __device__ __forceinline__ void operator()(int row, int col, f32x4 v0, f32x4 v1) const {
        const v4u xw = *(const v4u*)(X + (size_t)row * DM + col); float x[8]; UNPACK8(xw, x, 0);
        *(v4u*)(Y + (size_t)row * DM + col) = (v4u){pk2(DN_ALPHA * x[0] + v0[0], DN_ALPHA * x[1] + v0[1]), pk2(DN_ALPHA * x[2] + v0[2], DN_ALPHA * x[3] + v0[3]),
                                                    pk2(DN_ALPHA * x[4] + v1[0], DN_ALPHA * x[5] + v1[1]), pk2(DN_ALPHA * x[6] + v1[2], DN_ALPHA * x[7] + v1[3])}; }
};
struct EpiResid {
    static constexpr bool PERM = true, AFTER_DRAIN = false; bf16* Y; const bf16* X;
    __device__ __forceinline__ void operator()(const pg8::f32x4 (&acc)[2][2][4][2], const pg8::Unit& u, int wr, int wc, int fr, int fq) const {
        const int row0 = u.pm * pg8::BM + wr * 64 + fr, col0 = u.pn * pg8::BM + wc * 32 + 8 * fq;
#pragma unroll
        for (int ai = 0; ai < 2; ++ai) { v4u xw[8];
#pragma unroll
            for (int m = 0; m < 4; ++m)
#pragma unroll
                for (int bj = 0; bj < 2; ++bj) xw[2 * m + bj] = *(const v4u*)(X + (size_t)(row0 + ai * pg8::HALF + m * 16) * DM + col0 + bj * pg8::HALF);
#pragma unroll
            for (int m = 0; m < 4; ++m)
#pragma unroll
                for (int bj = 0; bj < 2; ++bj) { float x[8]; UNPACK8(xw[2 * m + bj], x, 0); const pg8::f32x4 v0 = acc[ai][bj][m][0], v1 = acc[ai][bj][m][1];
                    *(v4u*)(Y + (size_t)(row0 + ai * pg8::HALF + m * 16) * DM + col0 + bj * pg8::HALF) = (v4u){pk2(DN_ALPHA * x[0] + v0[0], DN_ALPHA * x[1] + v0[1]), pk2(DN_ALPHA * x[2] + v0[2], DN_ALPHA * x[3] + v0[3]),
                                                                                                              pk2(DN_ALPHA * x[4] + v1[0], DN_ALPHA * x[5] + v1[1]), pk2(DN_ALPHA * x[6] + v1[2], DN_ALPHA * x[7] + v1[3])}; }
            asm volatile("" ::: "memory"); }
    }
};
struct FoldOrder {
    int G, c;
    __device__ __forceinline__ bool next(int i, pg8::Unit& u) const { const int idx = i * G + c; if (idx >= DEPTH * 64) return false; const int l = idx >> 6, r = idx & 63; u.pm = l * 8 + (r >> 3); u.pn = l * 8 + (r & 7); return true; }
    __device__ __forceinline__ void a_ready(const pg8::Unit&) const {}
    __device__ __forceinline__ void done(const pg8::Unit&) const {}
};
constexpr int P1_MOVED = 64;
struct P1Order {
    pg8::StaticOrder S; int G, c;
    __device__ __forceinline__ void init(int G_, int c_) { S.init(TT, INP - 256, G_, c_); G = G_; c = c_; }
    __device__ __forceinline__ bool next(int i, pg8::Unit& u) const { if (S.next(i, u)) return true; const int e = i * G + c - S.nwg; if (e >= TT / 256 - P1_MOVED) return false; u.pm = P1_MOVED + e; u.pn = INP / 256 - 1; return true; }
    __device__ __forceinline__ void a_ready(const pg8::Unit&) const {}
    __device__ __forceinline__ void done(const pg8::Unit&) const {}
};
struct MovedOrder {
    int G, c;
    __device__ __forceinline__ bool next(int i, pg8::Unit& u) const { const int L = i * G + c; if (L >= P1_MOVED) return false; u.pm = L; u.pn = INP / 256 - 1; return true; }
    __device__ __forceinline__ void a_ready(const pg8::Unit&) const {}
    __device__ __forceinline__ void done(const pg8::Unit&) const {}
};
template <class F, class Sched> __device__ __forceinline__ void run_gemm_s(Frame& Fr, const bf16* Aop, int lda, const bf16* Bt, int M, int N, int K, const F& f, const Sched& S) {
    int Kv = K; asm volatile("" : "+s"(Kv));
    pg8::Gemm g{Aop, Bt, M, N, Kv, lda, K}; pg8::EpiRow8<F> E{f};
    pg8::gemm_phase<pg8::EpiRow8<F>, Sched, true, true>(Fr.lds, g, S, E);
}
template <class F> __device__ __forceinline__ void run_gemm(Frame& Fr, const bf16* Aop, int lda, const bf16* Bt, int M, int N, int K, const F& f, int skip = 0) {
    int Kv = K; asm volatile("" : "+s"(Kv));
    pg8::Gemm g{Aop, Bt, M, N, Kv, lda, K}; pg8::StaticOrder S; S.init(M, N, (int)gridDim.x - skip, (int)blockIdx.x >= skip ? (int)blockIdx.x - skip : (1 << 29));
    pg8::EpiRow8<F> E{f};
    pg8::gemm_phase<pg8::EpiRow8<F>, pg8::StaticOrder, true, true>(Fr.lds, g, S, E);
}

#ifndef ATTN_V2
#define ATTN_V2 1
#endif
#if ATTN_V2
#ifndef ATTN_V3
#define ATTN_V3 4
#endif
#if ATTN_V3 == 4
#define ATTN_FN attn_body4
#elif ATTN_V3 == 3
#define ATTN_FN attn_body3
#else
#define ATTN_FN attn_body2
#endif
#define ATTN_X
#define ATTN_L , F.lds
#else
#define ATTN_FN attn_body
#define ATTN_X , true
#define ATTN_L
#endif
__device__ __forceinline__ int queue_next(Frame& F, gu32* q) {
    volatile LAS unsigned* W = (volatile LAS unsigned*)(F.lds + MISC_OFF) + 4;
    __syncthreads();
    if (threadIdx.x == 0) W[0] = __hip_atomic_fetch_add(q, 1u, RLX_AGENT);
    __syncthreads();
    return (int)W[0];
}
__device__ __forceinline__ int queue_pass(Frame& F, unsigned nxt) {
    volatile LAS unsigned* W = (volatile LAS unsigned*)(F.lds + MISC_OFF) + 4;
    __syncthreads();
    if (threadIdx.x == 0) W[0] = nxt;
    __syncthreads();
    return (int)W[0];
}
__device__ __forceinline__ unsigned queue_mask(Frame& F, gu32* q0, unsigned N, int tid  ) {
    volatile LAS unsigned* W = (volatile LAS unsigned*)(F.lds + MISC_OFF) + 4;
    __syncthreads();
    if (tid < 64) { const unsigned c = tid < 16 ? __hip_atomic_load(q0 + 16 * tid, RLX_AGENT) : N; const unsigned long long m = __ballot(c < N); if (tid == 0) W[0] = (unsigned)m; }
    __syncthreads();
    return W[0];
}
constexpr int AQR = 32 * ATT_ACTIVE_WAVES, APB = T_PROMPT / AQR, ASB = S_SAMPLE / AQR;
__device__ __forceinline__ void att_unit(int u, int NH, int& head, int& t0, int& s0, int& slen) {
    if (u < NH * APB) { head = u / APB; s0 = 0; slen = T_PROMPT; t0 = (u % APB) * AQR; }
    else { const int v = u - NH * APB, sq = v / (NH * ASB), r = v % (NH * ASB); head = r / ASB; s0 = T_PROMPT + sq * S_SAMPLE; slen = S_SAMPLE; t0 = s0 + (r % ASB) * AQR; }
}
__device__ __forceinline__ void phase_attn(Frame& F, const Args& A, int l, int rep = 0) {
    const bf16* H = (const bf16*)(F.ws + WS_H); bf16* AO = (bf16*)(F.ws + WS_AO);
    float d1 = 0.f, d2 = 0.f;
    for (int i = 0; i < 64; ++i) { d1 += A.in[9][l * 64 + i] * A.in[10][l * 64 + i]; d2 += A.in[11][l * 64 + i] * A.in[12][l * 64 + i]; }
    const float lam_init = A.lam_init[l];
    const float lam = __uint_as_float(__builtin_amdgcn_readfirstlane(__float_as_uint(expf(d1) - expf(d2) + lam_init)));
#ifndef AT_EN
#define AT_EN 7
#endif
#ifndef MK_REP_TYPES
#define MK_REP_TYPES 7
#endif
    const int at_en = (rep == 0) ? AT_EN : MK_REP_TYPES;
    if (at_en & 1) {
        float* stash = (float*)(F.ws + WS_STASH) + (size_t)blockIdx.x * 256 * 128;
        for (;;) { const int u = queue_next(F, F.ctl + CW_QUEUE + 64 * (3 * l + 0) + 16 * rep); if (u >= 4 * APB + 4 * 4 * ASB) break;
            int head, t0, s0, slen; att_unit(u, 4, head, t0, s0, slen);
            att::OutArgs oa{AO + (size_t)t0 * DM + 1536 + head * 128, DM, stash, lam, 1.0f - lam_init, A.in[13] + l * 128, (unsigned long long*)(F.ws + WS_CTL) + 12000};
            att::ATTN_FN<64, INP, INP, INP, 1 ATTN_X>(H + (size_t)t0 * INP + H_CQ + head * 128, H + (size_t)s0 * INP + H_CK + head * 128, H + (size_t)s0 * INP + H_CV + head * 128, slen, 0.125f, oa, F.lds_g ATTN_L);
            att::ATTN_FN<64, INP, INP, INP, 2 ATTN_X>(H + (size_t)t0 * INP + H_CQ + head * 128 + 64, H + (size_t)s0 * INP + H_CK + head * 128 + 64, H + (size_t)s0 * INP + H_CV + head * 128, slen, 0.125f, oa, F.lds_g ATTN_L);
        }
    }
    if (at_en & 2) {
        const bf16* BQ = (const bf16*)(F.ws + WS_BQ); const bf16* BK = (const bf16*)(F.ws + WS_BK); const bf16* BV = (const bf16*)(F.ws + WS_BV);
        for (;;) { const int u = queue_next(F, F.ctl + CW_QUEUE + 64 * (3 * l + 1) + 16 * rep); if (u >= 6 * APB + 4 * 6 * ASB) break;
            int head, t0, s0, slen; att_unit(u, 6, head, t0, s0, slen);
            att::OutArgs oa{AO + (size_t)t0 * DM + 768 + head * 128, DM, nullptr, 0.f, 0.f, nullptr, (unsigned long long*)(F.ws + WS_CTL) + 12000};
            att::ATTN_FN<192, BQW, BQW, BVW, 0 ATTN_X>(BQ + (size_t)t0 * BQW + head * 192, BK + (size_t)s0 * BQW + head * 192, BV + (size_t)s0 * BVW + head * 128, slen, 0.07216878364870322f, oa, F.lds_g ATTN_L);
        }
    }
    if (at_en & 4) {
        for (;;) { const int u = queue_next(F, F.ctl + CW_QUEUE + 64 * (3 * l + 2) + 16 * rep); if (u >= 6 * APB + 4 * 6 * ASB) break;
            int head, t0, s0, slen; att_unit(u, 6, head, t0, s0, slen); const int kvh = head / 3;
            att::OutArgs oa{AO + (size_t)t0 * DM + head * 128, DM, nullptr, 0.f, 0.f, nullptr, (unsigned long long*)(F.ws + WS_CTL) + 12000};
            att::ATTN_FN<128, INP, INP, INP, 0 ATTN_X>(H + (size_t)t0 * INP + H_AQ + head * 128, H + (size_t)s0 * INP + H_AK + kvh * 128, H + (size_t)s0 * INP + H_AV + kvh * 128, slen, 0.08838834764831845f, oa, F.lds_g ATTN_L);
        }
    }
}

__device__ __forceinline__ void phase_ln1(Frame& F, const Args& A, int l) {
    int tid_ = threadIdx.x; asm volatile("" : "+v"(tid_)); const int lane = tid_ & 63;
    const bf16* Y = (const bf16*)(F.ws + WS_Y); bf16* X1 = (bf16*)(F.ws + WS_X1); const float* g = A.in[15] + l * DM; const float* b = A.in[16] + l * DM;
    float gg[32], bb[32];
#pragma unroll
    for (int j = 0; j < 4; ++j) { const int c0 = j * 512 + lane * 8; const f32x4 ga = *(const f32x4*)(g + c0), gb = *(const f32x4*)(g + c0 + 4), ba = *(const f32x4*)(b + c0), bc = *(const f32x4*)(b + c0 + 4);
#pragma unroll
        for (int i = 0; i < 4; ++i) { gg[8 * j + i] = ga[i]; gg[8 * j + 4 + i] = gb[i]; bb[8 * j + i] = ba[i]; bb[8 * j + 4 + i] = bc[i]; } }
    for (int ta = F.gw; ta < TT; ta += 2 * F.ngw) { const int tb = ta + F.ngw < TT ? ta + F.ngw : ta;
        v4u ya[4], yb[4];
#pragma unroll
        for (int j = 0; j < 4; ++j) ya[j] = *(const v4u*)(Y + (size_t)ta * DM + j * 512 + lane * 8);
#pragma unroll
        for (int j = 0; j < 4; ++j) yb[j] = *(const v4u*)(Y + (size_t)tb * DM + j * 512 + lane * 8);
        auto one = [&](int t, const v4u (&yw)[4]) {
            float v[32];
#pragma unroll
            for (int j = 0; j < 4; ++j) UNPACK8(yw[j], v, 8 * j);
            float s = 0.f;
    #pragma unroll
            for (int i = 0; i < 32; ++i) s += v[i];
            const float mean = wave_sum(s) * (1.0f / DM); float q = 0.f;
    #pragma unroll
            for (int i = 0; i < 32; ++i) { v[i] -= mean; q += v[i] * v[i]; }
            const float rstd = 1.0f / sqrtf(wave_sum(q) * (1.0f / DM) + EPS);
            float am = 0.f;
    #pragma unroll
            for (int j = 0; j < 4; ++j) { const int c0 = j * 512 + lane * 8;
    #pragma unroll
                for (int i = 0; i < 8; ++i) { v[8 * j + i] = v[8 * j + i] * rstd * gg[8 * j + i] + bb[8 * j + i]; am = fmaxf(am, fabsf(v[8 * j + i])); }
                *(v4u*)(X1 + (size_t)t * DM + c0) = PACK8(v, 8 * j); }
            am = wave_max(am);
            const float sc = am > 1e-30f ? 127.0f / am : 0.f;
    #pragma unroll
            for (int j = 0; j < 4; ++j) { unsigned q[2];
    #pragma unroll
                for (int hh = 0; hh < 2; ++hh) { const int q0 = (int)__builtin_rintf(v[8 * j + 4 * hh] * sc), q1 = (int)__builtin_rintf(v[8 * j + 4 * hh + 1] * sc), q2 = (int)__builtin_rintf(v[8 * j + 4 * hh + 2] * sc), q3 = (int)__builtin_rintf(v[8 * j + 4 * hh + 3] * sc);
                    q[hh] = (unsigned)(q0 & 0xff) | ((unsigned)(q1 & 0xff) << 8) | ((unsigned)(q2 & 0xff) << 16) | ((unsigned)(q3 & 0xff) << 24); }
                *(v2u*)(F.ws + WS_X8 + (size_t)t * DM + j * 512 + lane * 8) = (v2u){q[0], q[1]}; }
            if (lane == 0) ((float*)(F.ws + WS_XS))[t] = am * (1.0f / 127.0f);
        };
        one(ta, ya); one(tb, yb);
    }
}

#define PEER_CVT(wd, f0, f1) do { f0 = __builtin_amdgcn_cvt_pk_f32_fp8((int)(wd), false); f1 = __builtin_amdgcn_cvt_pk_f32_fp8((int)(wd), true); } while (0)
#define DPP_STEP8(c, ctrl) do { _Pragma("unroll") for (int _h = 0; _h < 8; ++_h) c[_h] += __builtin_amdgcn_update_dpp(0, c[_h], ctrl, 0xf, 0xf, true); } while (0)
__device__ __forceinline__ void sum32x8(int (&c)[8]) {
    DPP_STEP8(c, 0xB1); DPP_STEP8(c, 0x4E); DPP_STEP8(c, 0x141); DPP_STEP8(c, 0x140);
#pragma unroll
    for (int h = 0; h < 8; ++h) { const auto r = __builtin_amdgcn_permlane16_swap((unsigned)c[h], (unsigned)c[h], false, false); c[h] = (int)(r[0] + r[1]); } }
__device__ __forceinline__ void sum64x8(int (&c)[8]) {
    sum32x8(c);
#pragma unroll
    for (int h = 0; h < 8; ++h) { const auto r = __builtin_amdgcn_permlane32_swap((unsigned)c[h], (unsigned)c[h], false, false); c[h] = (int)(r[0] + r[1]); } }
__device__ __forceinline__ float funkey(unsigned k) { return __uint_as_float((k & 0x80000000u) ? (k ^ 0x80000000u) : ~k); }
__device__ __forceinline__ unsigned fkey(float f) { const unsigned u = __float_as_uint(f); return u ^ ((unsigned)((int)u >> 31) | 0x80000000u); }
#define DPPI(v, ctrl) __builtin_amdgcn_update_dpp(0, (v), (ctrl), 0xf, 0xf, true)
#define DPPU(v, ctrl) ((unsigned)__builtin_amdgcn_update_dpp(0, (int)(v), (ctrl), 0xf, 0xf, true))
__device__ __forceinline__ unsigned umax_(unsigned a, unsigned b) { return a > b ? a : b; }
__device__ __forceinline__ unsigned umin_(unsigned a, unsigned b) { return a < b ? a : b; }
#define TOPK_BISECT(NK, KEYS, DPPSUM) do { na = 0x7fff; _Pragma("unroll 1") for (;;) { const unsigned d = hi - lo; if (!__any(na != 16 && d != 0u)) break; \
            const unsigned cv = lo + (d >> 1) + (d & 1u); int c = 0; \
            _Pragma("unroll") for (int i = 0; i < (NK); ++i) c += (int)((KEYS)[i] >= cv); \
            DPPSUM; const bool ok = c >= 16; lo = ok ? cv : lo; hi = ok ? hi : cv - 1u; na = ok ? c : na; } } while (0)
__device__ __forceinline__ void phase_peer_topk(Frame& F, const Args& A, int l) {
    const float* SC = (const float*)(F.ws + WS_SC);
    const float* Usc = (const float*)(F.ws + WS_USC) + l * NEXP; const float* Vsc = (const float*)(F.ws + WS_VSC) + l * NEXP;
    int tid_ = threadIdx.x; asm volatile("" : "+v"(tid_)); const int lane = tid_ & 63;
    LAS unsigned* selk = (LAS unsigned*)(F.lds + F.wave * 16384);
    LAS int* seli = (LAS int*)(F.lds + F.wave * 16384 + 1024);
    LAS int* eid = (LAS int*)(F.lds + F.wave * 16384 + 2048);
    LAS float* gate = (LAS float*)(F.lds + F.wave * 16384 + 2560);
    LAS float* dummy = (LAS float*)(F.lds + F.wave * 16384 + 4096) + lane;
    LAS f32x2* ssp = (LAS f32x2*)(F.lds + F.wave * 16384 + 8192);
    const int q8c = lane & 7;
    const unsigned cw0 = q8c == 0 ? 0x20100800u : q8c == 1 ? 0x21110901u : q8c == 2 ? 0x22120a02u : q8c == 3 ? 0x23130b03u : q8c == 4 ? 0x24140c04u : q8c == 5 ? 0x30150d05u : q8c == 6 ? 0x31160e06u : 0x32170f07u;
    const unsigned cw1 = q8c == 0 ? 0x00e07033u : q8c == 1 ? 0x00f07140u : q8c == 2 ? 0x00008041u : q8c == 3 ? 0x00009042u : q8c == 4 ? 0x0000a050u : q8c == 5 ? 0x0000b051u : q8c == 6 ? 0x0000c060u : 0x0000d061u;
    f32x4 nx[8]; size_t pgo = 0; int pee0 = 0, pee1 = 0; float pg0 = 0.f, pg1 = 0.f, psu0 = 0.f, psu1 = 0.f, psv0 = 0.f, psv1 = 0.f;
#define TK_LD4(dst, ptr, OFF) asm volatile("global_load_dwordx4 %0, %1, off offset:" #OFF : "=v"(dst) : "v"(ptr) : "memory")
#define TK_LD1(dst, ptr) asm volatile("global_load_dword %0, %1, off" : "=v"(dst) : "v"(ptr) : "memory")
#define TK_LDNX(tt) do { const float* _sp = SC + (size_t)(tt) * 2048 + lane * 32; TK_LD4(nx[0], _sp, 0); TK_LD4(nx[1], _sp, 16); TK_LD4(nx[2], _sp, 32); TK_LD4(nx[3], _sp, 48); \
        TK_LD4(nx[4], _sp, 64); TK_LD4(nx[5], _sp, 80); TK_LD4(nx[6], _sp, 96); TK_LD4(nx[7], _sp, 112); } while (0)
    if (F.gw < TT) { TK_LDNX(F.gw);
        TK_LD1(psu0, Usc + lane); TK_LD1(psu1, Usc + lane + 64); TK_LD1(psv0, Vsc + lane); TK_LD1(psv1, Vsc + lane + 64); }
#define TOPK_FLUSH(N) do { asm volatile("s_waitcnt vmcnt(" #N ")" : "+v"(psu0), "+v"(psu1), "+v"(psv0), "+v"(psv1) :: "memory"); ((int*)(F.ws + WS_EID))[pgo] = pee0; ((int*)(F.ws + WS_EID))[pgo + 64] = pee1; ((float*)(F.ws + WS_GATEV))[pgo] = pg0 * psv0; ((float*)(F.ws + WS_GATEV))[pgo + 64] = pg1 * psv1; \
        ((float*)(F.ws + WS_USCT))[pgo] = psu0; ((float*)(F.ws + WS_USCT))[pgo + 64] = psu1; } while (0)
#pragma unroll 1
    for (int t = F.gw; t < TT; t += F.ngw) {
        unsigned kk[32]; unsigned lo, hi; int na;
        {
            asm volatile("s_waitcnt vmcnt(4)" : "+v"(nx[0]), "+v"(nx[1]), "+v"(nx[2]), "+v"(nx[3]), "+v"(nx[4]), "+v"(nx[5]), "+v"(nx[6]), "+v"(nx[7]) :: "memory");
#pragma unroll
            for (int j = 0; j < 8; ++j) {
#pragma unroll
                for (int c = 0; c < 4; ++c) { kk[4 * j + c] = fkey(nx[j][c]); asm volatile("" : "+v"(kk[4 * j + c])); } }
            const int tn = t + F.ngw < TT ? t + F.ngw : t; TK_LDNX(tn);
        }
        {   unsigned gm[4];
#pragma unroll
            for (int b = 0; b < 4; ++b) { unsigned m = kk[8 * b];
#pragma unroll
                for (int i = 1; i < 8; ++i) m = umax_(m, kk[8 * b + i]);
                gm[b] = m; }
            unsigned mx = umax_(umax_(gm[0], gm[1]), umax_(gm[2], gm[3])), mn = umin_(umin_(gm[0], gm[1]), umin_(gm[2], gm[3]));
            mx = umax_(mx, DPPU(mx, 0xB1)); mx = umax_(mx, DPPU(mx, 0x4E)); mn = umin_(mn, DPPU(mn, 0xB1)); mn = umin_(mn, DPPU(mn, 0x4E));
            lo = mn; hi = mx; }
        TOPK_BISECT(32, kk, (c += DPPI(c, 0xB1), c += DPPI(c, 0x4E)));
        if (t != F.gw) TOPK_FLUSH(8);
        {
            const unsigned pv = lo; int cl = 0;
#pragma unroll
            for (int i = 0; i < 32; ++i) cl += (int)(kk[i] >= pv);
            const int q = lane & 3; const int c1 = DPPI(cl, 0x90), c2 = DPPI(cl, 0x40), c3 = DPPI(cl, 0x00);
            int pos = (q >= 1 ? c1 : 0) + (q >= 2 ? c2 : 0) + (q >= 3 ? c3 : 0);
            const int lb = (lane >> 2) * 16, ib = q * 32;
#pragma unroll
            for (int i = 0; i < 32; ++i) { const bool f = kk[i] >= pv; const bool w = f && pos < 16;
                LAS unsigned* pvv = w ? selk + lb + pos : (LAS unsigned*)dummy; LAS int* pii = w ? seli + lb + pos : (LAS int*)dummy;
                *pvv = kk[i]; asm volatile("" ::: "memory"); *pii = ib + i; asm volatile("" ::: "memory"); pos += (int)f; }
        }
        LDS_WAIT(); asm volatile("" ::: "memory");
        {
            const int g = lane >> 2, q = lane & 3; const LAS v4u* sk4 = (const LAS v4u*)(selk + g * 16);
            const v4u y0 = sk4[0], y1 = sk4[1], y2 = sk4[2], y3 = sk4[3], xm = sk4[q]; const v4u xi = *(const LAS v4u*)(seli + g * 16 + 4 * q);
            int rk[4] = {0, 0, 0, 0};
#define RK_BLK(Y, qp) do { const unsigned adj = (qp) < q ? 1u : 0u; _Pragma("unroll") for (int c = 0; c < 4; ++c) { const unsigned cmpv = xm[c] - adj; \
                _Pragma("unroll") for (int cp = 0; cp < 4; ++cp) rk[c] += (int)((Y)[cp] > cmpv); } } while (0)
            RK_BLK(y0, 0); RK_BLK(y1, 1); RK_BLK(y2, 2); RK_BLK(y3, 3);
            rk[1] += (int)(xm[0] == xm[1]); rk[2] += (int)(xm[0] == xm[2]) + (int)(xm[1] == xm[2]); rk[3] += (int)(xm[0] == xm[3]) + (int)(xm[1] == xm[3]) + (int)(xm[2] == xm[3]);
#pragma unroll
            for (int c = 0; c < 4; ++c) { ssp[g * 16 + rk[c]] = (f32x2){funkey(xm[c]), __int_as_float((int)xi[c])}; asm volatile("" ::: "memory"); }
        }
        LDS_WAIT(); asm volatile("" ::: "memory");
        const int hd = lane >> 3, q8 = lane & 7; unsigned k2[7]; float s2[7]; int e2[7];
        {   const LAS f32x2* pa = ssp + hd * 32; const LAS f32x2* pb = pa + 16;
#pragma unroll
            for (int s = 0; s < 7; ++s) { const unsigned code = ((s < 4 ? cw0 >> (8 * s) : cw1 >> (8 * (s - 4))) & 0xffu); const f32x2 ea = pa[code >> 4], eb = pb[code & 15u];
                s2[s] = ea[0] + eb[0]; k2[s] = fkey(s2[s]); e2[s] = __float_as_int(ea[1]) * 128 + __float_as_int(eb[1]); }
            k2[6] = q8 < 2 ? k2[6] : 0u;
            const float a0 = pa[0][0], a3 = pa[3][0], a15 = pa[15][0], b0 = pb[0][0], b3 = pb[3][0], b15 = pb[15][0];
            hi = fkey(a0 + b0); lo = umax_(fkey(a3 + b3), umax_(fkey(a0 + b15), fkey(a15 + b0))); }
        TOPK_BISECT(7, k2, (c += DPPI(c, 0xB1), c += DPPI(c, 0x4E), c += DPPI(c, 0x141)));
        {   const unsigned pv = lo; int cl = 0;
#pragma unroll
            for (int i = 0; i < 7; ++i) cl += (int)(k2[i] >= pv);
            const int q = lane & 3; const int c1 = DPPI(cl, 0x90), c2 = DPPI(cl, 0x40), c3 = DPPI(cl, 0x00);
            int qt = cl; qt += DPPI(qt, 0xB1); qt += DPPI(qt, 0x4E); const int lowq = DPPI(qt, 0x141);
            int pos = (q >= 1 ? c1 : 0) + (q >= 2 ? c2 : 0) + (q >= 3 ? c3 : 0) + ((lane & 4) ? lowq : 0);
            const int lb = hd * 16;
#pragma unroll
            for (int i = 0; i < 7; ++i) { const bool f = k2[i] >= pv; const bool w = f && pos < 16;
                LAS float* pg = w ? gate + lb + pos : dummy; LAS int* pe = w ? eid + lb + pos : (LAS int*)dummy;
                *pg = s2[i]; asm volatile("" ::: "memory"); *pe = e2[i]; asm volatile("" ::: "memory"); pos += (int)f; }
        }
        LDS_WAIT(); asm volatile("" ::: "memory");
        {   float gq[2]; int eq[2];
#pragma unroll
            for (int qq = 0; qq < 2; ++qq) { const int e = lane + 64 * qq; const float sc = gate[e]; float mx = sc;
                mx = fmaxf(mx, __shfl_xor(mx, 1)); mx = fmaxf(mx, __shfl_xor(mx, 2)); mx = fmaxf(mx, __shfl_xor(mx, 4)); mx = fmaxf(mx, __shfl_xor(mx, 8));
                const float ex = __expf(sc - mx); float sm = ex;
                sm += __shfl_xor(sm, 1); sm += __shfl_xor(sm, 2); sm += __shfl_xor(sm, 4); sm += __shfl_xor(sm, 8);
                eq[qq] = eid[e]; gq[qq] = ex / sm; }
            pgo = (size_t)t * 128 + lane; pee0 = eq[0]; pee1 = eq[1]; pg0 = gq[0]; pg1 = gq[1]; TK_LD1(psu0, Usc + eq[0]); TK_LD1(psu1, Usc + eq[1]); TK_LD1(psv0, Vsc + eq[0]); TK_LD1(psv1, Vsc + eq[1]); }
        LDS_WAIT(); asm volatile("" ::: "memory");
    }
    if (F.gw < TT) TOPK_FLUSH(0);
}

#define SL_DEC16(Rv, fv) do { _Pragma("unroll") for (int _k = 0; _k < 4; ++_k) { f32x2 _a, _b; PEER_CVT((Rv)[_k], _a, _b); fv[4 * _k] = _a[0]; fv[4 * _k + 1] = _a[1]; fv[4 * _k + 2] = _b[0]; fv[4 * _k + 3] = _b[1]; } } while (0)
#define SL_LOADE(EB, tt) do { EB[0] = *(const v2u*)(EID + (size_t)(tt) * 128 + lane * 2); } while (0)
#define SL_SPREAD(OUT4, IN2, slot) do { *(LAS v2u*)((slot) + lane * 8) = (IN2); __builtin_amdgcn_wave_barrier(); const LAS v4u* _sp = (const LAS v4u*)((slot) + g * 64); OUT4[0] = _sp[0]; OUT4[1] = _sp[1]; OUT4[2] = _sp[2]; OUT4[3] = _sp[3]; } while (0)
#define SL_LOADR(R, EB, tbl) do { v4u _e[4]; SL_SPREAD(_e, EB[0], slot_e); _Pragma("unroll") for (int _i = 0; _i < 16; ++_i) R[_i] = *(const v4u*)((tbl) + (_e[_i >> 2][_i & 3] * 128u + coff)); } while (0)
#ifndef PEER_TPW
#define PEER_TPW 32
#endif
__device__ __forceinline__ void phase_peer_u(Frame& F, const Args& A, int l, int rep = 0) {
    int tid_ = threadIdx.x; asm volatile("" : "+v"(tid_)); const int lane = tid_ & 63, g = lane >> 3, j = lane & 7;
    LAS unsigned char* slot_e = F.lds + F.wave * 2048;
    const unsigned char* Ut = F.ws + WS_U + (size_t)l * NEXP * DM; const unsigned char* X8 = F.ws + WS_X8; const unsigned* EID = (const unsigned*)(F.ws + WS_EID);
    float* PD = (float*)(F.ws + WS_PD);
    const int xcd = (int)(xb_xcc_id() & 7u);
    unsigned avail = 0xffffu;
    for (int kk = 0; kk < 16; ++kk) { const int s = (2 * xcd + kk) & 15; const unsigned coff = (unsigned)(s * (NEXP * 128) + j * 16);
        if (kk == 2) avail = queue_mask(F, F.ctl + CW_SQ + 16 * ((2 * l + 0) * 16) + 8 * rep, TT / (8 * PEER_TPW), tid_);
        if (!((avail >> s) & 1u)) continue;
        gu32* qs = F.ctl + CW_SQ + 16 * ((2 * l + 0) * 16 + s) + 8 * rep;
        for (int it = queue_next(F, qs); it < TT / (8 * PEER_TPW);) { unsigned nxt = 0u; if (tid_ == 0) nxt = __hip_atomic_fetch_add(qs, 1u, RLX_AGENT);
            const int tb = it * (8 * PEER_TPW) + F.wave * PEER_TPW;
            v4u R0[16], R1[16], XA[1], XB[1]; v2u EB[1];
#define SU_LOADX(XV, tt) do { XV[0] = *(const v4u*)(X8 + (size_t)(tt) * DM + s * 128 + j * 16); } while (0)
#define SU_COMP(R, XV, tt) do { float p[16]; \
                _Pragma("unroll") for (int _i = 0; _i < 16; ++_i) { int ia = 0; _Pragma("unroll") for (int _k = 0; _k < 4; ++_k) ia = __builtin_amdgcn_sdot4((int)R[_i][_k], (int)XV[0][_k], ia, false); \
                    float acc = (float)ia; asm volatile("" : "+v"(acc)); p[_i] = acc; } \
                float q8[8], q4[4], q2[2]; \
                { const bool b = (lane & 4) != 0; _Pragma("unroll") for (int _i = 0; _i < 8; ++_i) { const float keep = b ? p[_i + 8] : p[_i], send = b ? p[_i] : p[_i + 8]; q8[_i] = keep + __shfl_xor(send, 4); } } \
                { const bool b = (lane & 2) != 0; _Pragma("unroll") for (int _i = 0; _i < 4; ++_i) { const float keep = b ? q8[_i + 4] : q8[_i], send = b ? q8[_i] : q8[_i + 4]; q4[_i] = keep + __shfl_xor(send, 2); } } \
                { const bool b = (lane & 1) != 0; _Pragma("unroll") for (int _i = 0; _i < 2; ++_i) { const float keep = b ? q4[_i + 2] : q4[_i], send = b ? q4[_i] : q4[_i + 2]; q2[_i] = keep + __shfl_xor(send, 1); } } \
                *(f32x2*)(PD + ((size_t)s * TT + (tt)) * 128 + 2 * lane) = (f32x2){q2[0], q2[1]}; } while (0)
            SL_LOADE(EB, tb); SU_LOADX(XA, tb); SL_LOADR(R0, EB, Ut); SL_LOADE(EB, tb + 1); SU_LOADX(XB, tb + 1);
#pragma unroll 1
            for (int k = 0; k < PEER_TPW; k += 2) {
                SL_LOADR(R1, EB, Ut); if (k + 2 < PEER_TPW) SL_LOADE(EB, tb + k + 2);
                __builtin_amdgcn_sched_barrier(0);
                SU_COMP(R0, XA, tb + k); if (k + 2 < PEER_TPW) SU_LOADX(XA, tb + k + 2);
                __builtin_amdgcn_sched_barrier(0);
                if (k + 2 < PEER_TPW) SL_LOADR(R0, EB, Ut); if (k + 3 < PEER_TPW) SL_LOADE(EB, tb + k + 3);
                __builtin_amdgcn_sched_barrier(0);
                SU_COMP(R1, XB, tb + k + 1); if (k + 3 < PEER_TPW) SU_LOADX(XB, tb + k + 3);
                __builtin_amdgcn_sched_barrier(0);
            }
            it = queue_pass(F, nxt);
        }
    }
}
__device__ __forceinline__ void phase_peer_w(Frame& F, const Args& A, int l) {
    int tid_ = threadIdx.x; asm volatile("" : "+v"(tid_)); const int lane = tid_ & 63;
    const float* PD = (const float*)(F.ws + WS_PD); const float* G = (const float*)(F.ws + WS_GATEV); const float* US = (const float*)(F.ws + WS_USCT); float* W = (float*)(F.ws + WS_WT);
    struct In { f32x2 p[16], us, gv; float xs; };
    auto fetch = [&](int t, In& r) {
#pragma unroll
        for (int s = 0; s < 16; ++s) r.p[s] = *(const f32x2*)(PD + ((size_t)s * TT + t) * 128 + 2 * lane);
        r.us = *(const f32x2*)(US + (size_t)t * 128 + 2 * lane); r.gv = *(const f32x2*)(G + (size_t)t * 128 + 2 * lane); r.xs = ((const float*)(F.ws + WS_XS))[t]; };
    auto one = [&](int t, const In& r) { f32x2 a = (f32x2){0.f, 0.f};
#pragma unroll
        for (int s = 0; s < 16; ++s) a += r.p[s];
        const float h0 = a[0] * r.us[0] * r.xs, h1 = a[1] * r.us[1] * r.xs;
        *(f32x2*)(W + (size_t)t * 128 + 2 * lane) = (f32x2){r.gv[0] * 0.5f * h0 * (1.0f + erff(h0 * 0.7071067811865476f)), r.gv[1] * 0.5f * h1 * (1.0f + erff(h1 * 0.7071067811865476f))}; };
    for (int ta = F.gw; ta < TT; ta += 2 * F.ngw) { const int tb = ta + F.ngw < TT ? ta + F.ngw : ta;
        In ra, rb; fetch(ta, ra); fetch(tb, rb); one(ta, ra); one(tb, rb); }
}
__device__ __forceinline__ void phase_peer_v(Frame& F, const Args& A, int l, int rep = 0) {
    int tid_ = threadIdx.x; asm volatile("" : "+v"(tid_)); const int lane = tid_ & 63, g = lane >> 3, j = lane & 7;
    LAS unsigned char* slot_e = F.lds + F.wave * 2048; LAS unsigned char* slot_w = slot_e + 512;
    const unsigned char* Vt = F.ws + WS_V + (size_t)l * NEXP * DM; const unsigned* EID = (const unsigned*)(F.ws + WS_EID); const float* W = (const float*)(F.ws + WS_WT);
    bf16* YP = (bf16*)(F.ws + WS_Y);
    const int xcd = (int)(xb_xcc_id() & 7u);
    unsigned avail = 0xffffu;
    for (int kk = 0; kk < 16; ++kk) { const int s = (2 * xcd + kk) & 15; const unsigned coff = (unsigned)(s * (NEXP * 128) + j * 16);
        if (kk == 2) avail = queue_mask(F, F.ctl + CW_SQ + 16 * ((2 * l + 1) * 16) + 8 * rep, TT / (8 * PEER_TPW), tid_);
        if (!((avail >> s) & 1u)) continue;
        gu32* qs = F.ctl + CW_SQ + 16 * ((2 * l + 1) * 16 + s) + 8 * rep;
        for (int it = queue_next(F, qs); it < TT / (8 * PEER_TPW);) { unsigned nxt = 0u; if (tid_ == 0) nxt = __hip_atomic_fetch_add(qs, 1u, RLX_AGENT);
            const int tb = it * (8 * PEER_TPW) + F.wave * PEER_TPW;
            v4u R0[16], R1[16]; v2u EB[1], WA[1], WB[1];
#define SV_LOADW(WV, tt) do { WV[0] = *(const v2u*)(W + (size_t)(tt) * 128 + lane * 2); } while (0)
#define SV_DEC(Rv, fv) do { _Pragma("unroll") for (int _k = 0; _k < 4; ++_k) { PEER_CVT((Rv)[_k], fv[2 * _k], fv[2 * _k + 1]); } } while (0)
#define SV_COMP(R, WV, tt) do { f32x2 y2[8]; _Pragma("unroll") for (int _k = 0; _k < 8; ++_k) y2[_k] = (f32x2){0.f, 0.f}; \
                v4u _w4[4]; SL_SPREAD(_w4, WV[0], slot_w); \
                f32x2 fd[2][8]; SV_DEC(R[0], fd[0]);     \
                _Pragma("unroll") for (int _i = 0; _i < 16; ++_i) { const float wi = __uint_as_float(_w4[_i >> 2][_i & 3]); const f32x2 w2 = (f32x2){wi, wi}; \
                    if (_i + 1 < 16) SV_DEC(R[(_i + 1) & 15], fd[(_i + 1) & 1]); \
                    _Pragma("unroll") for (int _k = 0; _k < 8; ++_k) y2[_k] = w2 * fd[_i & 1][_k] + y2[_k]; \
                    asm volatile("" : "+v"(y2[0]), "+v"(y2[1]), "+v"(y2[2]), "+v"(y2[3]), "+v"(y2[4]), "+v"(y2[5]), "+v"(y2[6]), "+v"(y2[7])); } \
                float y[16]; _Pragma("unroll") for (int _k = 0; _k < 8; ++_k) { y[2 * _k] = y2[_k][0]; y[2 * _k + 1] = y2[_k][1]; } \
                float z8[8], z4[4], z2[2]; \
                { const bool b = (lane & 32) != 0; _Pragma("unroll") for (int _i = 0; _i < 8; ++_i) { const float keep = b ? y[_i + 8] : y[_i], send = b ? y[_i] : y[_i + 8]; z8[_i] = keep + __shfl_xor(send, 32); } } \
                { const bool b = (lane & 16) != 0; _Pragma("unroll") for (int _i = 0; _i < 4; ++_i) { const float keep = b ? z8[_i + 4] : z8[_i], send = b ? z8[_i] : z8[_i + 4]; z4[_i] = keep + __shfl_xor(send, 16); } } \
                { const bool b = (lane & 8) != 0; _Pragma("unroll") for (int _i = 0; _i < 2; ++_i) { const float keep = b ? z4[_i + 2] : z4[_i], send = b ? z4[_i] : z4[_i + 2]; z2[_i] = keep + __shfl_xor(send, 8); } } \
                *(unsigned*)(YP + (size_t)(tt) * DM + s * 128 + j * 16 + 2 * g) = pk2(z2[0], z2[1]); } while (0)
            SL_LOADE(EB, tb); SV_LOADW(WA, tb); SL_LOADR(R0, EB, Vt); SL_LOADE(EB, tb + 1); SV_LOADW(WB, tb + 1);
#pragma unroll 1
            for (int k = 0; k < PEER_TPW; k += 2) {
                SL_LOADR(R1, EB, Vt); if (k + 2 < PEER_TPW) SL_LOADE(EB, tb + k + 2);
                __builtin_amdgcn_sched_barrier(0);
                SV_COMP(R0, WA, tb + k); if (k + 2 < PEER_TPW) SV_LOADW(WA, tb + k + 2);
                __builtin_amdgcn_sched_barrier(0);
                if (k + 2 < PEER_TPW) SL_LOADR(R0, EB, Vt); if (k + 3 < PEER_TPW) SL_LOADE(EB, tb + k + 3);
                __builtin_amdgcn_sched_barrier(0);
                SV_COMP(R1, WB, tb + k + 1); if (k + 3 < PEER_TPW) SV_LOADW(WB, tb + k + 3);
                __builtin_amdgcn_sched_barrier(0);
            }
            it = queue_pass(F, nxt);
        }
    }
}
template <bool FOLD = false> __device__ __forceinline__ void ln2_range(Frame& F, const Args& A, int l, int t_first, int t_step, int t_end) {
    int tid_ = threadIdx.x; asm volatile("" : "+v"(tid_)); const int lane = tid_ & 63;
    const bf16* YP = (const bf16*)(F.ws + WS_Y); const bf16* X1 = (const bf16*)(F.ws + WS_X1); bf16* Xn = (bf16*)(F.ws + WS_X); const float* g2 = A.in[21] + l * DM; const float* b2 = A.in[22] + l * DM;
    float gg[32], bb[32];
#pragma unroll
    for (int jj = 0; jj < 4; ++jj) { const int c0 = jj * 512 + lane * 8; const f32x4 ga = *(const f32x4*)(g2 + c0), gb = *(const f32x4*)(g2 + c0 + 4), ba = *(const f32x4*)(b2 + c0), bc = *(const f32x4*)(b2 + c0 + 4);
#pragma unroll
        for (int i = 0; i < 4; ++i) { gg[8 * jj + i] = ga[i]; gg[8 * jj + 4 + i] = gb[i]; bb[8 * jj + i] = ba[i]; bb[8 * jj + 4 + i] = bc[i]; } }
    for (int ta = t_first; ta < t_end; ta += 2 * t_step) { const int tb = ta + t_step < t_end ? ta + t_step : ta;
        v4u ya[4], xa[4], yb[4], xb[4];
#pragma unroll
        for (int jj = 0; jj < 4; ++jj) { const int c0 = jj * 512 + lane * 8; ya[jj] = *(const v4u*)(YP + (size_t)ta * DM + c0); if constexpr (!FOLD) xa[jj] = *(const v4u*)(X1 + (size_t)ta * DM + c0); else xa[jj] = (v4u){0u, 0u, 0u, 0u}; }
#pragma unroll
        for (int jj = 0; jj < 4; ++jj) { const int c0 = jj * 512 + lane * 8; yb[jj] = *(const v4u*)(YP + (size_t)tb * DM + c0); if constexpr (!FOLD) xb[jj] = *(const v4u*)(X1 + (size_t)tb * DM + c0); else xb[jj] = (v4u){0u, 0u, 0u, 0u}; }
        auto one = [&](int t, const v4u (&yw)[4], const v4u (&xw)[4]) {
            float v[32];
#pragma unroll
            for (int jj = 0; jj < 4; ++jj) { float y[8], x[8]; UNPACK8(yw[jj], y, 0); UNPACK8(xw[jj], x, 0);
#pragma unroll
                for (int i = 0; i < 8; ++i) v[8 * jj + i] = FOLD ? y[i] : DN_ALPHA * x[i] + y[i]; }
            float sm = 0.f;
#pragma unroll
            for (int i = 0; i < 32; ++i) sm += v[i];
            const float mean = wave_sum(sm) * (1.0f / DM); float qq = 0.f;
#pragma unroll
            for (int i = 0; i < 32; ++i) { v[i] -= mean; qq += v[i] * v[i]; }
            const float rstd = 1.0f / sqrtf(wave_sum(qq) * (1.0f / DM) + EPS);
#pragma unroll
            for (int jj = 0; jj < 4; ++jj) { const int c0 = jj * 512 + lane * 8; float o[8];
#pragma unroll
                for (int i = 0; i < 8; ++i) o[i] = v[8 * jj + i] * rstd * gg[8 * jj + i] + bb[8 * jj + i];
                if (l == DEPTH - 1) { float* op = A.out + (size_t)t * DM + c0; *(f32x4*)op = (f32x4){o[0], o[1], o[2], o[3]}; *(f32x4*)(op + 4) = (f32x4){o[4], o[5], o[6], o[7]}; }
                else *(v4u*)(Xn + (size_t)t * DM + c0) = PACK8(o, 0); } };
        one(ta, ya, xa); one(tb, yb, xb);
    }
}

__device__ __forceinline__ void phase_ln2(Frame& F, const Args& A, int l) { ln2_range(F, A, l, F.gw, F.ngw, TT); }

#ifndef PF_NT
#define PF_NT 0
#endif
#if PF_NT
#define PF_YST(p, v) __builtin_nontemporal_store((v), (p))
#else
#define PF_YST(p, v) (*(p) = (v))
#endif
#ifndef PF_XSTAGE
#define PF_XSTAGE 1
#endif
#ifndef PF_FOLD
#define PF_FOLD 0
#endif
#ifndef PF_LN2
#define PF_LN2 1
#endif
#ifndef PF_DYN
#define PF_DYN 0
#endif
#ifndef PF_SYNC
#define PF_SYNC 0
#endif
#ifndef PF_TPW
#define PF_TPW 12
#endif
static_assert(!PF_FOLD || PF_LN2, "the folded residual needs the in-chunk LN2");
constexpr int PF_CT = 8 * PF_TPW, PF_NCH = TT / PF_CT, PF_PER_XCD = PF_NCH / 8;
static_assert(TT % PF_CT == 0 && PF_NCH % 8 == 0 && (PF_TPW % 2) == 0, "PEER chunking");
__device__ __forceinline__ void peer_fused_chunk(Frame& F, const Args& A, int l, int chunk) {
    int tid_ = threadIdx.x; asm volatile("" : "+v"(tid_)); const int lane = tid_ & 63, g = lane >> 3, j = lane & 7;
    const unsigned char* Ut = F.ws + WS_U + (size_t)l * NEXP * DM; const unsigned char* Vt = F.ws + WS_V + (size_t)l * NEXP * DM; const unsigned char* X8 = F.ws + WS_X8;
    const unsigned* EID = (const unsigned*)(F.ws + WS_EID); bf16* YP = (bf16*)(F.ws + WS_Y);
    LAS unsigned char* ids = F.lds + F.wave * 16384; LAS unsigned char* wl = ids + PF_TPW * 512;
    const int tb0 = chunk * PF_CT + F.wave * PF_TPW;
#if PF_SYNC
    unsigned* const psync = (unsigned*)(F.ctl + CW_SQ + 16 * ((2 * l) * 16 + (int)(xb_xcc_id() & 7u)));
    const unsigned pnw = 8u * ((volatile LAS unsigned*)(F.lds + MISC_OFF))[0]; unsigned ptarget = 0u; const bool pon = (int)gridDim.x == PF_NCH && pnw != 0u;
#define PF_PACE() do { if (pon) { ptarget += pnw; if (lane == 0) (void)xb_add(psync, 1u); \
        for (int _i = 0; _i < 256; ++_i) { if ((unsigned)__builtin_amdgcn_readfirstlane((int)xb_ld(psync)) >= ptarget) break; __builtin_amdgcn_s_sleep(1); } } } while (0)
#else
#define PF_PACE() do {} while (0)
#endif
    {   v2u e[PF_TPW];
#pragma unroll
        for (int k = 0; k < PF_TPW; ++k) e[k] = *(const v2u*)(EID + (size_t)(tb0 + k) * 128 + lane * 2);
#pragma unroll
        for (int k = 0; k < PF_TPW; ++k) *(LAS v2u*)(ids + k * 512 + lane * 8) = e[k];
        __builtin_amdgcn_wave_barrier(); }
    v4u R0[16], R1[16];
#define PF_LOADR(R, k, s_, tbl) do { const LAS v4u* _ip = (const LAS v4u*)(ids + (k) * 512 + g * 64); const v4u _e0 = _ip[0], _e1 = _ip[1], _e2 = _ip[2], _e3 = _ip[3]; const unsigned _co = (unsigned)(s_) * (unsigned)(NEXP * 128) + (unsigned)(j * 16); \
        R[0] = *(const v4u*)((tbl) + (_e0[0] * 128u + _co)); R[1] = *(const v4u*)((tbl) + (_e0[1] * 128u + _co)); R[2] = *(const v4u*)((tbl) + (_e0[2] * 128u + _co)); R[3] = *(const v4u*)((tbl) + (_e0[3] * 128u + _co)); \
        R[4] = *(const v4u*)((tbl) + (_e1[0] * 128u + _co)); R[5] = *(const v4u*)((tbl) + (_e1[1] * 128u + _co)); R[6] = *(const v4u*)((tbl) + (_e1[2] * 128u + _co)); R[7] = *(const v4u*)((tbl) + (_e1[3] * 128u + _co)); \
        R[8] = *(const v4u*)((tbl) + (_e2[0] * 128u + _co)); R[9] = *(const v4u*)((tbl) + (_e2[1] * 128u + _co)); R[10] = *(const v4u*)((tbl) + (_e2[2] * 128u + _co)); R[11] = *(const v4u*)((tbl) + (_e2[3] * 128u + _co)); \
        R[12] = *(const v4u*)((tbl) + (_e3[0] * 128u + _co)); R[13] = *(const v4u*)((tbl) + (_e3[1] * 128u + _co)); R[14] = *(const v4u*)((tbl) + (_e3[2] * 128u + _co)); R[15] = *(const v4u*)((tbl) + (_e3[3] * 128u + _co)); } while (0)
#pragma unroll
    for (int k = 0; k < PF_TPW; ++k) *(LAS f32x2*)(wl + k * 512 + lane * 8) = (f32x2){0.f, 0.f};
    {   v4u XA, XB;
#if PF_XSTAGE
        LAS unsigned char* xst = wl + PF_TPW * 512;
        static_assert(PF_TPW <= 16 && 2 * PF_TPW * 512 + 2 * PF_TPW * 128 <= 16384, "x stage");
        v4u PA, PB;
        const int tkb = 8 + g < PF_TPW ? 8 + g : PF_TPW - 1;
#define PF_XREQ(s_) do { PA = *(const v4u*)(X8 + (size_t)(tb0 + g) * DM + (s_) * 128 + j * 16); PB = *(const v4u*)(X8 + (size_t)(tb0 + tkb) * DM + (s_) * 128 + j * 16); } while (0)
#define PF_XPUT(s_) do { LAS unsigned char* _xb = xst + ((s_) & 1) * (PF_TPW * 128); *(LAS v4u*)(_xb + g * 128 + j * 16) = PA; *(LAS v4u*)(_xb + tkb * 128 + j * 16) = PB; } while (0)
#define PF_LOADX(XV, k, s_) do { XV = *(const LAS v4u*)(xst + ((s_) & 1) * (PF_TPW * 128) + (k) * 128 + j * 16); } while (0)
        PF_XREQ(0); PF_XPUT(0); PF_XREQ(1);
#else
#define PF_XREQ(s_) do {} while (0)
#define PF_XPUT(s_) do {} while (0)
#define PF_LOADX(XV, k, s_) do { XV = *(const v4u*)(X8 + (size_t)(tb0 + (k)) * DM + (s_) * 128 + j * 16); } while (0)
#endif
#define PF_UCOMP(R, XV, k) do { LAS f32x2* _ap = (LAS f32x2*)(wl + (k) * 512 + lane * 8); const f32x2 _a = *_ap; float p[16]; \
            _Pragma("unroll") for (int _i = 0; _i < 16; ++_i) { int ia = 0; _Pragma("unroll") for (int _k = 0; _k < 4; ++_k) ia = __builtin_amdgcn_sdot4((int)R[_i][_k], (int)XV[_k], ia, false); \
                float a_ = (float)ia; asm volatile("" : "+v"(a_)); p[_i] = a_; } \
            float q8[8], q4[4], q2[2]; \
              \
            { const bool b = (lane & 4) != 0; _Pragma("unroll") for (int _i = 0; _i < 8; ++_i) { const float keep = b ? p[_i + 8] : p[_i], send = b ? p[_i] : p[_i + 8]; q8[_i] = keep + __int_as_float(__builtin_amdgcn_update_dpp(0, __float_as_int(send), 0x141, 0xf, 0xf, true)); } } \
            { const bool b = (lane & 2) != 0; _Pragma("unroll") for (int _i = 0; _i < 4; ++_i) { const float keep = b ? q8[_i + 4] : q8[_i], send = b ? q8[_i] : q8[_i + 4]; q4[_i] = keep + __int_as_float(__builtin_amdgcn_update_dpp(0, __float_as_int(send), 0x4E, 0xf, 0xf, true)); } } \
            { const bool b = (lane & 1) != 0; _Pragma("unroll") for (int _i = 0; _i < 2; ++_i) { const float keep = b ? q4[_i + 2] : q4[_i], send = b ? q4[_i] : q4[_i + 2]; q2[_i] = keep + __int_as_float(__builtin_amdgcn_update_dpp(0, __float_as_int(send), 0xB1, 0xf, 0xf, true)); } } \
            *_ap = (f32x2){_a[0] + q2[0], _a[1] + q2[1]}; } while (0)
        PF_LOADR(R0, 0, 0, Ut); PF_LOADX(XA, 0, 0);
#pragma unroll 1
        for (int s = 0, k = 0; s < 16;) {
            if (PF_SYNC && k == 0 && s != 0 && (s % (PF_SYNC ? PF_SYNC : 1)) == 0) PF_PACE();
            if (PF_XSTAGE && k == PF_TPW - 2 && s + 1 < 16) PF_XPUT(s + 1);
            if (PF_XSTAGE && k == 0 && s != 0 && s + 1 < 16) PF_XREQ(s + 1);
            PF_LOADR(R1, k + 1, s, Ut); PF_LOADX(XB, k + 1, s);
            __builtin_amdgcn_sched_barrier(0);
            PF_UCOMP(R0, XA, k);
            __builtin_amdgcn_sched_barrier(0);
            const int k2 = k + 2 < PF_TPW ? k + 2 : 0, s2 = k + 2 < PF_TPW ? s : s + 1;
            if (s2 < 16) { PF_LOADR(R0, k2, s2, Ut); PF_LOADX(XA, k2, s2); }
            __builtin_amdgcn_sched_barrier(0);
            PF_UCOMP(R1, XB, k + 1);
            __builtin_amdgcn_sched_barrier(0);
            k = k2; s = s2;
        }
    }
    {   const float* G = (const float*)(F.ws + WS_GATEV); const float* US = (const float*)(F.ws + WS_USCT); const float* XS = (const float*)(F.ws + WS_XS);
        {   constexpr int k0 = 0; f32x2 us[PF_TPW], gv[PF_TPW]; float xs[PF_TPW];
#pragma unroll
            for (int u = 0; u < PF_TPW; ++u) { us[u] = *(const f32x2*)(US + (size_t)(tb0 + k0 + u) * 128 + 2 * lane); gv[u] = *(const f32x2*)(G + (size_t)(tb0 + k0 + u) * 128 + 2 * lane); xs[u] = XS[tb0 + k0 + u]; }
#pragma unroll
            for (int u = 0; u < PF_TPW; ++u) { LAS f32x2* ap = (LAS f32x2*)(wl + (k0 + u) * 512 + lane * 8); const f32x2 a = *ap; const float h0 = a[0] * us[u][0] * xs[u], h1 = a[1] * us[u][1] * xs[u];
                *ap = (f32x2){gv[u][0] * 0.5f * h0 * (1.0f + erff(h0 * 0.7071067811865476f)), gv[u][1] * 0.5f * h1 * (1.0f + erff(h1 * 0.7071067811865476f))}; } }
        __builtin_amdgcn_wave_barrier(); }
    {
#define PF_LOADXP(XP, k, s_) do {} while (0)
        LAS unsigned char* xvs = wl + PF_TPW * 512; v4u Q[3];
        static_assert(!PF_FOLD || PF_TPW * 256 == 3 * 64 * 16, "x1 stage: 3 requests of 64 x 16 B per slice");
#define PF_VREQ(s_) do { if (PF_FOLD) { _Pragma("unroll") for (int _i = 0; _i < 3; ++_i) { const int _c = _i * 64 + lane; Q[_i] = *(const v4u*)((const bf16*)(F.ws + WS_X1) + (size_t)(tb0 + (_c >> 4)) * DM + (s_) * 128 + (_c & 15) * 8); } } } while (0)
#define PF_VPUT() do { if (PF_FOLD) { _Pragma("unroll") for (int _i = 0; _i < 3; ++_i) *(LAS v4u*)(xvs + (_i * 64 + lane) * 16) = Q[_i]; } } while (0)
#define PF_VCOMP(R, XP, k, s_) do { unsigned _xp = 0u; if (PF_FOLD) _xp = *(const LAS unsigned*)(xvs + (k) * 256 + j * 32 + g * 4); f32x2 y2[8]; _Pragma("unroll") for (int _k = 0; _k < 8; ++_k) y2[_k] = (f32x2){0.f, 0.f}; \
            const LAS v4u* _wp = (const LAS v4u*)(wl + (k) * 512 + g * 64); v4u _w4[4]; _w4[0] = _wp[0]; _w4[1] = _wp[1]; _w4[2] = _wp[2]; _w4[3] = _wp[3]; \
            f32x2 fd[2][8]; SV_DEC(R[0], fd[0]); \
            _Pragma("unroll") for (int _i = 0; _i < 16; ++_i) { const float wi = __uint_as_float(_w4[_i >> 2][_i & 3]); const f32x2 w2 = (f32x2){wi, wi}; \
                if (_i + 1 < 16) SV_DEC(R[(_i + 1) & 15], fd[(_i + 1) & 1]); \
                _Pragma("unroll") for (int _k = 0; _k < 8; ++_k) y2[_k] = w2 * fd[_i & 1][_k] + y2[_k]; \
                asm volatile("" : "+v"(y2[0]), "+v"(y2[1]), "+v"(y2[2]), "+v"(y2[3]), "+v"(y2[4]), "+v"(y2[5]), "+v"(y2[6]), "+v"(y2[7])); } \
            float y[16]; _Pragma("unroll") for (int _k = 0; _k < 8; ++_k) { y[2 * _k] = y2[_k][0]; y[2 * _k + 1] = y2[_k][1]; } \
            float z8[8], z4[4], z2[2]; \
              \
            _Pragma("unroll") for (int _i = 0; _i < 8; ++_i) { const auto _r = __builtin_amdgcn_permlane32_swap(__float_as_uint(y[_i]), __float_as_uint(y[_i + 8]), false, false); z8[_i] = __uint_as_float(_r[0]) + __uint_as_float(_r[1]); } \
            _Pragma("unroll") for (int _i = 0; _i < 4; ++_i) { const auto _r = __builtin_amdgcn_permlane16_swap(__float_as_uint(z8[_i]), __float_as_uint(z8[_i + 4]), false, false); z4[_i] = __uint_as_float(_r[0]) + __uint_as_float(_r[1]); } \
            { const bool b = (lane & 8) != 0; _Pragma("unroll") for (int _i = 0; _i < 2; ++_i) { const float keep = b ? z4[_i + 2] : z4[_i], send = b ? z4[_i] : z4[_i + 2]; z2[_i] = keep + __int_as_float(__builtin_amdgcn_update_dpp(0, __float_as_int(send), 0x128, 0xf, 0xf, true)); } }     \
            if (PF_FOLD) { z2[0] += DN_ALPHA * __uint_as_float(_xp << 16); z2[1] += DN_ALPHA * __uint_as_float(_xp & 0xffff0000u); } \
            PF_YST((unsigned*)(YP + (size_t)(tb0 + (k)) * DM + (s_) * 128 + j * 16 + 2 * g), pk2(z2[0], z2[1])); } while (0)
        unsigned XP0 = 0u, XP1 = 0u;
        PF_VREQ(0); PF_VPUT(); PF_VREQ(1);
        PF_LOADR(R0, 0, 0, Vt); PF_LOADXP(XP0, 0, 0);
#pragma unroll 1
        for (int s = 0, k = 0; s < 16;) {
            if (PF_SYNC && k == 0 && (s % (PF_SYNC ? PF_SYNC : 1)) == 0) PF_PACE();
            if (PF_FOLD && k == 0 && s != 0) { PF_VPUT(); if (s + 1 < 16) PF_VREQ(s + 1); }
            PF_LOADR(R1, k + 1, s, Vt); PF_LOADXP(XP1, k + 1, s);
            __builtin_amdgcn_sched_barrier(0);
            PF_VCOMP(R0, XP0, k, s);
            __builtin_amdgcn_sched_barrier(0);
            const int k2 = k + 2 < PF_TPW ? k + 2 : 0, s2 = k + 2 < PF_TPW ? s : s + 1;
            if (s2 < 16) { PF_LOADR(R0, k2, s2, Vt); PF_LOADXP(XP0, k2, s2); }
            __builtin_amdgcn_sched_barrier(0);
            PF_VCOMP(R1, XP1, k + 1, s);
            __builtin_amdgcn_sched_barrier(0);
            k = k2; s = s2;
        }
    }
#if PF_LN2
    asm volatile("s_waitcnt vmcnt(0)" ::: "memory");
    ln2_range<PF_FOLD != 0>(F, A, l, tb0, 1, tb0 + PF_TPW);
#endif
}
__device__ __forceinline__ void peer_fused_chunk_dyn(Frame& F, const Args& A, int l, int chunk) {
    int tid_ = threadIdx.x; asm volatile("" : "+v"(tid_)); const int lane = tid_ & 63, g = lane >> 3, j = lane & 7;
    const unsigned char* Ut = F.ws + WS_U + (size_t)l * NEXP * DM; const unsigned char* Vt = F.ws + WS_V + (size_t)l * NEXP * DM; const unsigned char* X8 = F.ws + WS_X8;
    const unsigned* EID = (const unsigned*)(F.ws + WS_EID); bf16* YP = (bf16*)(F.ws + WS_Y);
    LAS unsigned char* ids = F.lds; LAS unsigned char* wl = ids + PF_CT * 512;
    volatile LAS unsigned* dctr = (volatile LAS unsigned*)(F.lds + MISC_OFF) + 6;
    const int tb0 = chunk * PF_CT, kw0 = F.wave * PF_TPW;
    if (tid_ == 0) { dctr[0] = 0u; dctr[1] = 0u; }
    {   v2u e[PF_TPW];
#pragma unroll
        for (int k = 0; k < PF_TPW; ++k) e[k] = *(const v2u*)(EID + (size_t)(tb0 + kw0 + k) * 128 + lane * 2);
#pragma unroll
        for (int k = 0; k < PF_TPW; ++k) *(LAS v2u*)(ids + (kw0 + k) * 512 + lane * 8) = e[k];
        __builtin_amdgcn_wave_barrier(); }
    v4u R0[16], R1[16];
#define PD_LOADR(R, k, s_, tbl) do { const LAS v4u* _ip = (const LAS v4u*)(ids + (k) * 512 + g * 64); const v4u _e0 = _ip[0], _e1 = _ip[1], _e2 = _ip[2], _e3 = _ip[3]; const unsigned _co = (unsigned)(s_) * (unsigned)(NEXP * 128) + (unsigned)(j * 16); \
        R[0] = *(const v4u*)((tbl) + (_e0[0] * 128u + _co)); R[1] = *(const v4u*)((tbl) + (_e0[1] * 128u + _co)); R[2] = *(const v4u*)((tbl) + (_e0[2] * 128u + _co)); R[3] = *(const v4u*)((tbl) + (_e0[3] * 128u + _co)); \
        R[4] = *(const v4u*)((tbl) + (_e1[0] * 128u + _co)); R[5] = *(const v4u*)((tbl) + (_e1[1] * 128u + _co)); R[6] = *(const v4u*)((tbl) + (_e1[2] * 128u + _co)); R[7] = *(const v4u*)((tbl) + (_e1[3] * 128u + _co)); \
        R[8] = *(const v4u*)((tbl) + (_e2[0] * 128u + _co)); R[9] = *(const v4u*)((tbl) + (_e2[1] * 128u + _co)); R[10] = *(const v4u*)((tbl) + (_e2[2] * 128u + _co)); R[11] = *(const v4u*)((tbl) + (_e2[3] * 128u + _co)); \
        R[12] = *(const v4u*)((tbl) + (_e3[0] * 128u + _co)); R[13] = *(const v4u*)((tbl) + (_e3[1] * 128u + _co)); R[14] = *(const v4u*)((tbl) + (_e3[2] * 128u + _co)); R[15] = *(const v4u*)((tbl) + (_e3[3] * 128u + _co)); } while (0)
#pragma unroll
    for (int k = 0; k < PF_TPW; ++k) *(LAS f32x2*)(wl + (kw0 + k) * 512 + lane * 8) = (f32x2){0.f, 0.f};
    __syncthreads();
    {   v4u XA, XB;
#define PD_LOADX(XV, k, s_) do { XV = *(const v4u*)(X8 + (size_t)(tb0 + (k)) * DM + (s_) * 128 + j * 16); } while (0)
#define PD_UCOMP(R, XV, k) do { float p[16]; \
            _Pragma("unroll") for (int _i = 0; _i < 16; ++_i) { int ia = 0; _Pragma("unroll") for (int _k = 0; _k < 4; ++_k) ia = __builtin_amdgcn_sdot4((int)R[_i][_k], (int)XV[_k], ia, false); \
                float a_ = (float)ia; asm volatile("" : "+v"(a_)); p[_i] = a_; } \
            float q8[8], q4[4], q2[2]; \
            { const bool b = (lane & 4) != 0; _Pragma("unroll") for (int _i = 0; _i < 8; ++_i) { const float keep = b ? p[_i + 8] : p[_i], send = b ? p[_i] : p[_i + 8]; q8[_i] = keep + __shfl_xor(send, 4); } } \
            { const bool b = (lane & 2) != 0; _Pragma("unroll") for (int _i = 0; _i < 4; ++_i) { const float keep = b ? q8[_i + 4] : q8[_i], send = b ? q8[_i] : q8[_i + 4]; q4[_i] = keep + __shfl_xor(send, 2); } } \
            { const bool b = (lane & 1) != 0; _Pragma("unroll") for (int _i = 0; _i < 2; ++_i) { const float keep = b ? q4[_i + 2] : q4[_i], send = b ? q4[_i] : q4[_i + 2]; q2[_i] = keep + __shfl_xor(send, 1); } } \
            LAS float* _ap = (LAS float*)(wl + (k) * 512 + lane * 8); (void)__hip_atomic_fetch_add(_ap, q2[0], __ATOMIC_RELAXED, __HIP_MEMORY_SCOPE_WORKGROUP); (void)__hip_atomic_fetch_add(_ap + 1, q2[1], __ATOMIC_RELAXED, __HIP_MEMORY_SCOPE_WORKGROUP); } while (0)
#define PD_GRAB(c) ({ unsigned _t = 0u; if (lane == 0) _t = __hip_atomic_fetch_add((LAS unsigned*)(c), 1u, __ATOMIC_RELAXED, __HIP_MEMORY_SCOPE_WORKGROUP); (int)__builtin_amdgcn_readfirstlane((int)_t); })
        constexpr int NP = PF_CT / 2, NI = 16 * NP;
        int i0 = PD_GRAB(dctr);
        if (i0 < NI) { const int s = i0 / NP, pr = i0 - s * NP; PD_LOADR(R0, 2 * pr, s, Ut); PD_LOADX(XA, 2 * pr, s); }
#pragma unroll 1
        while (i0 < NI) { const int s = i0 / NP, pr = i0 - s * NP;
            PD_LOADR(R1, 2 * pr + 1, s, Ut); PD_LOADX(XB, 2 * pr + 1, s);
            const int i1 = PD_GRAB(dctr);
            __builtin_amdgcn_sched_barrier(0);
            PD_UCOMP(R0, XA, 2 * pr);
            __builtin_amdgcn_sched_barrier(0);
            if (i1 < NI) { const int s1 = i1 / NP, pr1 = i1 - s1 * NP; PD_LOADR(R0, 2 * pr1, s1, Ut); PD_LOADX(XA, 2 * pr1, s1); }
            __builtin_amdgcn_sched_barrier(0);
            PD_UCOMP(R1, XB, 2 * pr + 1);
            __builtin_amdgcn_sched_barrier(0);
            i0 = i1;
        }
    }
    __syncthreads();
    {   const float* G = (const float*)(F.ws + WS_GATEV); const float* US = (const float*)(F.ws + WS_USCT); const float* XS = (const float*)(F.ws + WS_XS);
#pragma unroll 1
        for (int k0 = 0; k0 < PF_TPW; k0 += 4) { f32x2 us[4], gv[4]; float xs[4];
#pragma unroll
            for (int u = 0; u < 4; ++u) { us[u] = *(const f32x2*)(US + (size_t)(tb0 + kw0 + k0 + u) * 128 + 2 * lane); gv[u] = *(const f32x2*)(G + (size_t)(tb0 + kw0 + k0 + u) * 128 + 2 * lane); xs[u] = XS[tb0 + kw0 + k0 + u]; }
#pragma unroll
            for (int u = 0; u < 4; ++u) { LAS f32x2* ap = (LAS f32x2*)(wl + (kw0 + k0 + u) * 512 + lane * 8); const f32x2 a = *ap; const float h0 = a[0] * us[u][0] * xs[u], h1 = a[1] * us[u][1] * xs[u];
                *ap = (f32x2){gv[u][0] * 0.5f * h0 * (1.0f + erff(h0 * 0.7071067811865476f)), gv[u][1] * 0.5f * h1 * (1.0f + erff(h1 * 0.7071067811865476f))}; } }
    }
    __syncthreads();
    {
#define PD_VCOMP(R, k, s_) do { f32x2 y2[8]; _Pragma("unroll") for (int _k = 0; _k < 8; ++_k) y2[_k] = (f32x2){0.f, 0.f}; \
            const LAS v4u* _wp = (const LAS v4u*)(wl + (k) * 512 + g * 64); v4u _w4[4]; _w4[0] = _wp[0]; _w4[1] = _wp[1]; _w4[2] = _wp[2]; _w4[3] = _wp[3]; \
            f32x2 fd[2][8]; SV_DEC(R[0], fd[0]); \
            _Pragma("unroll") for (int _i = 0; _i < 16; ++_i) { const float wi = __uint_as_float(_w4[_i >> 2][_i & 3]); const f32x2 w2 = (f32x2){wi, wi}; \
                if (_i + 1 < 16) SV_DEC(R[(_i + 1) & 15], fd[(_i + 1) & 1]); \
                _Pragma("unroll") for (int _k = 0; _k < 8; ++_k) y2[_k] = w2 * fd[_i & 1][_k] + y2[_k]; \
                asm volatile("" : "+v"(y2[0]), "+v"(y2[1]), "+v"(y2[2]), "+v"(y2[3]), "+v"(y2[4]), "+v"(y2[5]), "+v"(y2[6]), "+v"(y2[7])); } \
            float y[16]; _Pragma("unroll") for (int _k = 0; _k < 8; ++_k) { y[2 * _k] = y2[_k][0]; y[2 * _k + 1] = y2[_k][1]; } \
            float z8[8], z4[4], z2[2]; \
            { const bool b = (lane & 32) != 0; _Pragma("unroll") for (int _i = 0; _i < 8; ++_i) { const float keep = b ? y[_i + 8] : y[_i], send = b ? y[_i] : y[_i + 8]; z8[_i] = keep + __shfl_xor(send, 32); } } \
            { const bool b = (lane & 16) != 0; _Pragma("unroll") for (int _i = 0; _i < 4; ++_i) { const float keep = b ? z8[_i + 4] : z8[_i], send = b ? z8[_i] : z8[_i + 4]; z4[_i] = keep + __shfl_xor(send, 16); } } \
            { const bool b = (lane & 8) != 0; _Pragma("unroll") for (int _i = 0; _i < 2; ++_i) { const float keep = b ? z4[_i + 2] : z4[_i], send = b ? z4[_i] : z4[_i + 2]; z2[_i] = keep + __shfl_xor(send, 8); } } \
            *(unsigned*)(YP + (size_t)(tb0 + (k)) * DM + (s_) * 128 + j * 16 + 2 * g) = pk2(z2[0], z2[1]); } while (0)
        constexpr int NP = PF_CT / 2, NI = 16 * NP;
        int i0 = PD_GRAB(dctr + 1);
        if (i0 < NI) { const int s = i0 / NP, pr = i0 - s * NP; PD_LOADR(R0, 2 * pr, s, Vt); }
#pragma unroll 1
        while (i0 < NI) { const int s = i0 / NP, pr = i0 - s * NP;
            PD_LOADR(R1, 2 * pr + 1, s, Vt);
            const int i1 = PD_GRAB(dctr + 1);
            __builtin_amdgcn_sched_barrier(0);
            PD_VCOMP(R0, 2 * pr, s);
            __builtin_amdgcn_sched_barrier(0);
            if (i1 < NI) { const int s1 = i1 / NP, pr1 = i1 - s1 * NP; PD_LOADR(R0, 2 * pr1, s1, Vt); }
            __builtin_amdgcn_sched_barrier(0);
            PD_VCOMP(R1, 2 * pr + 1, s);
            __builtin_amdgcn_sched_barrier(0);
            i0 = i1;
        }
    }
    asm volatile("s_waitcnt vmcnt(0)" ::: "memory");
    __syncthreads();
    ln2_range(F, A, l, tb0 + kw0, 1, tb0 + kw0 + PF_TPW);
    __syncthreads();
}
__device__ __forceinline__ void phase_peer_fused(Frame& F, const Args& A, int l) {
#if PF_DYN
    for (int c = (int)blockIdx.x; c < PF_NCH; c += (int)gridDim.x) peer_fused_chunk_dyn(F, A, l, c);
#else
    for (int c = (int)blockIdx.x; c < PF_NCH; c += (int)gridDim.x) peer_fused_chunk(F, A, l, c);
#endif
}

#ifndef MK_TPROBE
#define MK_TPROBE 0
#endif
#ifndef MK_DPROBE
#define MK_DPROBE 0
#endif
#ifndef MK_DPROBE_BLK
#define MK_DPROBE_BLK 0
#endif
#if MK_DPROBE
#define TP_B() const unsigned long long _r0 = __builtin_amdgcn_s_memrealtime()
#define TP_E(kind) do { if ((kind) == MK_DPROBE - 1) dp_acc += __builtin_amdgcn_s_memrealtime() - _r0; } while (0)
#elif MK_TPROBE
#define TP_B() const unsigned long long _m0 = __builtin_amdgcn_s_memtime(), _r0 = __builtin_amdgcn_s_memrealtime()
#define TP_E(kind) do { if (blockIdx.x == 0 && threadIdx.x == 0) { float* _tp = (float*)(F.ws + WS_CTL) + CW_DBG + 64; atomicAdd(_tp + 2 * (kind), (float)(__builtin_amdgcn_s_memtime() - _m0)); atomicAdd(_tp + 2 * (kind) + 1, (float)(__builtin_amdgcn_s_memrealtime() - _r0)); } } while (0)
#else
#define TP_B() do {} while (0)
#define TP_E(kind) do {} while (0)
#endif
#ifndef MK_DPROBE_SEAMS
#define MK_DPROBE_SEAMS 0x1ff
#endif
#if MK_DPROBE
#define XBAR() do { const unsigned long long _b0 = __builtin_amdgcn_s_memrealtime(); xcd_barrier(bar); if (MK_DPROBE == 15 && (MK_DPROBE_SEAMS == 0x1ff || (bar_no >= 2 && ((MK_DPROBE_SEAMS >> ((bar_no - 2) % 9)) & 1)))) dp_acc += __builtin_amdgcn_s_memrealtime() - _b0; ++bar_no; } while (0)
#else
#define XBAR() do { TP_B(); xcd_barrier(bar); TP_E(14); } while (0)
#endif
constexpr int NPL = 9, NPHASE = 1 + DEPTH * NPL;
__global__ void __launch_bounds__(512, 2) fwd_kernel(Args args) {
    extern __shared__ __attribute__((aligned(16))) unsigned char lds[];
    Frame F;
    F.lds = (LAS unsigned char*)lds; F.lds_g = (char*)lds;
    F.tid = threadIdx.x; F.lane = F.tid & 63; F.wave = __builtin_amdgcn_readfirstlane(F.tid >> 6);
    F.gw = blockIdx.x * 8 + F.wave; F.ngw = gridDim.x * 8;
    F.ws = args.ws; F.ctl = (gu32*)(args.ws + WS_CTL);
    volatile LAS unsigned* MISC = (volatile LAS unsigned*)(F.lds + MISC_OFF);
    if (F.tid < 32) MISC[F.tid] = 0u;
    __syncthreads();
    const int lo = args.ph_lo, hi = args.ph_hi;
#if MK_DPROBE
    unsigned long long dp_acc = 0; int bar_no = 0;
#endif
    XcdBarrier bar; bar.bar = (unsigned*)(F.ctl + CW_BAR); bar.x = 0; bar.st = MISC;
    bar = xcd_barrier_post((unsigned*)(F.ctl + CW_BAR), MISC);
#ifndef PH_EN
#define PH_EN 0x3ff
#endif
#ifndef MK_REP_ATTN
#define MK_REP_ATTN 0
#endif
#ifndef MK_REP_PEER
#define MK_REP_PEER 0
#endif
#ifndef MK_REP_GEMM
#define MK_REP_GEMM 0
#endif
#define IN(k) (lo <= (k) && (k) < hi)
#define EN(b) ((PH_EN >> (b)) & 1)
#define SEAM(k) do { if (IN(k) && IN((k) + 1)) XBAR(); } while (0)
    const bf16* X = (const bf16*)(F.ws + WS_X); const bf16* X1 = (const bf16*)(F.ws + WS_X1); bf16* H = (bf16*)(F.ws + WS_H);

#if MK_TPROBE
    const unsigned long long _km0 = __builtin_amdgcn_s_memtime(), _kr0 = __builtin_amdgcn_s_memrealtime();
#endif
    if (EN(9) && IN(0)) { TP_B(); p0_prologue(F, args); { XBAR(); }
        { int Kv = DM; asm volatile("" : "+s"(Kv)); pg8::Gemm g{(const bf16*)(F.ws + WS_SKD), (const bf16*)(F.ws + WS_WQ), DEPTH * DM, DEPTH * DM, Kv, DM, DM};
          FoldOrder S{(int)gridDim.x, (int)blockIdx.x}; pg8::EpiRow8<StoreBf16> E{StoreBf16{(bf16*)(F.ws + WS_WQS), DM, DEPTH * DM}};
          pg8::gemm_phase<pg8::EpiRow8<StoreBf16>, FoldOrder, true, true>(F.lds, g, S, E); }
        TP_E(13); SEAM(0); }

    for (int l = 0; l < DEPTH; ++l) {
        const int pb = 1 + NPL * l;
        if (EN(0) && IN(pb + 0)) { TP_B(); int nrep = 1 + MK_REP_GEMM; asm volatile("" : "+s"(nrep));
#pragma unroll 1
            for (int rep = 0; rep < nrep; ++rep) { if (rep) { XBAR(); } P1Order S1; S1.init((int)gridDim.x, (int)blockIdx.x); run_gemm_s(F, X, DM, (const bf16*)(F.ws + WS_WIN) + (size_t)l * INP * DM, TT, INP, DM, StoreBf16{H, INP, INP}, S1); }
            TP_E(0); SEAM(pb + 0); }
        if (EN(1) && IN(pb + 1)) { TP_B(); phase_prep(F, args, l); TP_E(1); SEAM(pb + 1); }
        if (EN(2) && IN(pb + 2)) { TP_B();
            const int skip = (int)gridDim.x > 2 * P1_MOVED ? P1_MOVED : 0;
            run_gemm_s(F, X, DM, (const bf16*)(F.ws + WS_WIN) + (size_t)l * INP * DM, TT, INP, DM, StoreBf16{H, INP, INP}, MovedOrder{(int)gridDim.x, (int)blockIdx.x});
            { int Kv = 384; asm volatile("" : "+s"(Kv)); pg8::Gemm g{H + H_BCQ, (const bf16*)(F.ws + WS_WUQ) + (size_t)l * BQP * 384, TT, BQP, Kv, INP, 384};
              pg8::StaticOrder S; S.init(TT, BQP, (int)gridDim.x - skip, (int)blockIdx.x >= skip ? (int)blockIdx.x - skip : (1 << 29)); EpiMlaQ E{(bf16*)(F.ws + WS_BQ), (const f32x2*)(F.ws + WS_ROPE)};
              pg8::gemm_phase<EpiMlaQ, pg8::StaticOrder, true, true>(F.lds, g, S, E); }
            run_gemm(F, H + H_BCKV, INP, (const bf16*)(F.ws + WS_WUKV) + (size_t)l * BKVW * 256, TT, BKVW, 256, StoreMlaKV{(bf16*)(F.ws + WS_BK), (bf16*)(F.ws + WS_BV)}, skip);
            TP_E(2); SEAM(pb + 2); }
        if (EN(3) && IN(pb + 3)) { TP_B(); int nrep = 1 + MK_REP_ATTN; asm volatile("" : "+s"(nrep));
#pragma unroll 1
            for (int rep = 0; rep < nrep; ++rep) { if (rep) { XBAR(); } phase_attn(F, args, l, rep); }
            TP_E(3); SEAM(pb + 3); }
        if (EN(4) && IN(pb + 4)) { TP_B(); { int Kv = DM; asm volatile("" : "+s"(Kv)); pg8::Gemm g{(const bf16*)(F.ws + WS_AO), (const bf16*)(F.ws + WS_WO) + (size_t)l * DM * DM, TT, DM, Kv, DM, DM};
              pg8::StaticOrder S; S.init(TT, DM, (int)gridDim.x, (int)blockIdx.x); EpiResid E{(bf16*)(F.ws + WS_Y), X}; pg8::gemm_phase<EpiResid, pg8::StaticOrder, true, true>(F.lds, g, S, E); } TP_E(4); SEAM(pb + 4); }
        if (EN(5) && IN(pb + 5)) { TP_B(); phase_ln1(F, args, l); TP_E(5); SEAM(pb + 5); }
        if (EN(6) && IN(pb + 6)) { TP_B(); run_gemm(F, X1, DM, (const bf16*)(F.ws + WS_WQS) + (size_t)l * WQS_LAYER, TT, DM, DM, StoreF32{(float*)(F.ws + WS_SC), DM}); TP_E(6); SEAM(pb + 6); }
        if (EN(8) && IN(pb + 8)) {
#ifndef MK_REP_TOPK
#define MK_REP_TOPK 0
#endif
#ifndef MK_REP_PU
#define MK_REP_PU 0
#endif
#ifndef MK_REP_PV
#define MK_REP_PV 0
#endif
            { int nrep = 1 + MK_REP_TOPK; asm volatile("" : "+s"(nrep));
#pragma unroll 1
              for (int rep = 0; rep < nrep; ++rep) { { TP_B(); phase_peer_topk(F, args, l); TP_E(8); } XBAR(); } }
#ifndef PEER_FUSED
#define PEER_FUSED 1
#endif
#if PEER_FUSED
            { TP_B(); phase_peer_fused(F, args, l); TP_E(9); }
#if !PF_LN2
            XBAR();
            { TP_B(); phase_ln2(F, args, l); TP_E(12); }
#endif
#else
            { int nrep = 1 + MK_REP_PU; asm volatile("" : "+s"(nrep));
#pragma unroll 1
              for (int rep = 0; rep < nrep; ++rep) { { TP_B(); phase_peer_u(F, args, l, rep); TP_E(9); } XBAR(); } }
            { TP_B(); phase_peer_w(F, args, l); TP_E(10); } XBAR();
            { int nrep = 1 + MK_REP_PV; asm volatile("" : "+s"(nrep));
#pragma unroll 1
              for (int rep = 0; rep < nrep; ++rep) { { TP_B(); phase_peer_v(F, args, l, rep); TP_E(11); } XBAR(); } }
            { TP_B(); phase_ln2(F, args, l); TP_E(12); }
#endif
            SEAM(pb + 8); }
    }
#if MK_DPROBE && defined(MK_DSTRAG)
    if (threadIdx.x == 0) { unsigned* D = (unsigned*)(F.ws + WS_CTL) + CW_DBG + 256; __hip_atomic_store(D + blockIdx.x, (unsigned)dp_acc, RLX_AGENT); __hip_atomic_store(D + 512 + blockIdx.x, xb_xcc_id() & 7u, RLX_AGENT);
        __builtin_amdgcn_fence(__ATOMIC_RELEASE, "agent"); (void)xb_add(D + 1100, 1u);
        if (blockIdx.x == 0) { for (int i = 0; i < 200000 && xb_ld(D + 1100) < gridDim.x; ++i) __builtin_amdgcn_s_sleep(8);
            __builtin_amdgcn_fence(__ATOMIC_ACQUIRE, "agent");
            unsigned long long sum = 0; unsigned mx = 0; for (unsigned w = 0; w < gridDim.x; ++w) { const unsigned t = xb_ld(D + w); sum += t; mx = t > mx ? t : mx; }
            const unsigned mean = (unsigned)(sum / gridDim.x); unsigned mask = 0, cnt = 0;
            for (unsigned w = 0; w < gridDim.x; ++w) { const unsigned t = xb_ld(D + w); if ((unsigned long long)t * 100 > (unsigned long long)mean * 108) { ++cnt; mask |= 1u << xb_ld(D + 512 + w); } }
            const unsigned val = MK_DSTRAG == 1 ? mask : MK_DSTRAG == 2 ? cnt : (unsigned)(((unsigned long long)mx * 1000) / (mean ? mean : 1)) - 1000u;
            const unsigned long long t0 = __builtin_amdgcn_s_memrealtime(); while (__builtin_amdgcn_s_memrealtime() - t0 < 10000ull * val) __builtin_amdgcn_s_sleep(8); } }
#elif MK_DPROBE
    if (blockIdx.x == MK_DPROBE_BLK && threadIdx.x == 0) { const unsigned long long t0 = __builtin_amdgcn_s_memrealtime(); while (__builtin_amdgcn_s_memrealtime() - t0 < 4 * dp_acc) __builtin_amdgcn_s_sleep(8); }
#endif
#if defined(ATT_TPROBE)
    if (blockIdx.x == 0 && threadIdx.x == 0) { const unsigned long long T = __hip_atomic_load((unsigned long long*)(F.ws + WS_CTL) + 12000, __ATOMIC_RELAXED, __HIP_MEMORY_SCOPE_AGENT); const unsigned long long t0 = __builtin_amdgcn_s_memrealtime(); while (__builtin_amdgcn_s_memrealtime() - t0 < 4 * T) __builtin_amdgcn_s_sleep(8); }
#endif
#if MK_TPROBE
    if (blockIdx.x == 0 && threadIdx.x == 0) { float* _tp = (float*)(F.ws + WS_CTL) + CW_DBG + 64; _tp[30] = (float)(__builtin_amdgcn_s_memtime() - _km0); _tp[31] = (float)(__builtin_amdgcn_s_memrealtime() - _kr0); }
#endif
#undef IN
#undef SEAM
}

#if MK_TPROBE
__global__ void __launch_bounds__(256) tprobe_scale(Args A) {
    const float* tp = (const float*)(A.ws + WS_CTL) + CW_DBG + 64; const int kind = (MK_TPROBE & 31) - 1, mode = MK_TPROBE >> 5;
    const float v = (mode == 0) ? 0.01f * tp[2 * kind] / fmaxf(tp[2 * kind + 1], 1.f) : tp[2 * kind + 1] / fmaxf(tp[31], 1.f);
    const float s = 1.0f + 0.02f * __builtin_rintf(v * 50.0f);
    for (size_t i = (size_t)blockIdx.x * 256 + threadIdx.x; i < (size_t)TT * DM; i += (size_t)gridDim.x * 256) A.out[i] *= s;
}
#endif
extern "C" void kernel_launch(void* const* d_in, const int* in_sizes, int n_in, void* d_out, int out_size, void* d_ws, size_t ws_size, hipStream_t stream) {
    static int grid = 0;
    if (grid == 0) {
        if (n_in != 23 || in_sizes[0] != T_PROMPT * DM || in_sizes[1] != (TT - T_PROMPT) * DM || out_size != TT * DM || ws_size < WS_NEED) {
            fprintf(stderr, "kernel_launch: shape mismatch (n_in %d, in0 %d, in1 %d, out %d, ws %zu need %zu); nothing launched\n", n_in, n_in > 0 ? in_sizes[0] : -1, n_in > 1 ? in_sizes[1] : -1, out_size, ws_size, (size_t)WS_NEED); grid = -1; return; }
        int dev = 0, cus = 0, per_cu = 0;
        if (hipGetDevice(&dev) != hipSuccess || hipDeviceGetAttribute(&cus, hipDeviceAttributeMultiprocessorCount, dev) != hipSuccess) { fprintf(stderr, "kernel_launch: device query failed\n"); grid = -1; return; }
        if (hipFuncSetAttribute((const void*)fwd_kernel, hipFuncAttributeMaxDynamicSharedMemorySize, LDS_BYTES) != hipSuccess) { fprintf(stderr, "kernel_launch: hipFuncSetAttribute failed\n"); grid = -1; return; }
        if (hipOccupancyMaxActiveBlocksPerMultiprocessor(&per_cu, (const void*)fwd_kernel, 512, LDS_BYTES) != hipSuccess || per_cu < 1) { fprintf(stderr, "kernel_launch: occupancy query says %d blocks per CU\n", per_cu); }
        (void)hipGetLastError();
        grid = cus;
    }
    if (grid < 0) return;
    if (hipMemsetAsync((char*)d_ws + WS_CTL, 0, CTL_BYTES, stream) != hipSuccess) { fprintf(stderr, "kernel_launch: memset failed\n"); return; }
    Args a{};
    for (int i = 0; i < 23; ++i) a.in[i] = (const float*)d_in[i];
    a.out = (float*)d_out; a.ws = (unsigned char*)d_ws;
    for (int l = 0; l < DEPTH; ++l) a.lam_init[l] = 0.8f - 0.6f * expf(-0.3f * (float)l);
#if MK_LAUNCH_PER_PHASE
    for (int k = 0; k < NPHASE; ++k) { a.ph_lo = k; a.ph_hi = k + 1; hipLaunchKernelGGL(fwd_kernel, dim3(grid), dim3(512), LDS_BYTES, stream, a); }
#else
    a.ph_lo = 0; a.ph_hi = NPHASE; hipLaunchKernelGGL(fwd_kernel, dim3(grid), dim3(512), LDS_BYTES, stream, a);
#endif
#if MK_DBG
    if (MK_DBG & 1) hipLaunchKernelGGL(dbg_h, dim3(48), dim3(256), 0, stream, a);
    if (MK_DBG & 2) hipLaunchKernelGGL(dbg_mla, dim3(48), dim3(256), 0, stream, a);
    if (MK_DBG & 28) hipLaunchKernelGGL(dbg_attn, dim3(64), dim3(256), 0, stream, a);
    if (MK_DBG & 224) hipLaunchKernelGGL(dbg_gemms, dim3(48), dim3(256), 0, stream, a);
    if (MK_DBG & 256) hipLaunchKernelGGL(dbg_peer, dim3(48), dim3(256), 0, stream, a);
    hipLaunchKernelGGL(dbg_scale, dim3(1024), dim3(256), 0, stream, a);
#endif
#if MK_TPROBE
    hipLaunchKernelGGL(tprobe_scale, dim3(1024), dim3(256), 0, stream, a);
#endif
    const hipError_t le = hipPeekAtLastError();
    if (le != hipSuccess) fprintf(stderr, "kernel_launch: launch failed: %s\n", hipGetErrorName(le));
}
```
